# Optimizing an MI355X kernel written in HIP

```python
import math
import jax, jax.numpy as jnp
from jax import lax
import numpy as np

D_MODEL = 1024
BATCH = 16
SEQ = 2048
DEPTH = 2

A_HEADS = 8
A_NOPE = 64
A_ROPE = 32
A_V = 64
A_Q_LORA = 256
A_KV_LORA = 128
ROPE_THETA = 10000.0
Q_BLOCK = 128
B_HEADS = 8
B_HEAD_DIM = 64
B_GROUPS = ((128, 1), (512, 4), (2048, 16))
C_HEADS = 8
C_KV_HEADS = 2
C_HEAD_DIM = 64
C_RADIUS = 128
N_BUCKETS = 32
MAX_DISTANCE = 1024
D_FF_DENSE = 2816
N_EXPERTS = 8
TOP_K = 2
D_FF_EXPERT = 3584
N_BRANCH = 3
EPS = 1e-6
NEG_INF = -1e30

A_COLS = A_Q_LORA + A_KV_LORA + A_ROPE
B_COLS = 3 * B_HEADS * B_HEAD_DIM
C_COLS = (C_HEADS + 2 * C_KV_HEADS) * C_HEAD_DIM
G_COLS = N_BRANCH * D_MODEL
IN_COLS = A_COLS + B_COLS + C_COLS + G_COLS

kernel_name = 'hybrid_gated_mla_dilated_swa_moe_encoder'


def rmsnorm(x, g):
    xf = x.astype(jnp.float32)
    y = xf * lax.rsqrt(jnp.mean(xf * xf, axis=-1, keepdims=True) + EPS)
    return (y * g.astype(jnp.float32)).astype(x.dtype)


def t5_bucket(rel):
    nb = N_BUCKETS // 2
    max_exact = nb // 2
    ret = jnp.where(rel > 0, nb, 0)
    n = jnp.abs(rel)
    nf = jnp.maximum(n, 1).astype(jnp.float32)
    large = max_exact + (jnp.log(nf / max_exact) / math.log(MAX_DISTANCE / max_exact) * (nb - max_exact)).astype(jnp.int32)
    large = jnp.minimum(large, nb - 1)
    return ret + jnp.where(n < max_exact, n, large)


def rope_tables(S):
    half = A_ROPE // 2
    inv = ROPE_THETA ** (-jnp.arange(half, dtype=jnp.float32) / half)
    ang = jnp.arange(S, dtype=jnp.float32)[:, None] * inv[None, :]
    return jnp.cos(ang), jnp.sin(ang)


def apply_rope(t, cos, sin):
    half = t.shape[-1] // 2
    cos = cos.astype(t.dtype)
    sin = sin.astype(t.dtype)
    t1, t2 = t[..., :half], t[..., half:]
    return jnp.concatenate([t1 * cos - t2 * sin, t1 * sin + t2 * cos], axis=-1)


def to_blocks(t, blk, nb):
    L = t.shape[-2]
    pad = [(0, 0)] * (t.ndim - 2) + [(0, nb * blk - L), (0, 0)]
    return jnp.pad(t, pad).reshape(t.shape[:-2] + (nb, blk, t.shape[-1]))


def to_windows(t, blk, nb):
    L = t.shape[-2]
    pad = [(0, 0)] * (t.ndim - 2) + [(blk, (nb + 1) * blk - L), (0, 0)]
    tb = jnp.pad(t, pad).reshape(t.shape[:-2] + (nb + 2, blk, t.shape[-1]))
    return jnp.concatenate([tb[..., :-2, :, :], tb[..., 1:-1, :, :], tb[..., 2:, :, :]], axis=-2)


def band_geometry(blk, nb, L):
    a = jnp.arange(blk)
    c = jnp.arange(3 * blk)
    i = jnp.arange(nb)
    rel = c[None, :] - blk - a[:, None]
    kpos = (i[:, None, None] - 1) * blk + c[None, None, :]
    valid = (jnp.abs(rel) <= blk)[None] & (kpos >= 0) & (kpos < L)
    return rel, valid


def mla_branch(cq, ckv, kpe, q_norm_g, w_uq, kv_norm_g, w_ukv):
    B, S, _ = cq.shape
    cos, sin = rope_tables(S)
    scale = (A_NOPE + A_ROPE) ** -0.5
    q = (rmsnorm(cq, q_norm_g) @ w_uq).reshape(B, S, A_HEADS, A_NOPE + A_ROPE) * scale
    q_nope = q[..., :A_NOPE]
    q_pe = apply_rope(q[..., A_NOPE:], cos[:, None, :], sin[:, None, :])
    kv = (rmsnorm(ckv, kv_norm_g) @ w_ukv).reshape(B, S, A_HEADS, A_NOPE + A_V)
    k_nope, v = kv[..., :A_NOPE], kv[..., A_NOPE:]
    k_pe = apply_rope(kpe, cos, sin)
    nb = S // Q_BLOCK
    qn_b = q_nope.reshape(B, nb, Q_BLOCK, A_HEADS, A_NOPE).transpose(1, 0, 2, 3, 4)
    qp_b = q_pe.reshape(B, nb, Q_BLOCK, A_HEADS, A_ROPE).transpose(1, 0, 2, 3, 4)

    def attend(args):
        qn, qp = args
        s = jnp.einsum('bqhd,bkhd->bhqk', qn, k_nope) + jnp.einsum('bqhd,bkd->bhqk', qp, k_pe)
        p = jax.nn.softmax(s.astype(jnp.float32), axis=-1).astype(v.dtype)
        return jnp.einsum('bhqk,bkhd->bqhd', p, v)

    o = lax.map(attend, (qn_b, qp_b))
    return o.transpose(1, 0, 2, 3, 4).reshape(B, S, A_HEADS * A_V)


def dilated_branch(q, k, v, bias_tab):
    B, H, S, dh = q.shape
    q = q * (dh ** -0.5)
    ms, ls, os_ = [], [], []
    for window, dil in B_GROUPS:
        r = window // (2 * dil)
        L = S // dil
        nb = -(-L // r)

        def strided(t):
            return t.reshape(B, H, L, dil, dh).transpose(0, 1, 3, 2, 4)

        def unstride(t):
            t = t.reshape((B, H, dil, nb * r) + t.shape[5:])[:, :, :, :L]
            t = jnp.moveaxis(t, 2, 3)
            return t.reshape((B, H, S) + t.shape[4:])

        qb = to_blocks(strided(q), r, nb)
        kw = to_windows(strided(k), r, nb)
        vw = to_windows(strided(v), r, nb)
        rel, valid = band_geometry(r, nb, L)
        bias = bias_tab[t5_bucket(rel * dil)].transpose(2, 0, 1).astype(jnp.float32)
        s = jnp.einsum('bhgnqd,bhgnkd->bhgnqk', qb, kw).astype(jnp.float32) + bias[None, :, None, None]
        s = jnp.where(valid, s, NEG_INF)
        m = jnp.max(s, axis=-1, keepdims=True)
        p = jnp.exp(s - m)
        l = jnp.sum(p, axis=-1)
        o = jnp.einsum('bhgnqk,bhgnkd->bhgnqd', p.astype(v.dtype), vw).astype(jnp.float32)
        ms.append(unstride(m[..., 0]))
        ls.append(unstride(l))
        os_.append(unstride(o))
    m_all = jnp.max(jnp.stack(ms), axis=0)
    wts = [jnp.exp(mg - m_all) for mg in ms]
    num = sum(w[..., None] * og for w, og in zip(wts, os_))
    den = sum(w * lg for w, lg in zip(wts, ls))
    out = (num / den[..., None]).astype(v.dtype)
    return out.transpose(0, 2, 1, 3).reshape(B, S, H * dh)


def window_gqa_branch(q, k, v, sink, bias_tab):
    B, G, R, S, dh = q.shape
    blk = C_RADIUS
    nb = -(-S // blk)
    qb = to_blocks(q * (dh ** -0.5), blk, nb)
    kw = to_windows(k, blk, nb)
    vw = to_windows(v, blk, nb)
    rel, valid = band_geometry(blk, nb, S)
    bias = bias_tab[t5_bucket(rel)].reshape(blk, 3 * blk, G, R).transpose(2, 3, 0, 1).astype(jnp.float32)
    s = jnp.einsum('bgrnqd,bgnkd->bgrnqk', qb, kw).astype(jnp.float32) + bias[None, :, :, None]
    s = jnp.where(valid, s, NEG_INF)
    sk = sink.astype(jnp.float32).reshape(G, R)[None, :, :, None, None, None]
    m = jnp.maximum(jnp.max(s, axis=-1, keepdims=True), sk)
    p = jnp.exp(s - m)
    den = jnp.sum(p, axis=-1) + jnp.exp(sk - m)[..., 0]
    o = jnp.einsum('bgrnqk,bgnkd->bgrnqd', p.astype(v.dtype), vw).astype(jnp.float32) / den[..., None]
    o = o.reshape(B, G, R, nb * blk, dh)[:, :, :, :S].astype(v.dtype)
    return o.transpose(0, 3, 1, 2, 4).reshape(B, S, G * R * dh)


def hybrid_mixer(h, w_in, q_norm_g, w_uq, kv_norm_g, w_ukv, sink, rel_bias, w_br_a, w_br_b, w_br_c, w_out):
    B, S, D = h.shape
    z = h @ w_in
    o = 0
    cq = z[..., o:o + A_Q_LORA]; o += A_Q_LORA
    ckv = z[..., o:o + A_KV_LORA]; o += A_KV_LORA
    kpe = z[..., o:o + A_ROPE]; o += A_ROPE
    zb = z[..., o:o + B_COLS]; o += B_COLS
    zc = z[..., o:o + C_COLS]; o += C_COLS
    zg = z[..., o:o + G_COLS]
    y_a = mla_branch(cq, ckv, kpe, q_norm_g, w_uq, kv_norm_g, w_ukv)
    qkv_b = zb.reshape(B, S, 3, B_HEADS, B_HEAD_DIM).transpose(2, 0, 3, 1, 4)
    y_b = dilated_branch(qkv_b[0], qkv_b[1], qkv_b[2], rel_bias[:, :B_HEADS])
    R = C_HEADS // C_KV_HEADS
    nq = C_HEADS * C_HEAD_DIM
    nkv = C_KV_HEADS * C_HEAD_DIM
    q_c = zc[..., :nq].reshape(B, S, C_KV_HEADS, R, C_HEAD_DIM).transpose(0, 2, 3, 1, 4)
    k_c = zc[..., nq:nq + nkv].reshape(B, S, C_KV_HEADS, C_HEAD_DIM).transpose(0, 2, 1, 3)
    v_c = zc[..., nq + nkv:].reshape(B, S, C_KV_HEADS, C_HEAD_DIM).transpose(0, 2, 1, 3)
    y_c = window_gqa_branch(q_c, k_c, v_c, sink, rel_bias[:, B_HEADS:])
    gates = jax.nn.sigmoid(zg).reshape(B, S, N_BRANCH, D)
    merged = (gates[:, :, 0] * (y_a @ w_br_a) + gates[:, :, 1] * (y_b @ w_br_b)
              + gates[:, :, 2] * (y_c @ w_br_c))
    return merged @ w_out


def swiglu(h, wg, wu, wd):
    return (jax.nn.silu(h @ wg) * (h @ wu)) @ wd


def moe_swiglu(h, w_router, wg, wu, wd):
    logits = (h @ w_router).astype(jnp.float32)
    top_v, top_i = lax.top_k(logits, TOP_K)
    gate = jax.nn.softmax(top_v, axis=-1)
    combine = jnp.sum(jax.nn.one_hot(top_i, N_EXPERTS, dtype=jnp.float32) * gate[..., None], axis=-2)
    out = jnp.zeros_like(h)
    for e in range(N_EXPERTS):
        out = out + combine[..., e:e + 1].astype(h.dtype) * swiglu(h, wg[e], wu[e], wd[e])
    return out


def setup_inputs(seed: int = 0) -> dict:
    key = jax.random.key(seed)
    ks = iter(jax.random.split(key, 32))
    n_dense = (DEPTH + 1) // 2
    n_moe = DEPTH // 2
    L = DEPTH

    def nrm(shape, scale):
        return jax.random.normal(next(ks), shape, jnp.float32) * scale

    def gain(shape):
        return 1.0 + nrm(shape, 0.05)

    return {
        'x': nrm((BATCH, SEQ, D_MODEL), 1.0),
        'norm1_g': gain((L, D_MODEL)),
        'w_in': nrm((L, D_MODEL, IN_COLS), D_MODEL ** -0.5),
        'q_norm_g': gain((L, A_Q_LORA)),
        'w_uq': nrm((L, A_Q_LORA, A_HEADS * (A_NOPE + A_ROPE)), A_Q_LORA ** -0.5),
        'kv_norm_g': gain((L, A_KV_LORA)),
        'w_ukv': nrm((L, A_KV_LORA, A_HEADS * (A_NOPE + A_V)), A_KV_LORA ** -0.5),
        'sink_logit': nrm((L, C_HEADS), 0.5),
        'rel_bias': nrm((N_BUCKETS, B_HEADS + C_HEADS), 0.5),
        'w_branch_a': nrm((L, A_HEADS * A_V, D_MODEL), (A_HEADS * A_V) ** -0.5),
        'w_branch_b': nrm((L, B_HEADS * B_HEAD_DIM, D_MODEL), (B_HEADS * B_HEAD_DIM) ** -0.5),
        'w_branch_c': nrm((L, C_HEADS * C_HEAD_DIM, D_MODEL), (C_HEADS * C_HEAD_DIM) ** -0.5),
        'w_out': nrm((L, D_MODEL, D_MODEL), D_MODEL ** -0.5),
        'norm2_g': gain((L, D_MODEL)),
        'ffn_w_gate': nrm((n_dense, D_MODEL, D_FF_DENSE), D_MODEL ** -0.5),
        'ffn_w_up': nrm((n_dense, D_MODEL, D_FF_DENSE), D_MODEL ** -0.5),
        'ffn_w_down': nrm((n_dense, D_FF_DENSE, D_MODEL), D_FF_DENSE ** -0.5),
        'router_w': nrm((n_moe, D_MODEL, N_EXPERTS), D_MODEL ** -0.5),
        'exp_w_gate': nrm((n_moe, N_EXPERTS, D_MODEL, D_FF_EXPERT), D_MODEL ** -0.5),
        'exp_w_up': nrm((n_moe, N_EXPERTS, D_MODEL, D_FF_EXPERT), D_MODEL ** -0.5),
        'exp_w_down': nrm((n_moe, N_EXPERTS, D_FF_EXPERT, D_MODEL), D_FF_EXPERT ** -0.5),
        'final_g': gain((D_MODEL,)),
    }


def reference(x, norm1_g, w_in, q_norm_g, w_uq, kv_norm_g, w_ukv, sink_logit, rel_bias,
              w_branch_a, w_branch_b, w_branch_c, w_out, norm2_g, ffn_w_gate, ffn_w_up,
              ffn_w_down, router_w, exp_w_gate, exp_w_up, exp_w_down, final_g):
    for l in range(DEPTH):
        h = rmsnorm(x, norm1_g[l])
        x = x + hybrid_mixer(h, w_in[l], q_norm_g[l], w_uq[l], kv_norm_g[l], w_ukv[l], sink_logit[l],
                             rel_bias, w_branch_a[l], w_branch_b[l], w_branch_c[l], w_out[l])
        h = rmsnorm(x, norm2_g[l])
        i = l // 2
        if l % 2 == 0:
            x = x + swiglu(h, ffn_w_gate[i], ffn_w_up[i], ffn_w_down[i])
        else:
            x = x + moe_swiglu(h, router_w[i], exp_w_gate[i], exp_w_up[i], exp_w_down[i])
    return rmsnorm(x, final_g)
```

```cpp
#include <hip/hip_runtime.h>
#include <cstdio>
#include <cstdint>
#include <cmath>

#ifndef MK_DEBUG
#define MK_DEBUG 0
#endif
#ifndef CHB
#define CHB 8
#endif

#define GAS __attribute__((address_space(1)))
#define LAS __attribute__((address_space(3)))
typedef unsigned short bf16_t;
typedef short bf16x8 __attribute__((ext_vector_type(8)));
typedef short s16x4 __attribute__((ext_vector_type(4)));
typedef float f32x4 __attribute__((ext_vector_type(4)));
typedef float f32x2 __attribute__((ext_vector_type(2)));
typedef float f32x16 __attribute__((ext_vector_type(16)));
typedef unsigned u32x4 __attribute__((ext_vector_type(4)));
typedef unsigned u32x2 __attribute__((ext_vector_type(2)));
typedef __bf16 bf16x2_t __attribute__((ext_vector_type(2)));

constexpr int SEQ = 2048, DM = 1024, NBATCH = 16, MTOK = NBATCH * SEQ;
constexpr int MC = CHB * SEQ, NCHUNK = NBATCH / CHB;
constexpr int INC = 5792, ZW = 512, ZN = 5888;
constexpr int ZO_CQ = 0, ZO_CKV = 256, ZO_KPE = 384, ZO_QB = 512, ZO_KB = 1024, ZO_VB = 1536, ZO_QC = 2048, ZO_KC = 2560, ZO_VC = 2688, ZO_G = 2816;
constexpr int DFF = 2816, DFE = 3584, NEXP = 8;
constexpr int DF0 = 1792, DF1 = DFE - DF0;
constexpr float EPS = 1e-6f, LOG2E = 1.4426950408889634f;
constexpr float NEGB = -1e30f;
constexpr int MOE_ROWS = MTOK + NEXP * 256;

constexpr size_t MiB = 1u << 20;
constexpr size_t WS_CTL = 0, CTL_ZERO_BYTES = 256 * 1024;
constexpr size_t WS_META = 256 * 1024;
constexpr size_t WS_TAB = 1 * MiB;
constexpr size_t WS_WIN = 2 * MiB;
constexpr size_t SZ_WIN = (size_t)ZN * DM * 2;
constexpr size_t WS_WUQ = WS_WIN + 2 * SZ_WIN;
constexpr size_t SZ_WUQ = (size_t)768 * 256 * 2;
constexpr size_t WS_WUKV = WS_WUQ + 2 * SZ_WUQ;
constexpr size_t SZ_WUKV = (size_t)1024 * 256 * 2;
constexpr size_t WS_WBR = WS_WUKV + 2 * SZ_WUKV;
constexpr size_t SZ_WBR = (size_t)1024 * 1536 * 2;
constexpr size_t WS_WOUT = WS_WBR + 2 * SZ_WBR;
constexpr size_t SZ_WOUT = (size_t)1024 * 1024 * 2;
constexpr size_t WS_WGU = WS_WOUT + 2 * SZ_WOUT;
constexpr size_t WS_WD = WS_WGU + (size_t)2 * DFF * DM * 2;
constexpr size_t WS_SMALL_END = WS_WD + (size_t)DM * DFF * 2;
static_assert(WS_SMALL_END <= 54 * MiB, "small weights");
constexpr size_t WS_XB = 54 * MiB;
constexpr size_t WS_ST = 118 * MiB;
constexpr size_t WS_RR = 120 * MiB;
constexpr size_t WS_SEL = WS_RR + (size_t)MTOK * 4;
constexpr size_t WS_GW = WS_SEL + (size_t)MTOK * 8;
constexpr size_t WS_ROWTOK = WS_GW + (size_t)MTOK * 8;
constexpr size_t WS_ROWGW = WS_ROWTOK + (size_t)2 * MOE_ROWS * 4;
constexpr size_t WS_ROWRR = WS_ROWGW + (size_t)2 * MOE_ROWS * 4;
constexpr size_t WS_T = 122 * MiB;
static_assert(WS_ROWRR + (size_t)2 * MOE_ROWS * 4 <= WS_T, "fixed region");
constexpr size_t WS_GB = WS_T;
constexpr size_t WS_Y = WS_GB + (size_t)MTOK * 3072;
constexpr size_t WS_CH = WS_Y + (size_t)MTOK * 1536 * 2;
constexpr size_t WS_Z = WS_CH;
constexpr size_t WS_QKV = WS_Z + (size_t)MC * ZW * 2;
constexpr size_t SZ_H8 = (size_t)MC * 512 * 2, SZ_H2 = (size_t)MC * 128 * 2;
constexpr size_t WS_Q = WS_QKV + 4 * SZ_H8 + 2 * SZ_H2;
constexpr bool TMP_IN_OUT = (CHB == 16);
constexpr size_t WS_KV = WS_Q + (size_t)MC * 768 * 2;
constexpr size_t WS_PB = WS_KV + (TMP_IN_OUT ? 0 : (size_t)MC * 1024 * 2);
constexpr size_t WS_PBS = WS_PB + (TMP_IN_OUT ? 0 : (size_t)2 * MC * 512 * 2);
constexpr size_t WS_SQ = WS_PBS + (size_t)2 * MC * 16 * 4;
constexpr size_t WS_MIX_END = WS_SQ + (size_t)2 * MC * 4 * 4;
constexpr size_t WS_MG = WS_CH;
static_assert(WS_MG + (size_t)MTOK * 1024 * 2 <= (size_t)564 * MiB, "MG placement");
constexpr size_t WS_ACT = WS_T;
constexpr size_t WS_EGU = WS_T;
constexpr size_t WS_ED = WS_EGU + (size_t)NEXP * 2 * DFE * DM * 2;
constexpr size_t WS_MACT = WS_ED + (size_t)NEXP * DM * DFE * 2;
constexpr size_t WS_MOE_END = WS_MACT + (size_t)MOE_ROWS * DFE * 2;
constexpr size_t WS_NEED_ = (WS_MOE_END > WS_MIX_END ? WS_MOE_END : WS_MIX_END);
constexpr size_t WS_NEED = WS_MOE_END + (size_t)(MTOK - 26624) * DM * 2 > WS_NEED_ ? WS_MOE_END + (size_t)(MTOK - 26624) * DM * 2 : WS_NEED_;
static_assert(WS_NEED <= (size_t)564 * MiB, "workspace budget");

constexpr int XM_SPLIT = 26624;
constexpr size_t WS_XM_HI = WS_MOE_END;
static_assert((size_t)XM_SPLIT * DM * 2 <= WS_XB - WS_WIN && WS_XM_HI + (size_t)(MTOK - XM_SPLIT) * DM * 2 <= (size_t)564 * MiB, "XM placement");
__device__ __forceinline__ bf16_t* xm_row(unsigned char* ws, int tok) { return tok < XM_SPLIT ? (bf16_t*)(ws + WS_WIN) + (size_t)tok * DM : (bf16_t*)(ws + WS_XM_HI) + (size_t)(tok - XM_SPLIT) * DM; }

constexpr int CW_BAR = 4096, CW_Q = 8192;
constexpr int MI_CNT = 0, MI_NTILE = 4120, MI_TILEE = 4128;

__device__ __forceinline__ unsigned cvt_pk_bf16(float lo, float hi) { f32x2 v = {lo, hi}; bf16x2_t b = __builtin_convertvector(v, bf16x2_t); return __builtin_bit_cast(unsigned, b); }
__device__ __forceinline__ float bf_lo(unsigned w) { return __builtin_bit_cast(float, w << 16); }
__device__ __forceinline__ float bf_hi(unsigned w) { return __builtin_bit_cast(float, w & 0xffff0000u); }
template <int O> __device__ __forceinline__ float swz_xor(float v) { return __builtin_bit_cast(float, __builtin_amdgcn_ds_swizzle(__builtin_bit_cast(int, v), (O << 10) | 0x1f)); }
__device__ __forceinline__ void swap32(float& a, float& b) { asm volatile("s_nop 1\n\tv_permlane32_swap_b32 %0, %1\n\ts_nop 1" : "+v"(a), "+v"(b)); }
__device__ __forceinline__ float xsum32(float v) { float a = v, b = v; swap32(a, b); return a + b; }
__device__ __forceinline__ float xmax32(float v) { float a = v, b = v; swap32(a, b); return fmaxf(a, b); }
__device__ __forceinline__ float wave_sum(float v) {
    v += swz_xor<1>(v); v += swz_xor<2>(v); v += swz_xor<4>(v); v += swz_xor<8>(v); v += swz_xor<16>(v);
    return xsum32(v);
}
__device__ __forceinline__ float fast_rcp(float x) { return __builtin_amdgcn_rcpf(x); }
__device__ __forceinline__ float fast_exp2(float x) { return __builtin_amdgcn_exp2f(x); }
__device__ __forceinline__ float sigmoidf_(float v) { return fast_rcp(1.f + fast_exp2(-v * LOG2E)); }
__device__ __forceinline__ int t5_bucket(int rel) {
    const int ret = rel > 0 ? 16 : 0; const int n = rel < 0 ? -rel : rel;
    if (n < 8) return ret + n;
    int large = 8 + (int)(logf((float)n / 8.f) / logf(128.f) * 8.f);
    if (large > 15) large = 15;
    return ret + large;
}

#define XB_TMO      128
#define XB_XCNT(j)  (256  + 64 * (j))
#define XB_XSUB(j)  (1280 + 64 * (j))
#define XB_XGEN(j)  (2304 + 64 * (j))
#define XB_TOP      3328
#define XB_TOPGEN   3392
#define XCD_BAR_WORDS 3456
#define XB_SPIN_CAP (1u << 18)
__device__ __forceinline__ unsigned xb_ld(unsigned* p)              { return __hip_atomic_load(p, __ATOMIC_RELAXED, __HIP_MEMORY_SCOPE_AGENT); }
__device__ __forceinline__ unsigned xb_add(unsigned* p, unsigned v) { return __hip_atomic_fetch_add(p, v, __ATOMIC_RELAXED, __HIP_MEMORY_SCOPE_AGENT); }
__device__ __forceinline__ unsigned xb_xcc_id() { return (unsigned)__builtin_amdgcn_s_getreg((3 << 11) | 20) & 0xFu; }
#define XB_SPIN(cond, bar) do { unsigned _sp = 0; while (cond) { __builtin_amdgcn_s_sleep(1); \
    if ((++_sp & 255u) == 0u) { if (xb_ld(&(bar)[XB_TMO])) break; if (_sp > XB_SPIN_CAP) { atomicAdd(&(bar)[XB_TMO], 1u); break; } } } } while (0)
struct XcdBarrier { unsigned* bar; unsigned x; volatile LAS unsigned* st; };
__device__ __forceinline__ XcdBarrier xcd_barrier_post(unsigned* bar, volatile LAS unsigned* st) {
    XcdBarrier b; b.bar = bar; b.x = xb_xcc_id(); b.st = st;
    if (threadIdx.x == 0) (void)xb_add(&bar[XB_XCNT(b.x)], 1u);
    return b;
}
__device__ __forceinline__ void xcd_barrier_complete(unsigned* bar, unsigned x, unsigned& nloc, unsigned& nx) {
    const unsigned G = gridDim.x * gridDim.y * gridDim.z;
    unsigned sum, cnt, mine, sp = 0u;
    for (;;) {
        sum = 0u; cnt = 0u; mine = 0u;
#pragma unroll
        for (unsigned j = 0; j < 16; ++j) { const unsigned c = xb_ld(&bar[XB_XCNT(j)]); sum += c; cnt += (c > 0u) ? 1u : 0u; mine = (j == x) ? c : mine; }
        if (sum == G) break;
        __builtin_amdgcn_s_sleep(1);
        if ((++sp & 255u) == 0u) { if (xb_ld(&bar[XB_TMO])) break; if (sp > XB_SPIN_CAP) { atomicAdd(&bar[XB_TMO], 1u); break; } }
    }
    nloc = mine > 0u ? mine : 1u; nx = cnt > 0u ? cnt : 1u;
}
__device__ __forceinline__ void xcd_barrier(const XcdBarrier& b) {
    asm volatile("s_waitcnt vmcnt(0)" ::: "memory");
    __syncthreads();
    if (threadIdx.x == 0) {
        unsigned* bar = b.bar;
        __builtin_amdgcn_s_waitcnt(0);
        unsigned nloc = b.st[0], nx = b.st[1];
        if (nloc == 0u) { xcd_barrier_complete(bar, b.x, nloc, nx); b.st[0] = nloc; b.st[1] = nx; }
        const unsigned old = xb_add(&bar[XB_XSUB(b.x)], 1u);
        const unsigned gen = old / nloc;
        if (old + 1u == (gen + 1u) * nloc) {
            __builtin_amdgcn_fence(__ATOMIC_RELEASE, "agent");
            asm volatile("s_waitcnt vmcnt(0)" ::: "memory");
            const unsigned og = xb_add(&bar[XB_TOP], 1u);
            const unsigned tg = og / nx;
            if (og + 1u == (tg + 1u) * nx) xb_add(&bar[XB_TOPGEN], 1u);
            else XB_SPIN(xb_ld(&bar[XB_TOPGEN]) == tg, bar);
            __builtin_amdgcn_fence(__ATOMIC_ACQUIRE, "agent");
            xb_add(&bar[XB_XGEN(b.x)], 1u);
            asm volatile("s_waitcnt vmcnt(0)" ::: "memory");
        } else {
            XB_SPIN(xb_ld(&bar[XB_XGEN(b.x)]) == gen, bar);
            __builtin_amdgcn_fence(__ATOMIC_ACQUIRE, "agent");
            asm volatile("s_waitcnt vmcnt(0)" ::: "memory");
        }
    }
    __syncthreads();
}
#ifndef MOE_RGS
#define MOE_RGS 4
#endif
#ifndef MOE_RG
#define MOE_RG 4
#endif
#ifndef RELAXW
#define RELAXW 0
#endif
namespace pg8 {
constexpr int BM = 256, BK = 64, HALF = 128, HTB = HALF * BK * 2, STAGE_BYTES = 8 * HTB, NXCD = 8, WGM = 8;
__host__ __device__ __forceinline__ int lds_byte(int r, int c) { const int st = (r >> 4) * 2 + (c >> 5), rr = r & 15, cc = c & 31, ob = rr * 64 + cc * 2; return st * 1024 + (ob ^ (((ob >> 9) & 1) << 5)); }
__host__ __device__ __forceinline__ void stage_rc(int b, int& R, int& C) { const int st = b / 1024, sb = b % 1024, swz = sb ^ (((sb >> 9) & 1) << 5); R = (st >> 1) * 16 + swz / 64; C = (st & 1) * 32 + (swz % 64) / 2; }
__host__ __device__ __forceinline__ int perm32(int rho) { const int n = rho >> 4, i = rho & 15; return 8 * (i >> 2) + 4 * n + (i & 3); }

struct Unit { int pm, pn, aux; };
struct Gemm { const bf16_t* A; const bf16_t* Bt; int K, lda, ldb; const int* gidx; };

struct StaticOrder {
    static constexpr bool DYN = false;
    int nM, nN, nwg, G, c;
    __host__ __device__ void init(int M, int N, int G_, int c_) { nM = M / BM; nN = N / BM; nwg = nM * nN; G = G_; c = c_; }
    __host__ __device__ bool next(int i, Unit& u) const {
        const int L = i * G + c; if (L >= nwg) return false;
        int wgid = L; { const int q = nwg / NXCD, r = nwg % NXCD, xcd = wgid % NXCD, off = wgid / NXCD; wgid = (xcd < r ? xcd * (q + 1) : r * (q + 1) + (xcd - r) * q) + off; }
        const int nig = WGM * nN, gid = wgid / nig, fm = gid * WGM, gsz = (nM - fm) < WGM ? (nM - fm) : WGM;
        u.pm = fm + ((wgid % nig) % gsz); u.pn = (wgid % nig) / gsz; u.aux = u.pn; return true;
    }
};
struct MoeOrder {
    static constexpr bool DYN = false;
    int ntile, nN, G, c, pne, pn0; const int* tile_e;
    __device__ bool next(int i, Unit& u) const {
        const int L = i * G + c; if (L >= ntile * nN) return false;
        int pm, pnl; { const int grp = L / (MOE_RGS * nN), fm = grp * MOE_RGS, gsz = (ntile - fm) < MOE_RGS ? (ntile - fm) : MOE_RGS, r = L - grp * (MOE_RGS * nN); pm = fm + r % gsz; pnl = r / gsz; }
        u.pm = pm; u.aux = pnl; u.pn = tile_e[pm] * pne + pn0 + pnl; return true;
    }
};

struct DynMoeOrder {
    static constexpr bool DYN = true;
    unsigned* ctr; volatile LAS int* slot; int ntile, nN, pne, pn0; const int* tile_e; int vcu;
    __device__ __forceinline__ void begin() const {
        if (threadIdx.x == 0) { slot[0] = vcu; slot[1] = vcu + (int)gridDim.x; }
        __syncthreads();
    }
    __device__ __forceinline__ bool next(int i, Unit& u) const {
        const int L = __builtin_amdgcn_readfirstlane(slot[i & 1]); if (L >= ntile * nN) return false;
        int pm, pnl; { const int grp = L / (MOE_RG * nN), fm = grp * MOE_RG, gsz = (ntile - fm) < MOE_RG ? (ntile - fm) : MOE_RG, r = L - grp * (MOE_RG * nN); pm = fm + r % gsz; pnl = r / gsz; }
        u.pm = pm; u.aux = pnl; u.pn = tile_e[pm] * pne + pn0 + pnl; return true;
    }
    __device__ __forceinline__ unsigned claim_issue() const { unsigned v = 0u; if (threadIdx.x == 0) v = 2u * gridDim.x + __hip_atomic_fetch_add(ctr, 1u, __ATOMIC_RELAXED, __HIP_MEMORY_SCOPE_AGENT); return v; }
    __device__ __forceinline__ void claim_commit(unsigned v, int i) const { if (threadIdx.x == 0) { slot[i & 1] = (int)v; asm volatile("s_waitcnt lgkmcnt(0)" ::: "memory"); } }
};

__host__ __device__ __forceinline__ size_t blk_off(int row, int col, int ld) { return ((size_t)(row >> 4) * (ld >> 5) + (col >> 5)) * 512 + (row & 15) * 32 + (col & 31); }
template <class Epi, class Sched, bool ALIGN_EPI, bool GATHER, bool ABLK = false>
__device__ __forceinline__ void gemm_phase(LAS unsigned char* lds, const Gemm g, const Sched& S, const Epi& E) {
    int tid_ = threadIdx.x; asm volatile("" : "+v"(tid_));
    const int tid = tid_, wid = __builtin_amdgcn_readfirstlane(tid >> 6), lane = tid & 63, wr = wid >> 2, wc = wid & 3, fr = lane & 15, fq = lane >> 4;
    int K_ = g.K; asm volatile("" : "+s"(K_));
    const int K = K_, nt = K / BK;
    static_assert(!(GATHER && ABLK), "gathered A is row-major");
    const size_t kstep = (size_t)(BK * 2), kstepA = ABLK ? (size_t)2048 : kstep;
    const size_t hstepA = ABLK ? (size_t)8 * (g.lda >> 5) * 1024 : (size_t)HALF * g.lda * 2, hstepB = (size_t)HALF * g.ldb * 2, tstepA = 2 * hstepA, tstepB = 2 * hstepB;
    int Rs[2], Cs[2]; unsigned voffB[2];
#pragma unroll
    for (int i = 0; i < 2; ++i) { int R, C; stage_rc(tid * 16 + i * 8192, R, C); Rs[i] = R; Cs[i] = C; const int Rb = Epi::PERM ? ((R & ~31) + perm32(R & 31)) : R;
        voffB[i] = (unsigned)(Rb * g.ldb + C) * 2u; }
    asm volatile("" : "+v"(voffB[0]), "+v"(voffB[1]), "+v"(Rs[0]), "+v"(Rs[1]), "+v"(Cs[0]), "+v"(Cs[1]));
    unsigned vA[2][2], nvA[2][2];
    const size_t hsA = GATHER ? (size_t)0 : hstepA;
#define PG8_SETV(V, U) do { _Pragma("unroll") for (int _h = 0; _h < 2; ++_h) _Pragma("unroll") for (int _i = 0; _i < 2; ++_i) { \
        if constexpr (GATHER) { int _t = g.gidx[(U).pm * BM + _h * HALF + Rs[_i]]; _t = _t < 0 ? 0 : _t; V[_h][_i] = (unsigned)(_t * g.lda + Cs[_i]) * 2u; } \
        else if constexpr (ABLK) V[_h][_i] = (unsigned)blk_off(Rs[_i], Cs[_i], g.lda) * 2u; \
        else V[_h][_i] = (unsigned)(Rs[_i] * g.lda + Cs[_i]) * 2u; } } while (0)
    const unsigned ldsw = (unsigned)wid * 1024u;
    const int aoff = lds_byte(wr * 64 + fr, fq * 8), boff = lds_byte(wc * 32 + fr, fq * 8);
#define PG8_SA(b, h) (((b) * 2 + (h)) * HTB)
#define PG8_SB(b, h) ((4 + (b) * 2 + (h)) * HTB)
#define PG8_STAGE(bufoff, gbase, voff) do { _Pragma("unroll") for (int _i = 0; _i < 2; ++_i) \
        __builtin_amdgcn_global_load_lds((const unsigned*)((const char*)(gbase) + (voff)[_i]), (LAS unsigned*)(lds + (bufoff) + ldsw + _i * 8192), 16, 0, 0); } while (0)
#define PG8_LDA(dst, b, h) do { _Pragma("unroll") for (int m = 0; m < 4; ++m) _Pragma("unroll") for (int k = 0; k < 2; ++k) dst[m][k] = *(const LAS bf16x8*)(lds + PG8_SA(b, h) + aoff + m * 2048 + k * 1024); } while (0)
#define PG8_LDB(dst, b, h) do { _Pragma("unroll") for (int n = 0; n < 2; ++n) _Pragma("unroll") for (int k = 0; k < 2; ++k) dst[n][k] = *(const LAS bf16x8*)(lds + PG8_SB(b, h) + boff + n * 2048 + k * 1024); } while (0)
#define PG8_MMA(ai, bj, At, Bt) do { __builtin_amdgcn_s_setprio(1); _Pragma("unroll") for (int m = 0; m < 4; ++m) _Pragma("unroll") for (int n = 0; n < 2; ++n) _Pragma("unroll") for (int k = 0; k < 2; ++k) \
        acc[ai][bj][m][n] = __builtin_amdgcn_mfma_f32_16x16x32_bf16(Bt[n][k], At[m][k], acc[ai][bj][m][n], 0, 0, 0); __builtin_amdgcn_s_setprio(0); } while (0)
#define PG8_WAIT_V(n) asm volatile("s_waitcnt vmcnt(" #n ")" ::: "memory")
#define PG8_WAIT_VSEL(sel, n) asm volatile("s_cmp_eq_u32 %0, 0\n\ts_cbranch_scc1 1f\n\ts_waitcnt vmcnt(%1)\n\ts_branch 2f\n1:\n\ts_waitcnt vmcnt(8)\n2:" :: "s"(sel), "n"(n) : "memory", "scc")
#define PG8_WAIT_L(n) asm volatile("s_waitcnt lgkmcnt(" #n ")" ::: "memory")
#define PG8_BAR __builtin_amdgcn_s_barrier()
#define PG8_SCHED __builtin_amdgcn_sched_barrier(0)
    Unit cur, nxt; int ui = 0;
    if constexpr (Sched::DYN) S.begin();
    if (!S.next(0, cur)) return;
    f32x4 acc[2][2][4][2];
#pragma unroll
    for (int a = 0; a < 2; ++a)
#pragma unroll
        for (int b = 0; b < 2; ++b)
#pragma unroll
            for (int m = 0; m < 4; ++m)
#pragma unroll
                for (int n = 0; n < 2; ++n) acc[a][b][m][n] = (f32x4){0.f, 0.f, 0.f, 0.f};
    bf16x8 At[4][2], B0[2][2], B1[2][2];
    PG8_SETV(vA, cur);
    const char* cA = (const char*)g.A + (GATHER ? (size_t)0 : (size_t)cur.pm * tstepA); const char* cB = (const char*)g.Bt + (size_t)cur.pn * tstepB;
    PG8_STAGE(PG8_SB(0, 0), cB, voffB); PG8_STAGE(PG8_SB(0, 1), cB + hstepB, voffB); PG8_STAGE(PG8_SA(0, 0), cA, vA[0]); PG8_STAGE(PG8_SA(0, 1), cA + hsA, vA[1]);
    if (wr == 1) PG8_BAR;
    PG8_WAIT_V(2); PG8_BAR;
    PG8_STAGE(PG8_SB(1, 0), cB + kstep, voffB); PG8_STAGE(PG8_SA(1, 0), cA + kstepA, vA[0]); PG8_STAGE(PG8_SB(1, 1), cB + hstepB + kstep, voffB);
    PG8_WAIT_V(6); PG8_BAR;
    for (;;) {
        const bool has_next = S.next(ui + 1, nxt);
        unsigned claim_ = 0u; if constexpr (Sched::DYN) claim_ = S.claim_issue();
        const char* nA = has_next ? (const char*)g.A + (GATHER ? (size_t)0 : (size_t)nxt.pm * tstepA) : cA; const char* nB = has_next ? (const char*)g.Bt + (size_t)nxt.pn * tstepB : cB;
        if constexpr (GATHER) { if (has_next) PG8_SETV(nvA, nxt); else {
#pragma unroll
            for (int h = 0; h < 2; ++h) { nvA[h][0] = vA[h][0]; nvA[h][1] = vA[h][1]; } } }
        for (int t = 0; t < nt; t += 2) {
            if constexpr (Epi::MID) { if (t == 8 || t == 16) E.mid(acc, cur, t >> 3, wr, wc, fr, fq); }
            const bool last = (t == nt - 2);
            const char* a1 = cA + (size_t)(t + 1) * kstepA;
            const char* a2 = last ? nA : cA + (size_t)(t + 2) * kstepA; const char* b2 = last ? nB : cB + (size_t)(t + 2) * kstep;
            const char* a3 = a2 + kstepA; const char* b3 = b2 + kstep;
            unsigned v20[2], v21[2];
            if constexpr (GATHER) { v20[0] = last ? nvA[0][0] : vA[0][0]; v20[1] = last ? nvA[0][1] : vA[0][1]; v21[0] = last ? nvA[1][0] : vA[1][0]; v21[1] = last ? nvA[1][1] : vA[1][1]; }
            else { v20[0] = vA[0][0]; v20[1] = vA[0][1]; v21[0] = vA[1][0]; v21[1] = vA[1][1]; }
            const int relax_ = __builtin_amdgcn_readfirstlane((RELAXW && (t == 0) && (ui > 0)) ? 1 : 0);
            PG8_LDB(B0, 0, 0); PG8_LDB(B1, 0, 1); PG8_SCHED; PG8_LDA(At, 0, 0); PG8_STAGE(PG8_SA(1, 1), a1 + hsA, vA[1]);
            PG8_WAIT_VSEL(relax_, 8 + Epi::NVM);
            PG8_WAIT_L(0); PG8_BAR; PG8_MMA(0, 0, At, B0); PG8_MMA(0, 1, At, B1); PG8_BAR; PG8_SCHED;
            PG8_LDA(At, 0, 1); PG8_STAGE(PG8_SB(0, 0), b2, voffB); PG8_STAGE(PG8_SB(0, 1), b2 + hstepB, voffB); PG8_STAGE(PG8_SA(0, 0), a2, v20);
            PG8_WAIT_VSEL(relax_, 8 + Epi::NVM);
            PG8_WAIT_L(0); PG8_BAR; PG8_MMA(1, 0, At, B0); PG8_MMA(1, 1, At, B1); PG8_BAR; PG8_SCHED;
            PG8_LDB(B0, 1, 0); PG8_LDB(B1, 1, 1); PG8_SCHED; PG8_LDA(At, 1, 0); PG8_STAGE(PG8_SA(0, 1), a2 + hsA, v21);
            PG8_WAIT_V(8); PG8_WAIT_L(0); PG8_BAR; PG8_MMA(0, 0, At, B0); PG8_MMA(0, 1, At, B1); PG8_BAR; PG8_SCHED;
            PG8_LDA(At, 1, 1); PG8_STAGE(PG8_SB(1, 0), b3, voffB); PG8_STAGE(PG8_SB(1, 1), b3 + hstepB, voffB); PG8_STAGE(PG8_SA(1, 0), a3, v20);
            PG8_WAIT_V(8); PG8_WAIT_L(0); PG8_BAR; PG8_MMA(1, 0, At, B0); PG8_MMA(1, 1, At, B1); PG8_BAR; PG8_SCHED;
        }
        if constexpr (Sched::DYN) S.claim_commit(claim_, ui);
        if constexpr (ALIGN_EPI) { if (wr == 0) PG8_BAR; }
        E(acc, cur, wr, wc, fr, fq);
        if (!has_next) break;
#pragma unroll
        for (int a = 0; a < 2; ++a)
#pragma unroll
            for (int b = 0; b < 2; ++b)
#pragma unroll
                for (int m = 0; m < 4; ++m)
#pragma unroll
                    for (int n = 0; n < 2; ++n) acc[a][b][m][n] = (f32x4){0.f, 0.f, 0.f, 0.f};
        cur = nxt; cA = nA; cB = nB; ++ui;
        if constexpr (GATHER) {
#pragma unroll
            for (int h = 0; h < 2; ++h) { vA[h][0] = nvA[h][0]; vA[h][1] = nvA[h][1]; } }
        if constexpr (ALIGN_EPI) { if (wr == 1) PG8_BAR; }
    }
    PG8_WAIT_V(0);
    if constexpr (!ALIGN_EPI) { if (wr == 0) PG8_BAR; }
    PG8_BAR;
#undef PG8_SETV
#undef PG8_SA
#undef PG8_SB
#undef PG8_STAGE
#undef PG8_LDA
#undef PG8_LDB
#undef PG8_MMA
#undef PG8_WAIT_V
#undef PG8_WAIT_VSEL
#undef PG8_WAIT_L
#undef PG8_BAR
#undef PG8_SCHED
}

typedef f32x4 Acc[2][2][4][2];
#ifndef NT_Z
#define NT_Z 0
#endif
#ifndef NT_A
#define NT_A 1
#endif
#ifndef ST_SC1
#define ST_SC1 1
#endif
__device__ __forceinline__ void st16(unsigned char* wsb, u32x4* p, const u32x4& v) {
#if ST_SC1
    const __amdgpu_buffer_rsrc_t rsrc = __builtin_amdgcn_make_buffer_rsrc(wsb, 0, 0x7fffffff, 0x00020000);
    __builtin_amdgcn_raw_buffer_store_b128(v, rsrc, (int)((unsigned char*)p - wsb), 0, 16);
#else
    *p = v;
#endif
}
__device__ __forceinline__ float fq_sum(float s) { s += swz_xor<16>(s); return xsum32(s); }
__device__ __forceinline__ u32x4 pack8(const f32x4& a, const f32x4& b) { u32x4 w; w.x = cvt_pk_bf16(a.x, a.y); w.y = cvt_pk_bf16(a.z, a.w); w.z = cvt_pk_bf16(b.x, b.y); w.w = cvt_pk_bf16(b.z, b.w); return w; }
__device__ __forceinline__ void unpack8(const u32x4& w, f32x4& a, f32x4& b) { a = (f32x4){bf_lo(w.x), bf_hi(w.x), bf_lo(w.y), bf_hi(w.y)}; b = (f32x4){bf_lo(w.z), bf_hi(w.z), bf_lo(w.w), bf_hi(w.w)}; }
__device__ __forceinline__ unsigned g8pack(const f32x4& a) {
    const unsigned b0 = (unsigned)__builtin_fmaxf(a.x * 255.f + 0.5f, 1.f), b1 = (unsigned)__builtin_fmaxf(a.y * 255.f + 0.5f, 1.f), b2 = (unsigned)__builtin_fmaxf(a.z * 255.f + 0.5f, 1.f), b3 = (unsigned)__builtin_fmaxf(a.w * 255.f + 0.5f, 1.f);
    return b0 | (b1 << 8) | (b2 << 16) | (b3 << 24);
}
__device__ __forceinline__ f32x4 g8unpack(unsigned w) { return (f32x4){(float)(w & 0xffu), (float)((w >> 8) & 0xffu), (float)((w >> 16) & 0xffu), (float)(w >> 24)}; }
__device__ __forceinline__ float sq8(const f32x4& a, const f32x4& b) { return ((a.x * a.x + a.y * a.y) + (a.z * a.z + a.w * a.w)) + ((b.x * b.x + b.y * b.y) + (b.z * b.z + b.w * b.w)); }
__device__ __forceinline__ float sum4(const f32x4& a) { return (a.x + a.y) + (a.z + a.w); }
__device__ __forceinline__ void rope8(f32x4& a, f32x4& b, const float* cs, const float* sn) {
    const f32x4 c = *(const f32x4*)cs, s = *(const f32x4*)sn;
    const f32x4 ra = {a.x * c.x - a.y * s.x, a.x * s.x + a.y * c.x, a.z * c.y - a.w * s.y, a.z * s.y + a.w * c.y};
    const f32x4 rb = {b.x * c.z - b.y * s.z, b.x * s.z + b.y * c.z, b.z * c.w - b.w * s.w, b.z * s.w + b.w * c.w};
    a = ra; b = rb;
}
__device__ __forceinline__ void rowscale16(const float* st, int rbase, int fq, float (&r)[8]) {
    f32x4 p[8];
#pragma unroll
    for (int i = 0; i < 8; ++i) p[i] = *(const f32x4*)(st + (size_t)(rbase + (i >> 2) * HALF + (i & 3) * 16) * 16 + 4 * fq);
#pragma unroll
    for (int i = 0; i < 8; ++i) r[i] = rsqrtf(fq_sum(sum4(p[i])) * (1.f / 1024.f) + EPS);
}
__device__ __forceinline__ void rowscale4(const float* sq, int rbase, float inv_n, float (&r)[8]) {
    f32x4 p[8];
#pragma unroll
    for (int i = 0; i < 8; ++i) p[i] = *(const f32x4*)(sq + (size_t)(rbase + (i >> 2) * HALF + (i & 3) * 16) * 4);
#pragma unroll
    for (int i = 0; i < 8; ++i) r[i] = rsqrtf(sum4(p[i]) * inv_n + EPS);
}
#define EPI_ROWBASE int rl_ = wr * 64 + fr; asm volatile("" : "+v"(rl_)); const int rbase = u.pm * BM + rl_
#define EPI_LOOP _Pragma("unroll") for (int ai = 0; ai < 2; ++ai) _Pragma("unroll") for (int m = 0; m < 4; ++m)

struct EpiIn {
    static constexpr bool PERM = true, MID = false; static constexpr int NVM = 24;
    bf16_t* Z; const float* st; float* sq; float* skv; const float* cosT; const float* sinT; unsigned char* GB; bf16_t* HM; unsigned char* wsb;
    __device__ __forceinline__ void operator()(const Acc& acc, const Unit& u, int wr, int wc, int fr, int fq) const {
        EPI_ROWBASE; const int pn = u.pn;
        float r8[8]; rowscale16(st, rbase, fq, r8);
        __builtin_amdgcn_sched_barrier(0);
        EPI_LOOP {
            const int row = rbase + ai * HALF + m * 16; const float r = r8[ai * 4 + m];
            bf16_t* zr = Z + (size_t)row * ZW + pn * BM + wc * 32 + 8 * fq;
            float ssq = 0.f;
#pragma unroll
            for (int bj = 0; bj < 2; ++bj) {
                f32x4 v0 = acc[ai][bj][m][0] * r, v1 = acc[ai][bj][m][1] * r;
                if (pn == 0) ssq += sq8(v0, v1);
                else if (pn == 1) { if (bj == 0) ssq += sq8(v0, v1); else if (wc == 0) { const int pos = row & (SEQ - 1); rope8(v0, v1, cosT + pos * 16 + 4 * fq, sinT + pos * 16 + 4 * fq); } }
                else if (pn == 2 || pn == 3 || pn == 8 || pn == 9) { v0 = v0 * (0.125f * LOG2E); v1 = v1 * (0.125f * LOG2E); }
                else if (pn >= 11) {
                    v0 = (f32x4){sigmoidf_(v0.x), sigmoidf_(v0.y), sigmoidf_(v0.z), sigmoidf_(v0.w)}; v1 = (f32x4){sigmoidf_(v1.x), sigmoidf_(v1.y), sigmoidf_(v1.z), sigmoidf_(v1.w)}; }
                if (pn >= 11) { u32x2 w8; w8.x = g8pack(v0); w8.y = g8pack(v1); *(u32x2*)(GB + blk_off(row, (pn - 11) * BM + bj * HALF + wc * 32 + 8 * fq, 3072)) = w8; }
                else if (pn >= 2) {
                    const int hc = (pn - 2) * BM + bj * HALF + wc * 32;
                    const int reg = hc < 1536 ? hc >> 9 : (hc < 2048 ? 3 : (hc < 2176 ? 4 : 5)), hin = hc < 1536 ? hc & 511 : (hc < 2048 ? hc - 1536 : (hc - 2048) & 127);
                    const size_t base = reg <= 3 ? (size_t)reg * (MC * 512) : (size_t)4 * (MC * 512) + (size_t)(reg - 4) * (MC * 128);
                    const int nh = reg <= 3 ? 8 : 2, b = row >> 11, s = row & (SEQ - 1);
                    st16(wsb, (u32x4*)(HM + base + (((size_t)(b * nh + (hin >> 6)) * SEQ + s) * 64 + (hin & 63) + 8 * fq)), pack8(v0, v1));
                }
                else st16(wsb, (u32x4*)(zr + bj * HALF), pack8(v0, v1));
            }
            if (pn <= 1) { ssq = fq_sum(ssq); if (fq == 0) (pn == 0 ? sq : skv)[(size_t)row * 4 + wc] = ssq; }
        }
    }
};
struct EpiQ {
    static constexpr bool PERM = true, MID = false; static constexpr int NVM = 24;
    bf16_t* Q; const float* sq; const float* cosT; const float* sinT;
    __device__ __forceinline__ void operator()(const Acc& acc, const Unit& u, int wr, int wc, int fr, int fq) const {
        EPI_ROWBASE;
        float r8[8]; rowscale4(sq, rbase, 1.f / 256.f, r8);
        __builtin_amdgcn_sched_barrier(0);
        EPI_LOOP {
            __builtin_amdgcn_sched_barrier(0);
            const int row = rbase + ai * HALF + m * 16; const float r = r8[ai * 4 + m]; const int pos = row & (SEQ - 1);
#pragma unroll
            for (int bj = 0; bj < 2; ++bj) {
                const int col = u.pn * BM + bj * HALF + wc * 32 + 8 * fq; const int j0 = col % 96;
                f32x4 v0 = acc[ai][bj][m][0] * r, v1 = acc[ai][bj][m][1] * r;
                if (j0 >= 64) { const int i0 = (j0 - 64) >> 1; rope8(v0, v1, cosT + pos * 16 + i0, sinT + pos * 16 + i0); }
                *(u32x4*)(Q + (size_t)row * 768 + col) = pack8(v0, v1);
            }
        }
    }
};
struct EpiKV {
    static constexpr bool PERM = true, MID = false; static constexpr int NVM = 24;
    bf16_t* KV; const float* skv;
    __device__ __forceinline__ void operator()(const Acc& acc, const Unit& u, int wr, int wc, int fr, int fq) const {
        EPI_ROWBASE;
        float r8[8]; rowscale4(skv, rbase, 1.f / 128.f, r8);
        __builtin_amdgcn_sched_barrier(0);
        EPI_LOOP {
            const int row = rbase + ai * HALF + m * 16; const float r = r8[ai * 4 + m];
#pragma unroll
            for (int bj = 0; bj < 2; ++bj) {
                const int col = u.pn * BM + bj * HALF + wc * 32 + 8 * fq;
                *(u32x4*)(KV + (size_t)row * 1024 + col) = pack8(acc[ai][bj][m][0] * r, acc[ai][bj][m][1] * r);
            }
        }
    }
};
struct EpiBr {
    static constexpr bool PERM = true, MID = true; static constexpr int NVM = 32;
    const unsigned char* G; bf16_t* MG; unsigned char* wsb;
    __device__ __forceinline__ void mid(Acc& acc, const Unit& u, int seg, int wr, int wc, int fr, int fq) const {
        EPI_ROWBASE; const int col = u.pn * BM + wc * 32 + 8 * fq;
#pragma unroll
        for (int ai = 0; ai < 2; ++ai) {
            __builtin_amdgcn_sched_barrier(0);
            u32x2 wn[4][2], wd[4][2];
#pragma unroll
            for (int m = 0; m < 4; ++m)
#pragma unroll
                for (int bj = 0; bj < 2; ++bj) { const int row = rbase + ai * HALF + m * 16; wn[m][bj] = *(const u32x2*)(G + blk_off(row, (seg - 1) * 1024 + col + bj * HALF, 3072)); wd[m][bj] = *(const u32x2*)(G + blk_off(row, seg * 1024 + col + bj * HALF, 3072)); }
#pragma unroll
            for (int m = 0; m < 4; ++m)
#pragma unroll
                for (int bj = 0; bj < 2; ++bj) {
                    const f32x4 n0 = g8unpack(wn[m][bj].x), n1 = g8unpack(wn[m][bj].y), d0 = g8unpack(wd[m][bj].x), d1 = g8unpack(wd[m][bj].y);
                    f32x4 r0, r1;
                    r0.x = n0.x * fast_rcp(d0.x); r0.y = n0.y * fast_rcp(d0.y); r0.z = n0.z * fast_rcp(d0.z); r0.w = n0.w * fast_rcp(d0.w);
                    r1.x = n1.x * fast_rcp(d1.x); r1.y = n1.y * fast_rcp(d1.y); r1.z = n1.z * fast_rcp(d1.z); r1.w = n1.w * fast_rcp(d1.w);
                    acc[ai][bj][m][0] = acc[ai][bj][m][0] * r0; acc[ai][bj][m][1] = acc[ai][bj][m][1] * r1;
                }
        }
    }
    __device__ __forceinline__ void operator()(const Acc& acc, const Unit& u, int wr, int wc, int fr, int fq) const {
        EPI_ROWBASE; const int col = u.pn * BM + wc * 32 + 8 * fq;
#pragma unroll
        for (int ai = 0; ai < 2; ++ai) {
            __builtin_amdgcn_sched_barrier(0);
            u32x2 wg[4][2];
#pragma unroll
            for (int m = 0; m < 4; ++m)
#pragma unroll
                for (int bj = 0; bj < 2; ++bj) wg[m][bj] = *(const u32x2*)(G + blk_off(rbase + ai * HALF + m * 16, 2048 + col + bj * HALF, 3072));
#pragma unroll
            for (int m = 0; m < 4; ++m)
#pragma unroll
                for (int bj = 0; bj < 2; ++bj) { const f32x4 g0 = g8unpack(wg[m][bj].x) * (1.f / 255.f), g1 = g8unpack(wg[m][bj].y) * (1.f / 255.f);
                    st16(wsb, (u32x4*)(MG + blk_off(rbase + ai * HALF + m * 16, col + bj * HALF, 1024)), pack8(acc[ai][bj][m][0] * g0, acc[ai][bj][m][1] * g1)); }
        }
    }
};
template <bool F32OUT> struct EpiRes {
    static constexpr bool PERM = true, MID = false; static constexpr int NVM = 40;
    bf16_t* xb; float* st; int row0; float* xout;
    __device__ __forceinline__ void operator()(const Acc& acc, const Unit& u, int wr, int wc, int fr, int fq) const {
        EPI_ROWBASE; const int col = u.pn * BM + wc * 32 + 8 * fq;
#pragma unroll
        for (int ai = 0; ai < 2; ++ai) {
            __builtin_amdgcn_sched_barrier(0);
            u32x4 xi[4][2];
#pragma unroll
            for (int m = 0; m < 4; ++m)
#pragma unroll
                for (int bj = 0; bj < 2; ++bj) xi[m][bj] = *(const u32x4*)(xb + (size_t)(row0 + rbase + ai * HALF + m * 16) * DM + col + bj * HALF);
#pragma unroll
            for (int m = 0; m < 4; ++m) {
                const int row = row0 + rbase + ai * HALF + m * 16; float ssq = 0.f;
#pragma unroll
                for (int bj = 0; bj < 2; ++bj) { f32x4 x0, x1; unpack8(xi[m][bj], x0, x1);
                    const f32x4 v0 = x0 + acc[ai][bj][m][0], v1 = x1 + acc[ai][bj][m][1];
                    *(u32x4*)(xb + (size_t)row * DM + col + bj * HALF) = pack8(v0, v1); ssq += sq8(v0, v1);
                    if constexpr (F32OUT) { float* xo = xout + (size_t)row * DM + col + bj * HALF; *(f32x4*)xo = v0; *(f32x4*)(xo + 4) = v1; } }
                ssq = fq_sum(ssq); if (fq == 0) st[(size_t)row * 16 + u.pn * 4 + wc] = ssq;
            }
        }
    }
};
__device__ __forceinline__ float silu_mul(float g, float u) { return g * sigmoidf_(g) * u; }
struct EpiGU {
    static constexpr bool PERM = true, MID = false; static constexpr int NVM = 16;
    bf16_t* ACT; const float* st; int ldact; unsigned char* wsb;
    __device__ __forceinline__ void operator()(const Acc& acc, const Unit& u, int wr, int wc, int fr, int fq) const {
        EPI_ROWBASE;
        float r8[8]; rowscale16(st, rbase, fq, r8);
        __builtin_amdgcn_sched_barrier(0);
        EPI_LOOP {
            const int row = rbase + ai * HALF + m * 16; const float r = r8[ai * 4 + m];
            const f32x4 g0 = acc[ai][0][m][0] * r, g1 = acc[ai][0][m][1] * r, u0 = acc[ai][1][m][0] * r, u1 = acc[ai][1][m][1] * r;
            const f32x4 a0 = {silu_mul(g0.x, u0.x), silu_mul(g0.y, u0.y), silu_mul(g0.z, u0.z), silu_mul(g0.w, u0.w)};
            const f32x4 a1 = {silu_mul(g1.x, u1.x), silu_mul(g1.y, u1.y), silu_mul(g1.z, u1.z), silu_mul(g1.w, u1.w)};
            st16(wsb, (u32x4*)(ACT + blk_off(row, u.aux * HALF + wc * 32 + 8 * fq, ldact)), pack8(a0, a1));
        }
    }
};
struct EpiGUMoe {
    static constexpr bool PERM = true, MID = false; static constexpr int NVM = 16;
    bf16_t* ACT; const float* rowrr; int ldact; unsigned char* wsb;
    __device__ __forceinline__ void operator()(const Acc& acc, const Unit& u, int wr, int wc, int fr, int fq) const {
        EPI_ROWBASE;
        float r8[8];
#pragma unroll
        for (int i = 0; i < 8; ++i) r8[i] = rowrr[rbase + (i >> 2) * HALF + (i & 3) * 16];
        __builtin_amdgcn_sched_barrier(0);
        EPI_LOOP {
            const int row = rbase + ai * HALF + m * 16; const float r = r8[ai * 4 + m];
            const f32x4 g0 = acc[ai][0][m][0] * r, g1 = acc[ai][0][m][1] * r, u0 = acc[ai][1][m][0] * r, u1 = acc[ai][1][m][1] * r;
            const f32x4 a0 = {silu_mul(g0.x, u0.x), silu_mul(g0.y, u0.y), silu_mul(g0.z, u0.z), silu_mul(g0.w, u0.w)};
            const f32x4 a1 = {silu_mul(g1.x, u1.x), silu_mul(g1.y, u1.y), silu_mul(g1.z, u1.z), silu_mul(g1.w, u1.w)};
            st16(wsb, (u32x4*)(ACT + blk_off(row, u.aux * HALF + wc * 32 + 8 * fq, ldact)), pack8(a0, a1));
        }
    }
};
template <bool FIRST> struct EpiDnMoe {
    static constexpr bool PERM = true, MID = false; static constexpr int NVM = 32;
    unsigned char* ws; const int* rowtok; const float* rowgw;
    __device__ __forceinline__ void operator()(const Acc& acc, const Unit& u, int wr, int wc, int fr, int fq) const {
        EPI_ROWBASE; const int col = u.aux * BM + wc * 32 + 8 * fq;
        int tk[8]; float gw8[8];
#pragma unroll
        for (int i = 0; i < 8; ++i) { tk[i] = rowtok[rbase + (i >> 2) * HALF + (i & 3) * 16]; gw8[i] = rowgw[rbase + (i >> 2) * HALF + (i & 3) * 16]; }
#pragma unroll
        for (int ai = 0; ai < 2; ++ai) {
            __builtin_amdgcn_sched_barrier(0);
            u32x4 xi[4][2]; bf16_t* xr[4];
#pragma unroll
            for (int m = 0; m < 4; ++m) { const int tok = tk[ai * 4 + m] < 0 ? 0 : tk[ai * 4 + m]; xr[m] = xm_row(ws, tok) + col;
                const bf16_t* src = FIRST ? (const bf16_t*)(ws + WS_XB) + (size_t)tok * DM + col : xr[m];
#pragma unroll
                for (int bj = 0; bj < 2; ++bj) xi[m][bj] = *(const u32x4*)(src + bj * HALF); }
#pragma unroll
            for (int m = 0; m < 4; ++m) { const float gwv = gw8[ai * 4 + m];
                if (tk[ai * 4 + m] >= 0) {
#pragma unroll
                    for (int bj = 0; bj < 2; ++bj) { f32x4 x0, x1; unpack8(xi[m][bj], x0, x1);
                        *(u32x4*)(xr[m] + bj * HALF) = pack8(x0 + acc[ai][bj][m][0] * gwv, x1 + acc[ai][bj][m][1] * gwv); } } }
        }
    }
};
}
namespace att {
__device__ __forceinline__ int crow(int r, int hi) { return (r & 3) + 8 * (r >> 2) + 4 * hi; }
__device__ __forceinline__ float xhalf_max(float m) { return xmax32(m); }
__device__ __forceinline__ float xhalf_sum(float m) { return xsum32(m); }
typedef short v4i16_t __attribute__((ext_vector_type(4)));
__device__ __forceinline__ s16x4 vtr(const LAS unsigned char* p) { return __builtin_bit_cast(s16x4, __builtin_amdgcn_ds_read_tr16_b64_v4i16((LAS v4i16_t*)p)); }
__device__ __forceinline__ bf16x8 cat8(s16x4 a, s16x4 b) { return (bf16x8){a[0], a[1], a[2], a[3], b[0], b[1], b[2], b[3]}; }
__device__ __forceinline__ bf16x8 pfrag(const f32x16& p, int s8) {
    u32x4 w; w.x = cvt_pk_bf16(p[s8 + 0], p[s8 + 1]); w.y = cvt_pk_bf16(p[s8 + 2], p[s8 + 3]); w.z = cvt_pk_bf16(p[s8 + 4], p[s8 + 5]); w.w = cvt_pk_bf16(p[s8 + 6], p[s8 + 7]);
    return __builtin_bit_cast(bf16x8, w);
}
constexpr int TAB_STRIDE = 320;

constexpr int BW_ROWS = 384, BW_KP = 144;
constexpr int BW_K = 0, BW_V = BW_ROWS * BW_KP, BW_VDH = BW_ROWS * 64, BW_TAB = BW_V + 2 * BW_VDH, BW_END = BW_TAB + 4 * TAB_STRIDE * 4;
struct BandPre { u32x4 k[6], v[6]; float t[4]; bf16x8 q[4]; };
struct BandItem { int kind, b, hh, g0, a0; };
__device__ __forceinline__ BandItem band_decode(int i, int items_per_kind) {
    BandItem it; it.kind = i / items_per_kind; const int w = i % items_per_kind;
    if (it.kind < 3) { const int sub = w & 7; it.hh = (w >> 3) & 7; it.b = w >> 6;
        if (it.kind == 0) { it.g0 = 0; it.a0 = 256 * sub; } else if (it.kind == 1) { it.g0 = sub >> 1; it.a0 = 256 * (sub & 1); } else { it.g0 = 2 * sub; it.a0 = 0; } }
    else { it.a0 = 64 * (w & 31); it.hh = (w >> 5) & 1; it.b = w >> 6; it.g0 = 0; }
    return it;
}
__device__ __forceinline__ bool band_row(const BandItem& it, int r, int& pos) {
    int key, g = it.g0, dil, L;
    if (it.kind == 3) { if (r >= 320) return false; key = it.a0 - 128 + r; dil = 1; L = SEQ; }
    else if (it.kind == 2) { if (r >= 256) return false; g += r >> 7; key = r & 127; dil = 16; L = 128; }
    else { dil = it.kind == 0 ? 1 : 4; L = SEQ / dil; key = it.a0 - 64 + r; }
    if (key < 0 || key >= L) return false;
    pos = key * dil + g; return true;
}
__device__ __forceinline__ void band_issue(BandPre& P, const BandItem& it, const bf16_t* HM, const float* tabg, int tid, int wid, int lane) {
    const bf16_t* kb = it.kind == 3 ? HM + (size_t)4 * MC * 512 + ((size_t)(it.b * 2 + it.hh) * SEQ) * 64 : HM + (size_t)MC * 512 + ((size_t)(it.b * 8 + it.hh) * SEQ) * 64;
    const bf16_t* vb = it.kind == 3 ? kb + (size_t)MC * 128 : kb + (size_t)MC * 512;
#pragma unroll
    for (int i = 0; i < 6; ++i) { const int id = i * 512 + tid, r = id >> 3, c = id & 7; int pos; P.k[i] = (u32x4){0u, 0u, 0u, 0u}; P.v[i] = P.k[i];
        if (band_row(it, r, pos)) { P.k[i] = *(const u32x4*)(kb + (size_t)pos * 64 + c * 8); P.v[i] = *(const u32x4*)(vb + (size_t)pos * 64 + c * 8); } }
#pragma unroll
    for (int j = 0; j < 4; ++j) { P.t[j] = 0.f; if (tid < TAB_STRIDE && (it.kind == 3 || j == 0)) P.t[j] = tabg[((it.kind == 3 ? 3 * 8 + it.hh * 4 + j : it.kind * 8 + it.hh)) * TAB_STRIDE + tid]; }
    int a0w, g = it.g0, dil, qh; const bf16_t* qbuf;
    if (it.kind == 3) { a0w = it.a0 + 32 * (wid & 1); dil = 1; qh = it.hh * 4 + (wid >> 1); qbuf = HM + (size_t)3 * MC * 512; }
    else if (it.kind == 2) { a0w = 32 * (wid & 3); g += wid >> 2; dil = 16; qh = it.hh; qbuf = HM; }
    else { a0w = it.a0 + 32 * wid; dil = it.kind == 0 ? 1 : 4; qh = it.hh; qbuf = HM; }
    const bf16_t* qp = qbuf + (((size_t)(it.b * 8 + qh) * SEQ) + (size_t)(a0w + (lane & 31)) * dil + g) * 64 + (lane >> 5) * 8;
#pragma unroll
    for (int d0 = 0; d0 < 4; ++d0) P.q[d0] = *(const bf16x8*)(qp + d0 * 16);
}
__device__ __forceinline__ void band_store(const BandPre& P, const BandItem& it, LAS unsigned char* lds, int tid) {
#pragma unroll
    for (int i = 0; i < 6; ++i) { const int id = i * 512 + tid, r = id >> 3, c = id & 7;
        *(LAS u32x4*)(lds + BW_K + r * BW_KP + c * 16) = P.k[i]; *(LAS u32x4*)(lds + BW_V + (c >> 2) * BW_VDH + r * 64 + (c & 3) * 16) = P.v[i]; }
    if (tid < TAB_STRIDE) {
#pragma unroll
        for (int j = 0; j < 4; ++j) if (it.kind == 3 || j == 0) ((LAS float*)(lds + BW_TAB))[j * TAB_STRIDE + tid] = P.t[j]; }
}
template <int NKB, int MODE>
__device__ __forceinline__ void band_compute(const bf16x8 (&qf)[4], const LAS unsigned char* lds, int rowoff, int a0w, int L, const LAS float* tab, bf16_t* op, float* stp, float sink2, int lane,
                                             const bf16_t* pb0 = nullptr, const bf16_t* pb1 = nullptr, const float* st0 = nullptr, const float* st1 = nullptr) {
    constexpr int R = 16 * (NKB - 1);
    const int q = lane & 31, hi = lane >> 5;
    f32x16 o0, o1;
#pragma unroll
    for (int r = 0; r < 16; ++r) { o0[r] = 0.f; o1[r] = 0.f; }
    float m = -3e38f, l = 0.f;
    const LAS float* tb = tab + (31 - q + 4 * hi);
    const int kro = q * BW_KP + hi * 16, vro = (4 * hi + ((lane & 15) >> 2)) * 64 + (16 * ((lane >> 4) & 1) + 4 * (lane & 3)) * 2;
#pragma unroll 1
    for (int kb = 0; kb < NKB; ++kb) {
        const int k0 = a0w - R + 32 * kb;
        if (k0 < 0 || k0 >= L) continue;
        const LAS unsigned char* kp = lds + BW_K + (rowoff + k0) * BW_KP + kro;
        f32x16 s;
#pragma unroll
        for (int r = 0; r < 16; ++r) s[r] = 0.f;
#pragma unroll
        for (int d0 = 0; d0 < 4; ++d0) s = __builtin_amdgcn_mfma_f32_32x32x16_bf16(*(const LAS bf16x8*)(kp + d0 * 32), qf[d0], s, 0, 0, 0);
#pragma unroll
        for (int r = 0; r < 16; ++r) s[r] += tb[32 * kb + (r & 3) + 8 * (r >> 2)];
        float bm = s[0];
#pragma unroll
        for (int r = 1; r < 16; ++r) bm = fmaxf(bm, s[r]);
        bm = xhalf_max(bm);
        const float mn = fmaxf(m, bm), f = fast_exp2(m - mn);
        float ps = 0.f;
#pragma unroll
        for (int r = 0; r < 16; ++r) { s[r] = fast_exp2(s[r] - mn); ps += s[r]; }
        l = l * f + ps; m = mn;
#pragma unroll
        for (int r = 0; r < 16; ++r) { o0[r] *= f; o1[r] *= f; }
        const bf16x8 p0 = pfrag(s, 0), p1 = pfrag(s, 8);
        const LAS unsigned char* vp = lds + BW_V + (rowoff + k0) * 64 + vro;
        { const bf16x8 v00 = cat8(vtr(vp), vtr(vp + 512)), v01 = cat8(vtr(vp + BW_VDH), vtr(vp + BW_VDH + 512));
          const bf16x8 v10 = cat8(vtr(vp + 1024), vtr(vp + 1024 + 512)), v11 = cat8(vtr(vp + BW_VDH + 1024), vtr(vp + BW_VDH + 1024 + 512));
          o0 = __builtin_amdgcn_mfma_f32_32x32x16_bf16(v00, p0, o0, 0, 0, 0); o1 = __builtin_amdgcn_mfma_f32_32x32x16_bf16(v01, p0, o1, 0, 0, 0);
          o0 = __builtin_amdgcn_mfma_f32_32x32x16_bf16(v10, p1, o0, 0, 0, 0); o1 = __builtin_amdgcn_mfma_f32_32x32x16_bf16(v11, p1, o1, 0, 0, 0); }
    }
    float lt = xhalf_sum(l);
    if (MODE == 2) {
        const f32x2 s0 = *(const f32x2*)st0, s1 = *(const f32x2*)st1;
        u32x2 a0[8], a1[8];
#pragma unroll
        for (int j = 0; j < 4; ++j) { a0[j] = *(const u32x2*)(pb0 + 8 * j); a0[4 + j] = *(const u32x2*)(pb0 + 32 + 8 * j); a1[j] = *(const u32x2*)(pb1 + 8 * j); a1[4 + j] = *(const u32x2*)(pb1 + 32 + 8 * j); }
        const float M = fmaxf(m, fmaxf(s0.x, s1.x));
        const float w0 = fast_exp2(s0.x - M) * s0.y, w1 = fast_exp2(s1.x - M) * s1.y, w2 = fast_exp2(m - M);
        const float inv = 1.f / (w0 + w1 + w2 * lt), c0 = w0 * inv, c1 = w1 * inv, c2 = w2 * inv;
#pragma unroll
        for (int j = 0; j < 4; ++j) {
            u32x2 w0_, w1_;
            { const float x0 = bf_lo(a0[j].x) * c0 + bf_lo(a1[j].x) * c1 + o0[4 * j] * c2, x1 = bf_hi(a0[j].x) * c0 + bf_hi(a1[j].x) * c1 + o0[4 * j + 1] * c2;
              const float x2 = bf_lo(a0[j].y) * c0 + bf_lo(a1[j].y) * c1 + o0[4 * j + 2] * c2, x3 = bf_hi(a0[j].y) * c0 + bf_hi(a1[j].y) * c1 + o0[4 * j + 3] * c2;
              w0_.x = cvt_pk_bf16(x0, x1); w0_.y = cvt_pk_bf16(x2, x3); }
            { const float x0 = bf_lo(a0[4 + j].x) * c0 + bf_lo(a1[4 + j].x) * c1 + o1[4 * j] * c2, x1 = bf_hi(a0[4 + j].x) * c0 + bf_hi(a1[4 + j].x) * c1 + o1[4 * j + 1] * c2;
              const float x2 = bf_lo(a0[4 + j].y) * c0 + bf_lo(a1[4 + j].y) * c1 + o1[4 * j + 2] * c2, x3 = bf_hi(a0[4 + j].y) * c0 + bf_hi(a1[4 + j].y) * c1 + o1[4 * j + 3] * c2;
              w1_.x = cvt_pk_bf16(x0, x1); w1_.y = cvt_pk_bf16(x2, x3); }
            *(u32x2*)(op + 8 * j) = w0_; *(u32x2*)(op + 32 + 8 * j) = w1_;
        }
        return;
    }
    if (MODE == 1) lt += fast_exp2(sink2 - m);
    else if (hi == 0) { stp[0] = m; stp[1] = lt; }
    const float inv = 1.f / lt;
#pragma unroll
    for (int j = 0; j < 4; ++j) {
        u32x2 w0, w1; w0.x = cvt_pk_bf16(o0[4 * j] * inv, o0[4 * j + 1] * inv); w0.y = cvt_pk_bf16(o0[4 * j + 2] * inv, o0[4 * j + 3] * inv);
        w1.x = cvt_pk_bf16(o1[4 * j] * inv, o1[4 * j + 1] * inv); w1.y = cvt_pk_bf16(o1[4 * j + 2] * inv, o1[4 * j + 3] * inv);
        *(u32x2*)(op + 8 * j) = w0; *(u32x2*)(op + 32 + 8 * j) = w1;
    }
}

constexpr int MLA_KP = 208;
constexpr int MLA_TK = 128;
constexpr int MLA_KTB = MLA_TK * MLA_KP;
constexpr int MLA_VTB = MLA_TK * 128;
constexpr int MLA_SLOT = MLA_KTB + MLA_VTB;
__device__ __forceinline__ void mla_unit(const bf16_t* Q, const bf16_t* KV, const bf16_t* Zc, bf16_t* Y, int b, int h, int qblk, LAS unsigned char* lds, int tid, int wid, int lane) {
    const int q = lane & 31, hi = lane >> 5;
    const size_t rb = (size_t)b * SEQ;
    bf16x8 qf[6];
    { const bf16_t* qp = Q + (rb + qblk * 256 + wid * 32 + q) * 768 + h * 96 + hi * 8;
#pragma unroll
      for (int d0 = 0; d0 < 6; ++d0) qf[d0] = *(const bf16x8*)(qp + d0 * 16); }
    const bf16_t* gk = KV + (rb + (tid >> 3)) * 1024 + h * 64 + (tid & 7) * 8;
    const bf16_t* gv = gk + 512;
    const bf16_t* gp = Zc + (rb + (tid >> 2)) * ZW + ZO_KPE + (tid & 3) * 8;
    const int lk = (tid >> 3) * MLA_KP + (tid & 7) * 16, lp = (tid >> 2) * MLA_KP + 128 + (tid & 3) * 16;
    const int lv = MLA_KTB + ((tid & 7) >> 2) * (MLA_TK * 64) + (tid >> 3) * 64 + (tid & 3) * 16;
    u32x4 rk0, rk1, rv0, rv1, rp;
#define MLA_GLOADK(T) do { const size_t go_ = (size_t)(T) * MLA_TK; rk0 = *(const u32x4*)(gk + go_ * 1024); rk1 = *(const u32x4*)(gk + (go_ + 64) * 1024); rp = *(const u32x4*)(gp + go_ * ZW); } while (0)
#define MLA_GLOADV(T) do { const size_t go_ = (size_t)(T) * MLA_TK; rv0 = *(const u32x4*)(gv + go_ * 1024); rv1 = *(const u32x4*)(gv + (go_ + 64) * 1024); } while (0)
#define MLA_LSTOREK(slot) do { LAS unsigned char* sb_ = lds + (slot) * MLA_SLOT; *(LAS u32x4*)(sb_ + lk) = rk0; *(LAS u32x4*)(sb_ + lk + 64 * MLA_KP) = rk1; *(LAS u32x4*)(sb_ + lp) = rp; } while (0)
#define MLA_LSTOREV(slot) do { LAS unsigned char* sb_ = lds + (slot) * MLA_SLOT; *(LAS u32x4*)(sb_ + lv) = rv0; *(LAS u32x4*)(sb_ + lv + 64 * 64) = rv1; } while (0)
#define MLA_GLOAD(T) do { MLA_GLOADK(T); MLA_GLOADV(T); } while (0)
#define MLA_LSTORE(slot) do { MLA_LSTOREK(slot); MLA_LSTOREV(slot); } while (0)
    MLA_GLOAD(0); MLA_LSTORE(0); MLA_GLOAD(1); MLA_LSTORE(1);
    __syncthreads();
    f32x16 o0, o1;
#pragma unroll
    for (int r = 0; r < 16; ++r) { o0[r] = 0.f; o1[r] = 0.f; }
    float m = 0.f, l = 0.f;
    const int kro = q * MLA_KP + hi * 16;
    const int vro = MLA_KTB + (4 * hi + ((lane & 15) >> 2)) * 64 + (16 * ((lane >> 4) & 1) + 4 * (lane & 3)) * 2;
    f32x16 sa0, sa1, sb0, sb1, negm;
#pragma unroll
    for (int r = 0; r < 16; ++r) negm[r] = 0.f;
    m = 0.f;
#define MLA_QK(S0, S1, slot, sub) do { const LAS unsigned char* kb_ = lds + (slot) * MLA_SLOT + (sub) * 64 * MLA_KP + kro; \
        { const bf16x8 k0_ = *(const LAS bf16x8*)(kb_), k1_ = *(const LAS bf16x8*)(kb_ + 32 * MLA_KP); \
          S0 = __builtin_amdgcn_mfma_f32_32x32x16_bf16(k0_, qf[0], negm, 0, 0, 0); S1 = __builtin_amdgcn_mfma_f32_32x32x16_bf16(k1_, qf[0], negm, 0, 0, 0); } \
        _Pragma("unroll") for (int d0 = 1; d0 < 6; ++d0) { const bf16x8 k0_ = *(const LAS bf16x8*)(kb_ + d0 * 32), k1_ = *(const LAS bf16x8*)(kb_ + 32 * MLA_KP + d0 * 32); \
            S0 = __builtin_amdgcn_mfma_f32_32x32x16_bf16(k0_, qf[d0], S0, 0, 0, 0); S1 = __builtin_amdgcn_mfma_f32_32x32x16_bf16(k1_, qf[d0], S1, 0, 0, 0); } } while (0)
#define MAX3(a, b, c) __builtin_fmaxf(__builtin_fmaxf((a), (b)), (c))
#define MLA_STEP(C0, C1, N0, N1, NSLOT, NSUB, CSLOT, CSUB, FIRST) do { \
        float ba = MAX3(C0[0], C0[1], C1[0]), bb = MAX3(C0[2], C0[3], C1[1]); ba = MAX3(ba, C1[2], C1[3]); \
        _Pragma("unroll") for (int r = 4; r < 16; r += 4) { ba = MAX3(ba, C0[r], C0[r + 1]); bb = MAX3(bb, C0[r + 2], C0[r + 3]); ba = MAX3(ba, C1[r], C1[r + 1]); bb = MAX3(bb, C1[r + 2], C1[r + 3]); } \
        float bm = xhalf_max(__builtin_fmaxf(ba, bb)); \
        if ((FIRST) || __any(bm > 0.f)) {                                \
            const float dl = (FIRST) ? bm : __builtin_fmaxf(bm, 0.f), f = fast_exp2(-dl); m += dl; l *= f; \
            _Pragma("unroll") for (int r = 0; r < 16; ++r) { o0[r] *= f; o1[r] *= f; C0[r] -= dl; C1[r] -= dl; negm[r] = -m; } } \
        MLA_QK(N0, N1, NSLOT, NSUB);                                     \
        float ps = 0.f; \
        _Pragma("unroll") for (int r = 0; r < 16; ++r) { C0[r] = fast_exp2(C0[r]); C1[r] = fast_exp2(C1[r]); ps += C0[r] + C1[r]; } \
        l += ps; \
        const bf16x8 p0 = pfrag(C0, 0), p1 = pfrag(C0, 8), p2 = pfrag(C1, 0), p3 = pfrag(C1, 8); \
        const LAS unsigned char* vb = lds + (CSLOT) * MLA_SLOT + (CSUB) * 64 * 64 + vro; \
        MLA_PV(0, p0); MLA_PV(1, p1); MLA_PV(2, p2); MLA_PV(3, p3); } while (0)
#define MLA_PV(S, P) do { const bf16x8 va = cat8(vtr(vb + (S) * 1024), vtr(vb + (S) * 1024 + 512)), vc = cat8(vtr(vb + MLA_TK * 64 + (S) * 1024), vtr(vb + MLA_TK * 64 + (S) * 1024 + 512)); \
            o0 = __builtin_amdgcn_mfma_f32_32x32x16_bf16(va, P, o0, 0, 0, 0); o1 = __builtin_amdgcn_mfma_f32_32x32x16_bf16(vc, P, o1, 0, 0, 0); } while (0)
    MLA_QK(sa0, sa1, 0, 0);
    int sc = 0, sn = 1, sw = 2;
    constexpr int NT = SEQ / MLA_TK;
    for (int T = 0; T < NT; ++T) {
        const bool has2 = T + 2 < NT;
        if (has2) MLA_GLOADK(T + 2);
        MLA_STEP(sa0, sa1, sb0, sb1, sc, 1, sc, 0, T == 0);
        if (has2) { MLA_LSTOREK(sw); MLA_GLOADV(T + 2); }
        MLA_STEP(sb0, sb1, sa0, sa1, sn, 0, sc, 1, false);
        if (has2) MLA_LSTOREV(sw);
        __syncthreads();
        const int tmp = sc; sc = sn; sn = sw; sw = tmp;
    }
#undef MAX3
#undef MLA_GLOAD
#undef MLA_LSTORE
#undef MLA_GLOADK
#undef MLA_GLOADV
#undef MLA_LSTOREK
#undef MLA_LSTOREV
#undef MLA_QK
#undef MLA_STEP
#undef MLA_PV
    const float inv = 1.f / xhalf_sum(l);
    bf16_t* op = Y + (rb + qblk * 256 + wid * 32 + q) * 1536 + h * 64 + 4 * hi;
#pragma unroll
    for (int j = 0; j < 4; ++j) {
        u32x2 w0, w1; w0.x = cvt_pk_bf16(o0[4 * j] * inv, o0[4 * j + 1] * inv); w0.y = cvt_pk_bf16(o0[4 * j + 2] * inv, o0[4 * j + 3] * inv);
        w1.x = cvt_pk_bf16(o1[4 * j] * inv, o1[4 * j + 1] * inv); w1.y = cvt_pk_bf16(o1[4 * j + 2] * inv, o1[4 * j + 3] * inv);
        *(u32x2*)(op + 8 * j) = w0; *(u32x2*)(op + 32 + 8 * j) = w1;
    }
}
}
constexpr int NWAVES = 8, NTHREADS = 512;
constexpr int LDS_BYTES = 147456;
constexpr int MISC_OFF = 131072 + 320;
#define LDS_WAIT() asm volatile("s_waitcnt lgkmcnt(0)" ::: "memory")

struct Args { const float* in[22]; float* out; unsigned char* ws; int ph_lo, ph_hi; };

enum { MAP_ID = 0, MAP_WIN, MAP_WUQ, MAP_WUKV, MAP_GATE, MAP_UP };
__device__ __forceinline__ int map_row(int map, int n) {
    if (map == MAP_WIN) {
        if (n < 384) return n;
        if (n < 416) { const int i = n - 384; return 384 + (i < 16 ? 2 * i : 2 * (i - 16) + 1); }
        return n + 96;
    }
    if (map == MAP_WUQ) { const int h = n / 96, j = n % 96; if (j < 64) return n; const int i = j - 64; return h * 96 + 64 + (i < 16 ? 2 * i : 2 * (i - 16) + 1); }
    if (map == MAP_WUKV) { const int h = n >> 7, j = n & 127; return j < 64 ? h * 64 + j : 512 + h * 64 + (j - 64); }
    if (map == MAP_GATE) return (n >> 7) * 256 + (n & 127);
    if (map == MAP_UP) return (n >> 7) * 256 + 128 + (n & 127);
    return n;
}
__device__ __forceinline__ void cvt_item(const float* src, int ldsrc, int nblk, const float* gain, float scale, bf16_t* dst, int lddst, int kdst0, int map, LAS float* scr, int item, int lane) {
    const int kb = item / nblk, nb = item % nblk, k0 = 64 * kb, n0 = 32 * nb;
    f32x4 v[8]; float gs[8];
#pragma unroll
    for (int i = 0; i < 8; ++i) { const int idx = i * 64 + lane, kk = idx >> 3, c4 = idx & 7; v[i] = *(const f32x4*)(src + (size_t)(k0 + kk) * ldsrc + n0 + 4 * c4); gs[i] = gain ? gain[k0 + kk] * scale : scale; }
#pragma unroll
    for (int i = 0; i < 8; ++i) { const int idx = i * 64 + lane, kk = idx >> 3, c4 = idx & 7; LAS float* d = scr + kk * 33 + 4 * c4; d[0] = v[i].x * gs[i]; d[1] = v[i].y * gs[i]; d[2] = v[i].z * gs[i]; d[3] = v[i].w * gs[i]; }
    LDS_WAIT(); asm volatile("" ::: "memory");
    const int c = lane & 7;
#pragma unroll
    for (int j = 0; j < 4; ++j) { const int n = (lane >> 3) + 8 * j; const LAS float* s = scr + (8 * c) * 33 + n;
        u32x4 o; o.x = cvt_pk_bf16(s[0 * 33], s[1 * 33]); o.y = cvt_pk_bf16(s[2 * 33], s[3 * 33]); o.z = cvt_pk_bf16(s[4 * 33], s[5 * 33]); o.w = cvt_pk_bf16(s[6 * 33], s[7 * 33]);
        *(u32x4*)(dst + (size_t)map_row(map, n0 + n) * lddst + kdst0 + k0 + 8 * c) = o; }
    LDS_WAIT(); asm volatile("" ::: "memory");
}

struct Ctx {
    LAS unsigned char* lds; int tid, lane, wave, vcu, G, gw, NGW;
    const float* const* in; float* out; unsigned char* ws;
};

__device__ __forceinline__ void phase_prologue(const Ctx& C) {
    LAS float* scr = (LAS float*)(C.lds + C.wave * 16384);
    unsigned char* ws = C.ws;
    constexpr int I_IN = 16 * 181, I_UQ = 4 * 24, I_UKV = 2 * 32, I_BR = 8 * 32, I_OUT = 16 * 32, I_L = I_IN + I_UQ + I_UKV + 3 * I_BR + I_OUT;
    constexpr int I_G = 16 * 88, I_D = 44 * 32, NIT = 2 * I_L + 2 * I_G + I_D;
    for (int it = C.gw; it < NIT; it += C.NGW) {
        int r = it;
        if (r < 2 * I_L) { const int l = r / I_L; r -= l * I_L;
            if (r < I_IN) { cvt_item(C.in[2] + (size_t)l * DM * INC, INC, 181, C.in[1] + l * DM, 1.f, (bf16_t*)(ws + WS_WIN + l * SZ_WIN), DM, 0, MAP_WIN, scr, r, C.lane); continue; } r -= I_IN;
            if (r < I_UQ) { cvt_item(C.in[4] + (size_t)l * 256 * 768, 768, 24, C.in[3] + l * 256, 0.10206207261596577f * LOG2E, (bf16_t*)(ws + WS_WUQ + l * SZ_WUQ), 256, 0, MAP_WUQ, scr, r, C.lane); continue; } r -= I_UQ;
            if (r < I_UKV) { cvt_item(C.in[6] + (size_t)l * 128 * 1024, 1024, 32, C.in[5] + l * 128, 1.f, (bf16_t*)(ws + WS_WUKV + l * SZ_WUKV), 256, 0, MAP_WUKV, scr, r, C.lane); continue; } r -= I_UKV;
            if (r < 3 * I_BR) { const int br = r / I_BR; r -= br * I_BR; cvt_item(C.in[9 + br] + (size_t)l * 512 * DM, DM, 32, nullptr, 1.f, (bf16_t*)(ws + WS_WBR + l * SZ_WBR), 1536, br * 512, MAP_ID, scr, r, C.lane); continue; } r -= 3 * I_BR;
            cvt_item(C.in[12] + (size_t)l * DM * DM, DM, 32, nullptr, 1.f, (bf16_t*)(ws + WS_WOUT + l * SZ_WOUT), DM, 0, MAP_ID, scr, r, C.lane); continue; }
        r -= 2 * I_L;
        if (r < I_G) { cvt_item(C.in[14], DFF, 88, C.in[13], 1.f, (bf16_t*)(ws + WS_WGU), DM, 0, MAP_GATE, scr, r, C.lane); continue; } r -= I_G;
        if (r < I_G) { cvt_item(C.in[15], DFF, 88, C.in[13], 1.f, (bf16_t*)(ws + WS_WGU), DM, 0, MAP_UP, scr, r, C.lane); continue; } r -= I_G;
        cvt_item(C.in[16], DM, 32, nullptr, 1.f, (bf16_t*)(ws + WS_WD), DFF, 0, MAP_ID, scr, r, C.lane);
    }
    const int gt = C.vcu * NTHREADS + C.tid, NGT = C.G * NTHREADS;
    for (int i = gt; i < 2 * (12288 + 16384); i += NGT) { const int l = i / (12288 + 16384); int r = i % (12288 + 16384); const u32x4 z = {0u, 0u, 0u, 0u};
        if (r < 12288) *(u32x4*)(ws + WS_WIN + l * SZ_WIN + (size_t)416 * DM * 2 + (size_t)r * 16) = z;
        else { r -= 12288; *(u32x4*)(ws + WS_WUKV + l * SZ_WUKV + (size_t)(r >> 4) * 512 + 256 + (r & 15) * 16) = z; } }
    float* cosT = (float*)(ws + WS_TAB); float* sinT = cosT + SEQ * 16; float* tabb = sinT + SEQ * 16;
    for (int i = gt; i < SEQ * 16; i += NGT) { const int pos = i >> 4, k = i & 15; const float inv = powf(10000.f, -(float)k / 16.f); const float ang = (float)pos * inv; cosT[i] = cosf(ang); sinT[i] = sinf(ang); }
    for (int i = gt; i < 4 * 8 * att::TAB_STRIDE; i += NGT) { const int kind = i / (8 * att::TAB_STRIDE), h = (i / att::TAB_STRIDE) & 7, idx = i % att::TAB_STRIDE;
        const int R = kind == 3 ? 128 : 64, dil = kind == 1 ? 4 : (kind == 2 ? 16 : 1), rel = idx - (R + 31);
        float v = NEGB; if (rel >= -R && rel <= R) v = C.in[8][t5_bucket(rel * dil) * 16 + (kind == 3 ? 8 : 0) + h] * LOG2E;
        tabb[i] = v; }
    const float* x = C.in[0]; bf16_t* xb = (bf16_t*)(ws + WS_XB); float* st = (float*)(ws + WS_ST);
    for (int row = 2 * C.gw; row < MTOK; row += 2 * C.NGW) {
        const f32x4* xr = (const f32x4*)(x + (size_t)row * DM) + C.lane; f32x4 v[8];
#pragma unroll
        for (int j = 0; j < 8; ++j) v[j] = xr[64 * j];
        float s0 = 0.f, s1 = 0.f;
#pragma unroll
        for (int j = 0; j < 8; ++j) { const float q = (v[j].x * v[j].x + v[j].y * v[j].y) + (v[j].z * v[j].z + v[j].w * v[j].w); if (j < 4) s0 += q; else s1 += q;
            u32x2 w; w.x = cvt_pk_bf16(v[j].x, v[j].y); w.y = cvt_pk_bf16(v[j].z, v[j].w); *((u32x2*)(xb + (size_t)row * DM) + C.lane + 64 * j) = w; }
        s0 = wave_sum(s0); s1 = wave_sum(s1);
        if (C.lane < 32) st[(size_t)row * 16 + C.lane] = C.lane == 0 ? s0 : (C.lane == 16 ? s1 : 0.f);
    }
}

__device__ __forceinline__ void phase_moe_weights(const Ctx& C) {
    LAS float* scr = (LAS float*)(C.lds + 40960 + C.wave * 8704);
    constexpr int I_G = 16 * 112, I_D = 56 * 32, I_E = 2 * I_G + I_D;
    for (int it = C.gw; it < NEXP * I_E; it += C.NGW) {
        const int e = it / I_E; int r = it % I_E;
        if (r < I_G) { cvt_item(C.in[18] + (size_t)e * DM * DFE, DFE, 112, C.in[13] + DM, 1.f, (bf16_t*)(C.ws + WS_EGU) + (size_t)e * 2 * DFE * DM, DM, 0, MAP_GATE, scr, r, C.lane); continue; } r -= I_G;
        if (r < I_G) { cvt_item(C.in[19] + (size_t)e * DM * DFE, DFE, 112, C.in[13] + DM, 1.f, (bf16_t*)(C.ws + WS_EGU) + (size_t)e * 2 * DFE * DM, DM, 0, MAP_UP, scr, r, C.lane); continue; } r -= I_G;
        cvt_item(C.in[20] + (size_t)e * DFE * DM, DM, 32, nullptr, 1.f, (bf16_t*)(C.ws + WS_ED) + (size_t)e * DM * DFE, DFE, 0, MAP_ID, scr, r, C.lane);
    }
}

template <bool SECOND>
__device__ __forceinline__ void phase_band(const Ctx& C, const bf16_t* HM, bf16_t* PB, float* PBS, bf16_t* Y, const float* sink) {
    constexpr int IPK = MC / 2048 * 64, NIT = (SECOND ? 1 : 3) * IPK;
    const float* tabg = (const float*)(C.ws + WS_TAB) + 2 * SEQ * 16;
    att::BandPre P; att::BandItem it, nx;
    int i = C.vcu;
#define BAND_IDX(IDX) (SECOND ? 2 * IPK + (IDX) : ((IDX) < 2 * IPK ? (IDX) : (IDX) + IPK))
    if (i < NIT) { it = att::band_decode(BAND_IDX(i), IPK); att::band_issue(P, it, HM, tabg, C.tid, C.wave, C.lane); }
    for (; i < NIT; i += C.G) {
        att::band_store(P, it, C.lds, C.tid);
        bf16x8 qf[4];
#pragma unroll
        for (int d0 = 0; d0 < 4; ++d0) qf[d0] = P.q[d0];
        __syncthreads();
        const bool more = i + C.G < NIT;
        if (more) { nx = att::band_decode(BAND_IDX(i + C.G), IPK); att::band_issue(P, nx, HM, tabg, C.tid, C.wave, C.lane); }
        const int q = C.lane & 31, hi = C.lane >> 5, w = C.wave;
        if (it.kind == 3) {
            const int h = it.hh * 4 + (w >> 1), a0w = it.a0 + 32 * (w & 1); const size_t rowq = (size_t)it.b * SEQ + a0w + q;
            att::band_compute<9, 1>(qf, C.lds, 128 - it.a0, a0w, SEQ, (const LAS float*)(C.lds + att::BW_TAB) + (w >> 1) * att::TAB_STRIDE, Y + rowq * 1536 + 1024 + h * 64 + 4 * hi, nullptr, sink[h] * LOG2E, C.lane);
        } else if (it.kind == 2) {
            const int a0w = 32 * (w & 3), g = it.g0 + (w >> 2); const size_t rowq = (size_t)it.b * SEQ + (size_t)(a0w + q) * 16 + g;
            const size_t po = rowq * 512 + it.hh * 64 + 4 * hi, so = (rowq * 8 + it.hh) * 2;
            att::band_compute<5, 2>(qf, C.lds, (w >> 2) * 128, a0w, 128, (const LAS float*)(C.lds + att::BW_TAB), Y + rowq * 1536 + 512 + it.hh * 64 + 4 * hi, nullptr, 0.f, C.lane,
                                    PB + po, PB + (size_t)MC * 512 + po, PBS + so, PBS + (size_t)MC * 16 + so);
        } else {
            const int a0w = it.a0 + 32 * w, dil = it.kind == 0 ? 1 : 4, L = SEQ / dil, rowoff = 64 - it.a0;
            const size_t rowq = (size_t)it.b * SEQ + (size_t)(a0w + q) * dil + it.g0;
            att::band_compute<5, 0>(qf, C.lds, rowoff, a0w, L, (const LAS float*)(C.lds + att::BW_TAB), PB + (size_t)it.kind * MC * 512 + rowq * 512 + it.hh * 64 + 4 * hi,
                                    PBS + (size_t)it.kind * MC * 16 + (rowq * 8 + it.hh) * 2, 0.f, C.lane);
        }
        __syncthreads();
        it = nx;
    }
#undef BAND_IDX
}

__device__ __forceinline__ void phase_mla(const Ctx& C, const bf16_t* Q, const bf16_t* KV, const bf16_t* Zc, bf16_t* Y) {
    constexpr int NU = MC / 256 * 8;
    for (int u = C.vcu; u < NU; u += C.G) { const int qblk = u & 7, bh = u >> 3; att::mla_unit(Q, KV, Zc, Y, bh >> 3, bh & 7, qblk, C.lds, C.tid, C.wave, C.lane); }
}

__device__ __forceinline__ void phase_route(const Ctx& C) {
    LAS float* wr = (LAS float*)C.lds; LAS int* cnt = (LAS int*)(C.lds + 32768);
    const float* g2 = C.in[13] + DM; const float* router = C.in[17];
    for (int i = C.tid; i < DM * 8; i += NTHREADS) wr[i] = router[i] * g2[i >> 3];
    if (C.tid < 16) cnt[C.tid] = 0;
    __syncthreads();
    int* sel = (int*)(C.ws + WS_SEL); float* gwp = (float*)(C.ws + WS_GW); float* rr = (float*)(C.ws + WS_RR);
    const int w = blockIdx.x;
    for (int j = 0; j < 16; ++j) {
        const int tok = w * 128 + C.wave * 16 + j;
        const u32x2* xr = (const u32x2*)((const bf16_t*)(C.ws + WS_XB) + (size_t)tok * DM) + C.lane;
        float lg[8], ss = 0.f;
#pragma unroll
        for (int e = 0; e < 8; ++e) lg[e] = 0.f;
#pragma unroll
        for (int q = 0; q < 4; ++q) { const u32x2 wv = xr[64 * q]; const f32x4 v = {bf_lo(wv.x), bf_hi(wv.x), bf_lo(wv.y), bf_hi(wv.y)}; ss += (v.x * v.x + v.y * v.y) + (v.z * v.z + v.w * v.w);
            const int k = 4 * C.lane + 256 * q;
#pragma unroll
            for (int c = 0; c < 4; ++c) { const float xv = v[c]; const f32x4 w0 = *(const LAS f32x4*)(wr + (k + c) * 8), w1 = *(const LAS f32x4*)(wr + (k + c) * 8 + 4);
                lg[0] += xv * w0.x; lg[1] += xv * w0.y; lg[2] += xv * w0.z; lg[3] += xv * w0.w; lg[4] += xv * w1.x; lg[5] += xv * w1.y; lg[6] += xv * w1.z; lg[7] += xv * w1.w; } }
        ss = wave_sum(ss);
#pragma unroll
        for (int e = 0; e < 8; ++e) lg[e] = wave_sum(lg[e]);
        const float r = rsqrtf(ss * (1.f / 1024.f) + EPS);
        if (C.lane == 0) {
            int i1 = 0; float v1 = lg[0];
#pragma unroll
            for (int e = 1; e < 8; ++e) if (lg[e] > v1) { v1 = lg[e]; i1 = e; }
            int i2 = -1; float v2 = -3e38f;
#pragma unroll
            for (int e = 0; e < 8; ++e) if (e != i1 && lg[e] > v2) { v2 = lg[e]; i2 = e; }
            const float e2 = expf((v2 - v1) * r);
            sel[tok * 2] = i1; sel[tok * 2 + 1] = i2; gwp[tok * 2] = 1.f / (1.f + e2); gwp[tok * 2 + 1] = e2 / (1.f + e2); rr[tok] = r;
            __hip_atomic_fetch_add(&cnt[i1], 1, __ATOMIC_RELAXED, __HIP_MEMORY_SCOPE_WORKGROUP); __hip_atomic_fetch_add(&cnt[8 + i2], 1, __ATOMIC_RELAXED, __HIP_MEMORY_SCOPE_WORKGROUP);
        }
    }
    __syncthreads();
    if (C.tid < 16) ((int*)(C.ws + WS_META))[MI_CNT + (C.tid >> 3) * 2048 + w * 8 + (C.tid & 7)] = cnt[C.tid];
}

__device__ __forceinline__ void phase_sort(const Ctx& C) {
    LAS int* tot = (LAS int*)C.lds; LAS int* pre = tot + 16; LAS int* base = tot + 32;
    int* meta = (int*)(C.ws + WS_META); const int w = blockIdx.x;
    if (C.tid < 16) { const int k = C.tid >> 3, e = C.tid & 7; int t = 0, p = 0;
        for (int w2 = 0; w2 < 256; ++w2) { const int c = meta[MI_CNT + k * 2048 + w2 * 8 + e]; t += c; if (w2 < w) p += c; }
        tot[C.tid] = t; pre[C.tid] = p; }
    __syncthreads();
    if (C.tid < 16) { const int k = C.tid >> 3, e = C.tid & 7; int b = 0; for (int e2 = 0; e2 < e; ++e2) b += (tot[k * 8 + e2] + 255) & ~255; base[C.tid] = b; }
    __syncthreads();
    const int* sel = (const int*)(C.ws + WS_SEL); const float* gwp = (const float*)(C.ws + WS_GW);
    int* rowtok = (int*)(C.ws + WS_ROWTOK); float* rowgw = (float*)(C.ws + WS_ROWGW); float* rowrr = (float*)(C.ws + WS_ROWRR); const float* rr = (const float*)(C.ws + WS_RR);
    if (C.wave < 2) { const int k = C.wave; LAS int* runL = tot + 48 + k * 8;
        if (C.lane < 8) runL[C.lane] = base[k * 8 + C.lane] + pre[k * 8 + C.lane];
        for (int j = 0; j < 2; ++j) { const int tok = w * 128 + j * 64 + C.lane; const int e = sel[tok * 2 + k]; int pos = 0;
#pragma unroll 1
            for (int e2 = 0; e2 < 8; ++e2) { const unsigned long long mk = __ballot(e == e2); const int r0 = runL[e2]; const int rank = __popcll(mk & ((1ull << C.lane) - 1ull));
                if (e == e2) pos = r0 + rank; if (C.lane == 0) runL[e2] = r0 + __popcll(mk); }
            rowtok[k * MOE_ROWS + pos] = tok; rowgw[k * MOE_ROWS + pos] = gwp[tok * 2 + k]; rowrr[k * MOE_ROWS + pos] = rr[tok]; } }
    if (w < 16) { const int k = w >> 3, e = w & 7; const int t = tot[k * 8 + e], b = base[k * 8 + e], pe = (t + 255) & ~255;
        for (int i = b + t + C.tid; i < b + pe; i += NTHREADS) { rowtok[k * MOE_ROWS + i] = -1; rowgw[k * MOE_ROWS + i] = 0.f; rowrr[k * MOE_ROWS + i] = 0.f; } }
    if (w == 16 && C.tid < 2) { const int k = C.tid; int nt = 0;
        for (int e = 0; e < 8; ++e) { const int n = (tot[k * 8 + e] + 255) >> 8; for (int i = 0; i < n; ++i) meta[MI_TILEE + k * 160 + nt + i] = e; nt += n; }
        meta[MI_NTILE + k] = nt; }
}

__device__ __forceinline__ void phase_final(const Ctx& C) {
    const float* g = C.in[21];
    for (int row = 2 * C.gw; row < MTOK; row += 2 * C.NGW) {
        f32x4 v[8]; float s0 = 0.f, s1 = 0.f;
#pragma unroll
        for (int j = 0; j < 8; ++j) { const u32x2 wv = ((const u32x2*)xm_row(C.ws, row + (j >> 2)))[C.lane + 64 * (j & 3)]; v[j] = (f32x4){bf_lo(wv.x), bf_hi(wv.x), bf_lo(wv.y), bf_hi(wv.y)}; }
#pragma unroll
        for (int j = 0; j < 8; ++j) { const float q = (v[j].x * v[j].x + v[j].y * v[j].y) + (v[j].z * v[j].z + v[j].w * v[j].w); if (j < 4) s0 += q; else s1 += q; }
        const float r0 = rsqrtf(wave_sum(s0) * (1.f / 1024.f) + EPS), r1 = rsqrtf(wave_sum(s1) * (1.f / 1024.f) + EPS);
        f32x4* orow = (f32x4*)(C.out + (size_t)row * DM) + C.lane;
#pragma unroll
        for (int j = 0; j < 8; ++j) orow[64 * j] = v[j] * (j < 4 ? r0 : r1) * ((const f32x4*)g)[C.lane + 64 * (j & 3)];
    }
}
#ifndef MKP
#define MKP 0x1ffff
#endif
#ifndef ALEPI
#define ALEPI true
#endif
#ifndef ALEPI1
#define ALEPI1 ALEPI
#endif
#ifndef DUPK
#define DUPK 0
#endif
#define REP(bit) for (int rep_ = 0; rep_ < ((DUPK & (bit)) ? 2 : 1); ++rep_)
constexpr int PH_PER_CHUNK = 3, PH_LAYER_TAIL = 2;
constexpr int PH_L0 = 1, PH_FFN = PH_L0 + PH_PER_CHUNK * NCHUNK + PH_LAYER_TAIL, PH_L1 = PH_FFN + 2, PH_MOE = PH_L1 + PH_PER_CHUNK * NCHUNK + PH_LAYER_TAIL, PH_FINAL = PH_MOE + 7, PH_TOTAL = PH_FINAL + 1;

__global__ void __launch_bounds__(NTHREADS, 2) mega(Args args) {
    extern __shared__ __attribute__((aligned(16))) unsigned char lds_raw[];
#define MKCTX Ctx C; { int t_ = threadIdx.x; asm volatile("" : "+v"(t_)); C.lds = (LAS unsigned char*)lds_raw; C.tid = t_; C.lane = t_ & 63; C.wave = __builtin_amdgcn_readfirstlane(t_ >> 6); \
    C.G = gridDim.x; { const int bx = blockIdx.x; C.vcu = (C.G % 8 == 0) ? (bx % 8) * (C.G / 8) + bx / 8 : bx; } \
    C.gw = C.vcu * NWAVES + C.wave; C.NGW = C.G * NWAVES; C.in = args.in; C.out = args.out; C.ws = args.ws; }
    volatile LAS unsigned* MISC = (volatile LAS unsigned*)((LAS unsigned char*)lds_raw + MISC_OFF);
    if (threadIdx.x < 32) MISC[threadIdx.x] = 0u;
    __syncthreads();
    unsigned char* ws = args.ws;
    XcdBarrier bar; bar.bar = (unsigned*)(ws + WS_CTL) + CW_BAR; bar.x = 0; bar.st = nullptr;
    const int lo = args.ph_lo, hi = args.ph_hi;
    const bool use_bar = (hi - lo) > 1;
    if (use_bar) bar = xcd_barrier_post((unsigned*)(ws + WS_CTL) + CW_BAR, MISC + 8);
    int ph = 0;
#define IN_PH (ph >= lo && ph < hi)
#define END_PH do { if (ph >= lo && ph + 1 < hi) xcd_barrier(bar); ++ph; } while (0)

    bf16_t* xb = (bf16_t*)(ws + WS_XB); float* st = (float*)(ws + WS_ST);
    const float* cosT = (const float*)(ws + WS_TAB); const float* sinT = cosT + SEQ * 16;

    if (IN_PH) REP(1) { MKCTX; if (MKP & 1) phase_prologue(C); }
    END_PH;

#define CHUNK_BODY(l, c) \
{ \
            const int row0 = c * MC; \
            bf16_t* Z = (bf16_t*)(ws + WS_Z); bf16_t* Q = (bf16_t*)(ws + WS_Q); bf16_t* KV = TMP_IN_OUT ? (bf16_t*)args.out : (bf16_t*)(ws + WS_KV); bf16_t* Y = (bf16_t*)(ws + WS_Y) + (size_t)row0 * 1536; \
            bf16_t* PB = TMP_IN_OUT ? (bf16_t*)args.out + (size_t)MC * 1024 : (bf16_t*)(ws + WS_PB); float* PBS = (float*)(ws + WS_PBS); float* SQ = (float*)(ws + WS_SQ); float* SKV = SQ + (size_t)MC * 4; \
 \
            if (IN_PH && (MKP & 2)) REP(2) { MKCTX; \
                pg8::Gemm g{xb + (size_t)row0 * DM, (const bf16_t*)(ws + WS_WIN + l * SZ_WIN), DM, DM, DM, nullptr}; \
                pg8::StaticOrder S; S.init(MC, ZN, C.G, (int)blockIdx.x); \
                pg8::EpiIn E{Z, st + (size_t)row0 * 16, SQ, SKV, cosT, sinT, ws + WS_GB + (size_t)row0 * 3072, (bf16_t*)(ws + WS_QKV), ws}; \
                pg8::gemm_phase<pg8::EpiIn, pg8::StaticOrder, ALEPI1, false>(C.lds, g, S, E); \
            } \
            END_PH; \
 \
            if (IN_PH) { \
                if (MKP & 4) REP(4) { MKCTX; pg8::Gemm g{Z + ZO_CQ, (const bf16_t*)(ws + WS_WUQ + l * SZ_WUQ), 256, ZW, 256, nullptr}; \
                  pg8::StaticOrder S; S.init(MC, 768, C.G, (int)blockIdx.x); \
                  pg8::EpiQ E{Q, SQ, cosT, sinT}; \
                  pg8::gemm_phase<pg8::EpiQ, pg8::StaticOrder, ALEPI, false>(C.lds, g, S, E); } \
                if (MKP & 8) REP(8) { MKCTX; pg8::Gemm g{Z + ZO_CKV, (const bf16_t*)(ws + WS_WUKV + l * SZ_WUKV), 256, ZW, 256, nullptr}; \
                  pg8::StaticOrder S; S.init(MC, 1024, C.G, (int)((blockIdx.x + 128) % C.G)); \
                  pg8::EpiKV E{KV, SKV}; \
                  pg8::gemm_phase<pg8::EpiKV, pg8::StaticOrder, ALEPI, false>(C.lds, g, S, E); } \
                if (MKP & 16) REP(16) { MKCTX; phase_band<false>(C, (const bf16_t*)(ws + WS_QKV), PB, PBS, Y, C.in[7] + l * 8); } \
            } \
            END_PH; \
 \
            if (IN_PH) { \
                if (MKP & 32) REP(32) { MKCTX; phase_band<true>(C, (const bf16_t*)(ws + WS_QKV), PB, PBS, Y, C.in[7] + l * 8); } \
                if (MKP & 64) REP(64) { MKCTX; phase_mla(C, Q, KV, Z, Y); } \
            } \
            END_PH; \
 \
}
#define LAYER_TAIL(l) \
{ const int row0 = 0; bf16_t* MG = (bf16_t*)(ws + WS_MG); bf16_t* Y = (bf16_t*)(ws + WS_Y); (void)Y; \
            if (IN_PH && (MKP & 128)) REP(128) { MKCTX; \
                pg8::Gemm g{Y, (const bf16_t*)(ws + WS_WBR + l * SZ_WBR), 1536, 1536, 1536, nullptr}; \
                pg8::StaticOrder S; S.init(MTOK, DM, C.G, (int)blockIdx.x); \
                pg8::EpiBr E{ws + WS_GB, MG, ws}; \
                pg8::gemm_phase<pg8::EpiBr, pg8::StaticOrder, ALEPI, false>(C.lds, g, S, E); \
            } \
            END_PH; \
 \
            if (IN_PH && (MKP & 256)) REP(l == 0 ? 256 : 0) { MKCTX; \
                pg8::Gemm g{MG, (const bf16_t*)(ws + WS_WOUT + l * SZ_WOUT), DM, DM, DM, nullptr}; \
                pg8::StaticOrder S; S.init(MTOK, DM, C.G, (int)blockIdx.x); \
                pg8::EpiRes<false> E{xb, st, row0, nullptr}; pg8::gemm_phase<pg8::EpiRes<false>, pg8::StaticOrder, ALEPI, false, true>(C.lds, g, S, E); \
            } \
            END_PH; \
}
#define FFN_BODY() \
{ \
            bf16_t* ACT = (bf16_t*)(ws + WS_ACT); \
            if (IN_PH && (MKP & 512)) REP(512) { MKCTX; \
                pg8::Gemm g{xb, (const bf16_t*)(ws + WS_WGU), DM, DM, DM, nullptr}; \
                pg8::StaticOrder S; S.init(MTOK, 2 * DFF, C.G, (int)blockIdx.x); \
                pg8::EpiGU E{ACT, st, DFF, ws}; \
                pg8::gemm_phase<pg8::EpiGU, pg8::StaticOrder, ALEPI, false>(C.lds, g, S, E); \
            } \
            END_PH; \
            if (IN_PH && (MKP & 1024)) { MKCTX; \
                pg8::Gemm g{ACT, (const bf16_t*)(ws + WS_WD), DFF, DFF, DFF, nullptr}; \
                pg8::StaticOrder S; S.init(MTOK, DM, C.G, (int)blockIdx.x); \
                pg8::EpiRes<false> E{xb, st, 0, nullptr}; \
                pg8::gemm_phase<pg8::EpiRes<false>, pg8::StaticOrder, ALEPI, false, true>(C.lds, g, S, E); \
            } \
            END_PH; \
}
#define MOE_HEAD() \
{ \
            if (IN_PH) { if (MKP & 2048) REP(2048) { MKCTX; phase_route(C); } if (MKP & 4096) REP(4096) { MKCTX; phase_moe_weights(C); } } \
            END_PH; \
            if (IN_PH && (MKP & 8192)) { MKCTX; phase_sort(C); } \
            END_PH; \
}
#define MOE_GU(kh, dyn) { const int k = (kh) >> 1, half = (kh) & 1; MKCTX; \
        const int* rowtok = (const int*)(ws + WS_ROWTOK) + k * MOE_ROWS; \
        bf16_t* MACT = (bf16_t*)(ws + WS_MACT) + (size_t)half * MOE_ROWS * DF0; const int dfw = half ? DF1 : DF0; \
        pg8::Gemm g{xb, (const bf16_t*)(ws + WS_EGU), DM, DM, DM, rowtok}; \
        pg8::DynMoeOrder S{(unsigned*)(ws + WS_CTL) + CW_Q + 64 * (kh), (volatile LAS int*)(C.lds + MISC_OFF + 64), meta[MI_NTILE + k], dfw / 128, 28, half ? DF0 / 128 : 0, meta + MI_TILEE + k * 160, C.vcu}; \
        pg8::EpiGUMoe E{MACT, (const float*)(ws + WS_ROWRR) + k * MOE_ROWS, dfw, ws}; \
        pg8::gemm_phase<pg8::EpiGUMoe, pg8::DynMoeOrder, ALEPI, true>(C.lds, g, S, E); }
#define MOE_DN(kh) { const int k = (kh) >> 1, half = (kh) & 1; MKCTX; \
        const int* rowtok = (const int*)(ws + WS_ROWTOK) + k * MOE_ROWS; const float* rowgw = (const float*)(ws + WS_ROWGW) + k * MOE_ROWS; \
        bf16_t* MACT = (bf16_t*)(ws + WS_MACT) + (size_t)half * MOE_ROWS * DF0; const int dfw = half ? DF1 : DF0; \
        pg8::Gemm g{MACT, (const bf16_t*)(ws + WS_ED) + half * DF0, dfw, dfw, DFE, nullptr}; \
        pg8::MoeOrder S{meta[MI_NTILE + k], 4, C.G, (int)blockIdx.x, 4, 0, meta + MI_TILEE + k * 160}; \
        if ((kh) == 0) { pg8::EpiDnMoe<true> E{ws, rowtok, rowgw}; pg8::gemm_phase<pg8::EpiDnMoe<true>, pg8::MoeOrder, ALEPI, false, true>(C.lds, g, S, E); } \
        else { pg8::EpiDnMoe<false> E{ws, rowtok, rowgw}; pg8::gemm_phase<pg8::EpiDnMoe<false>, pg8::MoeOrder, ALEPI, false, true>(C.lds, g, S, E); } }
    CHUNK_BODY(0, 0)
#if CHB < 16
    CHUNK_BODY(0, 1)
#endif
#if CHB < 8
    CHUNK_BODY(0, 2)
    CHUNK_BODY(0, 3)
#endif
    LAYER_TAIL(0)
    FFN_BODY()
    CHUNK_BODY(1, 0)
#if CHB < 16
    CHUNK_BODY(1, 1)
#endif
#if CHB < 8
    CHUNK_BODY(1, 2)
    CHUNK_BODY(1, 3)
#endif
    LAYER_TAIL(1)
    MOE_HEAD()
    { const int* meta = (const int*)(ws + WS_META);
    if (IN_PH) { if (MKP & 16384) REP(16384) MOE_GU(0, 1) }
    END_PH;
    if (IN_PH) { if (MKP & 32768) MOE_DN(0) if (MKP & 16384) MOE_GU(1, 1) }
    END_PH;
    if (IN_PH) { if (MKP & 32768) MOE_DN(1) if (MKP & 16384) MOE_GU(2, 1) }
    END_PH;
    if (IN_PH) { if (MKP & 32768) MOE_DN(2) if (MKP & 16384) MOE_GU(3, 1) }
    END_PH;
    if (IN_PH) { if (MKP & 32768) MOE_DN(3) }
    END_PH;
    }
    if (IN_PH && (MKP & 65536)) { MKCTX; phase_final(C); }
    END_PH;
#undef IN_PH
#undef END_PH
}
#if !MK_DEBUG
extern "C" void kernel_launch(void* const* d_in, const int* in_sizes, int n_in, void* d_out, int out_size, void* d_ws, size_t ws_size, hipStream_t stream) {
    static int grid = 0;
    if (grid == 0) {
        if (n_in != 22 || out_size != MTOK * DM || ws_size < WS_NEED) { fprintf(stderr, "kernel_launch: unexpected shapes / workspace (%zu < %zu); nothing launched\n", ws_size, (size_t)WS_NEED); grid = -1; return; }
        int dev = 0, cus = 0, per_cu = 0;
        if (hipGetDevice(&dev) != hipSuccess || hipDeviceGetAttribute(&cus, hipDeviceAttributeMultiprocessorCount, dev) != hipSuccess) { grid = -1; return; }
        if (hipFuncSetAttribute((const void*)mega, hipFuncAttributeMaxDynamicSharedMemorySize, LDS_BYTES) != hipSuccess) { fprintf(stderr, "kernel_launch: hipFuncSetAttribute failed\n"); grid = -1; return; }
        if (hipOccupancyMaxActiveBlocksPerMultiprocessor(&per_cu, (const void*)mega, NTHREADS, LDS_BYTES) != hipSuccess || per_cu < 1) { fprintf(stderr, "kernel_launch: occupancy query says %d\n", per_cu); }
        (void)hipGetLastError();
        grid = cus;
        if (grid != 256) { fprintf(stderr, "kernel_launch: built for 256 CUs, device has %d; nothing launched\n", cus); grid = -1; return; }
    }
    if (grid < 0) return;
    if (hipMemsetAsync((char*)d_ws + WS_CTL, 0, CTL_ZERO_BYTES, stream) != hipSuccess) return;
    Args a{};
    for (int i = 0; i < 22; ++i) a.in[i] = (const float*)d_in[i];
    a.out = (float*)d_out; a.ws = (unsigned char*)d_ws; a.ph_lo = 0; a.ph_hi = PH_TOTAL;
    hipLaunchKernelGGL(mega, dim3(grid), dim3(NTHREADS), LDS_BYTES, stream, a);
}
#endif
```

```cpp
#include <hip/hip_runtime.h>
#include <cstdio>
#include <cstdint>
#include <cmath>

#ifndef MK_DEBUG
#define MK_DEBUG 0
#endif
#ifndef MOE_F8
#define MOE_F8 1
#endif
#ifndef MOE_DN_F8
#define MOE_DN_F8 1
#endif
#ifndef MOE_NOSPLIT
#define MOE_NOSPLIT 1
#endif
#ifndef P1_F8_FROM
#define P1_F8_FROM 0
#endif
#ifndef CHB
#define CHB 8
#endif

#define GAS __attribute__((address_space(1)))
#define LAS __attribute__((address_space(3)))
typedef unsigned short bf16_t;
typedef short bf16x8 __attribute__((ext_vector_type(8)));
typedef short s16x4 __attribute__((ext_vector_type(4)));
typedef float f32x4 __attribute__((ext_vector_type(4)));
typedef float f32x2 __attribute__((ext_vector_type(2)));
typedef float f32x16 __attribute__((ext_vector_type(16)));
typedef unsigned u32x4 __attribute__((ext_vector_type(4)));
typedef unsigned u32x2 __attribute__((ext_vector_type(2)));
typedef __bf16 bf16x2_t __attribute__((ext_vector_type(2)));

constexpr int SEQ = 2048, DM = 1024, NBATCH = 16, MTOK = NBATCH * SEQ;
constexpr int MC = CHB * SEQ, NCHUNK = NBATCH / CHB;
constexpr int INC = 5792, ZW = 512, ZN = 5888;
constexpr int ZO_CQ = 0, ZO_CKV = 256, ZO_KPE = 384, ZO_QB = 512, ZO_KB = 1024, ZO_VB = 1536, ZO_QC = 2048, ZO_KC = 2560, ZO_VC = 2688, ZO_G = 2816;
constexpr int DFF = 2816, DFE = 3584, NEXP = 8;
constexpr int DF0 = 1792, DF1 = DFE - DF0;
constexpr float EPS = 1e-6f, LOG2E = 1.4426950408889634f;
constexpr float NEGB = -1e30f;
constexpr int MOE_ROWS = MTOK + NEXP * 256;

constexpr size_t MiB = 1u << 20;
constexpr size_t WS_CTL = 0, CTL_ZERO_BYTES = 256 * 1024;
constexpr size_t WS_META = 256 * 1024;
constexpr size_t WS_TAB = 1 * MiB;
constexpr size_t WS_WIN = 2 * MiB;
constexpr size_t SZ_WIN = (size_t)ZN * DM * 2;
constexpr size_t WS_WUQ = WS_WIN + 2 * SZ_WIN;
constexpr size_t SZ_WUQ = (size_t)768 * 256 * 2;
constexpr size_t WS_WUKV = WS_WUQ + 2 * SZ_WUQ;
constexpr size_t SZ_WUKV = (size_t)1024 * 256 * 2;
constexpr size_t WS_WBR = WS_WUKV + 2 * SZ_WUKV;
constexpr size_t SZ_WBR = (size_t)1024 * 1536 * 2;
constexpr size_t WS_WOUT = WS_WBR + 2 * SZ_WBR;
constexpr size_t SZ_WOUT = (size_t)1024 * 1024 * 2;
constexpr size_t WS_WGU = WS_WOUT + 2 * SZ_WOUT;
constexpr size_t WS_WD = WS_WGU + (size_t)2 * DFF * DM * 2;
constexpr size_t WS_SMALL_END = WS_WD + (size_t)DM * DFF * 2;
static_assert(WS_SMALL_END <= 54 * MiB, "small weights");
constexpr size_t WS_XB = 54 * MiB;
constexpr size_t WS_ST = 118 * MiB;
constexpr size_t WS_RR = 120 * MiB;
constexpr size_t WS_SEL = WS_RR + (size_t)MTOK * 4;
constexpr size_t WS_GW = WS_SEL + (size_t)MTOK * 8;
constexpr size_t WS_ROWTOK = WS_GW + (size_t)MTOK * 8;
constexpr size_t WS_ROWGW = WS_ROWTOK + (size_t)2 * MOE_ROWS * 4;
constexpr size_t WS_ROWRR = WS_ROWGW + (size_t)2 * MOE_ROWS * 4;
constexpr size_t WS_T = 122 * MiB;
static_assert(WS_ROWRR + (size_t)2 * MOE_ROWS * 4 <= WS_T, "fixed region");
constexpr size_t WS_GB = WS_T;
constexpr size_t WS_Y = WS_GB + (size_t)MTOK * 3072;
constexpr size_t WS_CH = WS_Y + (size_t)MTOK * 1536 * 2;
constexpr size_t WS_Z = WS_CH;
constexpr size_t WS_QKV = WS_Z + (size_t)MC * ZW * 2;
constexpr size_t SZ_H8 = (size_t)MC * 512 * 2, SZ_H2 = (size_t)MC * 128 * 2;
constexpr size_t WS_Q = WS_QKV + 4 * SZ_H8 + 2 * SZ_H2;
constexpr bool TMP_IN_OUT = (CHB == 16);
constexpr size_t WS_KV = WS_Q + (size_t)MC * 768 * 2;
constexpr size_t WS_PB = WS_KV + (TMP_IN_OUT ? 0 : (size_t)MC * 1024 * 2);
constexpr size_t WS_PBS = WS_PB + (TMP_IN_OUT ? 0 : (size_t)2 * MC * 512 * 2);
constexpr size_t WS_SQ = WS_PBS + (size_t)2 * MC * 16 * 4;
constexpr size_t WS_MIX_END = WS_SQ + (size_t)2 * MC * 4 * 4;
constexpr size_t WS_XB8P = (size_t)496 * MiB;
constexpr size_t WS_WIN8 = WS_XB8P + (size_t)MTOK * DM;
constexpr size_t SZ_WIN8 = (size_t)(23 - P1_F8_FROM) * 256 * DM;
static_assert(WS_XB8P >= WS_MIX_END && WS_WIN8 + 2 * SZ_WIN8 <= (size_t)564 * MiB, "fp8 input-projection buffers");
constexpr size_t WS_MG = WS_CH;
static_assert(WS_MG + (size_t)MTOK * 1024 * 2 <= (size_t)564 * MiB, "MG placement");
constexpr size_t WS_ACT = WS_T;
constexpr size_t WS_EGU = WS_T;
constexpr size_t WS_XB8 = WS_EGU + (size_t)NEXP * 2 * DFE * DM;
constexpr size_t WS_ED = WS_EGU + (size_t)NEXP * 2 * DFE * DM * 2;
constexpr size_t WS_MACT = WS_ED + (size_t)NEXP * DM * DFE * 2;
constexpr size_t WS_MOE_END = WS_MACT + (size_t)MOE_ROWS * DFE * 2;
constexpr size_t WS_NEED_ = (WS_MOE_END > WS_MIX_END ? WS_MOE_END : WS_MIX_END);
constexpr size_t WS_NEED = WS_MOE_END + (size_t)(MTOK - 26624) * DM * 2 > WS_NEED_ ? WS_MOE_END + (size_t)(MTOK - 26624) * DM * 2 : WS_NEED_;
static_assert(WS_NEED <= (size_t)564 * MiB, "workspace budget");

constexpr int XM_SPLIT = 26624;
constexpr size_t WS_XM_HI = WS_MOE_END;
static_assert((size_t)XM_SPLIT * DM * 2 <= WS_XB - WS_WIN && WS_XM_HI + (size_t)(MTOK - XM_SPLIT) * DM * 2 <= (size_t)564 * MiB, "XM placement");
__device__ __forceinline__ bf16_t* xm_row(unsigned char* ws, int tok) { return tok < XM_SPLIT ? (bf16_t*)(ws + WS_WIN) + (size_t)tok * DM : (bf16_t*)(ws + WS_XM_HI) + (size_t)(tok - XM_SPLIT) * DM; }

constexpr int CW_BAR = 4096, CW_Q = 8192;
constexpr int MI_CNT = 0, MI_NTILE = 4120, MI_TILEE = 4128;

__device__ __forceinline__ unsigned cvt_pk_bf16(float lo, float hi) { f32x2 v = {lo, hi}; bf16x2_t b = __builtin_convertvector(v, bf16x2_t); return __builtin_bit_cast(unsigned, b); }
__device__ __forceinline__ unsigned pk_fp8x4(float a, float b, float c, float d) {
    a = __builtin_fminf(__builtin_fmaxf(a, -448.f), 448.f); b = __builtin_fminf(__builtin_fmaxf(b, -448.f), 448.f); c = __builtin_fminf(__builtin_fmaxf(c, -448.f), 448.f); d = __builtin_fminf(__builtin_fmaxf(d, -448.f), 448.f);
    int w = 0; w = __builtin_amdgcn_cvt_pk_fp8_f32(a, b, w, false); w = __builtin_amdgcn_cvt_pk_fp8_f32(c, d, w, true); return (unsigned)w; }
__device__ __forceinline__ float bf_lo(unsigned w) { return __builtin_bit_cast(float, w << 16); }
__device__ __forceinline__ float bf_hi(unsigned w) { return __builtin_bit_cast(float, w & 0xffff0000u); }
template <int O> __device__ __forceinline__ float swz_xor(float v) { return __builtin_bit_cast(float, __builtin_amdgcn_ds_swizzle(__builtin_bit_cast(int, v), (O << 10) | 0x1f)); }
__device__ __forceinline__ void swap32(float& a, float& b) { asm volatile("s_nop 1\n\tv_permlane32_swap_b32 %0, %1\n\ts_nop 1" : "+v"(a), "+v"(b)); }
__device__ __forceinline__ float xsum32(float v) { float a = v, b = v; swap32(a, b); return a + b; }
__device__ __forceinline__ float xmax32(float v) { float a = v, b = v; swap32(a, b); return fmaxf(a, b); }
__device__ __forceinline__ float wave_sum(float v) {
    v += swz_xor<1>(v); v += swz_xor<2>(v); v += swz_xor<4>(v); v += swz_xor<8>(v); v += swz_xor<16>(v);
    return xsum32(v);
}
__device__ __forceinline__ float fast_rcp(float x) { return __builtin_amdgcn_rcpf(x); }
__device__ __forceinline__ float fast_exp2(float x) { return __builtin_amdgcn_exp2f(x); }
__device__ __forceinline__ float sigmoidf_(float v) { return fast_rcp(1.f + fast_exp2(-v * LOG2E)); }
__device__ __forceinline__ int t5_bucket(int rel) {
    const int ret = rel > 0 ? 16 : 0; const int n = rel < 0 ? -rel : rel;
    if (n < 8) return ret + n;
    int large = 8 + (int)(logf((float)n / 8.f) / logf(128.f) * 8.f);
    if (large > 15) large = 15;
    return ret + large;
}

#define XB_TMO      128
#define XB_XCNT(j)  (256  + 64 * (j))
#define XB_XSUB(j)  (1280 + 64 * (j))
#define XB_XGEN(j)  (2304 + 64 * (j))
#define XB_TOP      3328
#define XB_TOPGEN   3392
#define XCD_BAR_WORDS 3456
#define XB_SPIN_CAP (1u << 18)
__device__ __forceinline__ unsigned xb_ld(unsigned* p)              { return __hip_atomic_load(p, __ATOMIC_RELAXED, __HIP_MEMORY_SCOPE_AGENT); }
__device__ __forceinline__ unsigned xb_add(unsigned* p, unsigned v) { return __hip_atomic_fetch_add(p, v, __ATOMIC_RELAXED, __HIP_MEMORY_SCOPE_AGENT); }
__device__ __forceinline__ unsigned xb_xcc_id() { return (unsigned)__builtin_amdgcn_s_getreg((3 << 11) | 20) & 0xFu; }
#define XB_SPIN(cond, bar) do { unsigned _sp = 0; while (cond) { __builtin_amdgcn_s_sleep(1); \
    if ((++_sp & 255u) == 0u) { if (xb_ld(&(bar)[XB_TMO])) break; if (_sp > XB_SPIN_CAP) { atomicAdd(&(bar)[XB_TMO], 1u); break; } } } } while (0)
struct XcdBarrier { unsigned* bar; unsigned x; volatile LAS unsigned* st; };
__device__ __forceinline__ XcdBarrier xcd_barrier_post(unsigned* bar, volatile LAS unsigned* st) {
    XcdBarrier b; b.bar = bar; b.x = xb_xcc_id(); b.st = st;
    if (threadIdx.x == 0) (void)xb_add(&bar[XB_XCNT(b.x)], 1u);
    return b;
}
__device__ __forceinline__ void xcd_barrier_complete(unsigned* bar, unsigned x, unsigned& nloc, unsigned& nx) {
    const unsigned G = gridDim.x * gridDim.y * gridDim.z;
    unsigned sum, cnt, mine, sp = 0u;
    for (;;) {
        sum = 0u; cnt = 0u; mine = 0u;
#pragma unroll
        for (unsigned j = 0; j < 16; ++j) { const unsigned c = xb_ld(&bar[XB_XCNT(j)]); sum += c; cnt += (c > 0u) ? 1u : 0u; mine = (j == x) ? c : mine; }
        if (sum == G) break;
        __builtin_amdgcn_s_sleep(1);
        if ((++sp & 255u) == 0u) { if (xb_ld(&bar[XB_TMO])) break; if (sp > XB_SPIN_CAP) { atomicAdd(&bar[XB_TMO], 1u); break; } }
    }
    nloc = mine > 0u ? mine : 1u; nx = cnt > 0u ? cnt : 1u;
}
__device__ __forceinline__ void xcd_barrier(const XcdBarrier& b) {
    asm volatile("s_waitcnt vmcnt(0)" ::: "memory");
    __syncthreads();
    if (threadIdx.x == 0) {
        unsigned* bar = b.bar;
        __builtin_amdgcn_s_waitcnt(0);
        unsigned nloc = b.st[0], nx = b.st[1];
        if (nloc == 0u) { xcd_barrier_complete(bar, b.x, nloc, nx); b.st[0] = nloc; b.st[1] = nx; }
        const unsigned old = xb_add(&bar[XB_XSUB(b.x)], 1u);
        const unsigned gen = old / nloc;
        if (old + 1u == (gen + 1u) * nloc) {
            __builtin_amdgcn_fence(__ATOMIC_RELEASE, "agent");
            asm volatile("s_waitcnt vmcnt(0)" ::: "memory");
            const unsigned og = xb_add(&bar[XB_TOP], 1u);
            const unsigned tg = og / nx;
            if (og + 1u == (tg + 1u) * nx) xb_add(&bar[XB_TOPGEN], 1u);
            else XB_SPIN(xb_ld(&bar[XB_TOPGEN]) == tg, bar);
            __builtin_amdgcn_fence(__ATOMIC_ACQUIRE, "agent");
            xb_add(&bar[XB_XGEN(b.x)], 1u);
            asm volatile("s_waitcnt vmcnt(0)" ::: "memory");
        } else {
            XB_SPIN(xb_ld(&bar[XB_XGEN(b.x)]) == gen, bar);
            __builtin_amdgcn_fence(__ATOMIC_ACQUIRE, "agent");
            asm volatile("s_waitcnt vmcnt(0)" ::: "memory");
        }
    }
    __syncthreads();
}
#ifndef MOE_RGS
#define MOE_RGS 4
#endif
#ifndef MOE_RG
#define MOE_RG 4
#endif
#ifndef RELAXW
#define RELAXW 0
#endif
namespace pg8 {
constexpr int BM = 256, BK = 64, HALF = 128, HTB = HALF * BK * 2, STAGE_BYTES = 8 * HTB, NXCD = 8, WGM = 8;
__host__ __device__ __forceinline__ int lds_byte(int r, int c) { const int st = (r >> 4) * 2 + (c >> 5), rr = r & 15, cc = c & 31, ob = rr * 64 + cc * 2; return st * 1024 + (ob ^ (((ob >> 9) & 1) << 5)); }
__host__ __device__ __forceinline__ void stage_rc(int b, int& R, int& C) { const int st = b / 1024, sb = b % 1024, swz = sb ^ (((sb >> 9) & 1) << 5); R = (st >> 1) * 16 + swz / 64; C = (st & 1) * 32 + (swz % 64) / 2; }
__host__ __device__ __forceinline__ int perm32(int rho) { const int n = rho >> 4, i = rho & 15; return 8 * (i >> 2) + 4 * n + (i & 3); }

struct Unit { int pm, pn, aux; };
struct Gemm { const bf16_t* A; const bf16_t* Bt; int K, lda, ldb; const int* gidx; };

struct StaticOrder {
    static constexpr bool DYN = false;
    int nM, nN, nwg, G, c;
    __host__ __device__ void init(int M, int N, int G_, int c_) { nM = M / BM; nN = N / BM; nwg = nM * nN; G = G_; c = c_; }
    __host__ __device__ bool next(int i, Unit& u) const {
        const int L = i * G + c; if (L >= nwg) return false;
        int wgid = L; { const int q = nwg / NXCD, r = nwg % NXCD, xcd = wgid % NXCD, off = wgid / NXCD; wgid = (xcd < r ? xcd * (q + 1) : r * (q + 1) + (xcd - r) * q) + off; }
        const int nig = WGM * nN, gid = wgid / nig, fm = gid * WGM, gsz = (nM - fm) < WGM ? (nM - fm) : WGM;
        u.pm = fm + ((wgid % nig) % gsz); u.pn = (wgid % nig) / gsz; u.aux = u.pn; return true;
    }
};
struct MoeOrder {
    static constexpr bool DYN = false;
    int ntile, nN, G, c, pne, pn0; const int* tile_e;
    __device__ bool next(int i, Unit& u) const {
        const int L = i * G + c; if (L >= ntile * nN) return false;
        int pm, pnl; { const int grp = L / (MOE_RGS * nN), fm = grp * MOE_RGS, gsz = (ntile - fm) < MOE_RGS ? (ntile - fm) : MOE_RGS, r = L - grp * (MOE_RGS * nN); pm = fm + r % gsz; pnl = r / gsz; }
        u.pm = pm; u.aux = pnl; u.pn = tile_e[pm] * pne + pn0 + pnl; return true;
    }
};

struct DynMoeOrder {
    static constexpr bool DYN = true;
    unsigned* ctr; volatile LAS int* slot; int ntile, nN, pne, pn0; const int* tile_e; int vcu;
    __device__ __forceinline__ void begin() const {
        if (threadIdx.x == 0) { slot[0] = vcu; slot[1] = vcu + (int)gridDim.x; }
        __syncthreads();
    }
    __device__ __forceinline__ bool next(int i, Unit& u) const {
        const int L = __builtin_amdgcn_readfirstlane(slot[i & 1]); if (L >= ntile * nN) return false;
        int pm, pnl; { const int grp = L / (MOE_RG * nN), fm = grp * MOE_RG, gsz = (ntile - fm) < MOE_RG ? (ntile - fm) : MOE_RG, r = L - grp * (MOE_RG * nN); pm = fm + r % gsz; pnl = r / gsz; }
        u.pm = pm; u.aux = pnl; u.pn = tile_e[pm] * pne + pn0 + pnl; return true;
    }
    __device__ __forceinline__ unsigned claim_issue() const { unsigned v = 0u; if (threadIdx.x == 0) v = 2u * gridDim.x + __hip_atomic_fetch_add(ctr, 1u, __ATOMIC_RELAXED, __HIP_MEMORY_SCOPE_AGENT); return v; }
    __device__ __forceinline__ void claim_commit(unsigned v, int i) const { if (threadIdx.x == 0) { slot[i & 1] = (int)v; asm volatile("s_waitcnt lgkmcnt(0)" ::: "memory"); } }
};

__host__ __device__ __forceinline__ size_t blk_off(int row, int col, int ld) { return ((size_t)(row >> 4) * (ld >> 5) + (col >> 5)) * 512 + (row & 15) * 32 + (col & 31); }
typedef int i32x4_t __attribute__((ext_vector_type(4))); typedef int i32x8_t __attribute__((ext_vector_type(8)));
template <bool F8> struct FragSel;
template <> struct FragSel<false> {
    struct P { bf16x8 k[2]; }; typedef P A[4]; typedef P B[2];
    static __device__ __forceinline__ void set(P& d, const i32x4_t& f0, const i32x4_t& f1) { d.k[0] = __builtin_bit_cast(bf16x8, f0); d.k[1] = __builtin_bit_cast(bf16x8, f1); }
    static __device__ __forceinline__ void mma(f32x4& c, const P& b, const P& a) { c = __builtin_amdgcn_mfma_f32_16x16x32_bf16(b.k[0], a.k[0], c, 0, 0, 0); c = __builtin_amdgcn_mfma_f32_16x16x32_bf16(b.k[1], a.k[1], c, 0, 0, 0); }
    static __device__ __forceinline__ void after_mma() {}
};
template <> struct FragSel<true> {
    typedef i32x8_t P; typedef P A[4]; typedef P B[2];
    static __device__ __forceinline__ void set(P& d, const i32x4_t& f0, const i32x4_t& f1) { d = __builtin_shufflevector(f0, f1, 0, 1, 2, 3, 4, 5, 6, 7); }
    static __device__ __forceinline__ void mma(f32x4& c, const P& b, const P& a) { int sc = 0x7f7f7f7f; asm volatile("v_mfma_scale_f32_16x16x128_f8f6f4 %0, %1, %2, %0, %3, %3 op_sel_hi:[0,0,0]" : "+v"(c) : "v"(b), "v"(a), "v"(sc)); }
    static __device__ __forceinline__ void after_mma() { asm volatile("s_nop 15\n\ts_nop 15" ::: "memory"); }
};
template <class Epi, class Sched, bool ALIGN_EPI, bool GATHER, bool ABLK = false, bool F8 = false>
__device__ __forceinline__ void gemm_phase(LAS unsigned char* lds, const Gemm g, const Sched& S, const Epi& E) {
    int tid_ = threadIdx.x; asm volatile("" : "+v"(tid_));
    const int tid = tid_, wid = __builtin_amdgcn_readfirstlane(tid >> 6), lane = tid & 63, wr = wid >> 2, wc = wid & 3, fr = lane & 15, fq = lane >> 4;
    int K_ = g.K; asm volatile("" : "+s"(K_));
    const int K = K_, nt = K / BK;
    static_assert(!(GATHER && ABLK), "gathered A is row-major");
    const size_t kstep = (size_t)(BK * 2), kstepA = ABLK ? (size_t)2048 : kstep;
    const size_t hstepA = ABLK ? (size_t)8 * (g.lda >> 5) * 1024 : (size_t)HALF * g.lda * 2, hstepB = (size_t)HALF * g.ldb * 2, tstepA = 2 * hstepA, tstepB = 2 * hstepB;
    int Rs[2], Cs[2]; unsigned voffB[2];
#pragma unroll
    for (int i = 0; i < 2; ++i) { int R, C; stage_rc(tid * 16 + i * 8192, R, C); Rs[i] = R; Cs[i] = C; const int Rb = Epi::PERM ? ((R & ~31) + perm32(R & 31)) : R;
        voffB[i] = (unsigned)(Rb * g.ldb + C) * 2u; }
    asm volatile("" : "+v"(voffB[0]), "+v"(voffB[1]), "+v"(Rs[0]), "+v"(Rs[1]), "+v"(Cs[0]), "+v"(Cs[1]));
    unsigned vA[2][2], nvA[2][2];
    const size_t hsA = GATHER ? (size_t)0 : hstepA;
#define PG8_SETV(V, U) do { _Pragma("unroll") for (int _h = 0; _h < 2; ++_h) _Pragma("unroll") for (int _i = 0; _i < 2; ++_i) { \
        if constexpr (GATHER) { int _t = g.gidx[(U).pm * BM + _h * HALF + Rs[_i]]; _t = _t < 0 ? 0 : _t; V[_h][_i] = (unsigned)(_t * g.lda + Cs[_i]) * 2u; } \
        else if constexpr (ABLK) V[_h][_i] = (unsigned)blk_off(Rs[_i], Cs[_i], g.lda) * 2u; \
        else V[_h][_i] = (unsigned)(Rs[_i] * g.lda + Cs[_i]) * 2u; } } while (0)
    const unsigned ldsw = (unsigned)wid * 1024u;
    const int aoff = lds_byte(wr * 64 + fr, fq * 8), boff = lds_byte(wc * 32 + fr, fq * 8);
#define PG8_SA(b, h) (((b) * 2 + (h)) * HTB)
#define PG8_SB(b, h) ((4 + (b) * 2 + (h)) * HTB)
#define PG8_STAGE(bufoff, gbase, voff) do { _Pragma("unroll") for (int _i = 0; _i < 2; ++_i) \
        __builtin_amdgcn_global_load_lds((const unsigned*)((const char*)(gbase) + (voff)[_i]), (LAS unsigned*)(lds + (bufoff) + ldsw + _i * 8192), 16, 0, 0); } while (0)
#define PG8_LDA(dst, b, h) do { _Pragma("unroll") for (int m = 0; m < 4; ++m) { const i32x4_t f0_ = *(const LAS i32x4_t*)(lds + PG8_SA(b, h) + aoff + m * 2048), f1_ = *(const LAS i32x4_t*)(lds + PG8_SA(b, h) + aoff + m * 2048 + 1024); FragSel<F8>::set(dst[m], f0_, f1_); } } while (0)
#define PG8_LDB(dst, b, h) do { _Pragma("unroll") for (int n = 0; n < 2; ++n) { const i32x4_t f0_ = *(const LAS i32x4_t*)(lds + PG8_SB(b, h) + boff + n * 2048), f1_ = *(const LAS i32x4_t*)(lds + PG8_SB(b, h) + boff + n * 2048 + 1024); FragSel<F8>::set(dst[n], f0_, f1_); } } while (0)
#define PG8_MMA(ai, bj, At, Bt) do { __builtin_amdgcn_s_setprio(1); _Pragma("unroll") for (int m = 0; m < 4; ++m) _Pragma("unroll") for (int n = 0; n < 2; ++n) FragSel<F8>::mma(acc[ai][bj][m][n], Bt[n], At[m]); __builtin_amdgcn_s_setprio(0); } while (0)
#define PG8_WAIT_V(n) asm volatile("s_waitcnt vmcnt(" #n ")" ::: "memory")
#define PG8_WAIT_VSEL(sel, n) asm volatile("s_cmp_eq_u32 %0, 0\n\ts_cbranch_scc1 1f\n\ts_waitcnt vmcnt(%1)\n\ts_branch 2f\n1:\n\ts_waitcnt vmcnt(8)\n2:" :: "s"(sel), "n"(n) : "memory", "scc")
#define PG8_WAIT_L(n) asm volatile("s_waitcnt lgkmcnt(" #n ")" ::: "memory")
#define PG8_BAR __builtin_amdgcn_s_barrier()
#define PG8_SCHED __builtin_amdgcn_sched_barrier(0)
    Unit cur, nxt; int ui = 0;
    if constexpr (Sched::DYN) S.begin();
    if (!S.next(0, cur)) return;
    f32x4 acc[2][2][4][2];
#pragma unroll
    for (int a = 0; a < 2; ++a)
#pragma unroll
        for (int b = 0; b < 2; ++b)
#pragma unroll
            for (int m = 0; m < 4; ++m)
#pragma unroll
                for (int n = 0; n < 2; ++n) acc[a][b][m][n] = (f32x4){0.f, 0.f, 0.f, 0.f};
    typename FragSel<F8>::A At; typename FragSel<F8>::B B0, B1;
    PG8_SETV(vA, cur);
    const char* cA = (const char*)g.A + (GATHER ? (size_t)0 : (size_t)cur.pm * tstepA); const char* cB = (const char*)g.Bt + (size_t)cur.pn * tstepB;
    PG8_STAGE(PG8_SB(0, 0), cB, voffB); PG8_STAGE(PG8_SB(0, 1), cB + hstepB, voffB); PG8_STAGE(PG8_SA(0, 0), cA, vA[0]); PG8_STAGE(PG8_SA(0, 1), cA + hsA, vA[1]);
    if (wr == 1) PG8_BAR;
    PG8_WAIT_V(2); PG8_BAR;
    PG8_STAGE(PG8_SB(1, 0), cB + kstep, voffB); PG8_STAGE(PG8_SA(1, 0), cA + kstepA, vA[0]); PG8_STAGE(PG8_SB(1, 1), cB + hstepB + kstep, voffB);
    PG8_WAIT_V(6); PG8_BAR;
    for (;;) {
        const bool has_next = S.next(ui + 1, nxt);
        unsigned claim_ = 0u; if constexpr (Sched::DYN) claim_ = S.claim_issue();
        const char* nA = has_next ? (const char*)g.A + (GATHER ? (size_t)0 : (size_t)nxt.pm * tstepA) : cA; const char* nB = has_next ? (const char*)g.Bt + (size_t)nxt.pn * tstepB : cB;
        if constexpr (GATHER) { if (has_next) PG8_SETV(nvA, nxt); else {
#pragma unroll
            for (int h = 0; h < 2; ++h) { nvA[h][0] = vA[h][0]; nvA[h][1] = vA[h][1]; } } }
        for (int t = 0; t < nt; t += 2) {
            if constexpr (Epi::MID) { if (t == 8 || t == 16) E.mid(acc, cur, t >> 3, wr, wc, fr, fq); }
            const bool last = (t == nt - 2);
            const char* a1 = cA + (size_t)(t + 1) * kstepA;
            const char* a2 = last ? nA : cA + (size_t)(t + 2) * kstepA; const char* b2 = last ? nB : cB + (size_t)(t + 2) * kstep;
            const char* a3 = a2 + kstepA; const char* b3 = b2 + kstep;
            unsigned v20[2], v21[2];
            if constexpr (GATHER) { v20[0] = last ? nvA[0][0] : vA[0][0]; v20[1] = last ? nvA[0][1] : vA[0][1]; v21[0] = last ? nvA[1][0] : vA[1][0]; v21[1] = last ? nvA[1][1] : vA[1][1]; }
            else { v20[0] = vA[0][0]; v20[1] = vA[0][1]; v21[0] = vA[1][0]; v21[1] = vA[1][1]; }
            const int relax_ = __builtin_amdgcn_readfirstlane((RELAXW && (t == 0) && (ui > 0)) ? 1 : 0);
            PG8_LDB(B0, 0, 0); PG8_LDB(B1, 0, 1); PG8_SCHED; PG8_LDA(At, 0, 0); PG8_STAGE(PG8_SA(1, 1), a1 + hsA, vA[1]);
            PG8_WAIT_VSEL(relax_, 8 + Epi::NVM);
            PG8_WAIT_L(0); PG8_BAR; PG8_MMA(0, 0, At, B0); PG8_MMA(0, 1, At, B1); PG8_BAR; PG8_SCHED;
            PG8_LDA(At, 0, 1); PG8_STAGE(PG8_SB(0, 0), b2, voffB); PG8_STAGE(PG8_SB(0, 1), b2 + hstepB, voffB); PG8_STAGE(PG8_SA(0, 0), a2, v20);
            PG8_WAIT_VSEL(relax_, 8 + Epi::NVM);
            PG8_WAIT_L(0); PG8_BAR; PG8_MMA(1, 0, At, B0); PG8_MMA(1, 1, At, B1); PG8_BAR; PG8_SCHED;
            PG8_LDB(B0, 1, 0); PG8_LDB(B1, 1, 1); PG8_SCHED; PG8_LDA(At, 1, 0); PG8_STAGE(PG8_SA(0, 1), a2 + hsA, v21);
            PG8_WAIT_V(8); PG8_WAIT_L(0); PG8_BAR; PG8_MMA(0, 0, At, B0); PG8_MMA(0, 1, At, B1); PG8_BAR; PG8_SCHED;
            PG8_LDA(At, 1, 1); PG8_STAGE(PG8_SB(1, 0), b3, voffB); PG8_STAGE(PG8_SB(1, 1), b3 + hstepB, voffB); PG8_STAGE(PG8_SA(1, 0), a3, v20);
            PG8_WAIT_V(8); PG8_WAIT_L(0); PG8_BAR; PG8_MMA(1, 0, At, B0); PG8_MMA(1, 1, At, B1); PG8_BAR; PG8_SCHED;
        }
        if constexpr (Sched::DYN) S.claim_commit(claim_, ui);
        if constexpr (ALIGN_EPI) { if (wr == 0) PG8_BAR; }
        FragSel<F8>::after_mma();
        E(acc, cur, wr, wc, fr, fq);
        if (!has_next) break;
#pragma unroll
        for (int a = 0; a < 2; ++a)
#pragma unroll
            for (int b = 0; b < 2; ++b)
#pragma unroll
                for (int m = 0; m < 4; ++m)
#pragma unroll
                    for (int n = 0; n < 2; ++n) acc[a][b][m][n] = (f32x4){0.f, 0.f, 0.f, 0.f};
        cur = nxt; cA = nA; cB = nB; ++ui;
        if constexpr (GATHER) {
#pragma unroll
            for (int h = 0; h < 2; ++h) { vA[h][0] = nvA[h][0]; vA[h][1] = nvA[h][1]; } }
        if constexpr (ALIGN_EPI) { if (wr == 1) PG8_BAR; }
    }
    PG8_WAIT_V(0);
    if constexpr (!ALIGN_EPI) { if (wr == 0) PG8_BAR; }
    PG8_BAR;
#undef PG8_SETV
#undef PG8_SA
#undef PG8_SB
#undef PG8_STAGE
#undef PG8_LDA
#undef PG8_LDB
#undef PG8_MMA
#undef PG8_WAIT_V
#undef PG8_WAIT_VSEL
#undef PG8_WAIT_L
#undef PG8_BAR
#undef PG8_SCHED
}

typedef f32x4 Acc[2][2][4][2];
#ifndef NT_Z
#define NT_Z 0
#endif
#ifndef NT_A
#define NT_A 1
#endif
#ifndef ST_SC1
#define ST_SC1 1
#endif
__device__ __forceinline__ void st16(unsigned char* wsb, u32x4* p, const u32x4& v) {
#if ST_SC1
    const __amdgpu_buffer_rsrc_t rsrc = __builtin_amdgcn_make_buffer_rsrc(wsb, 0, 0x7fffffff, 0x00020000);
    __builtin_amdgcn_raw_buffer_store_b128(v, rsrc, (int)((unsigned char*)p - wsb), 0, 16);
#else
    *p = v;
#endif
}
__device__ __forceinline__ void st8(unsigned char* wsb, u32x2* p, const u32x2& v) {
#if ST_SC1
    const __amdgpu_buffer_rsrc_t rsrc = __builtin_amdgcn_make_buffer_rsrc(wsb, 0, 0x7fffffff, 0x00020000);
    __builtin_amdgcn_raw_buffer_store_b64(v, rsrc, (int)((unsigned char*)p - wsb), 0, 16);
#else
    *p = v;
#endif
}
__device__ __forceinline__ float fq_sum(float s) { s += swz_xor<16>(s); return xsum32(s); }
__device__ __forceinline__ u32x4 pack8(const f32x4& a, const f32x4& b) { u32x4 w; w.x = cvt_pk_bf16(a.x, a.y); w.y = cvt_pk_bf16(a.z, a.w); w.z = cvt_pk_bf16(b.x, b.y); w.w = cvt_pk_bf16(b.z, b.w); return w; }
__device__ __forceinline__ void unpack8(const u32x4& w, f32x4& a, f32x4& b) { a = (f32x4){bf_lo(w.x), bf_hi(w.x), bf_lo(w.y), bf_hi(w.y)}; b = (f32x4){bf_lo(w.z), bf_hi(w.z), bf_lo(w.w), bf_hi(w.w)}; }
__device__ __forceinline__ unsigned g8pack(const f32x4& a) {
    const unsigned b0 = (unsigned)__builtin_fmaxf(a.x * 255.f + 0.5f, 1.f), b1 = (unsigned)__builtin_fmaxf(a.y * 255.f + 0.5f, 1.f), b2 = (unsigned)__builtin_fmaxf(a.z * 255.f + 0.5f, 1.f), b3 = (unsigned)__builtin_fmaxf(a.w * 255.f + 0.5f, 1.f);
    return b0 | (b1 << 8) | (b2 << 16) | (b3 << 24);
}
__device__ __forceinline__ f32x4 g8unpack(unsigned w) { return (f32x4){(float)(w & 0xffu), (float)((w >> 8) & 0xffu), (float)((w >> 16) & 0xffu), (float)(w >> 24)}; }
__device__ __forceinline__ float sq8(const f32x4& a, const f32x4& b) { return ((a.x * a.x + a.y * a.y) + (a.z * a.z + a.w * a.w)) + ((b.x * b.x + b.y * b.y) + (b.z * b.z + b.w * b.w)); }
__device__ __forceinline__ float sum4(const f32x4& a) { return (a.x + a.y) + (a.z + a.w); }
__device__ __forceinline__ void rope8(f32x4& a, f32x4& b, const float* cs, const float* sn) {
    const f32x4 c = *(const f32x4*)cs, s = *(const f32x4*)sn;
    const f32x4 ra = {a.x * c.x - a.y * s.x, a.x * s.x + a.y * c.x, a.z * c.y - a.w * s.y, a.z * s.y + a.w * c.y};
    const f32x4 rb = {b.x * c.z - b.y * s.z, b.x * s.z + b.y * c.z, b.z * c.w - b.w * s.w, b.z * s.w + b.w * c.w};
    a = ra; b = rb;
}
__device__ __forceinline__ void rowscale16(const float* st, int rbase, int fq, float (&r)[8]) {
    f32x4 p[8];
#pragma unroll
    for (int i = 0; i < 8; ++i) p[i] = *(const f32x4*)(st + (size_t)(rbase + (i >> 2) * HALF + (i & 3) * 16) * 16 + 4 * fq);
#pragma unroll
    for (int i = 0; i < 8; ++i) r[i] = rsqrtf(fq_sum(sum4(p[i])) * (1.f / 1024.f) + EPS);
}
__device__ __forceinline__ void rowscale4(const float* sq, int rbase, float inv_n, float (&r)[8]) {
    f32x4 p[8];
#pragma unroll
    for (int i = 0; i < 8; ++i) p[i] = *(const f32x4*)(sq + (size_t)(rbase + (i >> 2) * HALF + (i & 3) * 16) * 4);
#pragma unroll
    for (int i = 0; i < 8; ++i) r[i] = rsqrtf(sum4(p[i]) * inv_n + EPS);
}
#define EPI_ROWBASE int rl_ = wr * 64 + fr; asm volatile("" : "+v"(rl_)); const int rbase = u.pm * BM + rl_
#define EPI_LOOP _Pragma("unroll") for (int ai = 0; ai < 2; ++ai) _Pragma("unroll") for (int m = 0; m < 4; ++m)

struct EpiIn {
    static constexpr bool PERM = true, MID = false; static constexpr int NVM = 24;
    bf16_t* Z; const float* st; float* sq; float* skv; const float* cosT; const float* sinT; unsigned char* GB; bf16_t* HM; unsigned char* wsb; int pnoff; float asc;
    __device__ __forceinline__ void operator()(const Acc& acc, const Unit& u, int wr, int wc, int fr, int fq) const {
        EPI_ROWBASE; const int pn = u.pn + pnoff;
        float r8[8]; rowscale16(st, rbase, fq, r8);
#pragma unroll
        for (int i = 0; i < 8; ++i) r8[i] *= asc;
        __builtin_amdgcn_sched_barrier(0);
        EPI_LOOP {
            const int row = rbase + ai * HALF + m * 16; const float r = r8[ai * 4 + m];
            bf16_t* zr = Z + (size_t)row * ZW + pn * BM + wc * 32 + 8 * fq;
            float ssq = 0.f;
#pragma unroll
            for (int bj = 0; bj < 2; ++bj) {
                f32x4 v0 = acc[ai][bj][m][0] * r, v1 = acc[ai][bj][m][1] * r;
#ifdef PROBE_ANOISE
                if (pn < 11 && ((PROBE_ANOISE_MASK >> pn) & 1)) { unsigned h_ = (unsigned)row * 2654435761u ^ (unsigned)(pn * 64 + bj * 32 + wc * 8 + fq) * 40503u; float nz[8];
#pragma unroll
                      for (int e_ = 0; e_ < 8; ++e_) { h_ = h_ * 1664525u + 1013904223u; nz[e_] = ((float)(h_ >> 8) * (1.f / 16777216.f) - 0.5f) * 3.4641f * 0.035f * (float)(PROBE_ANOISE); }
                      v0.x += nz[0]; v0.y += nz[1]; v0.z += nz[2]; v0.w += nz[3]; v1.x += nz[4]; v1.y += nz[5]; v1.z += nz[6]; v1.w += nz[7]; }
#endif
                if (pn == 0) ssq += sq8(v0, v1);
                else if (pn == 1) { if (bj == 0) ssq += sq8(v0, v1); else if (wc == 0) { const int pos = row & (SEQ - 1); rope8(v0, v1, cosT + pos * 16 + 4 * fq, sinT + pos * 16 + 4 * fq); } }
                else if (pn == 2 || pn == 3 || pn == 8 || pn == 9) { v0 = v0 * (0.125f * LOG2E); v1 = v1 * (0.125f * LOG2E); }
                else if (pn >= 11) {
#ifdef PROBE_GNOISE
                    { unsigned h_ = (unsigned)row * 2654435761u ^ (unsigned)(pn * 64 + bj * 32 + wc * 8 + fq) * 40503u; float nz[8];
#pragma unroll
                      for (int e_ = 0; e_ < 8; ++e_) { h_ = h_ * 1664525u + 1013904223u; nz[e_] = ((float)(h_ >> 8) * (1.f / 16777216.f) - 0.5f) * 3.4641f * 0.035f * (float)(PROBE_GNOISE); }
                      v0.x += nz[0]; v0.y += nz[1]; v0.z += nz[2]; v0.w += nz[3]; v1.x += nz[4]; v1.y += nz[5]; v1.z += nz[6]; v1.w += nz[7]; }
#endif
                    v0 = (f32x4){sigmoidf_(v0.x), sigmoidf_(v0.y), sigmoidf_(v0.z), sigmoidf_(v0.w)}; v1 = (f32x4){sigmoidf_(v1.x), sigmoidf_(v1.y), sigmoidf_(v1.z), sigmoidf_(v1.w)}; }
                if (pn >= 11) { u32x2 w8; w8.x = g8pack(v0); w8.y = g8pack(v1); *(u32x2*)(GB + blk_off(row, (pn - 11) * BM + bj * HALF + wc * 32 + 8 * fq, 3072)) = w8; }
                else if (pn >= 2) {
                    const int hc = (pn - 2) * BM + bj * HALF + wc * 32;
                    const int reg = hc < 1536 ? hc >> 9 : (hc < 2048 ? 3 : (hc < 2176 ? 4 : 5)), hin = hc < 1536 ? hc & 511 : (hc < 2048 ? hc - 1536 : (hc - 2048) & 127);
                    const size_t base = reg <= 3 ? (size_t)reg * (MC * 512) : (size_t)4 * (MC * 512) + (size_t)(reg - 4) * (MC * 128);
                    const int nh = reg <= 3 ? 8 : 2, b = row >> 11, s = row & (SEQ - 1);
                    st16(wsb, (u32x4*)(HM + base + (((size_t)(b * nh + (hin >> 6)) * SEQ + s) * 64 + (hin & 63) + 8 * fq)), pack8(v0, v1));
                }
                else st16(wsb, (u32x4*)(zr + bj * HALF), pack8(v0, v1));
            }
            if (pn <= 1) { ssq = fq_sum(ssq); if (fq == 0) (pn == 0 ? sq : skv)[(size_t)row * 4 + wc] = ssq; }
        }
    }
};
struct EpiQ {
    static constexpr bool PERM = true, MID = false; static constexpr int NVM = 24;
    bf16_t* Q; const float* sq; const float* cosT; const float* sinT;
    __device__ __forceinline__ void operator()(const Acc& acc, const Unit& u, int wr, int wc, int fr, int fq) const {
        EPI_ROWBASE;
        float r8[8]; rowscale4(sq, rbase, 1.f / 256.f, r8);
        __builtin_amdgcn_sched_barrier(0);
        EPI_LOOP {
            __builtin_amdgcn_sched_barrier(0);
            const int row = rbase + ai * HALF + m * 16; const float r = r8[ai * 4 + m]; const int pos = row & (SEQ - 1);
#pragma unroll
            for (int bj = 0; bj < 2; ++bj) {
                const int col = u.pn * BM + bj * HALF + wc * 32 + 8 * fq; const int j0 = col % 96;
                f32x4 v0 = acc[ai][bj][m][0] * r, v1 = acc[ai][bj][m][1] * r;
                if (j0 >= 64) { const int i0 = (j0 - 64) >> 1; rope8(v0, v1, cosT + pos * 16 + i0, sinT + pos * 16 + i0); }
                *(u32x4*)(Q + (size_t)row * 768 + col) = pack8(v0, v1);
            }
        }
    }
};
struct EpiKV {
    static constexpr bool PERM = true, MID = false; static constexpr int NVM = 24;
    bf16_t* KV; const float* skv;
    __device__ __forceinline__ void operator()(const Acc& acc, const Unit& u, int wr, int wc, int fr, int fq) const {
        EPI_ROWBASE;
        float r8[8]; rowscale4(skv, rbase, 1.f / 128.f, r8);
        __builtin_amdgcn_sched_barrier(0);
        EPI_LOOP {
            const int row = rbase + ai * HALF + m * 16; const float r = r8[ai * 4 + m];
#pragma unroll
            for (int bj = 0; bj < 2; ++bj) {
                const int col = u.pn * BM + bj * HALF + wc * 32 + 8 * fq;
                *(u32x4*)(KV + (size_t)row * 1024 + col) = pack8(acc[ai][bj][m][0] * r, acc[ai][bj][m][1] * r);
            }
        }
    }
};
struct EpiBr {
    static constexpr bool PERM = true, MID = true; static constexpr int NVM = 32;
    const unsigned char* G; bf16_t* MG; unsigned char* wsb;
    __device__ __forceinline__ void mid(Acc& acc, const Unit& u, int seg, int wr, int wc, int fr, int fq) const {
        EPI_ROWBASE; const int col = u.pn * BM + wc * 32 + 8 * fq;
#pragma unroll
        for (int ai = 0; ai < 2; ++ai) {
            __builtin_amdgcn_sched_barrier(0);
            u32x2 wn[4][2], wd[4][2];
#pragma unroll
            for (int m = 0; m < 4; ++m)
#pragma unroll
                for (int bj = 0; bj < 2; ++bj) { const int row = rbase + ai * HALF + m * 16; wn[m][bj] = *(const u32x2*)(G + blk_off(row, (seg - 1) * 1024 + col + bj * HALF, 3072)); wd[m][bj] = *(const u32x2*)(G + blk_off(row, seg * 1024 + col + bj * HALF, 3072)); }
#pragma unroll
            for (int m = 0; m < 4; ++m)
#pragma unroll
                for (int bj = 0; bj < 2; ++bj) {
                    const f32x4 n0 = g8unpack(wn[m][bj].x), n1 = g8unpack(wn[m][bj].y), d0 = g8unpack(wd[m][bj].x), d1 = g8unpack(wd[m][bj].y);
                    f32x4 r0, r1;
                    r0.x = n0.x * fast_rcp(d0.x); r0.y = n0.y * fast_rcp(d0.y); r0.z = n0.z * fast_rcp(d0.z); r0.w = n0.w * fast_rcp(d0.w);
                    r1.x = n1.x * fast_rcp(d1.x); r1.y = n1.y * fast_rcp(d1.y); r1.z = n1.z * fast_rcp(d1.z); r1.w = n1.w * fast_rcp(d1.w);
                    acc[ai][bj][m][0] = acc[ai][bj][m][0] * r0; acc[ai][bj][m][1] = acc[ai][bj][m][1] * r1;
                }
        }
    }
    __device__ __forceinline__ void operator()(const Acc& acc, const Unit& u, int wr, int wc, int fr, int fq) const {
        EPI_ROWBASE; const int col = u.pn * BM + wc * 32 + 8 * fq;
#pragma unroll
        for (int ai = 0; ai < 2; ++ai) {
            __builtin_amdgcn_sched_barrier(0);
            u32x2 wg[4][2];
#pragma unroll
            for (int m = 0; m < 4; ++m)
#pragma unroll
                for (int bj = 0; bj < 2; ++bj) wg[m][bj] = *(const u32x2*)(G + blk_off(rbase + ai * HALF + m * 16, 2048 + col + bj * HALF, 3072));
#pragma unroll
            for (int m = 0; m < 4; ++m)
#pragma unroll
                for (int bj = 0; bj < 2; ++bj) { const f32x4 g0 = g8unpack(wg[m][bj].x) * (1.f / 255.f), g1 = g8unpack(wg[m][bj].y) * (1.f / 255.f);
                    st16(wsb, (u32x4*)(MG + blk_off(rbase + ai * HALF + m * 16, col + bj * HALF, 1024)), pack8(acc[ai][bj][m][0] * g0, acc[ai][bj][m][1] * g1)); }
        }
    }
};
template <bool F8OUT> struct EpiRes {
    static constexpr bool PERM = true, MID = false; static constexpr int NVM = 40;
    bf16_t* xb; float* st; int row0; unsigned char* x8;
    __device__ __forceinline__ void operator()(const Acc& acc, const Unit& u, int wr, int wc, int fr, int fq) const {
        EPI_ROWBASE; const int col = u.pn * BM + wc * 32 + 8 * fq;
#pragma unroll
        for (int ai = 0; ai < 2; ++ai) {
            __builtin_amdgcn_sched_barrier(0);
            u32x4 xi[4][2];
#pragma unroll
            for (int m = 0; m < 4; ++m)
#pragma unroll
                for (int bj = 0; bj < 2; ++bj) xi[m][bj] = *(const u32x4*)(xb + (size_t)(row0 + rbase + ai * HALF + m * 16) * DM + col + bj * HALF);
#pragma unroll
            for (int m = 0; m < 4; ++m) {
                const int row = row0 + rbase + ai * HALF + m * 16; float ssq = 0.f;
#pragma unroll
                for (int bj = 0; bj < 2; ++bj) { f32x4 x0, x1; unpack8(xi[m][bj], x0, x1);
                    const f32x4 v0 = x0 + acc[ai][bj][m][0], v1 = x1 + acc[ai][bj][m][1];
                    *(u32x4*)(xb + (size_t)row * DM + col + bj * HALF) = pack8(v0, v1); ssq += sq8(v0, v1);
                    if constexpr (F8OUT) { u32x2 o8; o8.x = pk_fp8x4(v0.x * 16.f, v0.y * 16.f, v0.z * 16.f, v0.w * 16.f); o8.y = pk_fp8x4(v1.x * 16.f, v1.y * 16.f, v1.z * 16.f, v1.w * 16.f); *(u32x2*)(x8 + (size_t)row * DM + col + bj * HALF) = o8; } }
                ssq = fq_sum(ssq); if (fq == 0) st[(size_t)row * 16 + u.pn * 4 + wc] = ssq;
            }
        }
    }
};
__device__ __forceinline__ float silu_mul(float g, float u) { return g * sigmoidf_(g) * u; }
struct EpiGU {
    static constexpr bool PERM = true, MID = false; static constexpr int NVM = 16;
    bf16_t* ACT; const float* st; int ldact; unsigned char* wsb;
    __device__ __forceinline__ void operator()(const Acc& acc, const Unit& u, int wr, int wc, int fr, int fq) const {
        EPI_ROWBASE;
        float r8[8]; rowscale16(st, rbase, fq, r8);
        __builtin_amdgcn_sched_barrier(0);
        EPI_LOOP {
            const int row = rbase + ai * HALF + m * 16; const float r = r8[ai * 4 + m];
            const f32x4 g0 = acc[ai][0][m][0] * r, g1 = acc[ai][0][m][1] * r, u0 = acc[ai][1][m][0] * r, u1 = acc[ai][1][m][1] * r;
            const f32x4 a0 = {silu_mul(g0.x, u0.x), silu_mul(g0.y, u0.y), silu_mul(g0.z, u0.z), silu_mul(g0.w, u0.w)};
            const f32x4 a1 = {silu_mul(g1.x, u1.x), silu_mul(g1.y, u1.y), silu_mul(g1.z, u1.z), silu_mul(g1.w, u1.w)};
            st16(wsb, (u32x4*)(ACT + blk_off(row, u.aux * HALF + wc * 32 + 8 * fq, ldact)), pack8(a0, a1));
        }
    }
};
struct EpiGUMoe {
    static constexpr bool PERM = true, MID = false; static constexpr int NVM = 16;
    bf16_t* ACT; const float* rowrr; int ldact; unsigned char* wsb;
    __device__ __forceinline__ void operator()(const Acc& acc, const Unit& u, int wr, int wc, int fr, int fq) const {
        EPI_ROWBASE;
        float r8[8];
#pragma unroll
        for (int i = 0; i < 8; ++i) r8[i] = rowrr[rbase + (i >> 2) * HALF + (i & 3) * 16] * (MOE_F8 ? 1.f / 4096.f : 1.f);
        __builtin_amdgcn_sched_barrier(0);
        EPI_LOOP {
            const int row = rbase + ai * HALF + m * 16; const float r = r8[ai * 4 + m];
            const f32x4 g0 = acc[ai][0][m][0] * r, g1 = acc[ai][0][m][1] * r, u0 = acc[ai][1][m][0] * r, u1 = acc[ai][1][m][1] * r;
            const f32x4 a0 = {silu_mul(g0.x, u0.x), silu_mul(g0.y, u0.y), silu_mul(g0.z, u0.z), silu_mul(g0.w, u0.w)};
            const f32x4 a1 = {silu_mul(g1.x, u1.x), silu_mul(g1.y, u1.y), silu_mul(g1.z, u1.z), silu_mul(g1.w, u1.w)};
            if (MOE_DN_F8) { u32x2 o8; o8.x = pk_fp8x4(a0.x * 8.f, a0.y * 8.f, a0.z * 8.f, a0.w * 8.f); o8.y = pk_fp8x4(a1.x * 8.f, a1.y * 8.f, a1.z * 8.f, a1.w * 8.f);
                st8(wsb, (u32x2*)((unsigned char*)ACT + blk_off(row, (u.aux * HALF + wc * 32 + 8 * fq) >> 1, ldact >> 1) * 2), o8); }
            else st16(wsb, (u32x4*)(ACT + blk_off(row, u.aux * HALF + wc * 32 + 8 * fq, ldact)), pack8(a0, a1));
        }
    }
};
template <bool FIRST> struct EpiDnMoe {
    static constexpr bool PERM = true, MID = false; static constexpr int NVM = 32;
    unsigned char* ws; const int* rowtok; const float* rowgw;
    __device__ __forceinline__ void operator()(const Acc& acc, const Unit& u, int wr, int wc, int fr, int fq) const {
        EPI_ROWBASE; const int col = u.aux * BM + wc * 32 + 8 * fq;
        int tk[8]; float gw8[8];
#pragma unroll
        for (int i = 0; i < 8; ++i) { tk[i] = rowtok[rbase + (i >> 2) * HALF + (i & 3) * 16]; gw8[i] = rowgw[rbase + (i >> 2) * HALF + (i & 3) * 16] * (MOE_DN_F8 ? 1.f / 8192.f : 1.f); }
#pragma unroll
        for (int ai = 0; ai < 2; ++ai) {
            __builtin_amdgcn_sched_barrier(0);
            u32x4 xi[4][2]; bf16_t* xr[4];
#pragma unroll
            for (int m = 0; m < 4; ++m) { const int tok = tk[ai * 4 + m] < 0 ? 0 : tk[ai * 4 + m]; xr[m] = xm_row(ws, tok) + col;
                const bf16_t* src = FIRST ? (const bf16_t*)(ws + WS_XB) + (size_t)tok * DM + col : xr[m];
#pragma unroll
                for (int bj = 0; bj < 2; ++bj) xi[m][bj] = *(const u32x4*)(src + bj * HALF); }
#pragma unroll
            for (int m = 0; m < 4; ++m) { const float gwv = gw8[ai * 4 + m];
                if (tk[ai * 4 + m] >= 0) {
#pragma unroll
                    for (int bj = 0; bj < 2; ++bj) { f32x4 x0, x1; unpack8(xi[m][bj], x0, x1);
                        *(u32x4*)(xr[m] + bj * HALF) = pack8(x0 + acc[ai][bj][m][0] * gwv, x1 + acc[ai][bj][m][1] * gwv); } } }
        }
    }
};
}
namespace att {
__device__ __forceinline__ int crow(int r, int hi) { return (r & 3) + 8 * (r >> 2) + 4 * hi; }
__device__ __forceinline__ float xhalf_max(float m) { return xmax32(m); }
__device__ __forceinline__ float xhalf_sum(float m) { return xsum32(m); }
typedef short v4i16_t __attribute__((ext_vector_type(4)));
__device__ __forceinline__ s16x4 vtr(const LAS unsigned char* p) { return __builtin_bit_cast(s16x4, __builtin_amdgcn_ds_read_tr16_b64_v4i16((LAS v4i16_t*)p)); }
__device__ __forceinline__ bf16x8 cat8(s16x4 a, s16x4 b) { return (bf16x8){a[0], a[1], a[2], a[3], b[0], b[1], b[2], b[3]}; }
__device__ __forceinline__ bf16x8 pfrag(const f32x16& p, int s8) {
    u32x4 w; w.x = cvt_pk_bf16(p[s8 + 0], p[s8 + 1]); w.y = cvt_pk_bf16(p[s8 + 2], p[s8 + 3]); w.z = cvt_pk_bf16(p[s8 + 4], p[s8 + 5]); w.w = cvt_pk_bf16(p[s8 + 6], p[s8 + 7]);
    return __builtin_bit_cast(bf16x8, w);
}
constexpr int TAB_STRIDE = 320;

constexpr int BW_ROWS = 384, BW_KP = 144;
constexpr int BW_K = 0, BW_V = BW_ROWS * BW_KP, BW_VDH = BW_ROWS * 64, BW_TAB = BW_V + 2 * BW_VDH, BW_END = BW_TAB + 4 * TAB_STRIDE * 4;
struct BandPre { u32x4 k[6], v[6]; float t[4]; bf16x8 q[4]; };
struct BandItem { int kind, b, hh, g0, a0; };
__device__ __forceinline__ BandItem band_decode(int i, int items_per_kind) {
    BandItem it; it.kind = i / items_per_kind; const int w = i % items_per_kind;
    if (it.kind < 3) { const int sub = w & 7; it.hh = (w >> 3) & 7; it.b = w >> 6;
        if (it.kind == 0) { it.g0 = 0; it.a0 = 256 * sub; } else if (it.kind == 1) { it.g0 = sub >> 1; it.a0 = 256 * (sub & 1); } else { it.g0 = 2 * sub; it.a0 = 0; } }
    else { it.a0 = 64 * (w & 31); it.hh = (w >> 5) & 1; it.b = w >> 6; it.g0 = 0; }
    return it;
}
__device__ __forceinline__ bool band_row(const BandItem& it, int r, int& pos) {
    int key, g = it.g0, dil, L;
    if (it.kind == 3) { if (r >= 320) return false; key = it.a0 - 128 + r; dil = 1; L = SEQ; }
    else if (it.kind == 2) { if (r >= 256) return false; g += r >> 7; key = r & 127; dil = 16; L = 128; }
    else { dil = it.kind == 0 ? 1 : 4; L = SEQ / dil; key = it.a0 - 64 + r; }
    if (key < 0 || key >= L) return false;
    pos = key * dil + g; return true;
}
__device__ __forceinline__ void band_issue(BandPre& P, const BandItem& it, const bf16_t* HM, const float* tabg, int tid, int wid, int lane) {
    const bf16_t* kb = it.kind == 3 ? HM + (size_t)4 * MC * 512 + ((size_t)(it.b * 2 + it.hh) * SEQ) * 64 : HM + (size_t)MC * 512 + ((size_t)(it.b * 8 + it.hh) * SEQ) * 64;
    const bf16_t* vb = it.kind == 3 ? kb + (size_t)MC * 128 : kb + (size_t)MC * 512;
#pragma unroll
    for (int i = 0; i < 6; ++i) { const int id = i * 512 + tid, r = id >> 3, c = id & 7; int pos; P.k[i] = (u32x4){0u, 0u, 0u, 0u}; P.v[i] = P.k[i];
        if (band_row(it, r, pos)) { P.k[i] = *(const u32x4*)(kb + (size_t)pos * 64 + c * 8); P.v[i] = *(const u32x4*)(vb + (size_t)pos * 64 + c * 8); } }
#pragma unroll
    for (int j = 0; j < 4; ++j) { P.t[j] = 0.f; if (tid < TAB_STRIDE && (it.kind == 3 || j == 0)) P.t[j] = tabg[((it.kind == 3 ? 3 * 8 + it.hh * 4 + j : it.kind * 8 + it.hh)) * TAB_STRIDE + tid]; }
    int a0w, g = it.g0, dil, qh; const bf16_t* qbuf;
    if (it.kind == 3) { a0w = it.a0 + 32 * (wid & 1); dil = 1; qh = it.hh * 4 + (wid >> 1); qbuf = HM + (size_t)3 * MC * 512; }
    else if (it.kind == 2) { a0w = 32 * (wid & 3); g += wid >> 2; dil = 16; qh = it.hh; qbuf = HM; }
    else { a0w = it.a0 + 32 * wid; dil = it.kind == 0 ? 1 : 4; qh = it.hh; qbuf = HM; }
    const bf16_t* qp = qbuf + (((size_t)(it.b * 8 + qh) * SEQ) + (size_t)(a0w + (lane & 31)) * dil + g) * 64 + (lane >> 5) * 8;
#pragma unroll
    for (int d0 = 0; d0 < 4; ++d0) P.q[d0] = *(const bf16x8*)(qp + d0 * 16);
}
__device__ __forceinline__ void band_store(const BandPre& P, const BandItem& it, LAS unsigned char* lds, int tid) {
#pragma unroll
    for (int i = 0; i < 6; ++i) { const int id = i * 512 + tid, r = id >> 3, c = id & 7;
        *(LAS u32x4*)(lds + BW_K + r * BW_KP + c * 16) = P.k[i]; *(LAS u32x4*)(lds + BW_V + (c >> 2) * BW_VDH + r * 64 + (c & 3) * 16) = P.v[i]; }
    if (tid < TAB_STRIDE) {
#pragma unroll
        for (int j = 0; j < 4; ++j) if (it.kind == 3 || j == 0) ((LAS float*)(lds + BW_TAB))[j * TAB_STRIDE + tid] = P.t[j]; }
}
template <int NKB, int MODE>
__device__ __forceinline__ void band_compute(const bf16x8 (&qf)[4], const LAS unsigned char* lds, int rowoff, int a0w, int L, const LAS float* tab, bf16_t* op, float* stp, float sink2, int lane,
                                             const bf16_t* pb0 = nullptr, const bf16_t* pb1 = nullptr, const float* st0 = nullptr, const float* st1 = nullptr) {
    constexpr int R = 16 * (NKB - 1);
    const int q = lane & 31, hi = lane >> 5;
    f32x16 o0, o1;
#pragma unroll
    for (int r = 0; r < 16; ++r) { o0[r] = 0.f; o1[r] = 0.f; }
    float m = -3e38f, l = 0.f;
    const LAS float* tb = tab + (31 - q + 4 * hi);
    const int kro = q * BW_KP + hi * 16, vro = (4 * hi + ((lane & 15) >> 2)) * 64 + (16 * ((lane >> 4) & 1) + 4 * (lane & 3)) * 2;
#pragma unroll 1
    for (int kb = 0; kb < NKB; ++kb) {
        const int k0 = a0w - R + 32 * kb;
        if (k0 < 0 || k0 >= L) continue;
        const LAS unsigned char* kp = lds + BW_K + (rowoff + k0) * BW_KP + kro;
        f32x16 s;
#pragma unroll
        for (int r = 0; r < 16; ++r) s[r] = 0.f;
#pragma unroll
        for (int d0 = 0; d0 < 4; ++d0) s = __builtin_amdgcn_mfma_f32_32x32x16_bf16(*(const LAS bf16x8*)(kp + d0 * 32), qf[d0], s, 0, 0, 0);
#pragma unroll
        for (int r = 0; r < 16; ++r) s[r] += tb[32 * kb + (r & 3) + 8 * (r >> 2)];
        float bm = s[0];
#pragma unroll
        for (int r = 1; r < 16; ++r) bm = fmaxf(bm, s[r]);
        bm = xhalf_max(bm);
        const float mn = fmaxf(m, bm), f = fast_exp2(m - mn);
        float ps = 0.f;
#pragma unroll
        for (int r = 0; r < 16; ++r) { s[r] = fast_exp2(s[r] - mn); ps += s[r]; }
        l = l * f + ps; m = mn;
#pragma unroll
        for (int r = 0; r < 16; ++r) { o0[r] *= f; o1[r] *= f; }
        const bf16x8 p0 = pfrag(s, 0), p1 = pfrag(s, 8);
        const LAS unsigned char* vp = lds + BW_V + (rowoff + k0) * 64 + vro;
        { const bf16x8 v00 = cat8(vtr(vp), vtr(vp + 512)), v01 = cat8(vtr(vp + BW_VDH), vtr(vp + BW_VDH + 512));
          const bf16x8 v10 = cat8(vtr(vp + 1024), vtr(vp + 1024 + 512)), v11 = cat8(vtr(vp + BW_VDH + 1024), vtr(vp + BW_VDH + 1024 + 512));
          o0 = __builtin_amdgcn_mfma_f32_32x32x16_bf16(v00, p0, o0, 0, 0, 0); o1 = __builtin_amdgcn_mfma_f32_32x32x16_bf16(v01, p0, o1, 0, 0, 0);
          o0 = __builtin_amdgcn_mfma_f32_32x32x16_bf16(v10, p1, o0, 0, 0, 0); o1 = __builtin_amdgcn_mfma_f32_32x32x16_bf16(v11, p1, o1, 0, 0, 0); }
    }
    float lt = xhalf_sum(l);
    if (MODE == 2) {
        const f32x2 s0 = *(const f32x2*)st0, s1 = *(const f32x2*)st1;
        u32x2 a0[8], a1[8];
#pragma unroll
        for (int j = 0; j < 4; ++j) { a0[j] = *(const u32x2*)(pb0 + 8 * j); a0[4 + j] = *(const u32x2*)(pb0 + 32 + 8 * j); a1[j] = *(const u32x2*)(pb1 + 8 * j); a1[4 + j] = *(const u32x2*)(pb1 + 32 + 8 * j); }
        const float M = fmaxf(m, fmaxf(s0.x, s1.x));
        const float w0 = fast_exp2(s0.x - M) * s0.y, w1 = fast_exp2(s1.x - M) * s1.y, w2 = fast_exp2(m - M);
        const float inv = 1.f / (w0 + w1 + w2 * lt), c0 = w0 * inv, c1 = w1 * inv, c2 = w2 * inv;
#pragma unroll
        for (int j = 0; j < 4; ++j) {
            u32x2 w0_, w1_;
            { const float x0 = bf_lo(a0[j].x) * c0 + bf_lo(a1[j].x) * c1 + o0[4 * j] * c2, x1 = bf_hi(a0[j].x) * c0 + bf_hi(a1[j].x) * c1 + o0[4 * j + 1] * c2;
              const float x2 = bf_lo(a0[j].y) * c0 + bf_lo(a1[j].y) * c1 + o0[4 * j + 2] * c2, x3 = bf_hi(a0[j].y) * c0 + bf_hi(a1[j].y) * c1 + o0[4 * j + 3] * c2;
              w0_.x = cvt_pk_bf16(x0, x1); w0_.y = cvt_pk_bf16(x2, x3); }
            { const float x0 = bf_lo(a0[4 + j].x) * c0 + bf_lo(a1[4 + j].x) * c1 + o1[4 * j] * c2, x1 = bf_hi(a0[4 + j].x) * c0 + bf_hi(a1[4 + j].x) * c1 + o1[4 * j + 1] * c2;
              const float x2 = bf_lo(a0[4 + j].y) * c0 + bf_lo(a1[4 + j].y) * c1 + o1[4 * j + 2] * c2, x3 = bf_hi(a0[4 + j].y) * c0 + bf_hi(a1[4 + j].y) * c1 + o1[4 * j + 3] * c2;
              w1_.x = cvt_pk_bf16(x0, x1); w1_.y = cvt_pk_bf16(x2, x3); }
            *(u32x2*)(op + 8 * j) = w0_; *(u32x2*)(op + 32 + 8 * j) = w1_;
        }
        return;
    }
    if (MODE == 1) lt += fast_exp2(sink2 - m);
    else if (hi == 0) { stp[0] = m; stp[1] = lt; }
    const float inv = 1.f / lt;
#pragma unroll
    for (int j = 0; j < 4; ++j) {
        u32x2 w0, w1; w0.x = cvt_pk_bf16(o0[4 * j] * inv, o0[4 * j + 1] * inv); w0.y = cvt_pk_bf16(o0[4 * j + 2] * inv, o0[4 * j + 3] * inv);
        w1.x = cvt_pk_bf16(o1[4 * j] * inv, o1[4 * j + 1] * inv); w1.y = cvt_pk_bf16(o1[4 * j + 2] * inv, o1[4 * j + 3] * inv);
        *(u32x2*)(op + 8 * j) = w0; *(u32x2*)(op + 32 + 8 * j) = w1;
    }
}

constexpr int MLA_KP = 208;
constexpr int MLA_TK = 128;
constexpr int MLA_KTB = MLA_TK * MLA_KP;
constexpr int MLA_VTB = MLA_TK * 128;
constexpr int MLA_SLOT = MLA_KTB + MLA_VTB;
__device__ __forceinline__ void mla_unit(const bf16_t* Q, const bf16_t* KV, const bf16_t* Zc, bf16_t* Y, int b, int h, int qblk, LAS unsigned char* lds, int tid, int wid, int lane) {
    const int q = lane & 31, hi = lane >> 5;
    const size_t rb = (size_t)b * SEQ;
    bf16x8 qf[6];
    { const bf16_t* qp = Q + (rb + qblk * 256 + wid * 32 + q) * 768 + h * 96 + hi * 8;
#pragma unroll
      for (int d0 = 0; d0 < 6; ++d0) qf[d0] = *(const bf16x8*)(qp + d0 * 16); }
    const bf16_t* gk = KV + (rb + (tid >> 3)) * 1024 + h * 64 + (tid & 7) * 8;
    const bf16_t* gv = gk + 512;
    const bf16_t* gp = Zc + (rb + (tid >> 2)) * ZW + ZO_KPE + (tid & 3) * 8;
    const int lk = (tid >> 3) * MLA_KP + (tid & 7) * 16, lp = (tid >> 2) * MLA_KP + 128 + (tid & 3) * 16;
    const int lv = MLA_KTB + ((tid & 7) >> 2) * (MLA_TK * 64) + (tid >> 3) * 64 + (tid & 3) * 16;
    u32x4 rk0, rk1, rv0, rv1, rp;
#define MLA_GLOAD(T) do { const size_t go_ = (size_t)(T) * MLA_TK; rk0 = *(const u32x4*)(gk + go_ * 1024); rk1 = *(const u32x4*)(gk + (go_ + 64) * 1024); \
        rv0 = *(const u32x4*)(gv + go_ * 1024); rv1 = *(const u32x4*)(gv + (go_ + 64) * 1024); rp = *(const u32x4*)(gp + go_ * ZW); } while (0)
#define MLA_LSTORE(slot) do { LAS unsigned char* sb_ = lds + (slot) * MLA_SLOT; *(LAS u32x4*)(sb_ + lk) = rk0; *(LAS u32x4*)(sb_ + lk + 64 * MLA_KP) = rk1; \
        *(LAS u32x4*)(sb_ + lv) = rv0; *(LAS u32x4*)(sb_ + lv + 64 * 64) = rv1; *(LAS u32x4*)(sb_ + lp) = rp; } while (0)
    MLA_GLOAD(0); MLA_LSTORE(0); MLA_GLOAD(1); MLA_LSTORE(1);
    __syncthreads();
    f32x16 o0, o1;
#pragma unroll
    for (int r = 0; r < 16; ++r) { o0[r] = 0.f; o1[r] = 0.f; }
    float m = 0.f, l = 0.f;
    const int kro = q * MLA_KP + hi * 16;
    const int vro = MLA_KTB + (4 * hi + ((lane & 15) >> 2)) * 64 + (16 * ((lane >> 4) & 1) + 4 * (lane & 3)) * 2;
    f32x16 sa0, sa1, sb0, sb1, negm;
#pragma unroll
    for (int r = 0; r < 16; ++r) negm[r] = 0.f;
    m = 0.f;
#define MLA_QK(S0, S1, slot, sub) do { const LAS unsigned char* kb_ = lds + (slot) * MLA_SLOT + (sub) * 64 * MLA_KP + kro; \
        { const bf16x8 k0_ = *(const LAS bf16x8*)(kb_), k1_ = *(const LAS bf16x8*)(kb_ + 32 * MLA_KP); \
          S0 = __builtin_amdgcn_mfma_f32_32x32x16_bf16(k0_, qf[0], negm, 0, 0, 0); S1 = __builtin_amdgcn_mfma_f32_32x32x16_bf16(k1_, qf[0], negm, 0, 0, 0); } \
        _Pragma("unroll") for (int d0 = 1; d0 < 6; ++d0) { const bf16x8 k0_ = *(const LAS bf16x8*)(kb_ + d0 * 32), k1_ = *(const LAS bf16x8*)(kb_ + 32 * MLA_KP + d0 * 32); \
            S0 = __builtin_amdgcn_mfma_f32_32x32x16_bf16(k0_, qf[d0], S0, 0, 0, 0); S1 = __builtin_amdgcn_mfma_f32_32x32x16_bf16(k1_, qf[d0], S1, 0, 0, 0); } } while (0)
#define MAX3(a, b, c) __builtin_fmaxf(__builtin_fmaxf((a), (b)), (c))
#define MLA_STEP(C0, C1, N0, N1, HASN, NSLOT, NSUB, CSLOT, CSUB, FIRST) do { \
        if (HASN) MLA_QK(N0, N1, NSLOT, NSUB); \
        float ba = MAX3(C0[0], C0[1], C1[0]), bb = MAX3(C0[2], C0[3], C1[1]); ba = MAX3(ba, C1[2], C1[3]); \
        _Pragma("unroll") for (int r = 4; r < 16; r += 4) { ba = MAX3(ba, C0[r], C0[r + 1]); bb = MAX3(bb, C0[r + 2], C0[r + 3]); ba = MAX3(ba, C1[r], C1[r + 1]); bb = MAX3(bb, C1[r + 2], C1[r + 3]); } \
        float bm = xhalf_max(__builtin_fmaxf(ba, bb)); \
        if ((FIRST) || __any(bm > 0.f)) {                                \
            const float dl = (FIRST) ? bm : __builtin_fmaxf(bm, 0.f), f = fast_exp2(-dl); m += dl; l *= f; \
            _Pragma("unroll") for (int r = 0; r < 16; ++r) { o0[r] *= f; o1[r] *= f; C0[r] -= dl; C1[r] -= dl; negm[r] = -m; } \
            if (HASN) { _Pragma("unroll") for (int r = 0; r < 16; ++r) { N0[r] -= dl; N1[r] -= dl; } } } \
        float ps = 0.f; \
        _Pragma("unroll") for (int r = 0; r < 16; ++r) { C0[r] = fast_exp2(C0[r]); C1[r] = fast_exp2(C1[r]); ps += C0[r] + C1[r]; } \
        l += ps; \
        const bf16x8 p0 = pfrag(C0, 0), p1 = pfrag(C0, 8), p2 = pfrag(C1, 0), p3 = pfrag(C1, 8); \
        const LAS unsigned char* vb = lds + (CSLOT) * MLA_SLOT + (CSUB) * 64 * 64 + vro; \
        MLA_PV(0, p0); MLA_PV(1, p1); MLA_PV(2, p2); MLA_PV(3, p3); } while (0)
#define MLA_PV(S, P) do { const bf16x8 va = cat8(vtr(vb + (S) * 1024), vtr(vb + (S) * 1024 + 512)), vc = cat8(vtr(vb + MLA_TK * 64 + (S) * 1024), vtr(vb + MLA_TK * 64 + (S) * 1024 + 512)); \
            o0 = __builtin_amdgcn_mfma_f32_32x32x16_bf16(va, P, o0, 0, 0, 0); o1 = __builtin_amdgcn_mfma_f32_32x32x16_bf16(vc, P, o1, 0, 0, 0); } while (0)
    MLA_QK(sa0, sa1, 0, 0);
    int sc = 0, sn = 1, sw = 2;
    constexpr int NT = SEQ / MLA_TK;
    for (int T = 0; T < NT; ++T) {
        const bool has1 = T + 1 < NT, has2 = T + 2 < NT;
        if (has2) MLA_GLOAD(T + 2);
        MLA_STEP(sa0, sa1, sb0, sb1, true, sc, 1, sc, 0, T == 0);
        MLA_STEP(sb0, sb1, sa0, sa1, has1, sn, 0, sc, 1, false);
        if (has2) MLA_LSTORE(sw);
        __syncthreads();
        const int tmp = sc; sc = sn; sn = sw; sw = tmp;
    }
#undef MAX3
#undef MLA_GLOAD
#undef MLA_LSTORE
#undef MLA_QK
#undef MLA_STEP
#undef MLA_PV
    const float inv = 1.f / xhalf_sum(l);
    bf16_t* op = Y + (rb + qblk * 256 + wid * 32 + q) * 1536 + h * 64 + 4 * hi;
#pragma unroll
    for (int j = 0; j < 4; ++j) {
        u32x2 w0, w1; w0.x = cvt_pk_bf16(o0[4 * j] * inv, o0[4 * j + 1] * inv); w0.y = cvt_pk_bf16(o0[4 * j + 2] * inv, o0[4 * j + 3] * inv);
        w1.x = cvt_pk_bf16(o1[4 * j] * inv, o1[4 * j + 1] * inv); w1.y = cvt_pk_bf16(o1[4 * j + 2] * inv, o1[4 * j + 3] * inv);
        *(u32x2*)(op + 8 * j) = w0; *(u32x2*)(op + 32 + 8 * j) = w1;
    }
}
}
constexpr int NWAVES = 8, NTHREADS = 512;
constexpr int LDS_BYTES = 147456;
constexpr int MISC_OFF = 131072 + 320;
#define LDS_WAIT() asm volatile("s_waitcnt lgkmcnt(0)" ::: "memory")

struct Args { const float* in[22]; float* out; unsigned char* ws; int ph_lo, ph_hi; };

enum { MAP_ID = 0, MAP_WIN, MAP_WUQ, MAP_WUKV, MAP_GATE, MAP_UP, MAP_WIN8 };
__device__ __forceinline__ int map_row(int map, int n) {
    if (map == MAP_WIN || map == MAP_WIN8) {
        const int o = map == MAP_WIN8 ? P1_F8_FROM * 256 : 0;
        if (n < 384) return n - o;
        if (n < 416) { const int i = n - 384; return 384 + (i < 16 ? 2 * i : 2 * (i - 16) + 1) - o; }
        return n + 96 - o;
    }
    if (map == MAP_WUQ) { const int h = n / 96, j = n % 96; if (j < 64) return n; const int i = j - 64; return h * 96 + 64 + (i < 16 ? 2 * i : 2 * (i - 16) + 1); }
    if (map == MAP_WUKV) { const int h = n >> 7, j = n & 127; return j < 64 ? h * 64 + j : 512 + h * 64 + (j - 64); }
    if (map == MAP_GATE) return (n >> 7) * 256 + (n & 127);
    if (map == MAP_UP) return (n >> 7) * 256 + 128 + (n & 127);
    return n;
}
template <bool F8 = false>
__device__ __forceinline__ void cvt_item(const float* src, int ldsrc, int nblk, const float* gain, float scale, bf16_t* dst, int lddst, int kdst0, int map, LAS float* scr, int item, int lane) {
    const int kb = item / nblk, nb = item % nblk, k0 = 64 * kb, n0 = 32 * nb;
    f32x4 v[8]; float gs[8];
#pragma unroll
    for (int i = 0; i < 8; ++i) { const int idx = i * 64 + lane, kk = idx >> 3, c4 = idx & 7; v[i] = *(const f32x4*)(src + (size_t)(k0 + kk) * ldsrc + n0 + 4 * c4); gs[i] = gain ? gain[k0 + kk] * scale : scale; }
#pragma unroll
    for (int i = 0; i < 8; ++i) { const int idx = i * 64 + lane, kk = idx >> 3, c4 = idx & 7; LAS float* d = scr + kk * 33 + 4 * c4; d[0] = v[i].x * gs[i]; d[1] = v[i].y * gs[i]; d[2] = v[i].z * gs[i]; d[3] = v[i].w * gs[i]; }
    LDS_WAIT(); asm volatile("" ::: "memory");
    const int c = lane & 7;
#pragma unroll
    for (int j = 0; j < 4; ++j) { const int n = (lane >> 3) + 8 * j; const LAS float* s = scr + (8 * c) * 33 + n;
        u32x4 o; o.x = cvt_pk_bf16(s[0 * 33], s[1 * 33]); o.y = cvt_pk_bf16(s[2 * 33], s[3 * 33]); o.z = cvt_pk_bf16(s[4 * 33], s[5 * 33]); o.w = cvt_pk_bf16(s[6 * 33], s[7 * 33]);
        if constexpr (F8) { u32x2 o8; o8.x = pk_fp8x4(s[0 * 33], s[1 * 33], s[2 * 33], s[3 * 33]); o8.y = pk_fp8x4(s[4 * 33], s[5 * 33], s[6 * 33], s[7 * 33]);
            *(u32x2*)((unsigned char*)dst + (size_t)map_row(map, n0 + n) * lddst + kdst0 + k0 + 8 * c) = o8; }
        else *(u32x4*)(dst + (size_t)map_row(map, n0 + n) * lddst + kdst0 + k0 + 8 * c) = o; }
    LDS_WAIT(); asm volatile("" ::: "memory");
}

struct Ctx {
    LAS unsigned char* lds; int tid, lane, wave, vcu, G, gw, NGW;
    const float* const* in; float* out; unsigned char* ws;
};

__device__ __forceinline__ void phase_prologue(const Ctx& C) {
    LAS float* scr = (LAS float*)(C.lds + C.wave * 16384);
    unsigned char* ws = C.ws;
    constexpr int I_IN = 16 * 181, I_UQ = 4 * 24, I_UKV = 2 * 32, I_BR = 8 * 32, I_OUT = 16 * 32, I_L = I_IN + I_UQ + I_UKV + 3 * I_BR + I_OUT;
    constexpr int I_G = 16 * 88, I_D = 44 * 32, NIT = 2 * I_L + 2 * I_G + I_D;
    for (int it = C.gw; it < NIT; it += C.NGW) {
        int r = it;
        if (r < 2 * I_L) { const int l = r / I_L; r -= l * I_L;
            if (r < I_IN) { if (r % 181 >= (P1_F8_FROM <= 1 ? P1_F8_FROM * 8 : (P1_F8_FROM * 256 - 96) / 32)) cvt_item<true>(C.in[2] + (size_t)l * DM * INC, INC, 181, C.in[1] + l * DM, 256.f, (bf16_t*)(ws + WS_WIN8 + l * SZ_WIN8), DM, 0, MAP_WIN8, scr, r, C.lane);
                            else cvt_item(C.in[2] + (size_t)l * DM * INC, INC, 181, C.in[1] + l * DM, 1.f, (bf16_t*)(ws + WS_WIN + l * SZ_WIN), DM, 0, MAP_WIN, scr, r, C.lane); continue; } r -= I_IN;
            if (r < I_UQ) { cvt_item(C.in[4] + (size_t)l * 256 * 768, 768, 24, C.in[3] + l * 256, 0.10206207261596577f * LOG2E, (bf16_t*)(ws + WS_WUQ + l * SZ_WUQ), 256, 0, MAP_WUQ, scr, r, C.lane); continue; } r -= I_UQ;
            if (r < I_UKV) { cvt_item(C.in[6] + (size_t)l * 128 * 1024, 1024, 32, C.in[5] + l * 128, 1.f, (bf16_t*)(ws + WS_WUKV + l * SZ_WUKV), 256, 0, MAP_WUKV, scr, r, C.lane); continue; } r -= I_UKV;
            if (r < 3 * I_BR) { const int br = r / I_BR; r -= br * I_BR; cvt_item(C.in[9 + br] + (size_t)l * 512 * DM, DM, 32, nullptr, 1.f, (bf16_t*)(ws + WS_WBR + l * SZ_WBR), 1536, br * 512, MAP_ID, scr, r, C.lane); continue; } r -= 3 * I_BR;
            cvt_item(C.in[12] + (size_t)l * DM * DM, DM, 32, nullptr, 1.f, (bf16_t*)(ws + WS_WOUT + l * SZ_WOUT), DM, 0, MAP_ID, scr, r, C.lane); continue; }
        r -= 2 * I_L;
        if (r < I_G) { cvt_item(C.in[14], DFF, 88, C.in[13], 1.f, (bf16_t*)(ws + WS_WGU), DM, 0, MAP_GATE, scr, r, C.lane); continue; } r -= I_G;
        if (r < I_G) { cvt_item(C.in[15], DFF, 88, C.in[13], 1.f, (bf16_t*)(ws + WS_WGU), DM, 0, MAP_UP, scr, r, C.lane); continue; } r -= I_G;
        cvt_item(C.in[16], DM, 32, nullptr, 1.f, (bf16_t*)(ws + WS_WD), DFF, 0, MAP_ID, scr, r, C.lane);
    }
    const int gt = C.vcu * NTHREADS + C.tid, NGT = C.G * NTHREADS;
    if (P1_F8_FROM <= 1) for (int i = gt; i < 2 * 6144; i += NGT) { const int l = i / 6144, r = i % 6144; const u32x4 z = {0u, 0u, 0u, 0u}; *(u32x4*)(ws + WS_WIN8 + l * SZ_WIN8 + (size_t)(416 - P1_F8_FROM * 256) * DM + (size_t)r * 16) = z; }
    for (int i = gt; i < 2 * (12288 + 16384); i += NGT) { const int l = i / (12288 + 16384); int r = i % (12288 + 16384); const u32x4 z = {0u, 0u, 0u, 0u};
        if (r < 12288) *(u32x4*)(ws + WS_WIN + l * SZ_WIN + (size_t)416 * DM * 2 + (size_t)r * 16) = z;
        else { r -= 12288; *(u32x4*)(ws + WS_WUKV + l * SZ_WUKV + (size_t)(r >> 4) * 512 + 256 + (r & 15) * 16) = z; } }
    float* cosT = (float*)(ws + WS_TAB); float* sinT = cosT + SEQ * 16; float* tabb = sinT + SEQ * 16;
    for (int i = gt; i < SEQ * 16; i += NGT) { const int pos = i >> 4, k = i & 15; const float inv = powf(10000.f, -(float)k / 16.f); const float ang = (float)pos * inv; cosT[i] = cosf(ang); sinT[i] = sinf(ang); }
    for (int i = gt; i < 4 * 8 * att::TAB_STRIDE; i += NGT) { const int kind = i / (8 * att::TAB_STRIDE), h = (i / att::TAB_STRIDE) & 7, idx = i % att::TAB_STRIDE;
        const int R = kind == 3 ? 128 : 64, dil = kind == 1 ? 4 : (kind == 2 ? 16 : 1), rel = idx - (R + 31);
        float v = NEGB; if (rel >= -R && rel <= R) v = C.in[8][t5_bucket(rel * dil) * 16 + (kind == 3 ? 8 : 0) + h] * LOG2E;
        tabb[i] = v; }
    const float* x = C.in[0]; bf16_t* xb = (bf16_t*)(ws + WS_XB); float* st = (float*)(ws + WS_ST);
    for (int row = 2 * C.gw; row < MTOK; row += 2 * C.NGW) {
        const f32x4* xr = (const f32x4*)(x + (size_t)row * DM) + C.lane; f32x4 v[8];
#pragma unroll
        for (int j = 0; j < 8; ++j) v[j] = xr[64 * j];
        float s0 = 0.f, s1 = 0.f;
#pragma unroll
        for (int j = 0; j < 8; ++j) { const float q = (v[j].x * v[j].x + v[j].y * v[j].y) + (v[j].z * v[j].z + v[j].w * v[j].w); if (j < 4) s0 += q; else s1 += q;
            u32x2 w; w.x = cvt_pk_bf16(v[j].x, v[j].y); w.y = cvt_pk_bf16(v[j].z, v[j].w); *((u32x2*)(xb + (size_t)row * DM) + C.lane + 64 * j) = w;
            if (P1_F8_FROM < 23) *((unsigned*)(ws + WS_XB8P + (size_t)(row + (j >> 2)) * DM) + C.lane + 64 * (j & 3)) = pk_fp8x4(v[j].x * 16.f, v[j].y * 16.f, v[j].z * 16.f, v[j].w * 16.f); }
        s0 = wave_sum(s0); s1 = wave_sum(s1);
        if (C.lane < 32) st[(size_t)row * 16 + C.lane] = C.lane == 0 ? s0 : (C.lane == 16 ? s1 : 0.f);
    }
}

__device__ __forceinline__ void phase_moe_weights(const Ctx& C) {
    LAS float* scr = (LAS float*)(C.lds + 40960 + C.wave * 8704);
    constexpr int I_G = 16 * 112, I_D = 56 * 32, I_E = 2 * I_G + I_D;
    for (int it = C.gw; it < NEXP * I_E; it += C.NGW) {
        const int e = it / I_E; int r = it % I_E;
        if (r < I_G) { cvt_item<MOE_F8 != 0>(C.in[18] + (size_t)e * DM * DFE, DFE, 112, C.in[13] + DM, MOE_F8 ? 256.f : 1.f, (bf16_t*)(C.ws + WS_EGU + (size_t)e * 2 * DFE * DM * (MOE_F8 ? 1 : 2)), DM, 0, MAP_GATE, scr, r, C.lane); continue; } r -= I_G;
        if (r < I_G) { cvt_item<MOE_F8 != 0>(C.in[19] + (size_t)e * DM * DFE, DFE, 112, C.in[13] + DM, MOE_F8 ? 256.f : 1.f, (bf16_t*)(C.ws + WS_EGU + (size_t)e * 2 * DFE * DM * (MOE_F8 ? 1 : 2)), DM, 0, MAP_UP, scr, r, C.lane); continue; } r -= I_G;
        cvt_item<MOE_DN_F8 != 0>(C.in[20] + (size_t)e * DFE * DM, DM, 32, nullptr, MOE_DN_F8 ? 1024.f : 1.f, (bf16_t*)(C.ws + WS_ED + (size_t)e * DM * DFE * (MOE_DN_F8 ? 1 : 2)), DFE, 0, MAP_ID, scr, r, C.lane);
    }
}

template <bool SECOND>
__device__ __forceinline__ void phase_band(const Ctx& C, const bf16_t* HM, bf16_t* PB, float* PBS, bf16_t* Y, const float* sink) {
    constexpr int IPK = MC / 2048 * 64, NIT = (SECOND ? 1 : 3) * IPK;
    const float* tabg = (const float*)(C.ws + WS_TAB) + 2 * SEQ * 16;
    att::BandPre P; att::BandItem it, nx;
    int i = C.vcu;
#define BAND_IDX(IDX) (SECOND ? 2 * IPK + (IDX) : ((IDX) < 2 * IPK ? (IDX) : (IDX) + IPK))
    if (i < NIT) { it = att::band_decode(BAND_IDX(i), IPK); att::band_issue(P, it, HM, tabg, C.tid, C.wave, C.lane); }
    for (; i < NIT; i += C.G) {
        att::band_store(P, it, C.lds, C.tid);
        bf16x8 qf[4];
#pragma unroll
        for (int d0 = 0; d0 < 4; ++d0) qf[d0] = P.q[d0];
        __syncthreads();
        const bool more = i + C.G < NIT;
        if (more) { nx = att::band_decode(BAND_IDX(i + C.G), IPK); att::band_issue(P, nx, HM, tabg, C.tid, C.wave, C.lane); }
        const int q = C.lane & 31, hi = C.lane >> 5, w = C.wave;
        if (it.kind == 3) {
            const int h = it.hh * 4 + (w >> 1), a0w = it.a0 + 32 * (w & 1); const size_t rowq = (size_t)it.b * SEQ + a0w + q;
            att::band_compute<9, 1>(qf, C.lds, 128 - it.a0, a0w, SEQ, (const LAS float*)(C.lds + att::BW_TAB) + (w >> 1) * att::TAB_STRIDE, Y + rowq * 1536 + 1024 + h * 64 + 4 * hi, nullptr, sink[h] * LOG2E, C.lane);
        } else if (it.kind == 2) {
            const int a0w = 32 * (w & 3), g = it.g0 + (w >> 2); const size_t rowq = (size_t)it.b * SEQ + (size_t)(a0w + q) * 16 + g;
            const size_t po = rowq * 512 + it.hh * 64 + 4 * hi, so = (rowq * 8 + it.hh) * 2;
            att::band_compute<5, 2>(qf, C.lds, (w >> 2) * 128, a0w, 128, (const LAS float*)(C.lds + att::BW_TAB), Y + rowq * 1536 + 512 + it.hh * 64 + 4 * hi, nullptr, 0.f, C.lane,
                                    PB + po, PB + (size_t)MC * 512 + po, PBS + so, PBS + (size_t)MC * 16 + so);
        } else {
            const int a0w = it.a0 + 32 * w, dil = it.kind == 0 ? 1 : 4, L = SEQ / dil, rowoff = 64 - it.a0;
            const size_t rowq = (size_t)it.b * SEQ + (size_t)(a0w + q) * dil + it.g0;
            att::band_compute<5, 0>(qf, C.lds, rowoff, a0w, L, (const LAS float*)(C.lds + att::BW_TAB), PB + (size_t)it.kind * MC * 512 + rowq * 512 + it.hh * 64 + 4 * hi,
                                    PBS + (size_t)it.kind * MC * 16 + (rowq * 8 + it.hh) * 2, 0.f, C.lane);
        }
        __syncthreads();
        it = nx;
    }
#undef BAND_IDX
}

__device__ __forceinline__ void phase_mla(const Ctx& C, const bf16_t* Q, const bf16_t* KV, const bf16_t* Zc, bf16_t* Y) {
    constexpr int NU = MC / 256 * 8;
    for (int u = C.vcu; u < NU; u += C.G) { const int qblk = u & 7, bh = u >> 3; att::mla_unit(Q, KV, Zc, Y, bh >> 3, bh & 7, qblk, C.lds, C.tid, C.wave, C.lane); }
}

__device__ __forceinline__ void phase_route(const Ctx& C) {
    LAS float* wr = (LAS float*)C.lds; LAS int* cnt = (LAS int*)(C.lds + 32768);
    const float* g2 = C.in[13] + DM; const float* router = C.in[17];
    for (int i = C.tid; i < DM * 8; i += NTHREADS) wr[i] = router[i] * g2[i >> 3];
    if (C.tid < 16) cnt[C.tid] = 0;
    __syncthreads();
    int* sel = (int*)(C.ws + WS_SEL); float* gwp = (float*)(C.ws + WS_GW); float* rr = (float*)(C.ws + WS_RR);
    const int w = blockIdx.x;
    for (int j = 0; j < 16; ++j) {
        const int tok = w * 128 + C.wave * 16 + j;
        const u32x2* xr = (const u32x2*)((const bf16_t*)(C.ws + WS_XB) + (size_t)tok * DM) + C.lane;
        float lg[8], ss = 0.f;
#pragma unroll
        for (int e = 0; e < 8; ++e) lg[e] = 0.f;
#pragma unroll
        for (int q = 0; q < 4; ++q) { const u32x2 wv = xr[64 * q]; const f32x4 v = {bf_lo(wv.x), bf_hi(wv.x), bf_lo(wv.y), bf_hi(wv.y)}; ss += (v.x * v.x + v.y * v.y) + (v.z * v.z + v.w * v.w);
            const int k = 4 * C.lane + 256 * q;
            if (MOE_F8) *(unsigned*)(C.ws + WS_XB8 + (size_t)tok * DM + k) = pk_fp8x4(v.x * 16.f, v.y * 16.f, v.z * 16.f, v.w * 16.f);
#pragma unroll
            for (int c = 0; c < 4; ++c) { const float xv = v[c]; const f32x4 w0 = *(const LAS f32x4*)(wr + (k + c) * 8), w1 = *(const LAS f32x4*)(wr + (k + c) * 8 + 4);
                lg[0] += xv * w0.x; lg[1] += xv * w0.y; lg[2] += xv * w0.z; lg[3] += xv * w0.w; lg[4] += xv * w1.x; lg[5] += xv * w1.y; lg[6] += xv * w1.z; lg[7] += xv * w1.w; } }
        ss = wave_sum(ss);
#pragma unroll
        for (int e = 0; e < 8; ++e) lg[e] = wave_sum(lg[e]);
        const float r = rsqrtf(ss * (1.f / 1024.f) + EPS);
        if (C.lane == 0) {
            int i1 = 0; float v1 = lg[0];
#pragma unroll
            for (int e = 1; e < 8; ++e) if (lg[e] > v1) { v1 = lg[e]; i1 = e; }
            int i2 = -1; float v2 = -3e38f;
#pragma unroll
            for (int e = 0; e < 8; ++e) if (e != i1 && lg[e] > v2) { v2 = lg[e]; i2 = e; }
            const float e2 = expf((v2 - v1) * r);
            sel[tok * 2] = i1; sel[tok * 2 + 1] = i2; gwp[tok * 2] = 1.f / (1.f + e2); gwp[tok * 2 + 1] = e2 / (1.f + e2); rr[tok] = r;
            __hip_atomic_fetch_add(&cnt[i1], 1, __ATOMIC_RELAXED, __HIP_MEMORY_SCOPE_WORKGROUP); __hip_atomic_fetch_add(&cnt[8 + i2], 1, __ATOMIC_RELAXED, __HIP_MEMORY_SCOPE_WORKGROUP);
        }
    }
    __syncthreads();
    if (C.tid < 16) ((int*)(C.ws + WS_META))[MI_CNT + (C.tid >> 3) * 2048 + w * 8 + (C.tid & 7)] = cnt[C.tid];
}

__device__ __forceinline__ void phase_sort(const Ctx& C) {
    LAS int* tot = (LAS int*)C.lds; LAS int* pre = tot + 16; LAS int* base = tot + 32;
    int* meta = (int*)(C.ws + WS_META); const int w = blockIdx.x;
    if (C.tid < 16) { const int k = C.tid >> 3, e = C.tid & 7; int t = 0, p = 0;
        for (int w2 = 0; w2 < 256; ++w2) { const int c = meta[MI_CNT + k * 2048 + w2 * 8 + e]; t += c; if (w2 < w) p += c; }
        tot[C.tid] = t; pre[C.tid] = p; }
    __syncthreads();
    if (C.tid < 16) { const int k = C.tid >> 3, e = C.tid & 7; int b = 0; for (int e2 = 0; e2 < e; ++e2) b += (tot[k * 8 + e2] + 255) & ~255; base[C.tid] = b; }
    __syncthreads();
    const int* sel = (const int*)(C.ws + WS_SEL); const float* gwp = (const float*)(C.ws + WS_GW);
    int* rowtok = (int*)(C.ws + WS_ROWTOK); float* rowgw = (float*)(C.ws + WS_ROWGW); float* rowrr = (float*)(C.ws + WS_ROWRR); const float* rr = (const float*)(C.ws + WS_RR);
    if (C.wave < 2) { const int k = C.wave; LAS int* runL = tot + 48 + k * 8;
        if (C.lane < 8) runL[C.lane] = base[k * 8 + C.lane] + pre[k * 8 + C.lane];
        for (int j = 0; j < 2; ++j) { const int tok = w * 128 + j * 64 + C.lane; const int e = sel[tok * 2 + k]; int pos = 0;
#pragma unroll 1
            for (int e2 = 0; e2 < 8; ++e2) { const unsigned long long mk = __ballot(e == e2); const int r0 = runL[e2]; const int rank = __popcll(mk & ((1ull << C.lane) - 1ull));
                if (e == e2) pos = r0 + rank; if (C.lane == 0) runL[e2] = r0 + __popcll(mk); }
            rowtok[k * MOE_ROWS + pos] = tok; rowgw[k * MOE_ROWS + pos] = gwp[tok * 2 + k]; rowrr[k * MOE_ROWS + pos] = rr[tok]; } }
    if (w < 16) { const int k = w >> 3, e = w & 7; const int t = tot[k * 8 + e], b = base[k * 8 + e], pe = (t + 255) & ~255;
        for (int i = b + t + C.tid; i < b + pe; i += NTHREADS) { rowtok[k * MOE_ROWS + i] = -1; rowgw[k * MOE_ROWS + i] = 0.f; rowrr[k * MOE_ROWS + i] = 0.f; } }
    if (w == 16 && C.tid < 2) { const int k = C.tid; int nt = 0;
        for (int e = 0; e < 8; ++e) { const int n = (tot[k * 8 + e] + 255) >> 8; for (int i = 0; i < n; ++i) meta[MI_TILEE + k * 160 + nt + i] = e; nt += n; }
        meta[MI_NTILE + k] = nt; }
}

__device__ __forceinline__ void phase_final(const Ctx& C) {
    const float* g = C.in[21];
    for (int row = 2 * C.gw; row < MTOK; row += 2 * C.NGW) {
        f32x4 v[8]; float s0 = 0.f, s1 = 0.f;
#pragma unroll
        for (int j = 0; j < 8; ++j) { const u32x2 wv = ((const u32x2*)xm_row(C.ws, row + (j >> 2)))[C.lane + 64 * (j & 3)]; v[j] = (f32x4){bf_lo(wv.x), bf_hi(wv.x), bf_lo(wv.y), bf_hi(wv.y)}; }
#ifdef PROBE_NAN
#pragma unroll
        for (int j = 0; j < 8; ++j) { v[j].x = v[j].x == v[j].x && fabsf(v[j].x) < 1e30f ? v[j].x : 0.f; v[j].y = v[j].y == v[j].y && fabsf(v[j].y) < 1e30f ? v[j].y : 0.f; v[j].z = v[j].z == v[j].z && fabsf(v[j].z) < 1e30f ? v[j].z : 0.f; v[j].w = v[j].w == v[j].w && fabsf(v[j].w) < 1e30f ? v[j].w : 0.f; }
#endif
#pragma unroll
        for (int j = 0; j < 8; ++j) { const float q = (v[j].x * v[j].x + v[j].y * v[j].y) + (v[j].z * v[j].z + v[j].w * v[j].w); if (j < 4) s0 += q; else s1 += q; }
        const float r0 = rsqrtf(wave_sum(s0) * (1.f / 1024.f) + EPS), r1 = rsqrtf(wave_sum(s1) * (1.f / 1024.f) + EPS);
        f32x4* orow = (f32x4*)(C.out + (size_t)row * DM) + C.lane;
#pragma unroll
        for (int j = 0; j < 8; ++j) orow[64 * j] = v[j] * (j < 4 ? r0 : r1) * ((const f32x4*)g)[C.lane + 64 * (j & 3)];
    }
}
#ifndef MKP
#define MKP 0x1ffff
#endif
#ifndef ALEPI
#define ALEPI true
#endif
#ifndef ALEPI1
#define ALEPI1 ALEPI
#endif
#ifndef DUPK
#define DUPK 0
#endif
#ifdef PROBE_TIMER
#define PROBE_T0 __syncthreads(); const unsigned long long pt0_ = __builtin_amdgcn_s_memrealtime()
#define PROBE_T1(slot) __syncthreads(); if (threadIdx.x == 0) { const unsigned long long pt1_ = __builtin_amdgcn_s_memrealtime(); atomicAdd((unsigned*)(ws + WS_CTL) + CW_Q + 2048 + (slot), (unsigned)(pt1_ - pt0_)); }
#else
#define PROBE_T0
#define PROBE_T1(slot)
#endif
#define REP(bit) for (int rep_ = 0; rep_ < ((DUPK & (bit)) ? 2 : 1); ++rep_)
constexpr int PH_PER_CHUNK = 3, PH_LAYER_TAIL = 2;
constexpr int PH_L0 = 1, PH_FFN = PH_L0 + PH_PER_CHUNK * NCHUNK + PH_LAYER_TAIL, PH_L1 = PH_FFN + 2, PH_MOE = PH_L1 + PH_PER_CHUNK * NCHUNK + PH_LAYER_TAIL, PH_FINAL = PH_MOE + (MOE_NOSPLIT ? 5 : 7), PH_TOTAL = PH_FINAL + 1;

__global__ void __launch_bounds__(NTHREADS, 2) mega(Args args) {
    extern __shared__ __attribute__((aligned(16))) unsigned char lds_raw[];
#define MKCTX Ctx C; { int t_ = threadIdx.x; asm volatile("" : "+v"(t_)); C.lds = (LAS unsigned char*)lds_raw; C.tid = t_; C.lane = t_ & 63; C.wave = __builtin_amdgcn_readfirstlane(t_ >> 6); \
    C.G = gridDim.x; { const int bx = blockIdx.x; C.vcu = (C.G % 8 == 0) ? (bx % 8) * (C.G / 8) + bx / 8 : bx; } \
    C.gw = C.vcu * NWAVES + C.wave; C.NGW = C.G * NWAVES; C.in = args.in; C.out = args.out; C.ws = args.ws; }
    volatile LAS unsigned* MISC = (volatile LAS unsigned*)((LAS unsigned char*)lds_raw + MISC_OFF);
    if (threadIdx.x < 32) MISC[threadIdx.x] = 0u;
    __syncthreads();
    unsigned char* ws = args.ws;
    XcdBarrier bar; bar.bar = (unsigned*)(ws + WS_CTL) + CW_BAR; bar.x = 0; bar.st = nullptr;
    const int lo = args.ph_lo, hi = args.ph_hi;
    const bool use_bar = (hi - lo) > 1;
    if (use_bar) bar = xcd_barrier_post((unsigned*)(ws + WS_CTL) + CW_BAR, MISC + 8);
    int ph = 0;
#define IN_PH (ph >= lo && ph < hi)
#ifdef PROBE_BAR
    const unsigned long long pk0_ = __builtin_amdgcn_s_memrealtime();
#define END_PH do { if (ph >= lo && ph + 1 < hi) { __syncthreads(); const unsigned long long pb0_ = __builtin_amdgcn_s_memrealtime(); xcd_barrier(bar); \
        if (threadIdx.x == 0 && (((unsigned)(PROBE_BAR) >> ph) & 1u)) atomicAdd((unsigned*)(ws + WS_CTL) + CW_Q + 2048, (unsigned)(__builtin_amdgcn_s_memrealtime() - pb0_)); } ++ph; } while (0)
#else
#define END_PH do { if (ph >= lo && ph + 1 < hi) xcd_barrier(bar); ++ph; } while (0)
#endif

    bf16_t* xb = (bf16_t*)(ws + WS_XB); float* st = (float*)(ws + WS_ST);
    const float* cosT = (const float*)(ws + WS_TAB); const float* sinT = cosT + SEQ * 16;

    if (IN_PH) REP(1) { MKCTX; if (MKP & 1) phase_prologue(C); }
    END_PH;
#ifdef PROBE_SLEEP
    { const unsigned long long t0_ = __builtin_amdgcn_s_memrealtime(); while (__builtin_amdgcn_s_memrealtime() - t0_ < (unsigned long long)(PROBE_SLEEP) * 100ull) __builtin_amdgcn_s_sleep(64); }
#endif

#define CHUNK_BODY(l, c) \
{ \
            const int row0 = c * MC; \
            bf16_t* Z = (bf16_t*)(ws + WS_Z); bf16_t* Q = (bf16_t*)(ws + WS_Q); bf16_t* KV = TMP_IN_OUT ? (bf16_t*)args.out : (bf16_t*)(ws + WS_KV); bf16_t* Y = (bf16_t*)(ws + WS_Y) + (size_t)row0 * 1536; \
            bf16_t* PB = TMP_IN_OUT ? (bf16_t*)args.out + (size_t)MC * 1024 : (bf16_t*)(ws + WS_PB); float* PBS = (float*)(ws + WS_PBS); float* SQ = (float*)(ws + WS_SQ); float* SKV = SQ + (size_t)MC * 4; \
 \
            if (IN_PH && (MKP & 2)) REP(2) { MKCTX; \
                pg8::Gemm g{xb + (size_t)row0 * DM, (const bf16_t*)(ws + WS_WIN + l * SZ_WIN), DM, DM, DM, nullptr}; \
                pg8::StaticOrder S; S.init(MC, P1_F8_FROM * 256, C.G, (int)blockIdx.x); \
                pg8::EpiIn E{Z, st + (size_t)row0 * 16, SQ, SKV, cosT, sinT, ws + WS_GB + (size_t)row0 * 3072, (bf16_t*)(ws + WS_QKV), ws, 0, 1.f}; \
                pg8::gemm_phase<pg8::EpiIn, pg8::StaticOrder, ALEPI1, false>(C.lds, g, S, E); \
            } \
            if (IN_PH && (MKP & 2) && P1_F8_FROM < 23) REP(2) { MKCTX;                          \
                pg8::Gemm g{(const bf16_t*)(ws + WS_XB8P + (size_t)row0 * DM), (const bf16_t*)(ws + WS_WIN8 + l * SZ_WIN8), DM / 2, DM / 2, DM / 2, nullptr}; \
                pg8::StaticOrder S; S.init(MC, (23 - P1_F8_FROM) * 256, C.G, (int)((blockIdx.x + (P1_F8_FROM * (MC / 256)) % 256) % C.G)); \
                pg8::EpiIn E{Z, st + (size_t)row0 * 16, SQ, SKV, cosT, sinT, ws + WS_GB + (size_t)row0 * 3072, (bf16_t*)(ws + WS_QKV), ws, P1_F8_FROM, 1.f / 4096.f}; \
                pg8::gemm_phase<pg8::EpiIn, pg8::StaticOrder, ALEPI1, false, false, true>(C.lds, g, S, E); \
            } \
            END_PH; \
 \
            if (IN_PH) { \
                if (MKP & 4) REP(4) { MKCTX; pg8::Gemm g{Z + ZO_CQ, (const bf16_t*)(ws + WS_WUQ + l * SZ_WUQ), 256, ZW, 256, nullptr}; \
                  pg8::StaticOrder S; S.init(MC, 768, C.G, (int)blockIdx.x); \
                  pg8::EpiQ E{Q, SQ, cosT, sinT}; \
                  pg8::gemm_phase<pg8::EpiQ, pg8::StaticOrder, ALEPI, false>(C.lds, g, S, E); } \
                if (MKP & 8) REP(8) { MKCTX; pg8::Gemm g{Z + ZO_CKV, (const bf16_t*)(ws + WS_WUKV + l * SZ_WUKV), 256, ZW, 256, nullptr}; \
                  pg8::StaticOrder S; S.init(MC, 1024, C.G, (int)((blockIdx.x + 128) % C.G)); \
                  pg8::EpiKV E{KV, SKV}; \
                  pg8::gemm_phase<pg8::EpiKV, pg8::StaticOrder, ALEPI, false>(C.lds, g, S, E); } \
                if (MKP & 16) REP(16) { MKCTX; phase_band<false>(C, (const bf16_t*)(ws + WS_QKV), PB, PBS, Y, C.in[7] + l * 8); } \
            } \
            END_PH; \
 \
            if (IN_PH) { \
                if (MKP & 32) REP(32) { MKCTX; phase_band<true>(C, (const bf16_t*)(ws + WS_QKV), PB, PBS, Y, C.in[7] + l * 8); } \
                if (MKP & 64) REP(64) { MKCTX; PROBE_T0; phase_mla(C, Q, KV, Z, Y); PROBE_T1(rep_); } \
            } \
            END_PH; \
 \
}
#define LAYER_TAIL(l) \
{ const int row0 = 0; bf16_t* MG = (bf16_t*)(ws + WS_MG); bf16_t* Y = (bf16_t*)(ws + WS_Y); (void)Y; \
            if (IN_PH && (MKP & 128)) REP(128) { MKCTX; \
                pg8::Gemm g{Y, (const bf16_t*)(ws + WS_WBR + l * SZ_WBR), 1536, 1536, 1536, nullptr}; \
                pg8::StaticOrder S; S.init(MTOK, DM, C.G, (int)blockIdx.x); \
                pg8::EpiBr E{ws + WS_GB, MG, ws}; \
                pg8::gemm_phase<pg8::EpiBr, pg8::StaticOrder, ALEPI, false>(C.lds, g, S, E); \
            } \
            END_PH; \
 \
            if (IN_PH && (MKP & 256)) REP(l == 0 ? 256 : 0) { MKCTX; \
                pg8::Gemm g{MG, (const bf16_t*)(ws + WS_WOUT + l * SZ_WOUT), DM, DM, DM, nullptr}; \
                pg8::StaticOrder S; S.init(MTOK, DM, C.G, (int)blockIdx.x); \
                pg8::EpiRes<false> E{xb, st, row0, nullptr}; pg8::gemm_phase<pg8::EpiRes<false>, pg8::StaticOrder, ALEPI, false, true>(C.lds, g, S, E); \
            } \
            END_PH; \
}
#define FFN_BODY() \
{ \
            bf16_t* ACT = (bf16_t*)(ws + WS_ACT); \
            if (IN_PH && (MKP & 512)) REP(512) { MKCTX; \
                pg8::Gemm g{xb, (const bf16_t*)(ws + WS_WGU), DM, DM, DM, nullptr}; \
                pg8::StaticOrder S; S.init(MTOK, 2 * DFF, C.G, (int)blockIdx.x); \
                pg8::EpiGU E{ACT, st, DFF, ws}; \
                pg8::gemm_phase<pg8::EpiGU, pg8::StaticOrder, ALEPI, false>(C.lds, g, S, E); \
            } \
            END_PH; \
            if (IN_PH && (MKP & 1024)) { MKCTX; \
                pg8::Gemm g{ACT, (const bf16_t*)(ws + WS_WD), DFF, DFF, DFF, nullptr}; \
                pg8::StaticOrder S; S.init(MTOK, DM, C.G, (int)blockIdx.x); \
                pg8::EpiRes<(P1_F8_FROM < 23)> E{xb, st, 0, ws + WS_XB8P};                                \
                pg8::gemm_phase<pg8::EpiRes<(P1_F8_FROM < 23)>, pg8::StaticOrder, ALEPI, false, true>(C.lds, g, S, E); \
            } \
            END_PH; \
}
#define MOE_HEAD() \
{ \
            if (IN_PH) { if (MKP & 2048) REP(2048) { MKCTX; phase_route(C); } if (MKP & 4096) REP(4096) { MKCTX; phase_moe_weights(C); } } \
            END_PH; \
            if (IN_PH && (MKP & 8192)) { MKCTX; phase_sort(C); } \
            END_PH; \
}
#define MOE_GU(kh, dyn) { const int k = MOE_NOSPLIT ? (kh) : (kh) >> 1, half = MOE_NOSPLIT ? 0 : (kh) & 1; MKCTX; \
        const int* rowtok = (const int*)(ws + WS_ROWTOK) + k * MOE_ROWS; \
        bf16_t* MACT = (bf16_t*)(ws + WS_MACT + (MOE_NOSPLIT ? (size_t)k * MOE_ROWS * DFE : (size_t)half * MOE_ROWS * DF0 * (MOE_DN_F8 ? 1 : 2))); const int dfw = MOE_NOSPLIT ? DFE : (half ? DF1 : DF0); \
        pg8::Gemm g{MOE_F8 ? (const bf16_t*)(ws + WS_XB8) : xb, (const bf16_t*)(ws + WS_EGU), MOE_F8 ? DM / 2 : DM, MOE_F8 ? DM / 2 : DM, MOE_F8 ? DM / 2 : DM, rowtok}; \
        pg8::DynMoeOrder S{(unsigned*)(ws + WS_CTL) + CW_Q + 64 * (kh), (volatile LAS int*)(C.lds + MISC_OFF + 64), meta[MI_NTILE + k], dfw / 128, 28, half ? DF0 / 128 : 0, meta + MI_TILEE + k * 160, C.vcu}; \
        pg8::EpiGUMoe E{MACT, (const float*)(ws + WS_ROWRR) + k * MOE_ROWS, dfw, ws}; \
        pg8::gemm_phase<pg8::EpiGUMoe, pg8::DynMoeOrder, ALEPI, true, false, MOE_F8 != 0>(C.lds, g, S, E); }
#define MOE_DN(kh) { const int k = MOE_NOSPLIT ? (kh) : (kh) >> 1, half = MOE_NOSPLIT ? 0 : (kh) & 1; MKCTX; \
        const int* rowtok = (const int*)(ws + WS_ROWTOK) + k * MOE_ROWS; const float* rowgw = (const float*)(ws + WS_ROWGW) + k * MOE_ROWS; \
        bf16_t* MACT = (bf16_t*)(ws + WS_MACT + (MOE_NOSPLIT ? (size_t)k * MOE_ROWS * DFE : (size_t)half * MOE_ROWS * DF0 * (MOE_DN_F8 ? 1 : 2))); const int dfw = MOE_NOSPLIT ? DFE : (half ? DF1 : DF0); \
        pg8::Gemm g{MACT, (const bf16_t*)(ws + WS_ED + (size_t)half * DF0 * (MOE_DN_F8 ? 1 : 2)), MOE_DN_F8 ? dfw / 2 : dfw, MOE_DN_F8 ? dfw / 2 : dfw, MOE_DN_F8 ? DFE / 2 : DFE, nullptr}; \
        pg8::MoeOrder S{meta[MI_NTILE + k], 4, C.G, (int)blockIdx.x, 4, 0, meta + MI_TILEE + k * 160}; \
        if ((kh) == 0) { pg8::EpiDnMoe<true> E{ws, rowtok, rowgw}; pg8::gemm_phase<pg8::EpiDnMoe<true>, pg8::MoeOrder, ALEPI, false, true, MOE_DN_F8 != 0>(C.lds, g, S, E); } \
        else { pg8::EpiDnMoe<false> E{ws, rowtok, rowgw}; pg8::gemm_phase<pg8::EpiDnMoe<false>, pg8::MoeOrder, ALEPI, false, true, MOE_DN_F8 != 0>(C.lds, g, S, E); } }
    CHUNK_BODY(0, 0)
#if CHB < 16
    CHUNK_BODY(0, 1)
#endif
#if CHB < 8
    CHUNK_BODY(0, 2)
    CHUNK_BODY(0, 3)
#endif
    LAYER_TAIL(0)
    FFN_BODY()
    CHUNK_BODY(1, 0)
#if CHB < 16
    CHUNK_BODY(1, 1)
#endif
#if CHB < 8
    CHUNK_BODY(1, 2)
    CHUNK_BODY(1, 3)
#endif
    LAYER_TAIL(1)
    MOE_HEAD()
    { const int* meta = (const int*)(ws + WS_META);
    if (IN_PH) { if (MKP & 16384) REP(16384) MOE_GU(0, 1) }
    END_PH;
    if (IN_PH) { if (MKP & 32768) MOE_DN(0) if (MKP & 16384) MOE_GU(1, 1) }
    END_PH;
#if !MOE_NOSPLIT
    if (IN_PH) { if (MKP & 32768) MOE_DN(1) if (MKP & 16384) MOE_GU(2, 1) }
    END_PH;
    if (IN_PH) { if (MKP & 32768) MOE_DN(2) if (MKP & 16384) MOE_GU(3, 1) }
    END_PH;
    if (IN_PH) { if (MKP & 32768) MOE_DN(3) }
    END_PH;
#else
    if (IN_PH) { if (MKP & 32768) MOE_DN(1) }
    END_PH;
#endif
    }
    if (IN_PH && (MKP & 65536)) { MKCTX; phase_final(C); }
    END_PH;
#ifdef PROBE_BAR
    { if (threadIdx.x == 0) atomicAdd((unsigned*)(ws + WS_CTL) + CW_Q + 2049, (unsigned)(__builtin_amdgcn_s_memrealtime() - pk0_));
      xcd_barrier(bar);
      const unsigned* tim = (const unsigned*)(ws + WS_CTL) + CW_Q + 2048;
      const float ta = (float)__hip_atomic_load(tim, __ATOMIC_RELAXED, __HIP_MEMORY_SCOPE_AGENT), tb = (float)__hip_atomic_load(tim + 1, __ATOMIC_RELAXED, __HIP_MEMORY_SCOPE_AGENT);
      float code = (float)(PROBE_UNIT) * ta / tb;
      code = fminf(98.f, fmaxf(1.f, rintf(code))); const float v = sqrtf(code);
      for (size_t i = (size_t)blockIdx.x * NTHREADS + threadIdx.x; i < (size_t)MTOK * DM; i += (size_t)gridDim.x * NTHREADS) args.out[i] = v; }
#endif
#ifdef PROBE_TIMER
    { xcd_barrier(bar);
      const unsigned* tim = (const unsigned*)(ws + WS_CTL) + CW_Q + 2048;
      const float ta = (float)__hip_atomic_load(tim, __ATOMIC_RELAXED, __HIP_MEMORY_SCOPE_AGENT), tb = (float)__hip_atomic_load(tim + 1, __ATOMIC_RELAXED, __HIP_MEMORY_SCOPE_AGENT);
      float code = PROBE_TIMER == 1 ? 10.f * ta / tb : (PROBE_TIMER == 2 ? ta * (1.f / (256.f * 100.f * 10.f)) : tb * (1.f / (256.f * 100.f * 10.f)));
      code = fminf(98.f, fmaxf(1.f, rintf(code))); const float v = sqrtf(code);
      for (size_t i = (size_t)blockIdx.x * NTHREADS + threadIdx.x; i < (size_t)MTOK * DM; i += (size_t)gridDim.x * NTHREADS) args.out[i] = v; }
#endif
#undef IN_PH
#undef END_PH
}
#if !MK_DEBUG
extern "C" void kernel_launch(void* const* d_in, const int* in_sizes, int n_in, void* d_out, int out_size, void* d_ws, size_t ws_size, hipStream_t stream) {
    static int grid = 0;
    if (grid == 0) {
        if (n_in != 22 || out_size != MTOK * DM || ws_size < WS_NEED) { fprintf(stderr, "kernel_launch: unexpected shapes / workspace (%zu < %zu); nothing launched\n", ws_size, (size_t)WS_NEED); grid = -1; return; }
        int dev = 0, cus = 0, per_cu = 0;
        if (hipGetDevice(&dev) != hipSuccess || hipDeviceGetAttribute(&cus, hipDeviceAttributeMultiprocessorCount, dev) != hipSuccess) { grid = -1; return; }
        if (hipFuncSetAttribute((const void*)mega, hipFuncAttributeMaxDynamicSharedMemorySize, LDS_BYTES) != hipSuccess) { fprintf(stderr, "kernel_launch: hipFuncSetAttribute failed\n"); grid = -1; return; }
        if (hipOccupancyMaxActiveBlocksPerMultiprocessor(&per_cu, (const void*)mega, NTHREADS, LDS_BYTES) != hipSuccess || per_cu < 1) { fprintf(stderr, "kernel_launch: occupancy query says %d\n", per_cu); }
        (void)hipGetLastError();
        grid = cus;
        if (grid != 256) { fprintf(stderr, "kernel_launch: built for 256 CUs, device has %d; nothing launched\n", cus); grid = -1; return; }
    }
    if (grid < 0) return;
    if (hipMemsetAsync((char*)d_ws + WS_CTL, 0, CTL_ZERO_BYTES, stream) != hipSuccess) return;
    Args a{};
    for (int i = 0; i < 22; ++i) a.in[i] = (const float*)d_in[i];
    a.out = (float*)d_out; a.ws = (unsigned char*)d_ws; a.ph_lo = 0; a.ph_hi = PH_TOTAL;
    hipLaunchKernelGGL(mega, dim3(grid), dim3(NTHREADS), LDS_BYTES, stream, a);
}
#endif
```

```cpp
#include <hip/hip_runtime.h>
#include <cstdio>
#include <cstdint>
#include <cmath>

#ifndef MK_DEBUG
#define MK_DEBUG 0
#endif
#ifndef MOE_F8
#define MOE_F8 1
#endif
#ifndef MOE_DN_F8
#define MOE_DN_F8 1
#endif
#ifndef MOE_NOSPLIT
#define MOE_NOSPLIT 1
#endif
#ifndef P1_F8_FROM
#define P1_F8_FROM 0
#endif
#ifndef CHB
#define CHB 8
#endif

#define GAS __attribute__((address_space(1)))
#define LAS __attribute__((address_space(3)))
typedef unsigned short bf16_t;
typedef short bf16x8 __attribute__((ext_vector_type(8)));
typedef short s16x4 __attribute__((ext_vector_type(4)));
typedef float f32x4 __attribute__((ext_vector_type(4)));
typedef float f32x2 __attribute__((ext_vector_type(2)));
typedef float f32x16 __attribute__((ext_vector_type(16)));
typedef unsigned u32x4 __attribute__((ext_vector_type(4)));
typedef unsigned u32x2 __attribute__((ext_vector_type(2)));
typedef __bf16 bf16x2_t __attribute__((ext_vector_type(2)));

constexpr int SEQ = 2048, DM = 1024, NBATCH = 16, MTOK = NBATCH * SEQ;
constexpr int MC = CHB * SEQ, NCHUNK = NBATCH / CHB;
constexpr int INC = 5792, ZW = 512, ZN = 5888;
constexpr int ZO_CQ = 0, ZO_CKV = 256, ZO_KPE = 384, ZO_QB = 512, ZO_KB = 1024, ZO_VB = 1536, ZO_QC = 2048, ZO_KC = 2560, ZO_VC = 2688, ZO_G = 2816;
constexpr int DFF = 2816, DFE = 3584, NEXP = 8;
constexpr int DF0 = 1792, DF1 = DFE - DF0;
constexpr float EPS = 1e-6f, LOG2E = 1.4426950408889634f;
constexpr float NEGB = -1e30f;
constexpr int MOE_ROWS = MTOK + NEXP * 256;

constexpr size_t MiB = 1u << 20;
constexpr size_t WS_CTL = 0, CTL_ZERO_BYTES = 256 * 1024;
constexpr size_t WS_META = 256 * 1024;
constexpr size_t WS_TAB = 1 * MiB;
constexpr size_t WS_WIN = 2 * MiB;
constexpr size_t SZ_WIN = (size_t)ZN * DM * 2;
constexpr size_t WS_WUQ = WS_WIN + 2 * SZ_WIN;
constexpr size_t SZ_WUQ = (size_t)768 * 256 * 2;
constexpr size_t WS_WUKV = WS_WUQ + 2 * SZ_WUQ;
constexpr size_t SZ_WUKV = (size_t)1024 * 256 * 2;
constexpr size_t WS_WBR = WS_WUKV + 2 * SZ_WUKV;
constexpr size_t SZ_WBR = (size_t)1024 * 1536 * 2;
constexpr size_t WS_WOUT = WS_WBR + 2 * SZ_WBR;
constexpr size_t SZ_WOUT = (size_t)1024 * 1024 * 2;
constexpr size_t WS_WGU = WS_WOUT + 2 * SZ_WOUT;
constexpr size_t WS_WD = WS_WGU + (size_t)2 * DFF * DM * 2;
constexpr size_t WS_SMALL_END = WS_WD + (size_t)DM * DFF * 2;
static_assert(WS_SMALL_END <= 54 * MiB, "small weights");
constexpr size_t WS_XB = 54 * MiB;
constexpr size_t WS_ST = 118 * MiB;
constexpr size_t WS_RR = 120 * MiB;
constexpr size_t WS_SEL = WS_RR + (size_t)MTOK * 4;
constexpr size_t WS_GW = WS_SEL + (size_t)MTOK * 8;
constexpr size_t WS_ROWTOK = WS_GW + (size_t)MTOK * 8;
constexpr size_t WS_ROWGW = WS_ROWTOK + (size_t)2 * MOE_ROWS * 4;
constexpr size_t WS_ROWRR = WS_ROWGW + (size_t)2 * MOE_ROWS * 4;
constexpr size_t WS_T = 122 * MiB;
static_assert(WS_ROWRR + (size_t)2 * MOE_ROWS * 4 <= WS_T, "fixed region");
constexpr size_t WS_GB = WS_T;
constexpr size_t WS_Y = WS_GB + (size_t)MTOK * 3072;
constexpr size_t WS_CH = WS_Y + (size_t)MTOK * 1536 * 2;
constexpr size_t WS_Z = WS_CH;
constexpr size_t WS_QKV = WS_Z + (size_t)MC * ZW * 2;
constexpr size_t SZ_H8 = (size_t)MC * 512 * 2, SZ_H2 = (size_t)MC * 128 * 2;
constexpr size_t WS_Q = WS_QKV + 4 * SZ_H8 + 2 * SZ_H2;
constexpr bool TMP_IN_OUT = (CHB == 16);
constexpr size_t WS_KV = WS_Q + (size_t)MC * 768 * 2;
constexpr size_t WS_PB = WS_KV + (TMP_IN_OUT ? 0 : (size_t)MC * 1024 * 2);
constexpr size_t WS_PBS = WS_PB + (TMP_IN_OUT ? 0 : (size_t)2 * MC * 512 * 2);
constexpr size_t WS_SQ = WS_PBS + (size_t)2 * MC * 16 * 4;
constexpr size_t WS_MIX_END = WS_SQ + (size_t)2 * MC * 4 * 4;
constexpr size_t WS_XB8P = (size_t)496 * MiB;
constexpr size_t WS_WIN8 = WS_XB8P + (size_t)MTOK * DM;
constexpr size_t SZ_WIN8 = (size_t)(23 - P1_F8_FROM) * 256 * DM;
static_assert(WS_XB8P >= WS_MIX_END && WS_WIN8 + 2 * SZ_WIN8 <= (size_t)564 * MiB, "fp8 input-projection buffers");
constexpr size_t WS_MG = WS_CH;
static_assert(WS_MG + (size_t)MTOK * 1024 * 2 <= (size_t)564 * MiB, "MG placement");
constexpr size_t WS_ACT = WS_T;
constexpr size_t WS_EGU = WS_T;
constexpr size_t WS_XB8 = WS_EGU + (size_t)NEXP * 2 * DFE * DM;
constexpr size_t WS_ED = WS_EGU + (size_t)NEXP * 2 * DFE * DM * 2;
constexpr size_t WS_MACT = WS_ED + (size_t)NEXP * DM * DFE * 2;
constexpr size_t WS_MOE_END = WS_MACT + (size_t)MOE_ROWS * DFE * 2;
constexpr size_t WS_NEED_ = (WS_MOE_END > WS_MIX_END ? WS_MOE_END : WS_MIX_END);
constexpr size_t WS_NEED = WS_MOE_END + (size_t)(MTOK - 26624) * DM * 2 > WS_NEED_ ? WS_MOE_END + (size_t)(MTOK - 26624) * DM * 2 : WS_NEED_;
static_assert(WS_NEED <= (size_t)564 * MiB, "workspace budget");

constexpr int XM_SPLIT = 26624;
constexpr size_t WS_XM_HI = WS_MOE_END;
static_assert((size_t)XM_SPLIT * DM * 2 <= WS_XB - WS_WIN && WS_XM_HI + (size_t)(MTOK - XM_SPLIT) * DM * 2 <= (size_t)564 * MiB, "XM placement");
__device__ __forceinline__ bf16_t* xm_row(unsigned char* ws, int tok) { return tok < XM_SPLIT ? (bf16_t*)(ws + WS_WIN) + (size_t)tok * DM : (bf16_t*)(ws + WS_XM_HI) + (size_t)(tok - XM_SPLIT) * DM; }

constexpr int CW_BAR = 4096, CW_Q = 8192;
constexpr int MI_CNT = 0, MI_NTILE = 4120, MI_TILEE = 4128;

__device__ __forceinline__ unsigned cvt_pk_bf16(float lo, float hi) { f32x2 v = {lo, hi}; bf16x2_t b = __builtin_convertvector(v, bf16x2_t); return __builtin_bit_cast(unsigned, b); }
__device__ __forceinline__ unsigned pk_fp8x4(float a, float b, float c, float d) {
    a = __builtin_fminf(__builtin_fmaxf(a, -448.f), 448.f); b = __builtin_fminf(__builtin_fmaxf(b, -448.f), 448.f); c = __builtin_fminf(__builtin_fmaxf(c, -448.f), 448.f); d = __builtin_fminf(__builtin_fmaxf(d, -448.f), 448.f);
    int w = 0; w = __builtin_amdgcn_cvt_pk_fp8_f32(a, b, w, false); w = __builtin_amdgcn_cvt_pk_fp8_f32(c, d, w, true); return (unsigned)w; }
__device__ __forceinline__ float bf_lo(unsigned w) { return __builtin_bit_cast(float, w << 16); }
__device__ __forceinline__ float bf_hi(unsigned w) { return __builtin_bit_cast(float, w & 0xffff0000u); }
template <int O> __device__ __forceinline__ float swz_xor(float v) { return __builtin_bit_cast(float, __builtin_amdgcn_ds_swizzle(__builtin_bit_cast(int, v), (O << 10) | 0x1f)); }
__device__ __forceinline__ void swap32(float& a, float& b) { asm volatile("s_nop 1\n\tv_permlane32_swap_b32 %0, %1\n\ts_nop 1" : "+v"(a), "+v"(b)); }
__device__ __forceinline__ float xsum32(float v) { float a = v, b = v; swap32(a, b); return a + b; }
__device__ __forceinline__ float xmax32(float v) { float a = v, b = v; swap32(a, b); return fmaxf(a, b); }
__device__ __forceinline__ float wave_sum(float v) {
    v += swz_xor<1>(v); v += swz_xor<2>(v); v += swz_xor<4>(v); v += swz_xor<8>(v); v += swz_xor<16>(v);
    return xsum32(v);
}
__device__ __forceinline__ float fast_rcp(float x) { return __builtin_amdgcn_rcpf(x); }
__device__ __forceinline__ float fast_exp2(float x) { return __builtin_amdgcn_exp2f(x); }
__device__ __forceinline__ float sigmoidf_(float v) { return fast_rcp(1.f + fast_exp2(-v * LOG2E)); }
__device__ __forceinline__ int t5_bucket(int rel) {
    const int ret = rel > 0 ? 16 : 0; const int n = rel < 0 ? -rel : rel;
    if (n < 8) return ret + n;
    int large = 8 + (int)(logf((float)n / 8.f) / logf(128.f) * 8.f);
    if (large > 15) large = 15;
    return ret + large;
}

#define XB_TMO      128
#define XB_XCNT(j)  (256  + 64 * (j))
#define XB_XSUB(j)  (1280 + 64 * (j))
#define XB_XGEN(j)  (2304 + 64 * (j))
#define XB_TOP      3328
#define XB_TOPGEN   3392
#define XCD_BAR_WORDS 3456
#define XB_SPIN_CAP (1u << 18)
__device__ __forceinline__ unsigned xb_ld(unsigned* p)              { return __hip_atomic_load(p, __ATOMIC_RELAXED, __HIP_MEMORY_SCOPE_AGENT); }
__device__ __forceinline__ unsigned xb_add(unsigned* p, unsigned v) { return __hip_atomic_fetch_add(p, v, __ATOMIC_RELAXED, __HIP_MEMORY_SCOPE_AGENT); }
__device__ __forceinline__ unsigned xb_xcc_id() { return (unsigned)__builtin_amdgcn_s_getreg((3 << 11) | 20) & 0xFu; }
#define XB_SPIN(cond, bar) do { unsigned _sp = 0; while (cond) { __builtin_amdgcn_s_sleep(1); \
    if ((++_sp & 255u) == 0u) { if (xb_ld(&(bar)[XB_TMO])) break; if (_sp > XB_SPIN_CAP) { atomicAdd(&(bar)[XB_TMO], 1u); break; } } } } while (0)
struct XcdBarrier { unsigned* bar; unsigned x; volatile LAS unsigned* st; };
__device__ __forceinline__ XcdBarrier xcd_barrier_post(unsigned* bar, volatile LAS unsigned* st) {
    XcdBarrier b; b.bar = bar; b.x = xb_xcc_id(); b.st = st;
    if (threadIdx.x == 0) (void)xb_add(&bar[XB_XCNT(b.x)], 1u);
    return b;
}
__device__ __forceinline__ void xcd_barrier_complete(unsigned* bar, unsigned x, unsigned& nloc, unsigned& nx) {
    const unsigned G = gridDim.x * gridDim.y * gridDim.z;
    unsigned sum, cnt, mine, sp = 0u;
    for (;;) {
        sum = 0u; cnt = 0u; mine = 0u;
#pragma unroll
        for (unsigned j = 0; j < 16; ++j) { const unsigned c = xb_ld(&bar[XB_XCNT(j)]); sum += c; cnt += (c > 0u) ? 1u : 0u; mine = (j == x) ? c : mine; }
        if (sum == G) break;
        __builtin_amdgcn_s_sleep(1);
        if ((++sp & 255u) == 0u) { if (xb_ld(&bar[XB_TMO])) break; if (sp > XB_SPIN_CAP) { atomicAdd(&bar[XB_TMO], 1u); break; } }
    }
    nloc = mine > 0u ? mine : 1u; nx = cnt > 0u ? cnt : 1u;
}
__device__ __forceinline__ void xcd_barrier(const XcdBarrier& b) {
    asm volatile("s_waitcnt vmcnt(0)" ::: "memory");
    __syncthreads();
    if (threadIdx.x == 0) {
        unsigned* bar = b.bar;
        __builtin_amdgcn_s_waitcnt(0);
        unsigned nloc = b.st[0], nx = b.st[1];
        if (nloc == 0u) { xcd_barrier_complete(bar, b.x, nloc, nx); b.st[0] = nloc; b.st[1] = nx; }
        const unsigned old = xb_add(&bar[XB_XSUB(b.x)], 1u);
        const unsigned gen = old / nloc;
        if (old + 1u == (gen + 1u) * nloc) {
            __builtin_amdgcn_fence(__ATOMIC_RELEASE, "agent");
            asm volatile("s_waitcnt vmcnt(0)" ::: "memory");
            const unsigned og = xb_add(&bar[XB_TOP], 1u);
            const unsigned tg = og / nx;
            if (og + 1u == (tg + 1u) * nx) xb_add(&bar[XB_TOPGEN], 1u);
            else XB_SPIN(xb_ld(&bar[XB_TOPGEN]) == tg, bar);
            __builtin_amdgcn_fence(__ATOMIC_ACQUIRE, "agent");
            xb_add(&bar[XB_XGEN(b.x)], 1u);
            asm volatile("s_waitcnt vmcnt(0)" ::: "memory");
        } else {
            XB_SPIN(xb_ld(&bar[XB_XGEN(b.x)]) == gen, bar);
            __builtin_amdgcn_fence(__ATOMIC_ACQUIRE, "agent");
            asm volatile("s_waitcnt vmcnt(0)" ::: "memory");
        }
    }
    __syncthreads();
}
#ifndef MOE_RGS
#define MOE_RGS 4
#endif
#ifndef MOE_RG
#define MOE_RG 4
#endif
#ifndef RELAXW
#define RELAXW 0
#endif
namespace pg8 {
constexpr int BM = 256, BK = 64, HALF = 128, HTB = HALF * BK * 2, STAGE_BYTES = 8 * HTB, NXCD = 8, WGM = 8;
__host__ __device__ __forceinline__ int lds_byte(int r, int c) { const int st = (r >> 4) * 2 + (c >> 5), rr = r & 15, cc = c & 31, ob = rr * 64 + cc * 2; return st * 1024 + (ob ^ (((ob >> 9) & 1) << 5)); }
__host__ __device__ __forceinline__ void stage_rc(int b, int& R, int& C) { const int st = b / 1024, sb = b % 1024, swz = sb ^ (((sb >> 9) & 1) << 5); R = (st >> 1) * 16 + swz / 64; C = (st & 1) * 32 + (swz % 64) / 2; }
__host__ __device__ __forceinline__ int perm32(int rho) { const int n = rho >> 4, i = rho & 15; return 8 * (i >> 2) + 4 * n + (i & 3); }

struct Unit { int pm, pn, aux; };
struct Gemm { const bf16_t* A; const bf16_t* Bt; int K, lda, ldb; const int* gidx; };

struct StaticOrder {
    static constexpr bool DYN = false;
    int nM, nN, nwg, G, c;
    __host__ __device__ void init(int M, int N, int G_, int c_) { nM = M / BM; nN = N / BM; nwg = nM * nN; G = G_; c = c_; }
    __host__ __device__ bool next(int i, Unit& u) const {
        const int L = i * G + c; if (L >= nwg) return false;
        int wgid = L; { const int q = nwg / NXCD, r = nwg % NXCD, xcd = wgid % NXCD, off = wgid / NXCD; wgid = (xcd < r ? xcd * (q + 1) : r * (q + 1) + (xcd - r) * q) + off; }
        const int nig = WGM * nN, gid = wgid / nig, fm = gid * WGM, gsz = (nM - fm) < WGM ? (nM - fm) : WGM;
        u.pm = fm + ((wgid % nig) % gsz); u.pn = (wgid % nig) / gsz; u.aux = u.pn; return true;
    }
};
struct MoeOrder {
    static constexpr bool DYN = false;
    int ntile, nN, G, c, pne, pn0; const int* tile_e;
    __device__ bool next(int i, Unit& u) const {
        const int L = i * G + c; if (L >= ntile * nN) return false;
        int pm, pnl; { const int grp = L / (MOE_RGS * nN), fm = grp * MOE_RGS, gsz = (ntile - fm) < MOE_RGS ? (ntile - fm) : MOE_RGS, r = L - grp * (MOE_RGS * nN); pm = fm + r % gsz; pnl = r / gsz; }
        u.pm = pm; u.aux = pnl; u.pn = tile_e[pm] * pne + pn0 + pnl; return true;
    }
};

struct DynMoeOrder {
    static constexpr bool DYN = true;
    unsigned* ctr; volatile LAS int* slot; int ntile, nN, pne, pn0; const int* tile_e; int vcu;
    __device__ __forceinline__ void begin() const {
        if (threadIdx.x == 0) { slot[0] = vcu; slot[1] = vcu + (int)gridDim.x; }
        __syncthreads();
    }
    __device__ __forceinline__ bool next(int i, Unit& u) const {
        const int L = __builtin_amdgcn_readfirstlane(slot[i & 1]); if (L >= ntile * nN) return false;
        int pm, pnl; { const int grp = L / (MOE_RG * nN), fm = grp * MOE_RG, gsz = (ntile - fm) < MOE_RG ? (ntile - fm) : MOE_RG, r = L - grp * (MOE_RG * nN); pm = fm + r % gsz; pnl = r / gsz; }
        u.pm = pm; u.aux = pnl; u.pn = tile_e[pm] * pne + pn0 + pnl; return true;
    }
    __device__ __forceinline__ unsigned claim_issue() const { unsigned v = 0u; if (threadIdx.x == 0) v = 2u * gridDim.x + __hip_atomic_fetch_add(ctr, 1u, __ATOMIC_RELAXED, __HIP_MEMORY_SCOPE_AGENT); return v; }
    __device__ __forceinline__ void claim_commit(unsigned v, int i) const { if (threadIdx.x == 0) { slot[i & 1] = (int)v; asm volatile("s_waitcnt lgkmcnt(0)" ::: "memory"); } }
};

__host__ __device__ __forceinline__ size_t blk_off(int row, int col, int ld) { return ((size_t)(row >> 4) * (ld >> 5) + (col >> 5)) * 512 + (row & 15) * 32 + (col & 31); }
typedef int i32x4_t __attribute__((ext_vector_type(4))); typedef int i32x8_t __attribute__((ext_vector_type(8)));
template <bool F8> struct FragSel;
template <> struct FragSel<false> {
    struct P { bf16x8 k[2]; }; typedef P A[4]; typedef P B[2];
    static __device__ __forceinline__ void set(P& d, const i32x4_t& f0, const i32x4_t& f1) { d.k[0] = __builtin_bit_cast(bf16x8, f0); d.k[1] = __builtin_bit_cast(bf16x8, f1); }
    static __device__ __forceinline__ void mma(f32x4& c, const P& b, const P& a) { c = __builtin_amdgcn_mfma_f32_16x16x32_bf16(b.k[0], a.k[0], c, 0, 0, 0); c = __builtin_amdgcn_mfma_f32_16x16x32_bf16(b.k[1], a.k[1], c, 0, 0, 0); }
    static __device__ __forceinline__ void after_mma() {}
};
template <> struct FragSel<true> {
    typedef i32x8_t P; typedef P A[4]; typedef P B[2];
    static __device__ __forceinline__ void set(P& d, const i32x4_t& f0, const i32x4_t& f1) { d = __builtin_shufflevector(f0, f1, 0, 1, 2, 3, 4, 5, 6, 7); }
    static __device__ __forceinline__ void mma(f32x4& c, const P& b, const P& a) { int sc = 0x7f7f7f7f; asm volatile("v_mfma_scale_f32_16x16x128_f8f6f4 %0, %1, %2, %0, %3, %3 op_sel_hi:[0,0,0]" : "+v"(c) : "v"(b), "v"(a), "v"(sc)); }
    static __device__ __forceinline__ void after_mma() { asm volatile("s_nop 15\n\ts_nop 15" ::: "memory"); }
};
template <class Epi, class Sched, bool ALIGN_EPI, bool GATHER, bool ABLK = false, bool F8 = false>
__device__ __forceinline__ void gemm_phase(LAS unsigned char* lds, const Gemm g, const Sched& S, const Epi& E) {
    int tid_ = threadIdx.x; asm volatile("" : "+v"(tid_));
    const int tid = tid_, wid = __builtin_amdgcn_readfirstlane(tid >> 6), lane = tid & 63, wr = wid >> 2, wc = wid & 3, fr = lane & 15, fq = lane >> 4;
    int K_ = g.K; asm volatile("" : "+s"(K_));
    const int K = K_, nt = K / BK;
    static_assert(!(GATHER && ABLK), "gathered A is row-major");
    const size_t kstep = (size_t)(BK * 2), kstepA = ABLK ? (size_t)2048 : kstep;
    const size_t hstepA = ABLK ? (size_t)8 * (g.lda >> 5) * 1024 : (size_t)HALF * g.lda * 2, hstepB = (size_t)HALF * g.ldb * 2, tstepA = 2 * hstepA, tstepB = 2 * hstepB;
    int Rs[2], Cs[2]; unsigned voffB[2];
#pragma unroll
    for (int i = 0; i < 2; ++i) { int R, C; stage_rc(tid * 16 + i * 8192, R, C); Rs[i] = R; Cs[i] = C; const int Rb = Epi::PERM ? ((R & ~31) + perm32(R & 31)) : R;
        voffB[i] = (unsigned)(Rb * g.ldb + C) * 2u; }
    asm volatile("" : "+v"(voffB[0]), "+v"(voffB[1]), "+v"(Rs[0]), "+v"(Rs[1]), "+v"(Cs[0]), "+v"(Cs[1]));
    unsigned vA[2][2], nvA[2][2];
    const size_t hsA = GATHER ? (size_t)0 : hstepA;
#define PG8_SETV(V, U) do { _Pragma("unroll") for (int _h = 0; _h < 2; ++_h) _Pragma("unroll") for (int _i = 0; _i < 2; ++_i) { \
        if constexpr (GATHER) { int _t = g.gidx[(U).pm * BM + _h * HALF + Rs[_i]]; _t = _t < 0 ? 0 : _t; V[_h][_i] = (unsigned)(_t * g.lda + Cs[_i]) * 2u; } \
        else if constexpr (ABLK) V[_h][_i] = (unsigned)blk_off(Rs[_i], Cs[_i], g.lda) * 2u; \
        else V[_h][_i] = (unsigned)(Rs[_i] * g.lda + Cs[_i]) * 2u; } } while (0)
    const unsigned ldsw = (unsigned)wid * 1024u;
    const int aoff = lds_byte(wr * 64 + fr, fq * 8), boff = lds_byte(wc * 32 + fr, fq * 8);
#define PG8_SA(b, h) (((b) * 2 + (h)) * HTB)
#define PG8_SB(b, h) ((4 + (b) * 2 + (h)) * HTB)
#define PG8_STAGE(bufoff, gbase, voff) do { _Pragma("unroll") for (int _i = 0; _i < 2; ++_i) \
        __builtin_amdgcn_global_load_lds((const unsigned*)((const char*)(gbase) + (voff)[_i]), (LAS unsigned*)(lds + (bufoff) + ldsw + _i * 8192), 16, 0, 0); } while (0)
#define PG8_LDA(dst, b, h) do { _Pragma("unroll") for (int m = 0; m < 4; ++m) { const i32x4_t f0_ = *(const LAS i32x4_t*)(lds + PG8_SA(b, h) + aoff + m * 2048), f1_ = *(const LAS i32x4_t*)(lds + PG8_SA(b, h) + aoff + m * 2048 + 1024); FragSel<F8>::set(dst[m], f0_, f1_); } } while (0)
#define PG8_LDB(dst, b, h) do { _Pragma("unroll") for (int n = 0; n < 2; ++n) { const i32x4_t f0_ = *(const LAS i32x4_t*)(lds + PG8_SB(b, h) + boff + n * 2048), f1_ = *(const LAS i32x4_t*)(lds + PG8_SB(b, h) + boff + n * 2048 + 1024); FragSel<F8>::set(dst[n], f0_, f1_); } } while (0)
#define PG8_MMA(ai, bj, At, Bt) do { __builtin_amdgcn_s_setprio(1); _Pragma("unroll") for (int m = 0; m < 4; ++m) _Pragma("unroll") for (int n = 0; n < 2; ++n) FragSel<F8>::mma(acc[ai][bj][m][n], Bt[n], At[m]); __builtin_amdgcn_s_setprio(0); } while (0)
#define PG8_WAIT_V(n) asm volatile("s_waitcnt vmcnt(" #n ")" ::: "memory")
#define PG8_WAIT_VSEL(sel, n) asm volatile("s_cmp_eq_u32 %0, 0\n\ts_cbranch_scc1 1f\n\ts_waitcnt vmcnt(%1)\n\ts_branch 2f\n1:\n\ts_waitcnt vmcnt(8)\n2:" :: "s"(sel), "n"(n) : "memory", "scc")
#define PG8_WAIT_L(n) asm volatile("s_waitcnt lgkmcnt(" #n ")" ::: "memory")
#define PG8_BAR __builtin_amdgcn_s_barrier()
#define PG8_SCHED __builtin_amdgcn_sched_barrier(0)
    Unit cur, nxt; int ui = 0;
    if constexpr (Sched::DYN) S.begin();
    if (!S.next(0, cur)) return;
    f32x4 acc[2][2][4][2];
#pragma unroll
    for (int a = 0; a < 2; ++a)
#pragma unroll
        for (int b = 0; b < 2; ++b)
#pragma unroll
            for (int m = 0; m < 4; ++m)
#pragma unroll
                for (int n = 0; n < 2; ++n) acc[a][b][m][n] = (f32x4){0.f, 0.f, 0.f, 0.f};
    typename FragSel<F8>::A At; typename FragSel<F8>::B B0, B1;
    PG8_SETV(vA, cur);
    const char* cA = (const char*)g.A + (GATHER ? (size_t)0 : (size_t)cur.pm * tstepA); const char* cB = (const char*)g.Bt + (size_t)cur.pn * tstepB;
    PG8_STAGE(PG8_SB(0, 0), cB, voffB); PG8_STAGE(PG8_SB(0, 1), cB + hstepB, voffB); PG8_STAGE(PG8_SA(0, 0), cA, vA[0]); PG8_STAGE(PG8_SA(0, 1), cA + hsA, vA[1]);
    if (wr == 1) PG8_BAR;
    PG8_WAIT_V(2); PG8_BAR;
    PG8_STAGE(PG8_SB(1, 0), cB + kstep, voffB); PG8_STAGE(PG8_SA(1, 0), cA + kstepA, vA[0]); PG8_STAGE(PG8_SB(1, 1), cB + hstepB + kstep, voffB);
    PG8_WAIT_V(6); PG8_BAR;
    for (;;) {
        const bool has_next = S.next(ui + 1, nxt);
        unsigned claim_ = 0u; if constexpr (Sched::DYN) claim_ = S.claim_issue();
        const char* nA = has_next ? (const char*)g.A + (GATHER ? (size_t)0 : (size_t)nxt.pm * tstepA) : cA; const char* nB = has_next ? (const char*)g.Bt + (size_t)nxt.pn * tstepB : cB;
        if constexpr (GATHER) { if (has_next) PG8_SETV(nvA, nxt); else {
#pragma unroll
            for (int h = 0; h < 2; ++h) { nvA[h][0] = vA[h][0]; nvA[h][1] = vA[h][1]; } } }
        for (int t = 0; t < nt; t += 2) {
            if constexpr (Epi::MID) { if (t == 8 || t == 16) E.mid(acc, cur, t >> 3, wr, wc, fr, fq); }
            const bool last = (t == nt - 2);
            const char* a1 = cA + (size_t)(t + 1) * kstepA;
            const char* a2 = last ? nA : cA + (size_t)(t + 2) * kstepA; const char* b2 = last ? nB : cB + (size_t)(t + 2) * kstep;
            const char* a3 = a2 + kstepA; const char* b3 = b2 + kstep;
            unsigned v20[2], v21[2];
            if constexpr (GATHER) { v20[0] = last ? nvA[0][0] : vA[0][0]; v20[1] = last ? nvA[0][1] : vA[0][1]; v21[0] = last ? nvA[1][0] : vA[1][0]; v21[1] = last ? nvA[1][1] : vA[1][1]; }
            else { v20[0] = vA[0][0]; v20[1] = vA[0][1]; v21[0] = vA[1][0]; v21[1] = vA[1][1]; }
            const int relax_ = __builtin_amdgcn_readfirstlane((RELAXW && (t == 0) && (ui > 0)) ? 1 : 0);
            PG8_LDB(B0, 0, 0); PG8_LDB(B1, 0, 1); PG8_SCHED; PG8_LDA(At, 0, 0); PG8_STAGE(PG8_SA(1, 1), a1 + hsA, vA[1]);
            PG8_WAIT_VSEL(relax_, 8 + Epi::NVM);
            PG8_WAIT_L(0); PG8_BAR; PG8_MMA(0, 0, At, B0); PG8_MMA(0, 1, At, B1); PG8_BAR; PG8_SCHED;
            PG8_LDA(At, 0, 1); PG8_STAGE(PG8_SB(0, 0), b2, voffB); PG8_STAGE(PG8_SB(0, 1), b2 + hstepB, voffB); PG8_STAGE(PG8_SA(0, 0), a2, v20);
            PG8_WAIT_VSEL(relax_, 8 + Epi::NVM);
            PG8_WAIT_L(0); PG8_BAR; PG8_MMA(1, 0, At, B0); PG8_MMA(1, 1, At, B1); PG8_BAR; PG8_SCHED;
            PG8_LDB(B0, 1, 0); PG8_LDB(B1, 1, 1); PG8_SCHED; PG8_LDA(At, 1, 0); PG8_STAGE(PG8_SA(0, 1), a2 + hsA, v21);
            PG8_WAIT_V(8); PG8_WAIT_L(0); PG8_BAR; PG8_MMA(0, 0, At, B0); PG8_MMA(0, 1, At, B1); PG8_BAR; PG8_SCHED;
            PG8_LDA(At, 1, 1); PG8_STAGE(PG8_SB(1, 0), b3, voffB); PG8_STAGE(PG8_SB(1, 1), b3 + hstepB, voffB); PG8_STAGE(PG8_SA(1, 0), a3, v20);
            PG8_WAIT_V(8); PG8_WAIT_L(0); PG8_BAR; PG8_MMA(1, 0, At, B0); PG8_MMA(1, 1, At, B1); PG8_BAR; PG8_SCHED;
        }
        if constexpr (Sched::DYN) S.claim_commit(claim_, ui);
        if constexpr (ALIGN_EPI) { if (wr == 0) PG8_BAR; }
        FragSel<F8>::after_mma();
        E(acc, cur, wr, wc, fr, fq);
        if (!has_next) break;
#pragma unroll
        for (int a = 0; a < 2; ++a)
#pragma unroll
            for (int b = 0; b < 2; ++b)
#pragma unroll
                for (int m = 0; m < 4; ++m)
#pragma unroll
                    for (int n = 0; n < 2; ++n) acc[a][b][m][n] = (f32x4){0.f, 0.f, 0.f, 0.f};
        cur = nxt; cA = nA; cB = nB; ++ui;
        if constexpr (GATHER) {
#pragma unroll
            for (int h = 0; h < 2; ++h) { vA[h][0] = nvA[h][0]; vA[h][1] = nvA[h][1]; } }
        if constexpr (ALIGN_EPI) { if (wr == 1) PG8_BAR; }
    }
    PG8_WAIT_V(0);
    if constexpr (!ALIGN_EPI) { if (wr == 0) PG8_BAR; }
    PG8_BAR;
#undef PG8_SETV
#undef PG8_SA
#undef PG8_SB
#undef PG8_STAGE
#undef PG8_LDA
#undef PG8_LDB
#undef PG8_MMA
#undef PG8_WAIT_V
#undef PG8_WAIT_VSEL
#undef PG8_WAIT_L
#undef PG8_BAR
#undef PG8_SCHED
}

typedef f32x4 Acc[2][2][4][2];
#ifndef NT_Z
#define NT_Z 0
#endif
#ifndef NT_A
#define NT_A 1
#endif
#ifndef ST_SC1
#define ST_SC1 1
#endif
__device__ __forceinline__ void st16(unsigned char* wsb, u32x4* p, const u32x4& v) {
#if ST_SC1
    const __amdgpu_buffer_rsrc_t rsrc = __builtin_amdgcn_make_buffer_rsrc(wsb, 0, 0x7fffffff, 0x00020000);
    __builtin_amdgcn_raw_buffer_store_b128(v, rsrc, (int)((unsigned char*)p - wsb), 0, 16);
#else
    *p = v;
#endif
}
__device__ __forceinline__ void st8(unsigned char* wsb, u32x2* p, const u32x2& v) {
#if ST_SC1
    const __amdgpu_buffer_rsrc_t rsrc = __builtin_amdgcn_make_buffer_rsrc(wsb, 0, 0x7fffffff, 0x00020000);
    __builtin_amdgcn_raw_buffer_store_b64(v, rsrc, (int)((unsigned char*)p - wsb), 0, 16);
#else
    *p = v;
#endif
}
__device__ __forceinline__ float fq_sum(float s) { s += swz_xor<16>(s); return xsum32(s); }
__device__ __forceinline__ u32x4 pack8(const f32x4& a, const f32x4& b) { u32x4 w; w.x = cvt_pk_bf16(a.x, a.y); w.y = cvt_pk_bf16(a.z, a.w); w.z = cvt_pk_bf16(b.x, b.y); w.w = cvt_pk_bf16(b.z, b.w); return w; }
__device__ __forceinline__ void unpack8(const u32x4& w, f32x4& a, f32x4& b) { a = (f32x4){bf_lo(w.x), bf_hi(w.x), bf_lo(w.y), bf_hi(w.y)}; b = (f32x4){bf_lo(w.z), bf_hi(w.z), bf_lo(w.w), bf_hi(w.w)}; }
__device__ __forceinline__ unsigned g8pack(const f32x4& a) {
    const unsigned b0 = (unsigned)__builtin_fmaxf(a.x * 255.f + 0.5f, 1.f), b1 = (unsigned)__builtin_fmaxf(a.y * 255.f + 0.5f, 1.f), b2 = (unsigned)__builtin_fmaxf(a.z * 255.f + 0.5f, 1.f), b3 = (unsigned)__builtin_fmaxf(a.w * 255.f + 0.5f, 1.f);
    return b0 | (b1 << 8) | (b2 << 16) | (b3 << 24);
}
__device__ __forceinline__ f32x4 g8unpack(unsigned w) { return (f32x4){(float)(w & 0xffu), (float)((w >> 8) & 0xffu), (float)((w >> 16) & 0xffu), (float)(w >> 24)}; }
__device__ __forceinline__ float sq8(const f32x4& a, const f32x4& b) { return ((a.x * a.x + a.y * a.y) + (a.z * a.z + a.w * a.w)) + ((b.x * b.x + b.y * b.y) + (b.z * b.z + b.w * b.w)); }
__device__ __forceinline__ float sum4(const f32x4& a) { return (a.x + a.y) + (a.z + a.w); }
__device__ __forceinline__ void rope8(f32x4& a, f32x4& b, const float* cs, const float* sn) {
    const f32x4 c = *(const f32x4*)cs, s = *(const f32x4*)sn;
    const f32x4 ra = {a.x * c.x - a.y * s.x, a.x * s.x + a.y * c.x, a.z * c.y - a.w * s.y, a.z * s.y + a.w * c.y};
    const f32x4 rb = {b.x * c.z - b.y * s.z, b.x * s.z + b.y * c.z, b.z * c.w - b.w * s.w, b.z * s.w + b.w * c.w};
    a = ra; b = rb;
}
__device__ __forceinline__ void rowscale16(const float* st, int rbase, int fq, float (&r)[8]) {
    f32x4 p[8];
#pragma unroll
    for (int i = 0; i < 8; ++i) p[i] = *(const f32x4*)(st + (size_t)(rbase + (i >> 2) * HALF + (i & 3) * 16) * 16 + 4 * fq);
#pragma unroll
    for (int i = 0; i < 8; ++i) r[i] = rsqrtf(fq_sum(sum4(p[i])) * (1.f / 1024.f) + EPS);
}
__device__ __forceinline__ void rowscale4(const float* sq, int rbase, float inv_n, float (&r)[8]) {
    f32x4 p[8];
#pragma unroll
    for (int i = 0; i < 8; ++i) p[i] = *(const f32x4*)(sq + (size_t)(rbase + (i >> 2) * HALF + (i & 3) * 16) * 4);
#pragma unroll
    for (int i = 0; i < 8; ++i) r[i] = rsqrtf(sum4(p[i]) * inv_n + EPS);
}
#define EPI_ROWBASE int rl_ = wr * 64 + fr; asm volatile("" : "+v"(rl_)); const int rbase = u.pm * BM + rl_
#define EPI_LOOP _Pragma("unroll") for (int ai = 0; ai < 2; ++ai) _Pragma("unroll") for (int m = 0; m < 4; ++m)

struct EpiIn {
    static constexpr bool PERM = true, MID = false; static constexpr int NVM = 24;
    bf16_t* Z; const float* st; float* sq; float* skv; const float* cosT; const float* sinT; unsigned char* GB; bf16_t* HM; unsigned char* wsb; int pnoff; float asc;
    __device__ __forceinline__ void operator()(const Acc& acc, const Unit& u, int wr, int wc, int fr, int fq) const {
        EPI_ROWBASE; const int pn = u.pn + pnoff;
        float r8[8]; rowscale16(st, rbase, fq, r8);
#pragma unroll
        for (int i = 0; i < 8; ++i) r8[i] *= asc;
        __builtin_amdgcn_sched_barrier(0);
        EPI_LOOP {
            const int row = rbase + ai * HALF + m * 16; const float r = r8[ai * 4 + m];
            bf16_t* zr = Z + (size_t)row * ZW + pn * BM + wc * 32 + 8 * fq;
            float ssq = 0.f;
#pragma unroll
            for (int bj = 0; bj < 2; ++bj) {
                f32x4 v0 = acc[ai][bj][m][0] * r, v1 = acc[ai][bj][m][1] * r;
#ifdef PROBE_ANOISE
                if (pn < 11 && ((PROBE_ANOISE_MASK >> pn) & 1)) { unsigned h_ = (unsigned)row * 2654435761u ^ (unsigned)(pn * 64 + bj * 32 + wc * 8 + fq) * 40503u; float nz[8];
#pragma unroll
                      for (int e_ = 0; e_ < 8; ++e_) { h_ = h_ * 1664525u + 1013904223u; nz[e_] = ((float)(h_ >> 8) * (1.f / 16777216.f) - 0.5f) * 3.4641f * 0.035f * (float)(PROBE_ANOISE); }
                      v0.x += nz[0]; v0.y += nz[1]; v0.z += nz[2]; v0.w += nz[3]; v1.x += nz[4]; v1.y += nz[5]; v1.z += nz[6]; v1.w += nz[7]; }
#endif
                if (pn == 0) ssq += sq8(v0, v1);
                else if (pn == 1) { if (bj == 0) ssq += sq8(v0, v1); else if (wc == 0) { const int pos = row & (SEQ - 1); rope8(v0, v1, cosT + pos * 16 + 4 * fq, sinT + pos * 16 + 4 * fq); } }
                else if (pn == 2 || pn == 3 || pn == 8 || pn == 9) { v0 = v0 * (0.125f * LOG2E); v1 = v1 * (0.125f * LOG2E); }
                else if (pn >= 11) {
#ifdef PROBE_GNOISE
                    { unsigned h_ = (unsigned)row * 2654435761u ^ (unsigned)(pn * 64 + bj * 32 + wc * 8 + fq) * 40503u; float nz[8];
#pragma unroll
                      for (int e_ = 0; e_ < 8; ++e_) { h_ = h_ * 1664525u + 1013904223u; nz[e_] = ((float)(h_ >> 8) * (1.f / 16777216.f) - 0.5f) * 3.4641f * 0.035f * (float)(PROBE_GNOISE); }
                      v0.x += nz[0]; v0.y += nz[1]; v0.z += nz[2]; v0.w += nz[3]; v1.x += nz[4]; v1.y += nz[5]; v1.z += nz[6]; v1.w += nz[7]; }
#endif
                    v0 = (f32x4){sigmoidf_(v0.x), sigmoidf_(v0.y), sigmoidf_(v0.z), sigmoidf_(v0.w)}; v1 = (f32x4){sigmoidf_(v1.x), sigmoidf_(v1.y), sigmoidf_(v1.z), sigmoidf_(v1.w)}; }
                if (pn >= 11) { u32x2 w8; w8.x = g8pack(v0); w8.y = g8pack(v1); *(u32x2*)(GB + blk_off(row, (pn - 11) * BM + bj * HALF + wc * 32 + 8 * fq, 3072)) = w8; }
                else if (pn >= 2) {
                    const int hc = (pn - 2) * BM + bj * HALF + wc * 32;
                    const int reg = hc < 1536 ? hc >> 9 : (hc < 2048 ? 3 : (hc < 2176 ? 4 : 5)), hin = hc < 1536 ? hc & 511 : (hc < 2048 ? hc - 1536 : (hc - 2048) & 127);
                    const size_t base = reg <= 3 ? (size_t)reg * (MC * 512) : (size_t)4 * (MC * 512) + (size_t)(reg - 4) * (MC * 128);
                    const int nh = reg <= 3 ? 8 : 2, b = row >> 11, s = row & (SEQ - 1);
                    st16(wsb, (u32x4*)(HM + base + (((size_t)(b * nh + (hin >> 6)) * SEQ + s) * 64 + (hin & 63) + 8 * fq)), pack8(v0, v1));
                }
                else st16(wsb, (u32x4*)(zr + bj * HALF), pack8(v0, v1));
            }
            if (pn <= 1) { ssq = fq_sum(ssq); if (fq == 0) (pn == 0 ? sq : skv)[(size_t)row * 4 + wc] = ssq; }
        }
    }
};
struct EpiQ {
    static constexpr bool PERM = true, MID = false; static constexpr int NVM = 24;
    bf16_t* Q; const float* sq; const float* cosT; const float* sinT;
    __device__ __forceinline__ void operator()(const Acc& acc, const Unit& u, int wr, int wc, int fr, int fq) const {
        EPI_ROWBASE;
        float r8[8]; rowscale4(sq, rbase, 1.f / 256.f, r8);
        __builtin_amdgcn_sched_barrier(0);
        EPI_LOOP {
            __builtin_amdgcn_sched_barrier(0);
            const int row = rbase + ai * HALF + m * 16; const float r = r8[ai * 4 + m]; const int pos = row & (SEQ - 1);
#pragma unroll
            for (int bj = 0; bj < 2; ++bj) {
                const int col = u.pn * BM + bj * HALF + wc * 32 + 8 * fq; const int j0 = col % 96;
                f32x4 v0 = acc[ai][bj][m][0] * r, v1 = acc[ai][bj][m][1] * r;
                if (j0 >= 64) { const int i0 = (j0 - 64) >> 1; rope8(v0, v1, cosT + pos * 16 + i0, sinT + pos * 16 + i0); }
                *(u32x4*)(Q + (size_t)row * 768 + col) = pack8(v0, v1);
            }
        }
    }
};
struct EpiKV {
    static constexpr bool PERM = true, MID = false; static constexpr int NVM = 24;
    bf16_t* KV; const float* skv;
    __device__ __forceinline__ void operator()(const Acc& acc, const Unit& u, int wr, int wc, int fr, int fq) const {
        EPI_ROWBASE;
        float r8[8]; rowscale4(skv, rbase, 1.f / 128.f, r8);
        __builtin_amdgcn_sched_barrier(0);
        EPI_LOOP {
            const int row = rbase + ai * HALF + m * 16; const float r = r8[ai * 4 + m];
#pragma unroll
            for (int bj = 0; bj < 2; ++bj) {
                const int col = u.pn * BM + bj * HALF + wc * 32 + 8 * fq;
                *(u32x4*)(KV + (size_t)row * 1024 + col) = pack8(acc[ai][bj][m][0] * r, acc[ai][bj][m][1] * r);
            }
        }
    }
};
struct EpiBr {
    static constexpr bool PERM = true, MID = true; static constexpr int NVM = 32;
    const unsigned char* G; bf16_t* MG; unsigned char* wsb;
    __device__ __forceinline__ void mid(Acc& acc, const Unit& u, int seg, int wr, int wc, int fr, int fq) const {
        EPI_ROWBASE; const int col = u.pn * BM + wc * 32 + 8 * fq;
#pragma unroll
        for (int ai = 0; ai < 2; ++ai) {
            __builtin_amdgcn_sched_barrier(0);
            u32x2 wn[4][2], wd[4][2];
#pragma unroll
            for (int m = 0; m < 4; ++m)
#pragma unroll
                for (int bj = 0; bj < 2; ++bj) { const int row = rbase + ai * HALF + m * 16; wn[m][bj] = *(const u32x2*)(G + blk_off(row, (seg - 1) * 1024 + col + bj * HALF, 3072)); wd[m][bj] = *(const u32x2*)(G + blk_off(row, seg * 1024 + col + bj * HALF, 3072)); }
#pragma unroll
            for (int m = 0; m < 4; ++m)
#pragma unroll
                for (int bj = 0; bj < 2; ++bj) {
                    const f32x4 n0 = g8unpack(wn[m][bj].x), n1 = g8unpack(wn[m][bj].y), d0 = g8unpack(wd[m][bj].x), d1 = g8unpack(wd[m][bj].y);
                    f32x4 r0, r1;
                    r0.x = n0.x * fast_rcp(d0.x); r0.y = n0.y * fast_rcp(d0.y); r0.z = n0.z * fast_rcp(d0.z); r0.w = n0.w * fast_rcp(d0.w);
                    r1.x = n1.x * fast_rcp(d1.x); r1.y = n1.y * fast_rcp(d1.y); r1.z = n1.z * fast_rcp(d1.z); r1.w = n1.w * fast_rcp(d1.w);
                    acc[ai][bj][m][0] = acc[ai][bj][m][0] * r0; acc[ai][bj][m][1] = acc[ai][bj][m][1] * r1;
                }
        }
    }
    __device__ __forceinline__ void operator()(const Acc& acc, const Unit& u, int wr, int wc, int fr, int fq) const {
        EPI_ROWBASE; const int col = u.pn * BM + wc * 32 + 8 * fq;
#pragma unroll
        for (int ai = 0; ai < 2; ++ai) {
            __builtin_amdgcn_sched_barrier(0);
            u32x2 wg[4][2];
#pragma unroll
            for (int m = 0; m < 4; ++m)
#pragma unroll
                for (int bj = 0; bj < 2; ++bj) wg[m][bj] = *(const u32x2*)(G + blk_off(rbase + ai * HALF + m * 16, 2048 + col + bj * HALF, 3072));
#pragma unroll
            for (int m = 0; m < 4; ++m)
#pragma unroll
                for (int bj = 0; bj < 2; ++bj) { const f32x4 g0 = g8unpack(wg[m][bj].x) * (1.f / 255.f), g1 = g8unpack(wg[m][bj].y) * (1.f / 255.f);
                    st16(wsb, (u32x4*)(MG + blk_off(rbase + ai * HALF + m * 16, col + bj * HALF, 1024)), pack8(acc[ai][bj][m][0] * g0, acc[ai][bj][m][1] * g1)); }
        }
    }
};
template <bool F8OUT> struct EpiRes {
    static constexpr bool PERM = true, MID = false; static constexpr int NVM = 40;
    bf16_t* xb; float* st; int row0; unsigned char* x8;
    __device__ __forceinline__ void operator()(const Acc& acc, const Unit& u, int wr, int wc, int fr, int fq) const {
        EPI_ROWBASE; const int col = u.pn * BM + wc * 32 + 8 * fq;
#pragma unroll
        for (int ai = 0; ai < 2; ++ai) {
            __builtin_amdgcn_sched_barrier(0);
            u32x4 xi[4][2];
#pragma unroll
            for (int m = 0; m < 4; ++m)
#pragma unroll
                for (int bj = 0; bj < 2; ++bj) xi[m][bj] = *(const u32x4*)(xb + (size_t)(row0 + rbase + ai * HALF + m * 16) * DM + col + bj * HALF);
#pragma unroll
            for (int m = 0; m < 4; ++m) {
                const int row = row0 + rbase + ai * HALF + m * 16; float ssq = 0.f;
#pragma unroll
                for (int bj = 0; bj < 2; ++bj) { f32x4 x0, x1; unpack8(xi[m][bj], x0, x1);
                    const f32x4 v0 = x0 + acc[ai][bj][m][0], v1 = x1 + acc[ai][bj][m][1];
                    *(u32x4*)(xb + (size_t)row * DM + col + bj * HALF) = pack8(v0, v1); ssq += sq8(v0, v1);
                    if constexpr (F8OUT) { u32x2 o8; o8.x = pk_fp8x4(v0.x * 16.f, v0.y * 16.f, v0.z * 16.f, v0.w * 16.f); o8.y = pk_fp8x4(v1.x * 16.f, v1.y * 16.f, v1.z * 16.f, v1.w * 16.f); *(u32x2*)(x8 + (size_t)row * DM + col + bj * HALF) = o8; } }
                ssq = fq_sum(ssq); if (fq == 0) st[(size_t)row * 16 + u.pn * 4 + wc] = ssq;
            }
        }
    }
};
__device__ __forceinline__ float silu_mul(float g, float u) { return g * sigmoidf_(g) * u; }
struct EpiGU {
    static constexpr bool PERM = true, MID = false; static constexpr int NVM = 16;
    bf16_t* ACT; const float* st; int ldact; unsigned char* wsb;
    __device__ __forceinline__ void operator()(const Acc& acc, const Unit& u, int wr, int wc, int fr, int fq) const {
        EPI_ROWBASE;
        float r8[8]; rowscale16(st, rbase, fq, r8);
        __builtin_amdgcn_sched_barrier(0);
        EPI_LOOP {
            const int row = rbase + ai * HALF + m * 16; const float r = r8[ai * 4 + m];
            f32x4 g0 = acc[ai][0][m][0] * r, g1 = acc[ai][0][m][1] * r, u0 = acc[ai][1][m][0] * r, u1 = acc[ai][1][m][1] * r;
#ifdef PROBE_P6NOISE
            { unsigned h_ = (unsigned)row * 2654435761u ^ (unsigned)(u.pn * 64 + wc * 8 + fq) * 40503u; float nz[16];
#pragma unroll
              for (int e_ = 0; e_ < 16; ++e_) { h_ = h_ * 1664525u + 1013904223u; nz[e_] = ((float)(h_ >> 8) * (1.f / 16777216.f) - 0.5f) * 3.4641f * 0.035f * (float)(PROBE_P6NOISE); }
              g0.x += nz[0]; g0.y += nz[1]; g0.z += nz[2]; g0.w += nz[3]; g1.x += nz[4]; g1.y += nz[5]; g1.z += nz[6]; g1.w += nz[7]; u0.x += nz[8]; u0.y += nz[9]; u0.z += nz[10]; u0.w += nz[11]; u1.x += nz[12]; u1.y += nz[13]; u1.z += nz[14]; u1.w += nz[15]; }
#endif
            const f32x4 a0 = {silu_mul(g0.x, u0.x), silu_mul(g0.y, u0.y), silu_mul(g0.z, u0.z), silu_mul(g0.w, u0.w)};
            const f32x4 a1 = {silu_mul(g1.x, u1.x), silu_mul(g1.y, u1.y), silu_mul(g1.z, u1.z), silu_mul(g1.w, u1.w)};
            st16(wsb, (u32x4*)(ACT + blk_off(row, u.aux * HALF + wc * 32 + 8 * fq, ldact)), pack8(a0, a1));
        }
    }
};
struct EpiGUMoe {
    static constexpr bool PERM = true, MID = false; static constexpr int NVM = 16;
    bf16_t* ACT; const float* rowrr; int ldact; unsigned char* wsb;
    __device__ __forceinline__ void operator()(const Acc& acc, const Unit& u, int wr, int wc, int fr, int fq) const {
        EPI_ROWBASE;
        float r8[8];
#pragma unroll
        for (int i = 0; i < 8; ++i) r8[i] = rowrr[rbase + (i >> 2) * HALF + (i & 3) * 16] * (MOE_F8 ? 1.f / 4096.f : 1.f);
        __builtin_amdgcn_sched_barrier(0);
        EPI_LOOP {
            const int row = rbase + ai * HALF + m * 16; const float r = r8[ai * 4 + m];
            const f32x4 g0 = acc[ai][0][m][0] * r, g1 = acc[ai][0][m][1] * r, u0 = acc[ai][1][m][0] * r, u1 = acc[ai][1][m][1] * r;
            const f32x4 a0 = {silu_mul(g0.x, u0.x), silu_mul(g0.y, u0.y), silu_mul(g0.z, u0.z), silu_mul(g0.w, u0.w)};
            const f32x4 a1 = {silu_mul(g1.x, u1.x), silu_mul(g1.y, u1.y), silu_mul(g1.z, u1.z), silu_mul(g1.w, u1.w)};
            if (MOE_DN_F8) { u32x2 o8; o8.x = pk_fp8x4(a0.x * 8.f, a0.y * 8.f, a0.z * 8.f, a0.w * 8.f); o8.y = pk_fp8x4(a1.x * 8.f, a1.y * 8.f, a1.z * 8.f, a1.w * 8.f);
                st8(wsb, (u32x2*)((unsigned char*)ACT + blk_off(row, (u.aux * HALF + wc * 32 + 8 * fq) >> 1, ldact >> 1) * 2), o8); }
            else st16(wsb, (u32x4*)(ACT + blk_off(row, u.aux * HALF + wc * 32 + 8 * fq, ldact)), pack8(a0, a1));
        }
    }
};
template <bool FIRST> struct EpiDnMoe {
    static constexpr bool PERM = true, MID = false; static constexpr int NVM = 32;
    unsigned char* ws; const int* rowtok; const float* rowgw;
    __device__ __forceinline__ void operator()(const Acc& acc, const Unit& u, int wr, int wc, int fr, int fq) const {
        EPI_ROWBASE; const int col = u.aux * BM + wc * 32 + 8 * fq;
        int tk[8]; float gw8[8];
#pragma unroll
        for (int i = 0; i < 8; ++i) { tk[i] = rowtok[rbase + (i >> 2) * HALF + (i & 3) * 16]; gw8[i] = rowgw[rbase + (i >> 2) * HALF + (i & 3) * 16] * (MOE_DN_F8 ? 1.f / 8192.f : 1.f); }
#pragma unroll
        for (int ai = 0; ai < 2; ++ai) {
            __builtin_amdgcn_sched_barrier(0);
            u32x4 xi[4][2]; bf16_t* xr[4];
#pragma unroll
            for (int m = 0; m < 4; ++m) { const int tok = tk[ai * 4 + m] < 0 ? 0 : tk[ai * 4 + m]; xr[m] = xm_row(ws, tok) + col;
                const bf16_t* src = FIRST ? (const bf16_t*)(ws + WS_XB) + (size_t)tok * DM + col : xr[m];
#pragma unroll
                for (int bj = 0; bj < 2; ++bj) xi[m][bj] = *(const u32x4*)(src + bj * HALF); }
#pragma unroll
            for (int m = 0; m < 4; ++m) { const float gwv = gw8[ai * 4 + m];
                if (tk[ai * 4 + m] >= 0) {
#pragma unroll
                    for (int bj = 0; bj < 2; ++bj) { f32x4 x0, x1; unpack8(xi[m][bj], x0, x1);
                        *(u32x4*)(xr[m] + bj * HALF) = pack8(x0 + acc[ai][bj][m][0] * gwv, x1 + acc[ai][bj][m][1] * gwv); } } }
        }
    }
};
}
namespace att {
__device__ __forceinline__ int crow(int r, int hi) { return (r & 3) + 8 * (r >> 2) + 4 * hi; }
__device__ __forceinline__ float xhalf_max(float m) { return xmax32(m); }
__device__ __forceinline__ float xhalf_sum(float m) { return xsum32(m); }
typedef short v4i16_t __attribute__((ext_vector_type(4)));
__device__ __forceinline__ s16x4 vtr(const LAS unsigned char* p) { return __builtin_bit_cast(s16x4, __builtin_amdgcn_ds_read_tr16_b64_v4i16((LAS v4i16_t*)p)); }
__device__ __forceinline__ bf16x8 cat8(s16x4 a, s16x4 b) { return (bf16x8){a[0], a[1], a[2], a[3], b[0], b[1], b[2], b[3]}; }
__device__ __forceinline__ bf16x8 pfrag(const f32x16& p, int s8) {
    u32x4 w; w.x = cvt_pk_bf16(p[s8 + 0], p[s8 + 1]); w.y = cvt_pk_bf16(p[s8 + 2], p[s8 + 3]); w.z = cvt_pk_bf16(p[s8 + 4], p[s8 + 5]); w.w = cvt_pk_bf16(p[s8 + 6], p[s8 + 7]);
    return __builtin_bit_cast(bf16x8, w);
}
constexpr int TAB_STRIDE = 320;

constexpr int BW_ROWS = 384, BW_KP = 144;
constexpr int BW_K = 0, BW_V = BW_ROWS * BW_KP, BW_VDH = BW_ROWS * 64, BW_TAB = BW_V + 2 * BW_VDH, BW_END = BW_TAB + 4 * TAB_STRIDE * 4;
struct BandPre { u32x4 k[6], v[6]; float t[4]; bf16x8 q[4]; };
struct BandItem { int kind, b, hh, g0, a0; };
__device__ __forceinline__ BandItem band_decode(int i, int items_per_kind) {
    BandItem it; it.kind = i / items_per_kind; const int w = i % items_per_kind;
    if (it.kind < 3) { const int sub = w & 7; it.hh = (w >> 3) & 7; it.b = w >> 6;
        if (it.kind == 0) { it.g0 = 0; it.a0 = 256 * sub; } else if (it.kind == 1) { it.g0 = sub >> 1; it.a0 = 256 * (sub & 1); } else { it.g0 = 2 * sub; it.a0 = 0; } }
    else { it.a0 = 64 * (w & 31); it.hh = (w >> 5) & 1; it.b = w >> 6; it.g0 = 0; }
    return it;
}
__device__ __forceinline__ bool band_row(const BandItem& it, int r, int& pos) {
    int key, g = it.g0, dil, L;
    if (it.kind == 3) { if (r >= 320) return false; key = it.a0 - 128 + r; dil = 1; L = SEQ; }
    else if (it.kind == 2) { if (r >= 256) return false; g += r >> 7; key = r & 127; dil = 16; L = 128; }
    else { dil = it.kind == 0 ? 1 : 4; L = SEQ / dil; key = it.a0 - 64 + r; }
    if (key < 0 || key >= L) return false;
    pos = key * dil + g; return true;
}
__device__ __forceinline__ void band_issue(BandPre& P, const BandItem& it, const bf16_t* HM, const float* tabg, int tid, int wid, int lane) {
    const bf16_t* kb = it.kind == 3 ? HM + (size_t)4 * MC * 512 + ((size_t)(it.b * 2 + it.hh) * SEQ) * 64 : HM + (size_t)MC * 512 + ((size_t)(it.b * 8 + it.hh) * SEQ) * 64;
    const bf16_t* vb = it.kind == 3 ? kb + (size_t)MC * 128 : kb + (size_t)MC * 512;
#pragma unroll
    for (int i = 0; i < 6; ++i) { const int id = i * 512 + tid, r = id >> 3, c = id & 7; int pos; P.k[i] = (u32x4){0u, 0u, 0u, 0u}; P.v[i] = P.k[i];
        if (band_row(it, r, pos)) { P.k[i] = *(const u32x4*)(kb + (size_t)pos * 64 + c * 8); P.v[i] = *(const u32x4*)(vb + (size_t)pos * 64 + c * 8); } }
#pragma unroll
    for (int j = 0; j < 4; ++j) { P.t[j] = 0.f; if (tid < TAB_STRIDE && (it.kind == 3 || j == 0)) P.t[j] = tabg[((it.kind == 3 ? 3 * 8 + it.hh * 4 + j : it.kind * 8 + it.hh)) * TAB_STRIDE + tid]; }
    int a0w, g = it.g0, dil, qh; const bf16_t* qbuf;
    if (it.kind == 3) { a0w = it.a0 + 32 * (wid & 1); dil = 1; qh = it.hh * 4 + (wid >> 1); qbuf = HM + (size_t)3 * MC * 512; }
    else if (it.kind == 2) { a0w = 32 * (wid & 3); g += wid >> 2; dil = 16; qh = it.hh; qbuf = HM; }
    else { a0w = it.a0 + 32 * wid; dil = it.kind == 0 ? 1 : 4; qh = it.hh; qbuf = HM; }
    const bf16_t* qp = qbuf + (((size_t)(it.b * 8 + qh) * SEQ) + (size_t)(a0w + (lane & 31)) * dil + g) * 64 + (lane >> 5) * 8;
#pragma unroll
    for (int d0 = 0; d0 < 4; ++d0) P.q[d0] = *(const bf16x8*)(qp + d0 * 16);
}
__device__ __forceinline__ void band_store(const BandPre& P, const BandItem& it, LAS unsigned char* lds, int tid) {
#pragma unroll
    for (int i = 0; i < 6; ++i) { const int id = i * 512 + tid, r = id >> 3, c = id & 7;
        *(LAS u32x4*)(lds + BW_K + r * BW_KP + c * 16) = P.k[i]; *(LAS u32x4*)(lds + BW_V + (c >> 2) * BW_VDH + r * 64 + (c & 3) * 16) = P.v[i]; }
    if (tid < TAB_STRIDE) {
#pragma unroll
        for (int j = 0; j < 4; ++j) if (it.kind == 3 || j == 0) ((LAS float*)(lds + BW_TAB))[j * TAB_STRIDE + tid] = P.t[j]; }
}
template <int NKB, int MODE>
__device__ __forceinline__ void band_compute(const bf16x8 (&qf)[4], const LAS unsigned char* lds, int rowoff, int a0w, int L, const LAS float* tab, bf16_t* op, float* stp, float sink2, int lane,
                                             const bf16_t* pb0 = nullptr, const bf16_t* pb1 = nullptr, const float* st0 = nullptr, const float* st1 = nullptr) {
    constexpr int R = 16 * (NKB - 1);
    const int q = lane & 31, hi = lane >> 5;
    f32x16 o0, o1;
#pragma unroll
    for (int r = 0; r < 16; ++r) { o0[r] = 0.f; o1[r] = 0.f; }
    float m = -3e38f, l = 0.f;
    const LAS float* tb = tab + (31 - q + 4 * hi);
    const int kro = q * BW_KP + hi * 16, vro = (4 * hi + ((lane & 15) >> 2)) * 64 + (16 * ((lane >> 4) & 1) + 4 * (lane & 3)) * 2;
#pragma unroll 1
    for (int kb = 0; kb < NKB; ++kb) {
        const int k0 = a0w - R + 32 * kb;
        if (k0 < 0 || k0 >= L) continue;
        const LAS unsigned char* kp = lds + BW_K + (rowoff + k0) * BW_KP + kro;
        f32x16 s;
#pragma unroll
        for (int r = 0; r < 16; ++r) s[r] = 0.f;
#pragma unroll
        for (int d0 = 0; d0 < 4; ++d0) s = __builtin_amdgcn_mfma_f32_32x32x16_bf16(*(const LAS bf16x8*)(kp + d0 * 32), qf[d0], s, 0, 0, 0);
#pragma unroll
        for (int r = 0; r < 16; ++r) s[r] += tb[32 * kb + (r & 3) + 8 * (r >> 2)];
        float bm = s[0];
#pragma unroll
        for (int r = 1; r < 16; ++r) bm = fmaxf(bm, s[r]);
        bm = xhalf_max(bm);
        const float mn = fmaxf(m, bm), f = fast_exp2(m - mn);
        float ps = 0.f;
#pragma unroll
        for (int r = 0; r < 16; ++r) { s[r] = fast_exp2(s[r] - mn); ps += s[r]; }
        l = l * f + ps; m = mn;
#pragma unroll
        for (int r = 0; r < 16; ++r) { o0[r] *= f; o1[r] *= f; }
        const bf16x8 p0 = pfrag(s, 0), p1 = pfrag(s, 8);
        const LAS unsigned char* vp = lds + BW_V + (rowoff + k0) * 64 + vro;
        { const bf16x8 v00 = cat8(vtr(vp), vtr(vp + 512)), v01 = cat8(vtr(vp + BW_VDH), vtr(vp + BW_VDH + 512));
          const bf16x8 v10 = cat8(vtr(vp + 1024), vtr(vp + 1024 + 512)), v11 = cat8(vtr(vp + BW_VDH + 1024), vtr(vp + BW_VDH + 1024 + 512));
          o0 = __builtin_amdgcn_mfma_f32_32x32x16_bf16(v00, p0, o0, 0, 0, 0); o1 = __builtin_amdgcn_mfma_f32_32x32x16_bf16(v01, p0, o1, 0, 0, 0);
          o0 = __builtin_amdgcn_mfma_f32_32x32x16_bf16(v10, p1, o0, 0, 0, 0); o1 = __builtin_amdgcn_mfma_f32_32x32x16_bf16(v11, p1, o1, 0, 0, 0); }
    }
    float lt = xhalf_sum(l);
    if (MODE == 2) {
        const f32x2 s0 = *(const f32x2*)st0, s1 = *(const f32x2*)st1;
        u32x2 a0[8], a1[8];
#pragma unroll
        for (int j = 0; j < 4; ++j) { a0[j] = *(const u32x2*)(pb0 + 8 * j); a0[4 + j] = *(const u32x2*)(pb0 + 32 + 8 * j); a1[j] = *(const u32x2*)(pb1 + 8 * j); a1[4 + j] = *(const u32x2*)(pb1 + 32 + 8 * j); }
        const float M = fmaxf(m, fmaxf(s0.x, s1.x));
        const float w0 = fast_exp2(s0.x - M) * s0.y, w1 = fast_exp2(s1.x - M) * s1.y, w2 = fast_exp2(m - M);
        const float inv = 1.f / (w0 + w1 + w2 * lt), c0 = w0 * inv, c1 = w1 * inv, c2 = w2 * inv;
#pragma unroll
        for (int j = 0; j < 4; ++j) {
            u32x2 w0_, w1_;
            { const float x0 = bf_lo(a0[j].x) * c0 + bf_lo(a1[j].x) * c1 + o0[4 * j] * c2, x1 = bf_hi(a0[j].x) * c0 + bf_hi(a1[j].x) * c1 + o0[4 * j + 1] * c2;
              const float x2 = bf_lo(a0[j].y) * c0 + bf_lo(a1[j].y) * c1 + o0[4 * j + 2] * c2, x3 = bf_hi(a0[j].y) * c0 + bf_hi(a1[j].y) * c1 + o0[4 * j + 3] * c2;
              w0_.x = cvt_pk_bf16(x0, x1); w0_.y = cvt_pk_bf16(x2, x3); }
            { const float x0 = bf_lo(a0[4 + j].x) * c0 + bf_lo(a1[4 + j].x) * c1 + o1[4 * j] * c2, x1 = bf_hi(a0[4 + j].x) * c0 + bf_hi(a1[4 + j].x) * c1 + o1[4 * j + 1] * c2;
              const float x2 = bf_lo(a0[4 + j].y) * c0 + bf_lo(a1[4 + j].y) * c1 + o1[4 * j + 2] * c2, x3 = bf_hi(a0[4 + j].y) * c0 + bf_hi(a1[4 + j].y) * c1 + o1[4 * j + 3] * c2;
              w1_.x = cvt_pk_bf16(x0, x1); w1_.y = cvt_pk_bf16(x2, x3); }
            *(u32x2*)(op + 8 * j) = w0_; *(u32x2*)(op + 32 + 8 * j) = w1_;
        }
        return;
    }
    if (MODE == 1) lt += fast_exp2(sink2 - m);
    else if (hi == 0) { stp[0] = m; stp[1] = lt; }
    const float inv = 1.f / lt;
#pragma unroll
    for (int j = 0; j < 4; ++j) {
        u32x2 w0, w1; w0.x = cvt_pk_bf16(o0[4 * j] * inv, o0[4 * j + 1] * inv); w0.y = cvt_pk_bf16(o0[4 * j + 2] * inv, o0[4 * j + 3] * inv);
        w1.x = cvt_pk_bf16(o1[4 * j] * inv, o1[4 * j + 1] * inv); w1.y = cvt_pk_bf16(o1[4 * j + 2] * inv, o1[4 * j + 3] * inv);
        *(u32x2*)(op + 8 * j) = w0; *(u32x2*)(op + 32 + 8 * j) = w1;
    }
}

constexpr int MLA_KP = 208;
constexpr float MLA_THR = 6.f;
constexpr int MLA_TK = 128;
constexpr int MLA_KTB = MLA_TK * MLA_KP;
constexpr int MLA_VTB = MLA_TK * 128;
constexpr int MLA_SLOT = MLA_KTB + MLA_VTB;
__device__ __forceinline__ void mla_unit(const bf16_t* Q, const bf16_t* KV, const bf16_t* Zc, bf16_t* Y, int b, int h, int qblk, LAS unsigned char* lds, int tid, int wid, int lane) {
    const int q = lane & 31, hi = lane >> 5;
    const size_t rb = (size_t)b * SEQ;
    bf16x8 qf[6];
    { const bf16_t* qp = Q + (rb + qblk * 256 + wid * 32 + q) * 768 + h * 96 + hi * 8;
#pragma unroll
      for (int d0 = 0; d0 < 6; ++d0) qf[d0] = *(const bf16x8*)(qp + d0 * 16); }
    const bf16_t* gk = KV + (rb + (tid >> 3)) * 1024 + h * 64 + (tid & 7) * 8;
    const bf16_t* gv = gk + 512;
    const bf16_t* gp = Zc + (rb + (tid >> 2)) * ZW + ZO_KPE + (tid & 3) * 8;
    const int lk = (tid >> 3) * MLA_KP + (tid & 7) * 16, lp = (tid >> 2) * MLA_KP + 128 + (tid & 3) * 16;
    const int lv = MLA_KTB + ((tid & 7) >> 2) * (MLA_TK * 64) + (tid >> 3) * 64 + (tid & 3) * 16;
    u32x4 rk0, rk1, rv0, rv1, rp;
#define MLA_GLOAD(T) do { const size_t go_ = (size_t)(T) * MLA_TK; rk0 = *(const u32x4*)(gk + go_ * 1024); rk1 = *(const u32x4*)(gk + (go_ + 64) * 1024); \
        rv0 = *(const u32x4*)(gv + go_ * 1024); rv1 = *(const u32x4*)(gv + (go_ + 64) * 1024); rp = *(const u32x4*)(gp + go_ * ZW); } while (0)
#define MLA_LSTORE(slot) do { LAS unsigned char* sb_ = lds + (slot) * MLA_SLOT; *(LAS u32x4*)(sb_ + lk) = rk0; *(LAS u32x4*)(sb_ + lk + 64 * MLA_KP) = rk1; \
        *(LAS u32x4*)(sb_ + lv) = rv0; *(LAS u32x4*)(sb_ + lv + 64 * 64) = rv1; *(LAS u32x4*)(sb_ + lp) = rp; } while (0)
    MLA_GLOAD(0); MLA_LSTORE(0); MLA_GLOAD(1); MLA_LSTORE(1);
    __syncthreads();
    f32x16 o0, o1;
#pragma unroll
    for (int r = 0; r < 16; ++r) { o0[r] = 0.f; o1[r] = 0.f; }
    float m = 0.f, l = 0.f;
    const int kro = q * MLA_KP + hi * 16;
    const int vro = MLA_KTB + (4 * hi + ((lane & 15) >> 2)) * 64 + (16 * ((lane >> 4) & 1) + 4 * (lane & 3)) * 2;
    f32x16 sa0, sa1, sb0, sb1, negm;
#pragma unroll
    for (int r = 0; r < 16; ++r) negm[r] = 0.f;
    m = 0.f;
#define MLA_QK(S0, S1, slot, sub) do { const LAS unsigned char* kb_ = lds + (slot) * MLA_SLOT + (sub) * 64 * MLA_KP + kro; \
        { const bf16x8 k0_ = *(const LAS bf16x8*)(kb_), k1_ = *(const LAS bf16x8*)(kb_ + 32 * MLA_KP); \
          S0 = __builtin_amdgcn_mfma_f32_32x32x16_bf16(k0_, qf[0], negm, 0, 0, 0); S1 = __builtin_amdgcn_mfma_f32_32x32x16_bf16(k1_, qf[0], negm, 0, 0, 0); } \
        _Pragma("unroll") for (int d0 = 1; d0 < 6; ++d0) { const bf16x8 k0_ = *(const LAS bf16x8*)(kb_ + d0 * 32), k1_ = *(const LAS bf16x8*)(kb_ + 32 * MLA_KP + d0 * 32); \
            S0 = __builtin_amdgcn_mfma_f32_32x32x16_bf16(k0_, qf[d0], S0, 0, 0, 0); S1 = __builtin_amdgcn_mfma_f32_32x32x16_bf16(k1_, qf[d0], S1, 0, 0, 0); } } while (0)
#define MAX3(a, b, c) __builtin_fmaxf(__builtin_fmaxf((a), (b)), (c))
#define MLA_STEP(C0, C1, N0, N1, HASN, NSLOT, NSUB, CSLOT, CSUB, FIRST) do { \
        if (HASN) MLA_QK(N0, N1, NSLOT, NSUB); \
        float ba = MAX3(C0[0], C0[1], C1[0]), bb = MAX3(C0[2], C0[3], C1[1]); ba = MAX3(ba, C1[2], C1[3]); \
        _Pragma("unroll") for (int r = 4; r < 16; r += 4) { ba = MAX3(ba, C0[r], C0[r + 1]); bb = MAX3(bb, C0[r + 2], C0[r + 3]); ba = MAX3(ba, C1[r], C1[r + 1]); bb = MAX3(bb, C1[r + 2], C1[r + 3]); } \
        float bm = xhalf_max(__builtin_fmaxf(ba, bb)); \
        if ((FIRST) || __any(bm > MLA_THR)) {                                \
            const float dl = (FIRST) ? bm : __builtin_fmaxf(bm, 0.f), f = fast_exp2(-dl); m += dl; l *= f; \
            _Pragma("unroll") for (int r = 0; r < 16; ++r) { o0[r] *= f; o1[r] *= f; C0[r] -= dl; C1[r] -= dl; negm[r] = -m; } \
            if (HASN) { _Pragma("unroll") for (int r = 0; r < 16; ++r) { N0[r] -= dl; N1[r] -= dl; } } } \
        float ps = 0.f; \
        _Pragma("unroll") for (int r = 0; r < 16; ++r) { C0[r] = fast_exp2(C0[r]); C1[r] = fast_exp2(C1[r]); ps += C0[r] + C1[r]; } \
        l += ps; \
        const bf16x8 p0 = pfrag(C0, 0), p1 = pfrag(C0, 8), p2 = pfrag(C1, 0), p3 = pfrag(C1, 8); \
        const LAS unsigned char* vb = lds + (CSLOT) * MLA_SLOT + (CSUB) * 64 * 64 + vro; \
        MLA_PV(0, p0); MLA_PV(1, p1); MLA_PV(2, p2); MLA_PV(3, p3); } while (0)
#define MLA_PV(S, P) do { const bf16x8 va = cat8(vtr(vb + (S) * 1024), vtr(vb + (S) * 1024 + 512)), vc = cat8(vtr(vb + MLA_TK * 64 + (S) * 1024), vtr(vb + MLA_TK * 64 + (S) * 1024 + 512)); \
            o0 = __builtin_amdgcn_mfma_f32_32x32x16_bf16(va, P, o0, 0, 0, 0); o1 = __builtin_amdgcn_mfma_f32_32x32x16_bf16(vc, P, o1, 0, 0, 0); } while (0)
    MLA_QK(sa0, sa1, 0, 0);
    int sc = 0, sn = 1, sw = 2;
    constexpr int NT = SEQ / MLA_TK;
    for (int T = 0; T < NT; ++T) {
        const bool has1 = T + 1 < NT, has2 = T + 2 < NT;
        if (has2) MLA_GLOAD(T + 2);
        MLA_STEP(sa0, sa1, sb0, sb1, true, sc, 1, sc, 0, T == 0);
        MLA_STEP(sb0, sb1, sa0, sa1, has1, sn, 0, sc, 1, false);
        if (has2) MLA_LSTORE(sw);
        __syncthreads();
        const int tmp = sc; sc = sn; sn = sw; sw = tmp;
    }
#undef MAX3
#undef MLA_GLOAD
#undef MLA_LSTORE
#undef MLA_QK
#undef MLA_STEP
#undef MLA_PV
    const float inv = 1.f / xhalf_sum(l);
    bf16_t* op = Y + (rb + qblk * 256 + wid * 32 + q) * 1536 + h * 64 + 4 * hi;
#pragma unroll
    for (int j = 0; j < 4; ++j) {
        u32x2 w0, w1; w0.x = cvt_pk_bf16(o0[4 * j] * inv, o0[4 * j + 1] * inv); w0.y = cvt_pk_bf16(o0[4 * j + 2] * inv, o0[4 * j + 3] * inv);
        w1.x = cvt_pk_bf16(o1[4 * j] * inv, o1[4 * j + 1] * inv); w1.y = cvt_pk_bf16(o1[4 * j + 2] * inv, o1[4 * j + 3] * inv);
        *(u32x2*)(op + 8 * j) = w0; *(u32x2*)(op + 32 + 8 * j) = w1;
    }
}
}
constexpr int NWAVES = 8, NTHREADS = 512;
constexpr int LDS_BYTES = 147456;
constexpr int MISC_OFF = 131072 + 320;
#define LDS_WAIT() asm volatile("s_waitcnt lgkmcnt(0)" ::: "memory")

struct Args { const float* in[22]; float* out; unsigned char* ws; int ph_lo, ph_hi; };

enum { MAP_ID = 0, MAP_WIN, MAP_WUQ, MAP_WUKV, MAP_GATE, MAP_UP, MAP_WIN8 };
__device__ __forceinline__ int map_row(int map, int n) {
    if (map == MAP_WIN || map == MAP_WIN8) {
        const int o = map == MAP_WIN8 ? P1_F8_FROM * 256 : 0;
        if (n < 384) return n - o;
        if (n < 416) { const int i = n - 384; return 384 + (i < 16 ? 2 * i : 2 * (i - 16) + 1) - o; }
        return n + 96 - o;
    }
    if (map == MAP_WUQ) { const int h = n / 96, j = n % 96; if (j < 64) return n; const int i = j - 64; return h * 96 + 64 + (i < 16 ? 2 * i : 2 * (i - 16) + 1); }
    if (map == MAP_WUKV) { const int h = n >> 7, j = n & 127; return j < 64 ? h * 64 + j : 512 + h * 64 + (j - 64); }
    if (map == MAP_GATE) return (n >> 7) * 256 + (n & 127);
    if (map == MAP_UP) return (n >> 7) * 256 + 128 + (n & 127);
    return n;
}
template <bool F8 = false>
__device__ __forceinline__ void cvt_item(const float* src, int ldsrc, int nblk, const float* gain, float scale, bf16_t* dst, int lddst, int kdst0, int map, LAS float* scr, int item, int lane) {
    const int kb = item / nblk, nb = item % nblk, k0 = 64 * kb, n0 = 32 * nb;
    f32x4 v[8]; float gs[8];
#pragma unroll
    for (int i = 0; i < 8; ++i) { const int idx = i * 64 + lane, kk = idx >> 3, c4 = idx & 7; v[i] = *(const f32x4*)(src + (size_t)(k0 + kk) * ldsrc + n0 + 4 * c4); gs[i] = gain ? gain[k0 + kk] * scale : scale; }
#pragma unroll
    for (int i = 0; i < 8; ++i) { const int idx = i * 64 + lane, kk = idx >> 3, c4 = idx & 7; LAS float* d = scr + kk * 33 + 4 * c4; d[0] = v[i].x * gs[i]; d[1] = v[i].y * gs[i]; d[2] = v[i].z * gs[i]; d[3] = v[i].w * gs[i]; }
    LDS_WAIT(); asm volatile("" ::: "memory");
    const int c = lane & 7;
#pragma unroll
    for (int j = 0; j < 4; ++j) { const int n = (lane >> 3) + 8 * j; const LAS float* s = scr + (8 * c) * 33 + n;
        u32x4 o; o.x = cvt_pk_bf16(s[0 * 33], s[1 * 33]); o.y = cvt_pk_bf16(s[2 * 33], s[3 * 33]); o.z = cvt_pk_bf16(s[4 * 33], s[5 * 33]); o.w = cvt_pk_bf16(s[6 * 33], s[7 * 33]);
        if constexpr (F8) { u32x2 o8; o8.x = pk_fp8x4(s[0 * 33], s[1 * 33], s[2 * 33], s[3 * 33]); o8.y = pk_fp8x4(s[4 * 33], s[5 * 33], s[6 * 33], s[7 * 33]);
            *(u32x2*)((unsigned char*)dst + (size_t)map_row(map, n0 + n) * lddst + kdst0 + k0 + 8 * c) = o8; }
        else *(u32x4*)(dst + (size_t)map_row(map, n0 + n) * lddst + kdst0 + k0 + 8 * c) = o; }
    LDS_WAIT(); asm volatile("" ::: "memory");
}

struct Ctx {
    LAS unsigned char* lds; int tid, lane, wave, vcu, G, gw, NGW;
    const float* const* in; float* out; unsigned char* ws;
};

__device__ __forceinline__ void phase_prologue(const Ctx& C) {
    LAS float* scr = (LAS float*)(C.lds + C.wave * 16384);
    unsigned char* ws = C.ws;
    constexpr int I_IN = 16 * 181, I_UQ = 4 * 24, I_UKV = 2 * 32, I_BR = 8 * 32, I_OUT = 16 * 32, I_L = I_IN + I_UQ + I_UKV + 3 * I_BR + I_OUT;
    constexpr int I_G = 16 * 88, I_D = 44 * 32, NIT = 2 * I_L + 2 * I_G + I_D;
    for (int it = C.gw; it < NIT; it += C.NGW) {
        int r = it;
        if (r < 2 * I_L) { const int l = r / I_L; r -= l * I_L;
            if (r < I_IN) { if (r % 181 >= (P1_F8_FROM <= 1 ? P1_F8_FROM * 8 : (P1_F8_FROM * 256 - 96) / 32)) cvt_item<true>(C.in[2] + (size_t)l * DM * INC, INC, 181, C.in[1] + l * DM, 256.f, (bf16_t*)(ws + WS_WIN8 + l * SZ_WIN8), DM, 0, MAP_WIN8, scr, r, C.lane);
                            else cvt_item(C.in[2] + (size_t)l * DM * INC, INC, 181, C.in[1] + l * DM, 1.f, (bf16_t*)(ws + WS_WIN + l * SZ_WIN), DM, 0, MAP_WIN, scr, r, C.lane); continue; } r -= I_IN;
            if (r < I_UQ) { cvt_item(C.in[4] + (size_t)l * 256 * 768, 768, 24, C.in[3] + l * 256, 0.10206207261596577f * LOG2E, (bf16_t*)(ws + WS_WUQ + l * SZ_WUQ), 256, 0, MAP_WUQ, scr, r, C.lane); continue; } r -= I_UQ;
            if (r < I_UKV) { cvt_item(C.in[6] + (size_t)l * 128 * 1024, 1024, 32, C.in[5] + l * 128, 1.f, (bf16_t*)(ws + WS_WUKV + l * SZ_WUKV), 256, 0, MAP_WUKV, scr, r, C.lane); continue; } r -= I_UKV;
            if (r < 3 * I_BR) { const int br = r / I_BR; r -= br * I_BR; cvt_item(C.in[9 + br] + (size_t)l * 512 * DM, DM, 32, nullptr, 1.f, (bf16_t*)(ws + WS_WBR + l * SZ_WBR), 1536, br * 512, MAP_ID, scr, r, C.lane); continue; } r -= 3 * I_BR;
            cvt_item(C.in[12] + (size_t)l * DM * DM, DM, 32, nullptr, 1.f, (bf16_t*)(ws + WS_WOUT + l * SZ_WOUT), DM, 0, MAP_ID, scr, r, C.lane); continue; }
        r -= 2 * I_L;
        if (r < I_G) { cvt_item(C.in[14], DFF, 88, C.in[13], 1.f, (bf16_t*)(ws + WS_WGU), DM, 0, MAP_GATE, scr, r, C.lane); continue; } r -= I_G;
        if (r < I_G) { cvt_item(C.in[15], DFF, 88, C.in[13], 1.f, (bf16_t*)(ws + WS_WGU), DM, 0, MAP_UP, scr, r, C.lane); continue; } r -= I_G;
        cvt_item(C.in[16], DM, 32, nullptr, 1.f, (bf16_t*)(ws + WS_WD), DFF, 0, MAP_ID, scr, r, C.lane);
    }
    const int gt = C.vcu * NTHREADS + C.tid, NGT = C.G * NTHREADS;
    if (P1_F8_FROM <= 1) for (int i = gt; i < 2 * 6144; i += NGT) { const int l = i / 6144, r = i % 6144; const u32x4 z = {0u, 0u, 0u, 0u}; *(u32x4*)(ws + WS_WIN8 + l * SZ_WIN8 + (size_t)(416 - P1_F8_FROM * 256) * DM + (size_t)r * 16) = z; }
    for (int i = gt; i < 2 * (12288 + 16384); i += NGT) { const int l = i / (12288 + 16384); int r = i % (12288 + 16384); const u32x4 z = {0u, 0u, 0u, 0u};
        if (r < 12288) *(u32x4*)(ws + WS_WIN + l * SZ_WIN + (size_t)416 * DM * 2 + (size_t)r * 16) = z;
        else { r -= 12288; *(u32x4*)(ws + WS_WUKV + l * SZ_WUKV + (size_t)(r >> 4) * 512 + 256 + (r & 15) * 16) = z; } }
    float* cosT = (float*)(ws + WS_TAB); float* sinT = cosT + SEQ * 16; float* tabb = sinT + SEQ * 16;
    for (int i = gt; i < SEQ * 16; i += NGT) { const int pos = i >> 4, k = i & 15; const float inv = powf(10000.f, -(float)k / 16.f); const float ang = (float)pos * inv; cosT[i] = cosf(ang); sinT[i] = sinf(ang); }
    for (int i = gt; i < 4 * 8 * att::TAB_STRIDE; i += NGT) { const int kind = i / (8 * att::TAB_STRIDE), h = (i / att::TAB_STRIDE) & 7, idx = i % att::TAB_STRIDE;
        const int R = kind == 3 ? 128 : 64, dil = kind == 1 ? 4 : (kind == 2 ? 16 : 1), rel = idx - (R + 31);
        float v = NEGB; if (rel >= -R && rel <= R) v = C.in[8][t5_bucket(rel * dil) * 16 + (kind == 3 ? 8 : 0) + h] * LOG2E;
        tabb[i] = v; }
    const float* x = C.in[0]; bf16_t* xb = (bf16_t*)(ws + WS_XB); float* st = (float*)(ws + WS_ST);
    for (int row = 2 * C.gw; row < MTOK; row += 2 * C.NGW) {
        const f32x4* xr = (const f32x4*)(x + (size_t)row * DM) + C.lane; f32x4 v[8];
#pragma unroll
        for (int j = 0; j < 8; ++j) v[j] = xr[64 * j];
        float s0 = 0.f, s1 = 0.f;
#pragma unroll
        for (int j = 0; j < 8; ++j) { const float q = (v[j].x * v[j].x + v[j].y * v[j].y) + (v[j].z * v[j].z + v[j].w * v[j].w); if (j < 4) s0 += q; else s1 += q;
            u32x2 w; w.x = cvt_pk_bf16(v[j].x, v[j].y); w.y = cvt_pk_bf16(v[j].z, v[j].w); *((u32x2*)(xb + (size_t)row * DM) + C.lane + 64 * j) = w;
            if (P1_F8_FROM < 23) *((unsigned*)(ws + WS_XB8P + (size_t)(row + (j >> 2)) * DM) + C.lane + 64 * (j & 3)) = pk_fp8x4(v[j].x * 16.f, v[j].y * 16.f, v[j].z * 16.f, v[j].w * 16.f); }
        s0 = wave_sum(s0); s1 = wave_sum(s1);
        if (C.lane < 32) st[(size_t)row * 16 + C.lane] = C.lane == 0 ? s0 : (C.lane == 16 ? s1 : 0.f);
    }
}

__device__ __forceinline__ void phase_moe_weights(const Ctx& C) {
    LAS float* scr = (LAS float*)(C.lds + 40960 + C.wave * 8704);
    constexpr int I_G = 16 * 112, I_D = 56 * 32, I_E = 2 * I_G + I_D;
    for (int it = C.gw; it < NEXP * I_E; it += C.NGW) {
        const int e = it / I_E; int r = it % I_E;
        if (r < I_G) { cvt_item<MOE_F8 != 0>(C.in[18] + (size_t)e * DM * DFE, DFE, 112, C.in[13] + DM, MOE_F8 ? 256.f : 1.f, (bf16_t*)(C.ws + WS_EGU + (size_t)e * 2 * DFE * DM * (MOE_F8 ? 1 : 2)), DM, 0, MAP_GATE, scr, r, C.lane); continue; } r -= I_G;
        if (r < I_G) { cvt_item<MOE_F8 != 0>(C.in[19] + (size_t)e * DM * DFE, DFE, 112, C.in[13] + DM, MOE_F8 ? 256.f : 1.f, (bf16_t*)(C.ws + WS_EGU + (size_t)e * 2 * DFE * DM * (MOE_F8 ? 1 : 2)), DM, 0, MAP_UP, scr, r, C.lane); continue; } r -= I_G;
        cvt_item<MOE_DN_F8 != 0>(C.in[20] + (size_t)e * DFE * DM, DM, 32, nullptr, MOE_DN_F8 ? 1024.f : 1.f, (bf16_t*)(C.ws + WS_ED + (size_t)e * DM * DFE * (MOE_DN_F8 ? 1 : 2)), DFE, 0, MAP_ID, scr, r, C.lane);
    }
}

template <bool SECOND>
__device__ __forceinline__ void phase_band(const Ctx& C, const bf16_t* HM, bf16_t* PB, float* PBS, bf16_t* Y, const float* sink) {
    constexpr int IPK = MC / 2048 * 64, NIT = (SECOND ? 1 : 3) * IPK;
    const float* tabg = (const float*)(C.ws + WS_TAB) + 2 * SEQ * 16;
    att::BandPre P; att::BandItem it, nx;
    int i = C.vcu;
#define BAND_IDX(IDX) (SECOND ? 2 * IPK + (IDX) : ((IDX) < 2 * IPK ? (IDX) : (IDX) + IPK))
    if (i < NIT) { it = att::band_decode(BAND_IDX(i), IPK); att::band_issue(P, it, HM, tabg, C.tid, C.wave, C.lane); }
    for (; i < NIT; i += C.G) {
        att::band_store(P, it, C.lds, C.tid);
        bf16x8 qf[4];
#pragma unroll
        for (int d0 = 0; d0 < 4; ++d0) qf[d0] = P.q[d0];
        __syncthreads();
        const bool more = i + C.G < NIT;
        if (more) { nx = att::band_decode(BAND_IDX(i + C.G), IPK); att::band_issue(P, nx, HM, tabg, C.tid, C.wave, C.lane); }
        const int q = C.lane & 31, hi = C.lane >> 5, w = C.wave;
        if (it.kind == 3) {
            const int h = it.hh * 4 + (w >> 1), a0w = it.a0 + 32 * (w & 1); const size_t rowq = (size_t)it.b * SEQ + a0w + q;
            att::band_compute<9, 1>(qf, C.lds, 128 - it.a0, a0w, SEQ, (const LAS float*)(C.lds + att::BW_TAB) + (w >> 1) * att::TAB_STRIDE, Y + rowq * 1536 + 1024 + h * 64 + 4 * hi, nullptr, sink[h] * LOG2E, C.lane);
        } else if (it.kind == 2) {
            const int a0w = 32 * (w & 3), g = it.g0 + (w >> 2); const size_t rowq = (size_t)it.b * SEQ + (size_t)(a0w + q) * 16 + g;
            const size_t po = rowq * 512 + it.hh * 64 + 4 * hi, so = (rowq * 8 + it.hh) * 2;
            att::band_compute<5, 2>(qf, C.lds, (w >> 2) * 128, a0w, 128, (const LAS float*)(C.lds + att::BW_TAB), Y + rowq * 1536 + 512 + it.hh * 64 + 4 * hi, nullptr, 0.f, C.lane,
                                    PB + po, PB + (size_t)MC * 512 + po, PBS + so, PBS + (size_t)MC * 16 + so);
        } else {
            const int a0w = it.a0 + 32 * w, dil = it.kind == 0 ? 1 : 4, L = SEQ / dil, rowoff = 64 - it.a0;
            const size_t rowq = (size_t)it.b * SEQ + (size_t)(a0w + q) * dil + it.g0;
            att::band_compute<5, 0>(qf, C.lds, rowoff, a0w, L, (const LAS float*)(C.lds + att::BW_TAB), PB + (size_t)it.kind * MC * 512 + rowq * 512 + it.hh * 64 + 4 * hi,
                                    PBS + (size_t)it.kind * MC * 16 + (rowq * 8 + it.hh) * 2, 0.f, C.lane);
        }
        __syncthreads();
        it = nx;
    }
#undef BAND_IDX
}

__device__ __forceinline__ void phase_mla(const Ctx& C, const bf16_t* Q, const bf16_t* KV, const bf16_t* Zc, bf16_t* Y) {
    constexpr int NU = MC / 256 * 8;
    for (int u = C.vcu; u < NU; u += C.G) { const int qblk = u & 7, bh = u >> 3; att::mla_unit(Q, KV, Zc, Y, bh >> 3, bh & 7, qblk, C.lds, C.tid, C.wave, C.lane); }
}

__device__ __forceinline__ void phase_route(const Ctx& C) {
    LAS float* wr = (LAS float*)C.lds; LAS int* cnt = (LAS int*)(C.lds + 32768);
    const float* g2 = C.in[13] + DM; const float* router = C.in[17];
    for (int i = C.tid; i < DM * 8; i += NTHREADS) wr[i] = router[i] * g2[i >> 3];
    if (C.tid < 16) cnt[C.tid] = 0;
    __syncthreads();
    int* sel = (int*)(C.ws + WS_SEL); float* gwp = (float*)(C.ws + WS_GW); float* rr = (float*)(C.ws + WS_RR);
    const int w = blockIdx.x;
    for (int j = 0; j < 16; ++j) {
        const int tok = w * 128 + C.wave * 16 + j;
        const u32x2* xr = (const u32x2*)((const bf16_t*)(C.ws + WS_XB) + (size_t)tok * DM) + C.lane;
        float lg[8], ss = 0.f;
#pragma unroll
        for (int e = 0; e < 8; ++e) lg[e] = 0.f;
#pragma unroll
        for (int q = 0; q < 4; ++q) { const u32x2 wv = xr[64 * q]; const f32x4 v = {bf_lo(wv.x), bf_hi(wv.x), bf_lo(wv.y), bf_hi(wv.y)}; ss += (v.x * v.x + v.y * v.y) + (v.z * v.z + v.w * v.w);
            const int k = 4 * C.lane + 256 * q;
            if (MOE_F8) *(unsigned*)(C.ws + WS_XB8 + (size_t)tok * DM + k) = pk_fp8x4(v.x * 16.f, v.y * 16.f, v.z * 16.f, v.w * 16.f);
#pragma unroll
            for (int c = 0; c < 4; ++c) { const float xv = v[c]; const f32x4 w0 = *(const LAS f32x4*)(wr + (k + c) * 8), w1 = *(const LAS f32x4*)(wr + (k + c) * 8 + 4);
                lg[0] += xv * w0.x; lg[1] += xv * w0.y; lg[2] += xv * w0.z; lg[3] += xv * w0.w; lg[4] += xv * w1.x; lg[5] += xv * w1.y; lg[6] += xv * w1.z; lg[7] += xv * w1.w; } }
        ss = wave_sum(ss);
#pragma unroll
        for (int e = 0; e < 8; ++e) lg[e] = wave_sum(lg[e]);
        const float r = rsqrtf(ss * (1.f / 1024.f) + EPS);
        if (C.lane == 0) {
            int i1 = 0; float v1 = lg[0];
#pragma unroll
            for (int e = 1; e < 8; ++e) if (lg[e] > v1) { v1 = lg[e]; i1 = e; }
            int i2 = -1; float v2 = -3e38f;
#pragma unroll
            for (int e = 0; e < 8; ++e) if (e != i1 && lg[e] > v2) { v2 = lg[e]; i2 = e; }
            const float e2 = expf((v2 - v1) * r);
            sel[tok * 2] = i1; sel[tok * 2 + 1] = i2; gwp[tok * 2] = 1.f / (1.f + e2); gwp[tok * 2 + 1] = e2 / (1.f + e2); rr[tok] = r;
            __hip_atomic_fetch_add(&cnt[i1], 1, __ATOMIC_RELAXED, __HIP_MEMORY_SCOPE_WORKGROUP); __hip_atomic_fetch_add(&cnt[8 + i2], 1, __ATOMIC_RELAXED, __HIP_MEMORY_SCOPE_WORKGROUP);
        }
    }
    __syncthreads();
    if (C.tid < 16) ((int*)(C.ws + WS_META))[MI_CNT + (C.tid >> 3) * 2048 + w * 8 + (C.tid & 7)] = cnt[C.tid];
}

__device__ __forceinline__ void phase_sort(const Ctx& C) {
    LAS int* tot = (LAS int*)C.lds; LAS int* pre = tot + 16; LAS int* base = tot + 32;
    int* meta = (int*)(C.ws + WS_META); const int w = blockIdx.x;
    if (C.tid < 16) { const int k = C.tid >> 3, e = C.tid & 7; int t = 0, p = 0;
        for (int w2 = 0; w2 < 256; ++w2) { const int c = meta[MI_CNT + k * 2048 + w2 * 8 + e]; t += c; if (w2 < w) p += c; }
        tot[C.tid] = t; pre[C.tid] = p; }
    __syncthreads();
    if (C.tid < 16) { const int k = C.tid >> 3, e = C.tid & 7; int b = 0; for (int e2 = 0; e2 < e; ++e2) b += (tot[k * 8 + e2] + 255) & ~255; base[C.tid] = b; }
    __syncthreads();
    const int* sel = (const int*)(C.ws + WS_SEL); const float* gwp = (const float*)(C.ws + WS_GW);
    int* rowtok = (int*)(C.ws + WS_ROWTOK); float* rowgw = (float*)(C.ws + WS_ROWGW); float* rowrr = (float*)(C.ws + WS_ROWRR); const float* rr = (const float*)(C.ws + WS_RR);
    if (C.wave < 2) { const int k = C.wave; LAS int* runL = tot + 48 + k * 8;
        if (C.lane < 8) runL[C.lane] = base[k * 8 + C.lane] + pre[k * 8 + C.lane];
        for (int j = 0; j < 2; ++j) { const int tok = w * 128 + j * 64 + C.lane; const int e = sel[tok * 2 + k]; int pos = 0;
#pragma unroll 1
            for (int e2 = 0; e2 < 8; ++e2) { const unsigned long long mk = __ballot(e == e2); const int r0 = runL[e2]; const int rank = __popcll(mk & ((1ull << C.lane) - 1ull));
                if (e == e2) pos = r0 + rank; if (C.lane == 0) runL[e2] = r0 + __popcll(mk); }
            rowtok[k * MOE_ROWS + pos] = tok; rowgw[k * MOE_ROWS + pos] = gwp[tok * 2 + k]; rowrr[k * MOE_ROWS + pos] = rr[tok]; } }
    if (w < 16) { const int k = w >> 3, e = w & 7; const int t = tot[k * 8 + e], b = base[k * 8 + e], pe = (t + 255) & ~255;
        for (int i = b + t + C.tid; i < b + pe; i += NTHREADS) { rowtok[k * MOE_ROWS + i] = -1; rowgw[k * MOE_ROWS + i] = 0.f; rowrr[k * MOE_ROWS + i] = 0.f; } }
    if (w == 16 && C.tid < 2) { const int k = C.tid; int nt = 0;
        for (int e = 0; e < 8; ++e) { const int n = (tot[k * 8 + e] + 255) >> 8; for (int i = 0; i < n; ++i) meta[MI_TILEE + k * 160 + nt + i] = e; nt += n; }
        meta[MI_NTILE + k] = nt; }
}

__device__ __forceinline__ void phase_final(const Ctx& C) {
    const float* g = C.in[21];
    for (int row = 2 * C.gw; row < MTOK; row += 2 * C.NGW) {
        f32x4 v[8]; float s0 = 0.f, s1 = 0.f;
#pragma unroll
        for (int j = 0; j < 8; ++j) { const u32x2 wv = ((const u32x2*)xm_row(C.ws, row + (j >> 2)))[C.lane + 64 * (j & 3)]; v[j] = (f32x4){bf_lo(wv.x), bf_hi(wv.x), bf_lo(wv.y), bf_hi(wv.y)}; }
#ifdef PROBE_NAN
#pragma unroll
        for (int j = 0; j < 8; ++j) { v[j].x = v[j].x == v[j].x && fabsf(v[j].x) < 1e30f ? v[j].x : 0.f; v[j].y = v[j].y == v[j].y && fabsf(v[j].y) < 1e30f ? v[j].y : 0.f; v[j].z = v[j].z == v[j].z && fabsf(v[j].z) < 1e30f ? v[j].z : 0.f; v[j].w = v[j].w == v[j].w && fabsf(v[j].w) < 1e30f ? v[j].w : 0.f; }
#endif
#pragma unroll
        for (int j = 0; j < 8; ++j) { const float q = (v[j].x * v[j].x + v[j].y * v[j].y) + (v[j].z * v[j].z + v[j].w * v[j].w); if (j < 4) s0 += q; else s1 += q; }
        const float r0 = rsqrtf(wave_sum(s0) * (1.f / 1024.f) + EPS), r1 = rsqrtf(wave_sum(s1) * (1.f / 1024.f) + EPS);
        f32x4* orow = (f32x4*)(C.out + (size_t)row * DM) + C.lane;
#pragma unroll
        for (int j = 0; j < 8; ++j) orow[64 * j] = v[j] * (j < 4 ? r0 : r1) * ((const f32x4*)g)[C.lane + 64 * (j & 3)];
    }
}
#ifndef MKP
#define MKP 0x1ffff
#endif
#ifndef ALEPI
#define ALEPI true
#endif
#ifndef ALEPI1
#define ALEPI1 ALEPI
#endif
#ifndef DUPK
#define DUPK 0
#endif
#ifdef PROBE_TIMER
#define PROBE_T0 __syncthreads(); const unsigned long long pt0_ = __builtin_amdgcn_s_memrealtime()
#define PROBE_T1(slot) __syncthreads(); if (threadIdx.x == 0) { const unsigned long long pt1_ = __builtin_amdgcn_s_memrealtime(); atomicAdd((unsigned*)(ws + WS_CTL) + CW_Q + 2048 + (slot), (unsigned)(pt1_ - pt0_)); }
#else
#define PROBE_T0
#define PROBE_T1(slot)
#endif
#define REP(bit) for (int rep_ = 0; rep_ < ((DUPK & (bit)) ? 2 : 1); ++rep_)
constexpr int PH_PER_CHUNK = 3, PH_LAYER_TAIL = 2;
constexpr int PH_L0 = 1, PH_FFN = PH_L0 + PH_PER_CHUNK * NCHUNK + PH_LAYER_TAIL, PH_L1 = PH_FFN + 2, PH_MOE = PH_L1 + PH_PER_CHUNK * NCHUNK + PH_LAYER_TAIL, PH_FINAL = PH_MOE + (MOE_NOSPLIT ? 5 : 7), PH_TOTAL = PH_FINAL + 1;

__global__ void __launch_bounds__(NTHREADS, 2) mega(Args args) {
    extern __shared__ __attribute__((aligned(16))) unsigned char lds_raw[];
#define MKCTX Ctx C; { int t_ = threadIdx.x; asm volatile("" : "+v"(t_)); C.lds = (LAS unsigned char*)lds_raw; C.tid = t_; C.lane = t_ & 63; C.wave = __builtin_amdgcn_readfirstlane(t_ >> 6); \
    C.G = gridDim.x; { const int bx = blockIdx.x; C.vcu = (C.G % 8 == 0) ? (bx % 8) * (C.G / 8) + bx / 8 : bx; } \
    C.gw = C.vcu * NWAVES + C.wave; C.NGW = C.G * NWAVES; C.in = args.in; C.out = args.out; C.ws = args.ws; }
    volatile LAS unsigned* MISC = (volatile LAS unsigned*)((LAS unsigned char*)lds_raw + MISC_OFF);
    if (threadIdx.x < 32) MISC[threadIdx.x] = 0u;
    __syncthreads();
    unsigned char* ws = args.ws;
    XcdBarrier bar; bar.bar = (unsigned*)(ws + WS_CTL) + CW_BAR; bar.x = 0; bar.st = nullptr;
    const int lo = args.ph_lo, hi = args.ph_hi;
    const bool use_bar = (hi - lo) > 1;
    if (use_bar) bar = xcd_barrier_post((unsigned*)(ws + WS_CTL) + CW_BAR, MISC + 8);
    int ph = 0;
#define IN_PH (ph >= lo && ph < hi)
#ifdef PROBE_BAR
    const unsigned long long pk0_ = __builtin_amdgcn_s_memrealtime();
#define END_PH do { if (ph >= lo && ph + 1 < hi) { __syncthreads(); const unsigned long long pb0_ = __builtin_amdgcn_s_memrealtime(); xcd_barrier(bar); \
        if (threadIdx.x == 0 && (((unsigned)(PROBE_BAR) >> ph) & 1u)) atomicAdd((unsigned*)(ws + WS_CTL) + CW_Q + 2048, (unsigned)(__builtin_amdgcn_s_memrealtime() - pb0_)); } ++ph; } while (0)
#else
#define END_PH do { if (ph >= lo && ph + 1 < hi) xcd_barrier(bar); ++ph; } while (0)
#endif

    bf16_t* xb = (bf16_t*)(ws + WS_XB); float* st = (float*)(ws + WS_ST);
    const float* cosT = (const float*)(ws + WS_TAB); const float* sinT = cosT + SEQ * 16;

    if (IN_PH) REP(1) { MKCTX; if (MKP & 1) phase_prologue(C); }
    END_PH;
#ifdef PROBE_SLEEP
    { const unsigned long long t0_ = __builtin_amdgcn_s_memrealtime(); while (__builtin_amdgcn_s_memrealtime() - t0_ < (unsigned long long)(PROBE_SLEEP) * 100ull) __builtin_amdgcn_s_sleep(64); }
#endif

#define CHUNK_BODY(l, c) \
{ \
            const int row0 = c * MC; \
            bf16_t* Z = (bf16_t*)(ws + WS_Z); bf16_t* Q = (bf16_t*)(ws + WS_Q); bf16_t* KV = TMP_IN_OUT ? (bf16_t*)args.out : (bf16_t*)(ws + WS_KV); bf16_t* Y = (bf16_t*)(ws + WS_Y) + (size_t)row0 * 1536; \
            bf16_t* PB = TMP_IN_OUT ? (bf16_t*)args.out + (size_t)MC * 1024 : (bf16_t*)(ws + WS_PB); float* PBS = (float*)(ws + WS_PBS); float* SQ = (float*)(ws + WS_SQ); float* SKV = SQ + (size_t)MC * 4; \
 \
            if (IN_PH && (MKP & 2)) REP(2) { MKCTX; \
                pg8::Gemm g{xb + (size_t)row0 * DM, (const bf16_t*)(ws + WS_WIN + l * SZ_WIN), DM, DM, DM, nullptr}; \
                pg8::StaticOrder S; S.init(MC, P1_F8_FROM * 256, C.G, (int)blockIdx.x); \
                pg8::EpiIn E{Z, st + (size_t)row0 * 16, SQ, SKV, cosT, sinT, ws + WS_GB + (size_t)row0 * 3072, (bf16_t*)(ws + WS_QKV), ws, 0, 1.f}; \
                pg8::gemm_phase<pg8::EpiIn, pg8::StaticOrder, ALEPI1, false>(C.lds, g, S, E); \
            } \
            if (IN_PH && (MKP & 2) && P1_F8_FROM < 23) REP(2) { MKCTX;                          \
                pg8::Gemm g{(const bf16_t*)(ws + WS_XB8P + (size_t)row0 * DM), (const bf16_t*)(ws + WS_WIN8 + l * SZ_WIN8), DM / 2, DM / 2, DM / 2, nullptr}; \
                pg8::StaticOrder S; S.init(MC, (23 - P1_F8_FROM) * 256, C.G, (int)((blockIdx.x + (P1_F8_FROM * (MC / 256)) % 256) % C.G)); \
                pg8::EpiIn E{Z, st + (size_t)row0 * 16, SQ, SKV, cosT, sinT, ws + WS_GB + (size_t)row0 * 3072, (bf16_t*)(ws + WS_QKV), ws, P1_F8_FROM, 1.f / 4096.f}; \
                pg8::gemm_phase<pg8::EpiIn, pg8::StaticOrder, ALEPI1, false, false, true>(C.lds, g, S, E); \
            } \
            END_PH; \
 \
            if (IN_PH) { \
                if (MKP & 4) REP(4) { MKCTX; pg8::Gemm g{Z + ZO_CQ, (const bf16_t*)(ws + WS_WUQ + l * SZ_WUQ), 256, ZW, 256, nullptr}; \
                  pg8::StaticOrder S; S.init(MC, 768, C.G, (int)blockIdx.x); \
                  pg8::EpiQ E{Q, SQ, cosT, sinT}; \
                  pg8::gemm_phase<pg8::EpiQ, pg8::StaticOrder, ALEPI, false>(C.lds, g, S, E); } \
                if (MKP & 8) REP(8) { MKCTX; pg8::Gemm g{Z + ZO_CKV, (const bf16_t*)(ws + WS_WUKV + l * SZ_WUKV), 256, ZW, 256, nullptr}; \
                  pg8::StaticOrder S; S.init(MC, 1024, C.G, (int)((blockIdx.x + 128) % C.G)); \
                  pg8::EpiKV E{KV, SKV}; \
                  pg8::gemm_phase<pg8::EpiKV, pg8::StaticOrder, ALEPI, false>(C.lds, g, S, E); } \
                if (MKP & 16) REP(16) { MKCTX; phase_band<false>(C, (const bf16_t*)(ws + WS_QKV), PB, PBS, Y, C.in[7] + l * 8); } \
            } \
            END_PH; \
 \
            if (IN_PH) { \
                if (MKP & 32) REP(32) { MKCTX; phase_band<true>(C, (const bf16_t*)(ws + WS_QKV), PB, PBS, Y, C.in[7] + l * 8); } \
                if (MKP & 64) REP(64) { MKCTX; PROBE_T0; phase_mla(C, Q, KV, Z, Y); PROBE_T1(rep_); } \
            } \
            END_PH; \
 \
}
#define LAYER_TAIL(l) \
{ const int row0 = 0; bf16_t* MG = (bf16_t*)(ws + WS_MG); bf16_t* Y = (bf16_t*)(ws + WS_Y); (void)Y; \
            if (IN_PH && (MKP & 128)) REP(128) { MKCTX; \
                pg8::Gemm g{Y, (const bf16_t*)(ws + WS_WBR + l * SZ_WBR), 1536, 1536, 1536, nullptr}; \
                pg8::StaticOrder S; S.init(MTOK, DM, C.G, (int)blockIdx.x); \
                pg8::EpiBr E{ws + WS_GB, MG, ws}; \
                pg8::gemm_phase<pg8::EpiBr, pg8::StaticOrder, ALEPI, false>(C.lds, g, S, E); \
            } \
            END_PH; \
 \
            if (IN_PH && (MKP & 256)) REP(l == 0 ? 256 : 0) { MKCTX; \
                pg8::Gemm g{MG, (const bf16_t*)(ws + WS_WOUT + l * SZ_WOUT), DM, DM, DM, nullptr}; \
                pg8::StaticOrder S; S.init(MTOK, DM, C.G, (int)blockIdx.x); \
                pg8::EpiRes<false> E{xb, st, row0, nullptr}; pg8::gemm_phase<pg8::EpiRes<false>, pg8::StaticOrder, ALEPI, false, true>(C.lds, g, S, E); \
            } \
            END_PH; \
}
#define FFN_BODY() \
{ \
            bf16_t* ACT = (bf16_t*)(ws + WS_ACT); \
            if (IN_PH && (MKP & 512)) REP(512) { MKCTX; \
                pg8::Gemm g{xb, (const bf16_t*)(ws + WS_WGU), DM, DM, DM, nullptr}; \
                pg8::StaticOrder S; S.init(MTOK, 2 * DFF, C.G, (int)blockIdx.x); \
                pg8::EpiGU E{ACT, st, DFF, ws}; \
                pg8::gemm_phase<pg8::EpiGU, pg8::StaticOrder, ALEPI, false>(C.lds, g, S, E); \
            } \
            END_PH; \
            if (IN_PH && (MKP & 1024)) { MKCTX; \
                pg8::Gemm g{ACT, (const bf16_t*)(ws + WS_WD), DFF, DFF, DFF, nullptr}; \
                pg8::StaticOrder S; S.init(MTOK, DM, C.G, (int)blockIdx.x); \
                pg8::EpiRes<(P1_F8_FROM < 23)> E{xb, st, 0, ws + WS_XB8P};                                \
                pg8::gemm_phase<pg8::EpiRes<(P1_F8_FROM < 23)>, pg8::StaticOrder, ALEPI, false, true>(C.lds, g, S, E); \
            } \
            END_PH; \
}
#define MOE_HEAD() \
{ \
            if (IN_PH) { if (MKP & 2048) REP(2048) { MKCTX; phase_route(C); } if (MKP & 4096) REP(4096) { MKCTX; phase_moe_weights(C); } } \
            END_PH; \
            if (IN_PH && (MKP & 8192)) { MKCTX; phase_sort(C); } \
            END_PH; \
}
#define MOE_GU(kh, dyn) { const int k = MOE_NOSPLIT ? (kh) : (kh) >> 1, half = MOE_NOSPLIT ? 0 : (kh) & 1; MKCTX; \
        const int* rowtok = (const int*)(ws + WS_ROWTOK) + k * MOE_ROWS; \
        bf16_t* MACT = (bf16_t*)(ws + WS_MACT + (MOE_NOSPLIT ? (size_t)k * MOE_ROWS * DFE : (size_t)half * MOE_ROWS * DF0 * (MOE_DN_F8 ? 1 : 2))); const int dfw = MOE_NOSPLIT ? DFE : (half ? DF1 : DF0); \
        pg8::Gemm g{MOE_F8 ? (const bf16_t*)(ws + WS_XB8) : xb, (const bf16_t*)(ws + WS_EGU), MOE_F8 ? DM / 2 : DM, MOE_F8 ? DM / 2 : DM, MOE_F8 ? DM / 2 : DM, rowtok}; \
        pg8::DynMoeOrder S{(unsigned*)(ws + WS_CTL) + CW_Q + 64 * (kh), (volatile LAS int*)(C.lds + MISC_OFF + 64), meta[MI_NTILE + k], dfw / 128, 28, half ? DF0 / 128 : 0, meta + MI_TILEE + k * 160, C.vcu}; \
        pg8::EpiGUMoe E{MACT, (const float*)(ws + WS_ROWRR) + k * MOE_ROWS, dfw, ws}; \
        pg8::gemm_phase<pg8::EpiGUMoe, pg8::DynMoeOrder, ALEPI, true, false, MOE_F8 != 0>(C.lds, g, S, E); }
#define MOE_DN(kh) { const int k = MOE_NOSPLIT ? (kh) : (kh) >> 1, half = MOE_NOSPLIT ? 0 : (kh) & 1; MKCTX; \
        const int* rowtok = (const int*)(ws + WS_ROWTOK) + k * MOE_ROWS; const float* rowgw = (const float*)(ws + WS_ROWGW) + k * MOE_ROWS; \
        bf16_t* MACT = (bf16_t*)(ws + WS_MACT + (MOE_NOSPLIT ? (size_t)k * MOE_ROWS * DFE : (size_t)half * MOE_ROWS * DF0 * (MOE_DN_F8 ? 1 : 2))); const int dfw = MOE_NOSPLIT ? DFE : (half ? DF1 : DF0); \
        pg8::Gemm g{MACT, (const bf16_t*)(ws + WS_ED + (size_t)half * DF0 * (MOE_DN_F8 ? 1 : 2)), MOE_DN_F8 ? dfw / 2 : dfw, MOE_DN_F8 ? dfw / 2 : dfw, MOE_DN_F8 ? DFE / 2 : DFE, nullptr}; \
        pg8::MoeOrder S{meta[MI_NTILE + k], 4, C.G, (int)blockIdx.x, 4, 0, meta + MI_TILEE + k * 160}; \
        if ((kh) == 0) { pg8::EpiDnMoe<true> E{ws, rowtok, rowgw}; pg8::gemm_phase<pg8::EpiDnMoe<true>, pg8::MoeOrder, ALEPI, false, true, MOE_DN_F8 != 0>(C.lds, g, S, E); } \
        else { pg8::EpiDnMoe<false> E{ws, rowtok, rowgw}; pg8::gemm_phase<pg8::EpiDnMoe<false>, pg8::MoeOrder, ALEPI, false, true, MOE_DN_F8 != 0>(C.lds, g, S, E); } }
    CHUNK_BODY(0, 0)
#if CHB < 16
    CHUNK_BODY(0, 1)
#endif
#if CHB < 8
    CHUNK_BODY(0, 2)
    CHUNK_BODY(0, 3)
#endif
    LAYER_TAIL(0)
    FFN_BODY()
    CHUNK_BODY(1, 0)
#if CHB < 16
    CHUNK_BODY(1, 1)
#endif
#if CHB < 8
    CHUNK_BODY(1, 2)
    CHUNK_BODY(1, 3)
#endif
    LAYER_TAIL(1)
    MOE_HEAD()
    { const int* meta = (const int*)(ws + WS_META);
    if (IN_PH) { if (MKP & 16384) REP(16384) MOE_GU(0, 1) }
    END_PH;
    if (IN_PH) { if (MKP & 32768) MOE_DN(0) if (MKP & 16384) MOE_GU(1, 1) }
    END_PH;
#if !MOE_NOSPLIT
    if (IN_PH) { if (MKP & 32768) MOE_DN(1) if (MKP & 16384) MOE_GU(2, 1) }
    END_PH;
    if (IN_PH) { if (MKP & 32768) MOE_DN(2) if (MKP & 16384) MOE_GU(3, 1) }
    END_PH;
    if (IN_PH) { if (MKP & 32768) MOE_DN(3) }
    END_PH;
#else
    if (IN_PH) { if (MKP & 32768) MOE_DN(1) }
    END_PH;
#endif
    }
    if (IN_PH && (MKP & 65536)) { MKCTX; phase_final(C); }
    END_PH;
#ifdef PROBE_BAR
    { if (threadIdx.x == 0) atomicAdd((unsigned*)(ws + WS_CTL) + CW_Q + 2049, (unsigned)(__builtin_amdgcn_s_memrealtime() - pk0_));
      xcd_barrier(bar);
      const unsigned* tim = (const unsigned*)(ws + WS_CTL) + CW_Q + 2048;
      const float ta = (float)__hip_atomic_load(tim, __ATOMIC_RELAXED, __HIP_MEMORY_SCOPE_AGENT), tb = (float)__hip_atomic_load(tim + 1, __ATOMIC_RELAXED, __HIP_MEMORY_SCOPE_AGENT);
      float code = (float)(PROBE_UNIT) * ta / tb;
      code = fminf(98.f, fmaxf(1.f, rintf(code))); const float v = sqrtf(code);
      for (size_t i = (size_t)blockIdx.x * NTHREADS + threadIdx.x; i < (size_t)MTOK * DM; i += (size_t)gridDim.x * NTHREADS) args.out[i] = v; }
#endif
#ifdef PROBE_TIMER
    { xcd_barrier(bar);
      const unsigned* tim = (const unsigned*)(ws + WS_CTL) + CW_Q + 2048;
      const float ta = (float)__hip_atomic_load(tim, __ATOMIC_RELAXED, __HIP_MEMORY_SCOPE_AGENT), tb = (float)__hip_atomic_load(tim + 1, __ATOMIC_RELAXED, __HIP_MEMORY_SCOPE_AGENT);
      float code = PROBE_TIMER == 1 ? 10.f * ta / tb : (PROBE_TIMER == 2 ? ta * (1.f / (256.f * 100.f * 10.f)) : tb * (1.f / (256.f * 100.f * 10.f)));
      code = fminf(98.f, fmaxf(1.f, rintf(code))); const float v = sqrtf(code);
      for (size_t i = (size_t)blockIdx.x * NTHREADS + threadIdx.x; i < (size_t)MTOK * DM; i += (size_t)gridDim.x * NTHREADS) args.out[i] = v; }
#endif
#undef IN_PH
#undef END_PH
}
#if !MK_DEBUG
extern "C" void kernel_launch(void* const* d_in, const int* in_sizes, int n_in, void* d_out, int out_size, void* d_ws, size_t ws_size, hipStream_t stream) {
    static int grid = 0;
    if (grid == 0) {
        if (n_in != 22 || out_size != MTOK * DM || ws_size < WS_NEED) { fprintf(stderr, "kernel_launch: unexpected shapes / workspace (%zu < %zu); nothing launched\n", ws_size, (size_t)WS_NEED); grid = -1; return; }
        int dev = 0, cus = 0, per_cu = 0;
        if (hipGetDevice(&dev) != hipSuccess || hipDeviceGetAttribute(&cus, hipDeviceAttributeMultiprocessorCount, dev) != hipSuccess) { grid = -1; return; }
        if (hipFuncSetAttribute((const void*)mega, hipFuncAttributeMaxDynamicSharedMemorySize, LDS_BYTES) != hipSuccess) { fprintf(stderr, "kernel_launch: hipFuncSetAttribute failed\n"); grid = -1; return; }
        if (hipOccupancyMaxActiveBlocksPerMultiprocessor(&per_cu, (const void*)mega, NTHREADS, LDS_BYTES) != hipSuccess || per_cu < 1) { fprintf(stderr, "kernel_launch: occupancy query says %d\n", per_cu); }
        (void)hipGetLastError();
        grid = cus;
        if (grid != 256) { fprintf(stderr, "kernel_launch: built for 256 CUs, device has %d; nothing launched\n", cus); grid = -1; return; }
    }
    if (grid < 0) return;
    if (hipMemsetAsync((char*)d_ws + WS_CTL, 0, CTL_ZERO_BYTES, stream) != hipSuccess) return;
    Args a{};
    for (int i = 0; i < 22; ++i) a.in[i] = (const float*)d_in[i];
    a.out = (float*)d_out; a.ws = (unsigned char*)d_ws; a.ph_lo = 0; a.ph_hi = PH_TOTAL;
    hipLaunchKernelGGL(mega, dim3(grid), dim3(NTHREADS), LDS_BYTES, stream, a);
}
#endif
```

```cpp
#include <hip/hip_runtime.h>
#include <cstdio>
#include <cstdint>
#include <cmath>

#ifndef MK_DEBUG
#define MK_DEBUG 0
#endif
#ifndef MOE_F8
#define MOE_F8 1
#endif
#ifndef MOE_DN_F8
#define MOE_DN_F8 1
#endif
#ifndef MOE_NOSPLIT
#define MOE_NOSPLIT 1
#endif
#ifndef P1_F8_FROM
#define P1_F8_FROM 0
#endif
#ifndef CHB
#define CHB 8
#endif

#define GAS __attribute__((address_space(1)))
#define LAS __attribute__((address_space(3)))
typedef unsigned short bf16_t;
typedef short bf16x8 __attribute__((ext_vector_type(8)));
typedef short s16x4 __attribute__((ext_vector_type(4)));
typedef float f32x4 __attribute__((ext_vector_type(4)));
typedef float f32x2 __attribute__((ext_vector_type(2)));
typedef float f32x16 __attribute__((ext_vector_type(16)));
typedef unsigned u32x4 __attribute__((ext_vector_type(4)));
typedef unsigned u32x2 __attribute__((ext_vector_type(2)));
typedef __bf16 bf16x2_t __attribute__((ext_vector_type(2)));

constexpr int SEQ = 2048, DM = 1024, NBATCH = 16, MTOK = NBATCH * SEQ;
constexpr int MC = CHB * SEQ, NCHUNK = NBATCH / CHB;
constexpr int INC = 5792, ZW = 512, ZN = 5888;
constexpr int ZO_CQ = 0, ZO_CKV = 256, ZO_KPE = 384, ZO_QB = 512, ZO_KB = 1024, ZO_VB = 1536, ZO_QC = 2048, ZO_KC = 2560, ZO_VC = 2688, ZO_G = 2816;
constexpr int DFF = 2816, DFE = 3584, NEXP = 8;
constexpr int DF0 = 1792, DF1 = DFE - DF0;
constexpr float EPS = 1e-6f, LOG2E = 1.4426950408889634f;
constexpr float NEGB = -1e30f;
constexpr int MOE_ROWS = MTOK + NEXP * 256;

constexpr size_t MiB = 1u << 20;
constexpr size_t WS_CTL = 0, CTL_ZERO_BYTES = 256 * 1024;
constexpr size_t WS_META = 256 * 1024;
constexpr size_t WS_TAB = 1 * MiB;
constexpr size_t WS_WIN = 2 * MiB;
constexpr size_t SZ_WIN = (size_t)ZN * DM * 2;
constexpr size_t WS_WUQ = WS_WIN + 2 * SZ_WIN;
constexpr size_t SZ_WUQ = (size_t)768 * 256 * 2;
constexpr size_t WS_WUKV = WS_WUQ + 2 * SZ_WUQ;
constexpr size_t SZ_WUKV = (size_t)1024 * 256 * 2;
constexpr size_t WS_WBR = WS_WUKV + 2 * SZ_WUKV;
constexpr size_t SZ_WBR = (size_t)1024 * 1536 * 2;
constexpr size_t WS_WOUT = WS_WBR + 2 * SZ_WBR;
constexpr size_t SZ_WOUT = (size_t)1024 * 1024 * 2;
constexpr size_t WS_WGU = WS_WOUT + 2 * SZ_WOUT;
constexpr size_t WS_WD = WS_WGU + (size_t)2 * DFF * DM * 2;
constexpr size_t WS_SMALL_END = WS_WD + (size_t)DM * DFF * 2;
static_assert(WS_SMALL_END <= 54 * MiB, "small weights");
constexpr size_t WS_XB = 54 * MiB;
constexpr size_t WS_ST = 118 * MiB;
constexpr size_t WS_RR = 120 * MiB;
constexpr size_t WS_SEL = WS_RR + (size_t)MTOK * 4;
constexpr size_t WS_GW = WS_SEL + (size_t)MTOK * 8;
constexpr size_t WS_ROWTOK = WS_GW + (size_t)MTOK * 8;
constexpr size_t WS_ROWGW = WS_ROWTOK + (size_t)2 * MOE_ROWS * 4;
constexpr size_t WS_ROWRR = WS_ROWGW + (size_t)2 * MOE_ROWS * 4;
constexpr size_t WS_T = 122 * MiB;
static_assert(WS_ROWRR + (size_t)2 * MOE_ROWS * 4 <= WS_T, "fixed region");
constexpr size_t WS_GB = WS_T;
constexpr size_t WS_Y = WS_GB + (size_t)MTOK * 3072;
constexpr size_t WS_CH = WS_Y + (size_t)MTOK * 1536 * 2;
constexpr size_t WS_Z = WS_CH;
constexpr size_t WS_QKV = WS_Z + (size_t)MC * ZW * 2;
constexpr size_t SZ_H8 = (size_t)MC * 512 * 2, SZ_H2 = (size_t)MC * 128 * 2;
constexpr size_t WS_Q = WS_QKV + 4 * SZ_H8 + 2 * SZ_H2;
constexpr bool TMP_IN_OUT = (CHB == 16);
constexpr size_t WS_KV = WS_Q + (size_t)MC * 768 * 2;
constexpr size_t WS_PB = WS_KV + (TMP_IN_OUT ? 0 : (size_t)MC * 1024 * 2);
constexpr size_t WS_PBS = WS_PB + (TMP_IN_OUT ? 0 : (size_t)2 * MC * 512 * 2);
constexpr size_t WS_SQ = WS_PBS + (size_t)2 * MC * 16 * 4;
constexpr size_t WS_MIX_END = WS_SQ + (size_t)2 * MC * 4 * 4;
constexpr size_t WS_XB8P = (size_t)496 * MiB;
constexpr size_t WS_WIN8 = WS_XB8P + (size_t)MTOK * DM;
constexpr size_t SZ_WIN8 = (size_t)(23 - P1_F8_FROM) * 256 * DM;
static_assert(WS_XB8P >= WS_MIX_END && WS_WIN8 + 2 * SZ_WIN8 <= (size_t)564 * MiB, "fp8 input-projection buffers");
constexpr size_t WS_MG = WS_CH;
static_assert(WS_MG + (size_t)MTOK * 1024 * 2 <= (size_t)564 * MiB, "MG placement");
constexpr size_t WS_ACT = WS_T;
constexpr size_t WS_EGU = WS_T;
constexpr size_t WS_XB8 = WS_EGU + (size_t)NEXP * 2 * DFE * DM;
constexpr size_t WS_ED = WS_EGU + (size_t)NEXP * 2 * DFE * DM * 2;
constexpr size_t WS_MACT = WS_ED + (size_t)NEXP * DM * DFE * 2;
constexpr size_t WS_MOE_END = WS_MACT + (size_t)MOE_ROWS * DFE * 2;
constexpr size_t WS_NEED_ = (WS_MOE_END > WS_MIX_END ? WS_MOE_END : WS_MIX_END);
constexpr size_t WS_NEED = WS_MOE_END + (size_t)(MTOK - 26624) * DM * 2 > WS_NEED_ ? WS_MOE_END + (size_t)(MTOK - 26624) * DM * 2 : WS_NEED_;
static_assert(WS_NEED <= (size_t)564 * MiB, "workspace budget");

constexpr int XM_SPLIT = 26624;
constexpr size_t WS_XM_HI = WS_MOE_END;
static_assert((size_t)XM_SPLIT * DM * 2 <= WS_XB - WS_WIN && WS_XM_HI + (size_t)(MTOK - XM_SPLIT) * DM * 2 <= (size_t)564 * MiB, "XM placement");
__device__ __forceinline__ bf16_t* xm_row(unsigned char* ws, int tok) { return tok < XM_SPLIT ? (bf16_t*)(ws + WS_WIN) + (size_t)tok * DM : (bf16_t*)(ws + WS_XM_HI) + (size_t)(tok - XM_SPLIT) * DM; }

constexpr int CW_BAR = 4096, CW_Q = 8192;
constexpr int MI_CNT = 0, MI_NTILE = 4120, MI_TILEE = 4128;

__device__ __forceinline__ unsigned cvt_pk_bf16(float lo, float hi) { f32x2 v = {lo, hi}; bf16x2_t b = __builtin_convertvector(v, bf16x2_t); return __builtin_bit_cast(unsigned, b); }
__device__ __forceinline__ unsigned pk_fp8x4(float a, float b, float c, float d) {
    a = __builtin_fminf(__builtin_fmaxf(a, -448.f), 448.f); b = __builtin_fminf(__builtin_fmaxf(b, -448.f), 448.f); c = __builtin_fminf(__builtin_fmaxf(c, -448.f), 448.f); d = __builtin_fminf(__builtin_fmaxf(d, -448.f), 448.f);
    int w = 0; w = __builtin_amdgcn_cvt_pk_fp8_f32(a, b, w, false); w = __builtin_amdgcn_cvt_pk_fp8_f32(c, d, w, true); return (unsigned)w; }
__device__ __forceinline__ float bf_lo(unsigned w) { return __builtin_bit_cast(float, w << 16); }
__device__ __forceinline__ float bf_hi(unsigned w) { return __builtin_bit_cast(float, w & 0xffff0000u); }
template <int O> __device__ __forceinline__ float swz_xor(float v) { return __builtin_bit_cast(float, __builtin_amdgcn_ds_swizzle(__builtin_bit_cast(int, v), (O << 10) | 0x1f)); }
__device__ __forceinline__ void swap32(float& a, float& b) { asm volatile("s_nop 1\n\tv_permlane32_swap_b32 %0, %1\n\ts_nop 1" : "+v"(a), "+v"(b)); }
__device__ __forceinline__ float xsum32(float v) { float a = v, b = v; swap32(a, b); return a + b; }
__device__ __forceinline__ float xmax32(float v) { float a = v, b = v; swap32(a, b); return fmaxf(a, b); }
__device__ __forceinline__ float wave_sum(float v) {
    v += swz_xor<1>(v); v += swz_xor<2>(v); v += swz_xor<4>(v); v += swz_xor<8>(v); v += swz_xor<16>(v);
    return xsum32(v);
}
__device__ __forceinline__ float fast_rcp(float x) { return __builtin_amdgcn_rcpf(x); }
__device__ __forceinline__ float fast_exp2(float x) { return __builtin_amdgcn_exp2f(x); }
__device__ __forceinline__ float sigmoidf_(float v) { return fast_rcp(1.f + fast_exp2(-v * LOG2E)); }
__device__ __forceinline__ int t5_bucket(int rel) {
    const int ret = rel > 0 ? 16 : 0; const int n = rel < 0 ? -rel : rel;
    if (n < 8) return ret + n;
    int large = 8 + (int)(logf((float)n / 8.f) / logf(128.f) * 8.f);
    if (large > 15) large = 15;
    return ret + large;
}

#define XB_TMO      128
#define XB_XCNT(j)  (256  + 64 * (j))
#define XB_XSUB(j)  (1280 + 64 * (j))
#define XB_XGEN(j)  (2304 + 64 * (j))
#define XB_TOP      3328
#define XB_TOPGEN   3392
#define XCD_BAR_WORDS 3456
#define XB_SPIN_CAP (1u << 18)
__device__ __forceinline__ unsigned xb_ld(unsigned* p)              { return __hip_atomic_load(p, __ATOMIC_RELAXED, __HIP_MEMORY_SCOPE_AGENT); }
__device__ __forceinline__ unsigned xb_add(unsigned* p, unsigned v) { return __hip_atomic_fetch_add(p, v, __ATOMIC_RELAXED, __HIP_MEMORY_SCOPE_AGENT); }
__device__ __forceinline__ unsigned xb_xcc_id() { return (unsigned)__builtin_amdgcn_s_getreg((3 << 11) | 20) & 0xFu; }
#define XB_SPIN(cond, bar) do { unsigned _sp = 0; while (cond) { __builtin_amdgcn_s_sleep(1); \
    if ((++_sp & 255u) == 0u) { if (xb_ld(&(bar)[XB_TMO])) break; if (_sp > XB_SPIN_CAP) { atomicAdd(&(bar)[XB_TMO], 1u); break; } } } } while (0)
struct XcdBarrier { unsigned* bar; unsigned x; volatile LAS unsigned* st; };
__device__ __forceinline__ XcdBarrier xcd_barrier_post(unsigned* bar, volatile LAS unsigned* st) {
    XcdBarrier b; b.bar = bar; b.x = xb_xcc_id(); b.st = st;
    if (threadIdx.x == 0) (void)xb_add(&bar[XB_XCNT(b.x)], 1u);
    return b;
}
__device__ __forceinline__ void xcd_barrier_complete(unsigned* bar, unsigned x, unsigned& nloc, unsigned& nx) {
    const unsigned G = gridDim.x * gridDim.y * gridDim.z;
    unsigned sum, cnt, mine, sp = 0u;
    for (;;) {
        sum = 0u; cnt = 0u; mine = 0u;
#pragma unroll
        for (unsigned j = 0; j < 16; ++j) { const unsigned c = xb_ld(&bar[XB_XCNT(j)]); sum += c; cnt += (c > 0u) ? 1u : 0u; mine = (j == x) ? c : mine; }
        if (sum == G) break;
        __builtin_amdgcn_s_sleep(1);
        if ((++sp & 255u) == 0u) { if (xb_ld(&bar[XB_TMO])) break; if (sp > XB_SPIN_CAP) { atomicAdd(&bar[XB_TMO], 1u); break; } }
    }
    nloc = mine > 0u ? mine : 1u; nx = cnt > 0u ? cnt : 1u;
}
__device__ __forceinline__ void xcd_barrier(const XcdBarrier& b) {
    asm volatile("s_waitcnt vmcnt(0)" ::: "memory");
    __syncthreads();
    if (threadIdx.x == 0) {
        unsigned* bar = b.bar;
        __builtin_amdgcn_s_waitcnt(0);
        unsigned nloc = b.st[0], nx = b.st[1];
        if (nloc == 0u) { xcd_barrier_complete(bar, b.x, nloc, nx); b.st[0] = nloc; b.st[1] = nx; }
        const unsigned old = xb_add(&bar[XB_XSUB(b.x)], 1u);
        const unsigned gen = old / nloc;
        if (old + 1u == (gen + 1u) * nloc) {
            __builtin_amdgcn_fence(__ATOMIC_RELEASE, "agent");
            asm volatile("s_waitcnt vmcnt(0)" ::: "memory");
            const unsigned og = xb_add(&bar[XB_TOP], 1u);
            const unsigned tg = og / nx;
            if (og + 1u == (tg + 1u) * nx) xb_add(&bar[XB_TOPGEN], 1u);
            else XB_SPIN(xb_ld(&bar[XB_TOPGEN]) == tg, bar);
            __builtin_amdgcn_fence(__ATOMIC_ACQUIRE, "agent");
            xb_add(&bar[XB_XGEN(b.x)], 1u);
            asm volatile("s_waitcnt vmcnt(0)" ::: "memory");
        } else {
            XB_SPIN(xb_ld(&bar[XB_XGEN(b.x)]) == gen, bar);
            __builtin_amdgcn_fence(__ATOMIC_ACQUIRE, "agent");
            asm volatile("s_waitcnt vmcnt(0)" ::: "memory");
        }
    }
    __syncthreads();
}
#ifndef MOE_RGS
#define MOE_RGS 4
#endif
#ifndef MOE_RG
#define MOE_RG 4
#endif
#ifndef RELAXW
#define RELAXW 0
#endif
namespace pg8 {
constexpr int BM = 256, BK = 64, HALF = 128, HTB = HALF * BK * 2, STAGE_BYTES = 8 * HTB, NXCD = 8, WGM = 8;
__host__ __device__ __forceinline__ int lds_byte(int r, int c) { const int st = (r >> 4) * 2 + (c >> 5), rr = r & 15, cc = c & 31, ob = rr * 64 + cc * 2; return st * 1024 + (ob ^ (((ob >> 9) & 1) << 5)); }
__host__ __device__ __forceinline__ void stage_rc(int b, int& R, int& C) { const int st = b / 1024, sb = b % 1024, swz = sb ^ (((sb >> 9) & 1) << 5); R = (st >> 1) * 16 + swz / 64; C = (st & 1) * 32 + (swz % 64) / 2; }
__host__ __device__ __forceinline__ int perm32(int rho) { const int n = rho >> 4, i = rho & 15; return 8 * (i >> 2) + 4 * n + (i & 3); }

struct Unit { int pm, pn, aux; };
struct Gemm { const bf16_t* A; const bf16_t* Bt; int K, lda, ldb; const int* gidx; };

struct StaticOrder {
    static constexpr bool DYN = false;
    int nM, nN, nwg, G, c;
    __host__ __device__ void init(int M, int N, int G_, int c_) { nM = M / BM; nN = N / BM; nwg = nM * nN; G = G_; c = c_; }
    __host__ __device__ bool next(int i, Unit& u) const {
        const int L = i * G + c; if (L >= nwg) return false;
        int wgid = L; { const int q = nwg / NXCD, r = nwg % NXCD, xcd = wgid % NXCD, off = wgid / NXCD; wgid = (xcd < r ? xcd * (q + 1) : r * (q + 1) + (xcd - r) * q) + off; }
        const int nig = WGM * nN, gid = wgid / nig, fm = gid * WGM, gsz = (nM - fm) < WGM ? (nM - fm) : WGM;
        u.pm = fm + ((wgid % nig) % gsz); u.pn = (wgid % nig) / gsz; u.aux = u.pn; return true;
    }
};
struct MoeOrder {
    static constexpr bool DYN = false;
    int ntile, nN, G, c, pne, pn0; const int* tile_e;
    __device__ bool next(int i, Unit& u) const {
        const int L = i * G + c; if (L >= ntile * nN) return false;
        int pm, pnl; { const int grp = L / (MOE_RGS * nN), fm = grp * MOE_RGS, gsz = (ntile - fm) < MOE_RGS ? (ntile - fm) : MOE_RGS, r = L - grp * (MOE_RGS * nN); pm = fm + r % gsz; pnl = r / gsz; }
        u.pm = pm; u.aux = pnl; u.pn = tile_e[pm] * pne + pn0 + pnl; return true;
    }
};

struct DynMoeOrder {
    static constexpr bool DYN = true;
    unsigned* ctr; volatile LAS int* slot; int ntile, nN, pne, pn0; const int* tile_e; int vcu;
    __device__ __forceinline__ void begin() const {
        if (threadIdx.x == 0) { slot[0] = vcu; slot[1] = vcu + (int)gridDim.x; }
        __syncthreads();
    }
    __device__ __forceinline__ bool next(int i, Unit& u) const {
        const int L = __builtin_amdgcn_readfirstlane(slot[i & 1]); if (L >= ntile * nN) return false;
        int pm, pnl; { const int grp = L / (MOE_RG * nN), fm = grp * MOE_RG, gsz = (ntile - fm) < MOE_RG ? (ntile - fm) : MOE_RG, r = L - grp * (MOE_RG * nN); pm = fm + r % gsz; pnl = r / gsz; }
        u.pm = pm; u.aux = pnl; u.pn = tile_e[pm] * pne + pn0 + pnl; return true;
    }
    __device__ __forceinline__ unsigned claim_issue() const { unsigned v = 0u; if (threadIdx.x == 0) v = 2u * gridDim.x + __hip_atomic_fetch_add(ctr, 1u, __ATOMIC_RELAXED, __HIP_MEMORY_SCOPE_AGENT); return v; }
    __device__ __forceinline__ void claim_commit(unsigned v, int i) const { if (threadIdx.x == 0) { slot[i & 1] = (int)v; asm volatile("s_waitcnt lgkmcnt(0)" ::: "memory"); } }
};

__host__ __device__ __forceinline__ size_t blk_off(int row, int col, int ld) { return ((size_t)(row >> 4) * (ld >> 5) + (col >> 5)) * 512 + (row & 15) * 32 + (col & 31); }
typedef int i32x4_t __attribute__((ext_vector_type(4))); typedef int i32x8_t __attribute__((ext_vector_type(8)));
template <bool F8> struct FragSel;
template <> struct FragSel<false> {
    struct P { bf16x8 k[2]; }; typedef P A[4]; typedef P B[2];
    static __device__ __forceinline__ void set(P& d, const i32x4_t& f0, const i32x4_t& f1) { d.k[0] = __builtin_bit_cast(bf16x8, f0); d.k[1] = __builtin_bit_cast(bf16x8, f1); }
    static __device__ __forceinline__ void mma(f32x4& c, const P& b, const P& a) { c = __builtin_amdgcn_mfma_f32_16x16x32_bf16(b.k[0], a.k[0], c, 0, 0, 0); c = __builtin_amdgcn_mfma_f32_16x16x32_bf16(b.k[1], a.k[1], c, 0, 0, 0); }
    static __device__ __forceinline__ void after_mma() {}
};
template <> struct FragSel<true> {
    typedef i32x8_t P; typedef P A[4]; typedef P B[2];
    static __device__ __forceinline__ void set(P& d, const i32x4_t& f0, const i32x4_t& f1) { d = __builtin_shufflevector(f0, f1, 0, 1, 2, 3, 4, 5, 6, 7); }
    static __device__ __forceinline__ void mma(f32x4& c, const P& b, const P& a) { int sc = 0x7f7f7f7f; asm volatile("v_mfma_scale_f32_16x16x128_f8f6f4 %0, %1, %2, %0, %3, %3 op_sel_hi:[0,0,0]" : "+v"(c) : "v"(b), "v"(a), "v"(sc)); }
    static __device__ __forceinline__ void after_mma() { asm volatile("s_nop 15\n\ts_nop 15" ::: "memory"); }
};
template <class Epi, class Sched, bool ALIGN_EPI, bool GATHER, bool ABLK = false, bool F8 = false>
__device__ __forceinline__ void gemm_phase(LAS unsigned char* lds, const Gemm g, const Sched& S, const Epi& E) {
    int tid_ = threadIdx.x; asm volatile("" : "+v"(tid_));
    const int tid = tid_, wid = __builtin_amdgcn_readfirstlane(tid >> 6), lane = tid & 63, wr = wid >> 2, wc = wid & 3, fr = lane & 15, fq = lane >> 4;
    int K_ = g.K; asm volatile("" : "+s"(K_));
    const int K = K_, nt = K / BK;
    static_assert(!(GATHER && ABLK), "gathered A is row-major");
    const size_t kstep = (size_t)(BK * 2), kstepA = ABLK ? (size_t)2048 : kstep;
    const size_t hstepA = ABLK ? (size_t)8 * (g.lda >> 5) * 1024 : (size_t)HALF * g.lda * 2, hstepB = (size_t)HALF * g.ldb * 2, tstepA = 2 * hstepA, tstepB = 2 * hstepB;
    int Rs[2], Cs[2]; unsigned voffB[2];
#pragma unroll
    for (int i = 0; i < 2; ++i) { int R, C; stage_rc(tid * 16 + i * 8192, R, C); Rs[i] = R; Cs[i] = C; const int Rb = Epi::PERM ? ((R & ~31) + perm32(R & 31)) : R;
        voffB[i] = (unsigned)(Rb * g.ldb + C) * 2u; }
    asm volatile("" : "+v"(voffB[0]), "+v"(voffB[1]), "+v"(Rs[0]), "+v"(Rs[1]), "+v"(Cs[0]), "+v"(Cs[1]));
    unsigned vA[2][2], nvA[2][2];
    const size_t hsA = GATHER ? (size_t)0 : hstepA;
#define PG8_SETV(V, U) do { _Pragma("unroll") for (int _h = 0; _h < 2; ++_h) _Pragma("unroll") for (int _i = 0; _i < 2; ++_i) { \
        if constexpr (GATHER) { int _t = g.gidx[(U).pm * BM + _h * HALF + Rs[_i]]; _t = _t < 0 ? 0 : _t; V[_h][_i] = (unsigned)(_t * g.lda + Cs[_i]) * 2u; } \
        else if constexpr (ABLK) V[_h][_i] = (unsigned)blk_off(Rs[_i], Cs[_i], g.lda) * 2u; \
        else V[_h][_i] = (unsigned)(Rs[_i] * g.lda + Cs[_i]) * 2u; } } while (0)
    const unsigned ldsw = (unsigned)wid * 1024u;
    const int aoff = lds_byte(wr * 64 + fr, fq * 8), boff = lds_byte(wc * 32 + fr, fq * 8);
#define PG8_SA(b, h) (((b) * 2 + (h)) * HTB)
#define PG8_SB(b, h) ((4 + (b) * 2 + (h)) * HTB)
#define PG8_STAGE(bufoff, gbase, voff) do { _Pragma("unroll") for (int _i = 0; _i < 2; ++_i) \
        __builtin_amdgcn_global_load_lds((const unsigned*)((const char*)(gbase) + (voff)[_i]), (LAS unsigned*)(lds + (bufoff) + ldsw + _i * 8192), 16, 0, 0); } while (0)
#define PG8_LDA(dst, b, h) do { _Pragma("unroll") for (int m = 0; m < 4; ++m) { const i32x4_t f0_ = *(const LAS i32x4_t*)(lds + PG8_SA(b, h) + aoff + m * 2048), f1_ = *(const LAS i32x4_t*)(lds + PG8_SA(b, h) + aoff + m * 2048 + 1024); FragSel<F8>::set(dst[m], f0_, f1_); } } while (0)
#define PG8_LDB(dst, b, h) do { _Pragma("unroll") for (int n = 0; n < 2; ++n) { const i32x4_t f0_ = *(const LAS i32x4_t*)(lds + PG8_SB(b, h) + boff + n * 2048), f1_ = *(const LAS i32x4_t*)(lds + PG8_SB(b, h) + boff + n * 2048 + 1024); FragSel<F8>::set(dst[n], f0_, f1_); } } while (0)
#define PG8_MMA(ai, bj, At, Bt) do { __builtin_amdgcn_s_setprio(1); _Pragma("unroll") for (int m = 0; m < 4; ++m) _Pragma("unroll") for (int n = 0; n < 2; ++n) FragSel<F8>::mma(acc[ai][bj][m][n], Bt[n], At[m]); __builtin_amdgcn_s_setprio(0); } while (0)
#define PG8_WAIT_V(n) asm volatile("s_waitcnt vmcnt(" #n ")" ::: "memory")
#define PG8_WAIT_VSEL(sel, n) asm volatile("s_cmp_eq_u32 %0, 0\n\ts_cbranch_scc1 1f\n\ts_waitcnt vmcnt(%1)\n\ts_branch 2f\n1:\n\ts_waitcnt vmcnt(8)\n2:" :: "s"(sel), "n"(n) : "memory", "scc")
#define PG8_WAIT_L(n) asm volatile("s_waitcnt lgkmcnt(" #n ")" ::: "memory")
#define PG8_BAR __builtin_amdgcn_s_barrier()
#define PG8_SCHED __builtin_amdgcn_sched_barrier(0)
    Unit cur, nxt; int ui = 0;
    if constexpr (Sched::DYN) S.begin();
    if (!S.next(0, cur)) return;
    f32x4 acc[2][2][4][2];
#pragma unroll
    for (int a = 0; a < 2; ++a)
#pragma unroll
        for (int b = 0; b < 2; ++b)
#pragma unroll
            for (int m = 0; m < 4; ++m)
#pragma unroll
                for (int n = 0; n < 2; ++n) acc[a][b][m][n] = (f32x4){0.f, 0.f, 0.f, 0.f};
    typename FragSel<F8>::A At; typename FragSel<F8>::B B0, B1;
    PG8_SETV(vA, cur);
    const char* cA = (const char*)g.A + (GATHER ? (size_t)0 : (size_t)cur.pm * tstepA); const char* cB = (const char*)g.Bt + (size_t)cur.pn * tstepB;
    PG8_STAGE(PG8_SB(0, 0), cB, voffB); PG8_STAGE(PG8_SB(0, 1), cB + hstepB, voffB); PG8_STAGE(PG8_SA(0, 0), cA, vA[0]); PG8_STAGE(PG8_SA(0, 1), cA + hsA, vA[1]);
    if (wr == 1) PG8_BAR;
    PG8_WAIT_V(2); PG8_BAR;
    PG8_STAGE(PG8_SB(1, 0), cB + kstep, voffB); PG8_STAGE(PG8_SA(1, 0), cA + kstepA, vA[0]); PG8_STAGE(PG8_SB(1, 1), cB + hstepB + kstep, voffB);
    PG8_WAIT_V(6); PG8_BAR;
    for (;;) {
        const bool has_next = S.next(ui + 1, nxt);
        unsigned claim_ = 0u; if constexpr (Sched::DYN) claim_ = S.claim_issue();
        const char* nA = has_next ? (const char*)g.A + (GATHER ? (size_t)0 : (size_t)nxt.pm * tstepA) : cA; const char* nB = has_next ? (const char*)g.Bt + (size_t)nxt.pn * tstepB : cB;
        if constexpr (GATHER) { if (has_next) PG8_SETV(nvA, nxt); else {
#pragma unroll
            for (int h = 0; h < 2; ++h) { nvA[h][0] = vA[h][0]; nvA[h][1] = vA[h][1]; } } }
        for (int t = 0; t < nt; t += 2) {
            if constexpr (Epi::MID) { if (t == 8 || t == 16) E.mid(acc, cur, t >> 3, wr, wc, fr, fq); }
            const bool last = (t == nt - 2);
            const char* a1 = cA + (size_t)(t + 1) * kstepA;
            const char* a2 = last ? nA : cA + (size_t)(t + 2) * kstepA; const char* b2 = last ? nB : cB + (size_t)(t + 2) * kstep;
            const char* a3 = a2 + kstepA; const char* b3 = b2 + kstep;
            unsigned v20[2], v21[2];
            if constexpr (GATHER) { v20[0] = last ? nvA[0][0] : vA[0][0]; v20[1] = last ? nvA[0][1] : vA[0][1]; v21[0] = last ? nvA[1][0] : vA[1][0]; v21[1] = last ? nvA[1][1] : vA[1][1]; }
            else { v20[0] = vA[0][0]; v20[1] = vA[0][1]; v21[0] = vA[1][0]; v21[1] = vA[1][1]; }
            const int relax_ = __builtin_amdgcn_readfirstlane((RELAXW && (t == 0) && (ui > 0)) ? 1 : 0);
            PG8_LDB(B0, 0, 0); PG8_LDB(B1, 0, 1); PG8_SCHED; PG8_LDA(At, 0, 0); PG8_STAGE(PG8_SA(1, 1), a1 + hsA, vA[1]);
            PG8_WAIT_VSEL(relax_, 8 + Epi::NVM);
            PG8_WAIT_L(0); PG8_BAR; PG8_MMA(0, 0, At, B0); PG8_MMA(0, 1, At, B1); PG8_BAR; PG8_SCHED;
            PG8_LDA(At, 0, 1); PG8_STAGE(PG8_SB(0, 0), b2, voffB); PG8_STAGE(PG8_SB(0, 1), b2 + hstepB, voffB); PG8_STAGE(PG8_SA(0, 0), a2, v20);
            PG8_WAIT_VSEL(relax_, 8 + Epi::NVM);
            PG8_WAIT_L(0); PG8_BAR; PG8_MMA(1, 0, At, B0); PG8_MMA(1, 1, At, B1); PG8_BAR; PG8_SCHED;
            PG8_LDB(B0, 1, 0); PG8_LDB(B1, 1, 1); PG8_SCHED; PG8_LDA(At, 1, 0); PG8_STAGE(PG8_SA(0, 1), a2 + hsA, v21);
            PG8_WAIT_V(8); PG8_WAIT_L(0); PG8_BAR; PG8_MMA(0, 0, At, B0); PG8_MMA(0, 1, At, B1); PG8_BAR; PG8_SCHED;
            PG8_LDA(At, 1, 1); PG8_STAGE(PG8_SB(1, 0), b3, voffB); PG8_STAGE(PG8_SB(1, 1), b3 + hstepB, voffB); PG8_STAGE(PG8_SA(1, 0), a3, v20);
            PG8_WAIT_V(8); PG8_WAIT_L(0); PG8_BAR; PG8_MMA(1, 0, At, B0); PG8_MMA(1, 1, At, B1); PG8_BAR; PG8_SCHED;
        }
        if constexpr (Sched::DYN) S.claim_commit(claim_, ui);
        if constexpr (ALIGN_EPI) { if (wr == 0) PG8_BAR; }
        FragSel<F8>::after_mma();
        E(acc, cur, wr, wc, fr, fq);
        if (!has_next) break;
#pragma unroll
        for (int a = 0; a < 2; ++a)
#pragma unroll
            for (int b = 0; b < 2; ++b)
#pragma unroll
                for (int m = 0; m < 4; ++m)
#pragma unroll
                    for (int n = 0; n < 2; ++n) acc[a][b][m][n] = (f32x4){0.f, 0.f, 0.f, 0.f};
        cur = nxt; cA = nA; cB = nB; ++ui;
        if constexpr (GATHER) {
#pragma unroll
            for (int h = 0; h < 2; ++h) { vA[h][0] = nvA[h][0]; vA[h][1] = nvA[h][1]; } }
        if constexpr (ALIGN_EPI) { if (wr == 1) PG8_BAR; }
    }
    PG8_WAIT_V(0);
    if constexpr (!ALIGN_EPI) { if (wr == 0) PG8_BAR; }
    PG8_BAR;
#undef PG8_SETV
#undef PG8_SA
#undef PG8_SB
#undef PG8_STAGE
#undef PG8_LDA
#undef PG8_LDB
#undef PG8_MMA
#undef PG8_WAIT_V
#undef PG8_WAIT_VSEL
#undef PG8_WAIT_L
#undef PG8_BAR
#undef PG8_SCHED
}

typedef f32x4 Acc[2][2][4][2];
#ifndef NT_Z
#define NT_Z 0
#endif
#ifndef NT_A
#define NT_A 1
#endif
#ifndef ST_SC1
#define ST_SC1 1
#endif
__device__ __forceinline__ void st16(unsigned char* wsb, u32x4* p, const u32x4& v) {
#if ST_SC1
    const __amdgpu_buffer_rsrc_t rsrc = __builtin_amdgcn_make_buffer_rsrc(wsb, 0, 0x7fffffff, 0x00020000);
    __builtin_amdgcn_raw_buffer_store_b128(v, rsrc, (int)((unsigned char*)p - wsb), 0, 16);
#else
    *p = v;
#endif
}
__device__ __forceinline__ void st8(unsigned char* wsb, u32x2* p, const u32x2& v) {
#if ST_SC1
    const __amdgpu_buffer_rsrc_t rsrc = __builtin_amdgcn_make_buffer_rsrc(wsb, 0, 0x7fffffff, 0x00020000);
    __builtin_amdgcn_raw_buffer_store_b64(v, rsrc, (int)((unsigned char*)p - wsb), 0, 16);
#else
    *p = v;
#endif
}
__device__ __forceinline__ float fq_sum(float s) { s += swz_xor<16>(s); return xsum32(s); }
__device__ __forceinline__ u32x4 pack8(const f32x4& a, const f32x4& b) { u32x4 w; w.x = cvt_pk_bf16(a.x, a.y); w.y = cvt_pk_bf16(a.z, a.w); w.z = cvt_pk_bf16(b.x, b.y); w.w = cvt_pk_bf16(b.z, b.w); return w; }
__device__ __forceinline__ void unpack8(const u32x4& w, f32x4& a, f32x4& b) { a = (f32x4){bf_lo(w.x), bf_hi(w.x), bf_lo(w.y), bf_hi(w.y)}; b = (f32x4){bf_lo(w.z), bf_hi(w.z), bf_lo(w.w), bf_hi(w.w)}; }
__device__ __forceinline__ unsigned g8pack(const f32x4& a) {
    const unsigned b0 = (unsigned)__builtin_fmaxf(a.x * 255.f + 0.5f, 1.f), b1 = (unsigned)__builtin_fmaxf(a.y * 255.f + 0.5f, 1.f), b2 = (unsigned)__builtin_fmaxf(a.z * 255.f + 0.5f, 1.f), b3 = (unsigned)__builtin_fmaxf(a.w * 255.f + 0.5f, 1.f);
    return b0 | (b1 << 8) | (b2 << 16) | (b3 << 24);
}
__device__ __forceinline__ f32x4 g8unpack(unsigned w) { return (f32x4){(float)(w & 0xffu), (float)((w >> 8) & 0xffu), (float)((w >> 16) & 0xffu), (float)(w >> 24)}; }
__device__ __forceinline__ float sq8(const f32x4& a, const f32x4& b) { return ((a.x * a.x + a.y * a.y) + (a.z * a.z + a.w * a.w)) + ((b.x * b.x + b.y * b.y) + (b.z * b.z + b.w * b.w)); }
__device__ __forceinline__ float sum4(const f32x4& a) { return (a.x + a.y) + (a.z + a.w); }
__device__ __forceinline__ void rope8(f32x4& a, f32x4& b, const float* cs, const float* sn) {
    const f32x4 c = *(const f32x4*)cs, s = *(const f32x4*)sn;
    const f32x4 ra = {a.x * c.x - a.y * s.x, a.x * s.x + a.y * c.x, a.z * c.y - a.w * s.y, a.z * s.y + a.w * c.y};
    const f32x4 rb = {b.x * c.z - b.y * s.z, b.x * s.z + b.y * c.z, b.z * c.w - b.w * s.w, b.z * s.w + b.w * c.w};
    a = ra; b = rb;
}
__device__ __forceinline__ void rowscale16(const float* st, int rbase, int fq, float (&r)[8]) {
    f32x4 p[8];
#pragma unroll
    for (int i = 0; i < 8; ++i) p[i] = *(const f32x4*)(st + (size_t)(rbase + (i >> 2) * HALF + (i & 3) * 16) * 16 + 4 * fq);
#pragma unroll
    for (int i = 0; i < 8; ++i) r[i] = rsqrtf(fq_sum(sum4(p[i])) * (1.f / 1024.f) + EPS);
}
__device__ __forceinline__ void rowscale4(const float* sq, int rbase, float inv_n, float (&r)[8]) {
    f32x4 p[8];
#pragma unroll
    for (int i = 0; i < 8; ++i) p[i] = *(const f32x4*)(sq + (size_t)(rbase + (i >> 2) * HALF + (i & 3) * 16) * 4);
#pragma unroll
    for (int i = 0; i < 8; ++i) r[i] = rsqrtf(sum4(p[i]) * inv_n + EPS);
}
#define EPI_ROWBASE int rl_ = wr * 64 + fr; asm volatile("" : "+v"(rl_)); const int rbase = u.pm * BM + rl_
#define EPI_LOOP _Pragma("unroll") for (int ai = 0; ai < 2; ++ai) _Pragma("unroll") for (int m = 0; m < 4; ++m)

struct EpiIn {
    static constexpr bool PERM = true, MID = false; static constexpr int NVM = 24;
    bf16_t* Z; const float* st; float* sq; float* skv; const float* cosT; const float* sinT; unsigned char* GB; bf16_t* HM; unsigned char* wsb; int pnoff; float asc;
    __device__ __forceinline__ void operator()(const Acc& acc, const Unit& u, int wr, int wc, int fr, int fq) const {
        EPI_ROWBASE; const int pn = u.pn + pnoff;
        float r8[8]; rowscale16(st, rbase, fq, r8);
#pragma unroll
        for (int i = 0; i < 8; ++i) r8[i] *= asc;
        __builtin_amdgcn_sched_barrier(0);
        EPI_LOOP {
            const int row = rbase + ai * HALF + m * 16; const float r = r8[ai * 4 + m];
            bf16_t* zr = Z + (size_t)row * ZW + pn * BM + wc * 32 + 8 * fq;
            float ssq = 0.f;
#pragma unroll
            for (int bj = 0; bj < 2; ++bj) {
                f32x4 v0 = acc[ai][bj][m][0] * r, v1 = acc[ai][bj][m][1] * r;
#ifdef PROBE_ANOISE
                if (pn < 11 && ((PROBE_ANOISE_MASK >> pn) & 1)) { unsigned h_ = (unsigned)row * 2654435761u ^ (unsigned)(pn * 64 + bj * 32 + wc * 8 + fq) * 40503u; float nz[8];
#pragma unroll
                      for (int e_ = 0; e_ < 8; ++e_) { h_ = h_ * 1664525u + 1013904223u; nz[e_] = ((float)(h_ >> 8) * (1.f / 16777216.f) - 0.5f) * 3.4641f * 0.035f * (float)(PROBE_ANOISE); }
                      v0.x += nz[0]; v0.y += nz[1]; v0.z += nz[2]; v0.w += nz[3]; v1.x += nz[4]; v1.y += nz[5]; v1.z += nz[6]; v1.w += nz[7]; }
#endif
                if (pn == 0) ssq += sq8(v0, v1);
                else if (pn == 1) { if (bj == 0) ssq += sq8(v0, v1); else if (wc == 0) { const int pos = row & (SEQ - 1); rope8(v0, v1, cosT + pos * 16 + 4 * fq, sinT + pos * 16 + 4 * fq); } }
                else if (pn == 2 || pn == 3 || pn == 8 || pn == 9) { v0 = v0 * (0.125f * LOG2E); v1 = v1 * (0.125f * LOG2E); }
                else if (pn >= 11) {
#ifdef PROBE_GNOISE
                    { unsigned h_ = (unsigned)row * 2654435761u ^ (unsigned)(pn * 64 + bj * 32 + wc * 8 + fq) * 40503u; float nz[8];
#pragma unroll
                      for (int e_ = 0; e_ < 8; ++e_) { h_ = h_ * 1664525u + 1013904223u; nz[e_] = ((float)(h_ >> 8) * (1.f / 16777216.f) - 0.5f) * 3.4641f * 0.035f * (float)(PROBE_GNOISE); }
                      v0.x += nz[0]; v0.y += nz[1]; v0.z += nz[2]; v0.w += nz[3]; v1.x += nz[4]; v1.y += nz[5]; v1.z += nz[6]; v1.w += nz[7]; }
#endif
                    v0 = (f32x4){sigmoidf_(v0.x), sigmoidf_(v0.y), sigmoidf_(v0.z), sigmoidf_(v0.w)}; v1 = (f32x4){sigmoidf_(v1.x), sigmoidf_(v1.y), sigmoidf_(v1.z), sigmoidf_(v1.w)}; }
                if (pn >= 11) { u32x2 w8; w8.x = g8pack(v0); w8.y = g8pack(v1); *(u32x2*)(GB + blk_off(row, (pn - 11) * BM + bj * HALF + wc * 32 + 8 * fq, 3072)) = w8; }
                else if (pn >= 2) {
                    const int hc = (pn - 2) * BM + bj * HALF + wc * 32;
                    const int reg = hc < 1536 ? hc >> 9 : (hc < 2048 ? 3 : (hc < 2176 ? 4 : 5)), hin = hc < 1536 ? hc & 511 : (hc < 2048 ? hc - 1536 : (hc - 2048) & 127);
                    const size_t base = reg <= 3 ? (size_t)reg * (MC * 512) : (size_t)4 * (MC * 512) + (size_t)(reg - 4) * (MC * 128);
                    const int nh = reg <= 3 ? 8 : 2, b = row >> 11, s = row & (SEQ - 1);
                    st16(wsb, (u32x4*)(HM + base + (((size_t)(b * nh + (hin >> 6)) * SEQ + s) * 64 + (hin & 63) + 8 * fq)), pack8(v0, v1));
                }
                else st16(wsb, (u32x4*)(zr + bj * HALF), pack8(v0, v1));
            }
            if (pn <= 1) { ssq = fq_sum(ssq); if (fq == 0) (pn == 0 ? sq : skv)[(size_t)row * 4 + wc] = ssq; }
        }
    }
};
struct EpiQ {
    static constexpr bool PERM = true, MID = false; static constexpr int NVM = 24;
    bf16_t* Q; const float* sq; const float* cosT; const float* sinT;
    __device__ __forceinline__ void operator()(const Acc& acc, const Unit& u, int wr, int wc, int fr, int fq) const {
        EPI_ROWBASE;
        float r8[8]; rowscale4(sq, rbase, 1.f / 256.f, r8);
        __builtin_amdgcn_sched_barrier(0);
        EPI_LOOP {
            __builtin_amdgcn_sched_barrier(0);
            const int row = rbase + ai * HALF + m * 16; const float r = r8[ai * 4 + m]; const int pos = row & (SEQ - 1);
#pragma unroll
            for (int bj = 0; bj < 2; ++bj) {
                const int col = u.pn * BM + bj * HALF + wc * 32 + 8 * fq; const int j0 = col % 96;
                f32x4 v0 = acc[ai][bj][m][0] * r, v1 = acc[ai][bj][m][1] * r;
                if (j0 >= 64) { const int i0 = (j0 - 64) >> 1; rope8(v0, v1, cosT + pos * 16 + i0, sinT + pos * 16 + i0); }
                *(u32x4*)(Q + (size_t)row * 768 + col) = pack8(v0, v1);
            }
        }
    }
};
struct EpiKV {
    static constexpr bool PERM = true, MID = false; static constexpr int NVM = 24;
    bf16_t* KV; const float* skv;
    __device__ __forceinline__ void operator()(const Acc& acc, const Unit& u, int wr, int wc, int fr, int fq) const {
        EPI_ROWBASE;
        float r8[8]; rowscale4(skv, rbase, 1.f / 128.f, r8);
        __builtin_amdgcn_sched_barrier(0);
        EPI_LOOP {
            const int row = rbase + ai * HALF + m * 16; const float r = r8[ai * 4 + m];
#pragma unroll
            for (int bj = 0; bj < 2; ++bj) {
                const int col = u.pn * BM + bj * HALF + wc * 32 + 8 * fq;
                *(u32x4*)(KV + (size_t)row * 1024 + col) = pack8(acc[ai][bj][m][0] * r, acc[ai][bj][m][1] * r);
            }
        }
    }
};
struct EpiBr {
    static constexpr bool PERM = true, MID = true; static constexpr int NVM = 32;
    const unsigned char* G; bf16_t* MG; unsigned char* wsb;
    __device__ __forceinline__ void mid(Acc& acc, const Unit& u, int seg, int wr, int wc, int fr, int fq) const {
        EPI_ROWBASE; const int col = u.pn * BM + wc * 32 + 8 * fq;
#pragma unroll
        for (int ai = 0; ai < 2; ++ai) {
            __builtin_amdgcn_sched_barrier(0);
            u32x2 wn[4][2], wd[4][2];
#pragma unroll
            for (int m = 0; m < 4; ++m)
#pragma unroll
                for (int bj = 0; bj < 2; ++bj) { const int row = rbase + ai * HALF + m * 16; wn[m][bj] = *(const u32x2*)(G + blk_off(row, (seg - 1) * 1024 + col + bj * HALF, 3072)); wd[m][bj] = *(const u32x2*)(G + blk_off(row, seg * 1024 + col + bj * HALF, 3072)); }
#pragma unroll
            for (int m = 0; m < 4; ++m)
#pragma unroll
                for (int bj = 0; bj < 2; ++bj) {
                    const f32x4 n0 = g8unpack(wn[m][bj].x), n1 = g8unpack(wn[m][bj].y), d0 = g8unpack(wd[m][bj].x), d1 = g8unpack(wd[m][bj].y);
                    f32x4 r0, r1;
                    r0.x = n0.x * fast_rcp(d0.x); r0.y = n0.y * fast_rcp(d0.y); r0.z = n0.z * fast_rcp(d0.z); r0.w = n0.w * fast_rcp(d0.w);
                    r1.x = n1.x * fast_rcp(d1.x); r1.y = n1.y * fast_rcp(d1.y); r1.z = n1.z * fast_rcp(d1.z); r1.w = n1.w * fast_rcp(d1.w);
                    acc[ai][bj][m][0] = acc[ai][bj][m][0] * r0; acc[ai][bj][m][1] = acc[ai][bj][m][1] * r1;
                }
        }
    }
    __device__ __forceinline__ void operator()(const Acc& acc, const Unit& u, int wr, int wc, int fr, int fq) const {
        EPI_ROWBASE; const int col = u.pn * BM + wc * 32 + 8 * fq;
#pragma unroll
        for (int ai = 0; ai < 2; ++ai) {
            __builtin_amdgcn_sched_barrier(0);
            u32x2 wg[4][2];
#pragma unroll
            for (int m = 0; m < 4; ++m)
#pragma unroll
                for (int bj = 0; bj < 2; ++bj) wg[m][bj] = *(const u32x2*)(G + blk_off(rbase + ai * HALF + m * 16, 2048 + col + bj * HALF, 3072));
#pragma unroll
            for (int m = 0; m < 4; ++m)
#pragma unroll
                for (int bj = 0; bj < 2; ++bj) { const f32x4 g0 = g8unpack(wg[m][bj].x) * (1.f / 255.f), g1 = g8unpack(wg[m][bj].y) * (1.f / 255.f);
                    st16(wsb, (u32x4*)(MG + blk_off(rbase + ai * HALF + m * 16, col + bj * HALF, 1024)), pack8(acc[ai][bj][m][0] * g0, acc[ai][bj][m][1] * g1)); }
        }
    }
};
template <bool F8OUT> struct EpiRes {
    static constexpr bool PERM = true, MID = false; static constexpr int NVM = 40;
    bf16_t* xb; float* st; int row0; unsigned char* x8;
    __device__ __forceinline__ void operator()(const Acc& acc, const Unit& u, int wr, int wc, int fr, int fq) const {
        EPI_ROWBASE; const int col = u.pn * BM + wc * 32 + 8 * fq;
#pragma unroll
        for (int ai = 0; ai < 2; ++ai) {
            __builtin_amdgcn_sched_barrier(0);
            u32x4 xi[4][2];
#pragma unroll
            for (int m = 0; m < 4; ++m)
#pragma unroll
                for (int bj = 0; bj < 2; ++bj) xi[m][bj] = *(const u32x4*)(xb + (size_t)(row0 + rbase + ai * HALF + m * 16) * DM + col + bj * HALF);
#pragma unroll
            for (int m = 0; m < 4; ++m) {
                const int row = row0 + rbase + ai * HALF + m * 16; float ssq = 0.f;
#pragma unroll
                for (int bj = 0; bj < 2; ++bj) { f32x4 x0, x1; unpack8(xi[m][bj], x0, x1);
                    const f32x4 v0 = x0 + acc[ai][bj][m][0], v1 = x1 + acc[ai][bj][m][1];
                    *(u32x4*)(xb + (size_t)row * DM + col + bj * HALF) = pack8(v0, v1); ssq += sq8(v0, v1);
                    if constexpr (F8OUT) { u32x2 o8; o8.x = pk_fp8x4(v0.x * 16.f, v0.y * 16.f, v0.z * 16.f, v0.w * 16.f); o8.y = pk_fp8x4(v1.x * 16.f, v1.y * 16.f, v1.z * 16.f, v1.w * 16.f); *(u32x2*)(x8 + (size_t)row * DM + col + bj * HALF) = o8; } }
                ssq = fq_sum(ssq); if (fq == 0) st[(size_t)row * 16 + u.pn * 4 + wc] = ssq;
            }
        }
    }
};
__device__ __forceinline__ float silu_mul(float g, float u) { return g * sigmoidf_(g) * u; }
struct EpiGU {
    static constexpr bool PERM = true, MID = false; static constexpr int NVM = 16;
    bf16_t* ACT; const float* st; int ldact; unsigned char* wsb;
    __device__ __forceinline__ void operator()(const Acc& acc, const Unit& u, int wr, int wc, int fr, int fq) const {
        EPI_ROWBASE;
        float r8[8]; rowscale16(st, rbase, fq, r8);
        __builtin_amdgcn_sched_barrier(0);
        EPI_LOOP {
            const int row = rbase + ai * HALF + m * 16; const float r = r8[ai * 4 + m];
            f32x4 g0 = acc[ai][0][m][0] * r, g1 = acc[ai][0][m][1] * r, u0 = acc[ai][1][m][0] * r, u1 = acc[ai][1][m][1] * r;
#ifdef PROBE_P6NOISE
            { unsigned h_ = (unsigned)row * 2654435761u ^ (unsigned)(u.pn * 64 + wc * 8 + fq) * 40503u; float nz[16];
#pragma unroll
              for (int e_ = 0; e_ < 16; ++e_) { h_ = h_ * 1664525u + 1013904223u; nz[e_] = ((float)(h_ >> 8) * (1.f / 16777216.f) - 0.5f) * 3.4641f * 0.035f * (float)(PROBE_P6NOISE); }
              g0.x += nz[0]; g0.y += nz[1]; g0.z += nz[2]; g0.w += nz[3]; g1.x += nz[4]; g1.y += nz[5]; g1.z += nz[6]; g1.w += nz[7]; u0.x += nz[8]; u0.y += nz[9]; u0.z += nz[10]; u0.w += nz[11]; u1.x += nz[12]; u1.y += nz[13]; u1.z += nz[14]; u1.w += nz[15]; }
#endif
            const f32x4 a0 = {silu_mul(g0.x, u0.x), silu_mul(g0.y, u0.y), silu_mul(g0.z, u0.z), silu_mul(g0.w, u0.w)};
            const f32x4 a1 = {silu_mul(g1.x, u1.x), silu_mul(g1.y, u1.y), silu_mul(g1.z, u1.z), silu_mul(g1.w, u1.w)};
            st16(wsb, (u32x4*)(ACT + blk_off(row, u.aux * HALF + wc * 32 + 8 * fq, ldact)), pack8(a0, a1));
        }
    }
};
struct EpiGUMoe {
    static constexpr bool PERM = true, MID = false; static constexpr int NVM = 16;
    bf16_t* ACT; const float* rowrr; int ldact; unsigned char* wsb;
    __device__ __forceinline__ void operator()(const Acc& acc, const Unit& u, int wr, int wc, int fr, int fq) const {
        EPI_ROWBASE;
        float r8[8];
#pragma unroll
        for (int i = 0; i < 8; ++i) r8[i] = rowrr[rbase + (i >> 2) * HALF + (i & 3) * 16] * (MOE_F8 ? 1.f / 4096.f : 1.f);
        __builtin_amdgcn_sched_barrier(0);
        EPI_LOOP {
            const int row = rbase + ai * HALF + m * 16; const float r = r8[ai * 4 + m];
            const f32x4 g0 = acc[ai][0][m][0] * r, g1 = acc[ai][0][m][1] * r, u0 = acc[ai][1][m][0] * r, u1 = acc[ai][1][m][1] * r;
            const f32x4 a0 = {silu_mul(g0.x, u0.x), silu_mul(g0.y, u0.y), silu_mul(g0.z, u0.z), silu_mul(g0.w, u0.w)};
            const f32x4 a1 = {silu_mul(g1.x, u1.x), silu_mul(g1.y, u1.y), silu_mul(g1.z, u1.z), silu_mul(g1.w, u1.w)};
            if (MOE_DN_F8) { u32x2 o8; o8.x = pk_fp8x4(a0.x * 8.f, a0.y * 8.f, a0.z * 8.f, a0.w * 8.f); o8.y = pk_fp8x4(a1.x * 8.f, a1.y * 8.f, a1.z * 8.f, a1.w * 8.f);
                st8(wsb, (u32x2*)((unsigned char*)ACT + blk_off(row, (u.aux * HALF + wc * 32 + 8 * fq) >> 1, ldact >> 1) * 2), o8); }
            else st16(wsb, (u32x4*)(ACT + blk_off(row, u.aux * HALF + wc * 32 + 8 * fq, ldact)), pack8(a0, a1));
        }
    }
};
template <bool FIRST> struct EpiDnMoe {
    static constexpr bool PERM = true, MID = false; static constexpr int NVM = 32;
    unsigned char* ws; const int* rowtok; const float* rowgw;
    __device__ __forceinline__ void operator()(const Acc& acc, const Unit& u, int wr, int wc, int fr, int fq) const {
        EPI_ROWBASE; const int col = u.aux * BM + wc * 32 + 8 * fq;
        int tk[8]; float gw8[8];
#pragma unroll
        for (int i = 0; i < 8; ++i) { tk[i] = rowtok[rbase + (i >> 2) * HALF + (i & 3) * 16]; gw8[i] = rowgw[rbase + (i >> 2) * HALF + (i & 3) * 16] * (MOE_DN_F8 ? 1.f / 8192.f : 1.f); }
#pragma unroll
        for (int ai = 0; ai < 2; ++ai) {
            __builtin_amdgcn_sched_barrier(0);
            u32x4 xi[4][2]; bf16_t* xr[4];
#pragma unroll
            for (int m = 0; m < 4; ++m) { const int tok = tk[ai * 4 + m] < 0 ? 0 : tk[ai * 4 + m]; xr[m] = xm_row(ws, tok) + col;
                const bf16_t* src = FIRST ? (const bf16_t*)(ws + WS_XB) + (size_t)tok * DM + col : xr[m];
#pragma unroll
                for (int bj = 0; bj < 2; ++bj) xi[m][bj] = *(const u32x4*)(src + bj * HALF); }
#pragma unroll
            for (int m = 0; m < 4; ++m) { const float gwv = gw8[ai * 4 + m];
                if (tk[ai * 4 + m] >= 0) {
#pragma unroll
                    for (int bj = 0; bj < 2; ++bj) { f32x4 x0, x1; unpack8(xi[m][bj], x0, x1);
                        *(u32x4*)(xr[m] + bj * HALF) = pack8(x0 + acc[ai][bj][m][0] * gwv, x1 + acc[ai][bj][m][1] * gwv); } } }
        }
    }
};
}
namespace att {
constexpr float MLA_THR = 6.f;
__device__ __forceinline__ int crow(int r, int hi) { return (r & 3) + 8 * (r >> 2) + 4 * hi; }
__device__ __forceinline__ float xhalf_max(float m) { return xmax32(m); }
__device__ __forceinline__ float xhalf_sum(float m) { return xsum32(m); }
typedef short v4i16_t __attribute__((ext_vector_type(4)));
__device__ __forceinline__ s16x4 vtr(const LAS unsigned char* p) { return __builtin_bit_cast(s16x4, __builtin_amdgcn_ds_read_tr16_b64_v4i16((LAS v4i16_t*)p)); }
__device__ __forceinline__ bf16x8 cat8(s16x4 a, s16x4 b) { return (bf16x8){a[0], a[1], a[2], a[3], b[0], b[1], b[2], b[3]}; }
__device__ __forceinline__ bf16x8 pfrag(const f32x16& p, int s8) {
    u32x4 w; w.x = cvt_pk_bf16(p[s8 + 0], p[s8 + 1]); w.y = cvt_pk_bf16(p[s8 + 2], p[s8 + 3]); w.z = cvt_pk_bf16(p[s8 + 4], p[s8 + 5]); w.w = cvt_pk_bf16(p[s8 + 6], p[s8 + 7]);
    return __builtin_bit_cast(bf16x8, w);
}
constexpr int TAB_STRIDE = 320;

constexpr int BW_ROWS = 384, BW_KP = 144;
constexpr int BW_K = 0, BW_V = BW_ROWS * BW_KP, BW_VDH = BW_ROWS * 64, BW_TAB = BW_V + 2 * BW_VDH, BW_END = BW_TAB + 4 * TAB_STRIDE * 4;
struct BandPre { u32x4 k[6], v[6]; float t[4]; bf16x8 q[4]; };
struct BandItem { int kind, b, hh, g0, a0; };
__device__ __forceinline__ BandItem band_decode(int i, int items_per_kind) {
    BandItem it; it.kind = i / items_per_kind; const int w = i % items_per_kind;
    if (it.kind < 3) { const int sub = w & 7; it.hh = (w >> 3) & 7; it.b = w >> 6;
        if (it.kind == 0) { it.g0 = 0; it.a0 = 256 * sub; } else if (it.kind == 1) { it.g0 = sub >> 1; it.a0 = 256 * (sub & 1); } else { it.g0 = 2 * sub; it.a0 = 0; } }
    else { it.a0 = 64 * (w & 31); it.hh = (w >> 5) & 1; it.b = w >> 6; it.g0 = 0; }
    return it;
}
__device__ __forceinline__ bool band_row(const BandItem& it, int r, int& pos) {
    int key, g = it.g0, dil, L;
    if (it.kind == 3) { if (r >= 320) return false; key = it.a0 - 128 + r; dil = 1; L = SEQ; }
    else if (it.kind == 2) { if (r >= 256) return false; g += r >> 7; key = r & 127; dil = 16; L = 128; }
    else { dil = it.kind == 0 ? 1 : 4; L = SEQ / dil; key = it.a0 - 64 + r; }
    if (key < 0 || key >= L) return false;
    pos = key * dil + g; return true;
}
__device__ __forceinline__ void band_issue(BandPre& P, const BandItem& it, const bf16_t* HM, const float* tabg, int tid, int wid, int lane) {
    const bf16_t* kb = it.kind == 3 ? HM + (size_t)4 * MC * 512 + ((size_t)(it.b * 2 + it.hh) * SEQ) * 64 : HM + (size_t)MC * 512 + ((size_t)(it.b * 8 + it.hh) * SEQ) * 64;
    const bf16_t* vb = it.kind == 3 ? kb + (size_t)MC * 128 : kb + (size_t)MC * 512;
#pragma unroll
    for (int i = 0; i < 6; ++i) { const int id = i * 512 + tid, r = id >> 3, c = id & 7; int pos; P.k[i] = (u32x4){0u, 0u, 0u, 0u}; P.v[i] = P.k[i];
        if (band_row(it, r, pos)) { P.k[i] = *(const u32x4*)(kb + (size_t)pos * 64 + c * 8); P.v[i] = *(const u32x4*)(vb + (size_t)pos * 64 + c * 8); } }
#pragma unroll
    for (int j = 0; j < 4; ++j) { P.t[j] = 0.f; if (tid < TAB_STRIDE && (it.kind == 3 || j == 0)) P.t[j] = tabg[((it.kind == 3 ? 3 * 8 + it.hh * 4 + j : it.kind * 8 + it.hh)) * TAB_STRIDE + tid]; }
    int a0w, g = it.g0, dil, qh; const bf16_t* qbuf;
    if (it.kind == 3) { a0w = it.a0 + 32 * (wid & 1); dil = 1; qh = it.hh * 4 + (wid >> 1); qbuf = HM + (size_t)3 * MC * 512; }
    else if (it.kind == 2) { a0w = 32 * (wid & 3); g += wid >> 2; dil = 16; qh = it.hh; qbuf = HM; }
    else { a0w = it.a0 + 32 * wid; dil = it.kind == 0 ? 1 : 4; qh = it.hh; qbuf = HM; }
    const bf16_t* qp = qbuf + (((size_t)(it.b * 8 + qh) * SEQ) + (size_t)(a0w + (lane & 31)) * dil + g) * 64 + (lane >> 5) * 8;
#pragma unroll
    for (int d0 = 0; d0 < 4; ++d0) P.q[d0] = *(const bf16x8*)(qp + d0 * 16);
}
__device__ __forceinline__ void band_store(const BandPre& P, const BandItem& it, LAS unsigned char* lds, int tid) {
#pragma unroll
    for (int i = 0; i < 6; ++i) { const int id = i * 512 + tid, r = id >> 3, c = id & 7;
        *(LAS u32x4*)(lds + BW_K + r * BW_KP + c * 16) = P.k[i]; *(LAS u32x4*)(lds + BW_V + (c >> 2) * BW_VDH + r * 64 + (c & 3) * 16) = P.v[i]; }
    if (tid < TAB_STRIDE) {
#pragma unroll
        for (int j = 0; j < 4; ++j) if (it.kind == 3 || j == 0) ((LAS float*)(lds + BW_TAB))[j * TAB_STRIDE + tid] = P.t[j]; }
}
template <int NKB, int MODE>
__device__ __forceinline__ void band_compute(const bf16x8 (&qf)[4], const LAS unsigned char* lds, int rowoff, int a0w, int L, const LAS float* tab, bf16_t* op, float* stp, float sink2, int lane,
                                             const bf16_t* pb0 = nullptr, const bf16_t* pb1 = nullptr, const float* st0 = nullptr, const float* st1 = nullptr) {
    constexpr int R = 16 * (NKB - 1);
    const int q = lane & 31, hi = lane >> 5;
    f32x16 o0, o1;
#pragma unroll
    for (int r = 0; r < 16; ++r) { o0[r] = 0.f; o1[r] = 0.f; }
    float m = -3e38f, l = 0.f;
    const LAS float* tb = tab + (31 - q + 4 * hi);
    const int kro = q * BW_KP + hi * 16, vro = (4 * hi + ((lane & 15) >> 2)) * 64 + (16 * ((lane >> 4) & 1) + 4 * (lane & 3)) * 2;
#pragma unroll 1
    for (int kb = 0; kb < NKB; ++kb) {
        const int k0 = a0w - R + 32 * kb;
        if (k0 < 0 || k0 >= L) continue;
        const LAS unsigned char* kp = lds + BW_K + (rowoff + k0) * BW_KP + kro;
        f32x16 s;
#pragma unroll
        for (int r = 0; r < 16; ++r) s[r] = 0.f;
#pragma unroll
        for (int d0 = 0; d0 < 4; ++d0) s = __builtin_amdgcn_mfma_f32_32x32x16_bf16(*(const LAS bf16x8*)(kp + d0 * 32), qf[d0], s, 0, 0, 0);
#pragma unroll
        for (int r = 0; r < 16; ++r) s[r] += tb[32 * kb + (r & 3) + 8 * (r >> 2)];
        float bm = s[0];
#pragma unroll
        for (int r = 1; r < 16; ++r) bm = fmaxf(bm, s[r]);
        bm = xhalf_max(bm);
        if (__any(bm > m + MLA_THR)) {
            const float mn = fmaxf(m, bm), f = fast_exp2(m - mn); l *= f; m = mn;
#pragma unroll
            for (int r = 0; r < 16; ++r) { o0[r] *= f; o1[r] *= f; } }
        float ps = 0.f;
#pragma unroll
        for (int r = 0; r < 16; ++r) { s[r] = fast_exp2(s[r] - m); ps += s[r]; }
        l += ps;
        const bf16x8 p0 = pfrag(s, 0), p1 = pfrag(s, 8);
        const LAS unsigned char* vp = lds + BW_V + (rowoff + k0) * 64 + vro;
        { const bf16x8 v00 = cat8(vtr(vp), vtr(vp + 512)), v01 = cat8(vtr(vp + BW_VDH), vtr(vp + BW_VDH + 512));
          const bf16x8 v10 = cat8(vtr(vp + 1024), vtr(vp + 1024 + 512)), v11 = cat8(vtr(vp + BW_VDH + 1024), vtr(vp + BW_VDH + 1024 + 512));
          o0 = __builtin_amdgcn_mfma_f32_32x32x16_bf16(v00, p0, o0, 0, 0, 0); o1 = __builtin_amdgcn_mfma_f32_32x32x16_bf16(v01, p0, o1, 0, 0, 0);
          o0 = __builtin_amdgcn_mfma_f32_32x32x16_bf16(v10, p1, o0, 0, 0, 0); o1 = __builtin_amdgcn_mfma_f32_32x32x16_bf16(v11, p1, o1, 0, 0, 0); }
    }
    float lt = xhalf_sum(l);
    if (MODE == 2) {
        const f32x2 s0 = *(const f32x2*)st0, s1 = *(const f32x2*)st1;
        u32x2 a0[8], a1[8];
#pragma unroll
        for (int j = 0; j < 4; ++j) { a0[j] = *(const u32x2*)(pb0 + 8 * j); a0[4 + j] = *(const u32x2*)(pb0 + 32 + 8 * j); a1[j] = *(const u32x2*)(pb1 + 8 * j); a1[4 + j] = *(const u32x2*)(pb1 + 32 + 8 * j); }
        const float M = fmaxf(m, fmaxf(s0.x, s1.x));
        const float w0 = fast_exp2(s0.x - M) * s0.y, w1 = fast_exp2(s1.x - M) * s1.y, w2 = fast_exp2(m - M);
        const float inv = 1.f / (w0 + w1 + w2 * lt), c0 = w0 * inv, c1 = w1 * inv, c2 = w2 * inv;
#pragma unroll
        for (int j = 0; j < 4; ++j) {
            u32x2 w0_, w1_;
            { const float x0 = bf_lo(a0[j].x) * c0 + bf_lo(a1[j].x) * c1 + o0[4 * j] * c2, x1 = bf_hi(a0[j].x) * c0 + bf_hi(a1[j].x) * c1 + o0[4 * j + 1] * c2;
              const float x2 = bf_lo(a0[j].y) * c0 + bf_lo(a1[j].y) * c1 + o0[4 * j + 2] * c2, x3 = bf_hi(a0[j].y) * c0 + bf_hi(a1[j].y) * c1 + o0[4 * j + 3] * c2;
              w0_.x = cvt_pk_bf16(x0, x1); w0_.y = cvt_pk_bf16(x2, x3); }
            { const float x0 = bf_lo(a0[4 + j].x) * c0 + bf_lo(a1[4 + j].x) * c1 + o1[4 * j] * c2, x1 = bf_hi(a0[4 + j].x) * c0 + bf_hi(a1[4 + j].x) * c1 + o1[4 * j + 1] * c2;
              const float x2 = bf_lo(a0[4 + j].y) * c0 + bf_lo(a1[4 + j].y) * c1 + o1[4 * j + 2] * c2, x3 = bf_hi(a0[4 + j].y) * c0 + bf_hi(a1[4 + j].y) * c1 + o1[4 * j + 3] * c2;
              w1_.x = cvt_pk_bf16(x0, x1); w1_.y = cvt_pk_bf16(x2, x3); }
            *(u32x2*)(op + 8 * j) = w0_; *(u32x2*)(op + 32 + 8 * j) = w1_;
        }
        return;
    }
    if (MODE == 1) lt += fast_exp2(sink2 - m);
    else if (hi == 0) { stp[0] = m; stp[1] = lt; }
    const float inv = 1.f / lt;
#pragma unroll
    for (int j = 0; j < 4; ++j) {
        u32x2 w0, w1; w0.x = cvt_pk_bf16(o0[4 * j] * inv, o0[4 * j + 1] * inv); w0.y = cvt_pk_bf16(o0[4 * j + 2] * inv, o0[4 * j + 3] * inv);
        w1.x = cvt_pk_bf16(o1[4 * j] * inv, o1[4 * j + 1] * inv); w1.y = cvt_pk_bf16(o1[4 * j + 2] * inv, o1[4 * j + 3] * inv);
        *(u32x2*)(op + 8 * j) = w0; *(u32x2*)(op + 32 + 8 * j) = w1;
    }
}

constexpr int MLA_KP = 208;
constexpr int MLA_TK = 128;
constexpr int MLA_KTB = MLA_TK * MLA_KP;
constexpr int MLA_VTB = MLA_TK * 128;
constexpr int MLA_SLOT = MLA_KTB + MLA_VTB;
__device__ __forceinline__ void mla_unit(const bf16_t* Q, const bf16_t* KV, const bf16_t* Zc, bf16_t* Y, int b, int h, int qblk, LAS unsigned char* lds, int tid, int wid, int lane) {
    const int q = lane & 31, hi = lane >> 5;
    const size_t rb = (size_t)b * SEQ;
    bf16x8 qf[6];
    { const bf16_t* qp = Q + (rb + qblk * 256 + wid * 32 + q) * 768 + h * 96 + hi * 8;
#pragma unroll
      for (int d0 = 0; d0 < 6; ++d0) qf[d0] = *(const bf16x8*)(qp + d0 * 16); }
    const bf16_t* gk = KV + (rb + (tid >> 3)) * 1024 + h * 64 + (tid & 7) * 8;
    const bf16_t* gv = gk + 512;
    const bf16_t* gp = Zc + (rb + (tid >> 2)) * ZW + ZO_KPE + (tid & 3) * 8;
    const int lk = (tid >> 3) * MLA_KP + (tid & 7) * 16, lp = (tid >> 2) * MLA_KP + 128 + (tid & 3) * 16;
    const int lv = MLA_KTB + ((tid & 7) >> 2) * (MLA_TK * 64) + (tid >> 3) * 64 + (tid & 3) * 16;
    u32x4 rk0, rk1, rv0, rv1, rp;
#define MLA_GLOAD(T) do { const size_t go_ = (size_t)(T) * MLA_TK; rk0 = *(const u32x4*)(gk + go_ * 1024); rk1 = *(const u32x4*)(gk + (go_ + 64) * 1024); \
        rv0 = *(const u32x4*)(gv + go_ * 1024); rv1 = *(const u32x4*)(gv + (go_ + 64) * 1024); rp = *(const u32x4*)(gp + go_ * ZW); } while (0)
#define MLA_LSTORE(slot) do { LAS unsigned char* sb_ = lds + (slot) * MLA_SLOT; *(LAS u32x4*)(sb_ + lk) = rk0; *(LAS u32x4*)(sb_ + lk + 64 * MLA_KP) = rk1; \
        *(LAS u32x4*)(sb_ + lv) = rv0; *(LAS u32x4*)(sb_ + lv + 64 * 64) = rv1; *(LAS u32x4*)(sb_ + lp) = rp; } while (0)
    MLA_GLOAD(0); MLA_LSTORE(0); MLA_GLOAD(1); MLA_LSTORE(1);
    __syncthreads();
    f32x16 o0, o1;
#pragma unroll
    for (int r = 0; r < 16; ++r) { o0[r] = 0.f; o1[r] = 0.f; }
    float m = 0.f, l = 0.f;
    const int kro = q * MLA_KP + hi * 16;
    const int vro = MLA_KTB + (4 * hi + ((lane & 15) >> 2)) * 64 + (16 * ((lane >> 4) & 1) + 4 * (lane & 3)) * 2;
    f32x16 sa0, sa1, sb0, sb1, negm;
#pragma unroll
    for (int r = 0; r < 16; ++r) negm[r] = 0.f;
    m = 0.f;
#define MLA_QK(S0, S1, slot, sub) do { const LAS unsigned char* kb_ = lds + (slot) * MLA_SLOT + (sub) * 64 * MLA_KP + kro; \
        { const bf16x8 k0_ = *(const LAS bf16x8*)(kb_), k1_ = *(const LAS bf16x8*)(kb_ + 32 * MLA_KP); \
          S0 = __builtin_amdgcn_mfma_f32_32x32x16_bf16(k0_, qf[0], negm, 0, 0, 0); S1 = __builtin_amdgcn_mfma_f32_32x32x16_bf16(k1_, qf[0], negm, 0, 0, 0); } \
        _Pragma("unroll") for (int d0 = 1; d0 < 6; ++d0) { const bf16x8 k0_ = *(const LAS bf16x8*)(kb_ + d0 * 32), k1_ = *(const LAS bf16x8*)(kb_ + 32 * MLA_KP + d0 * 32); \
            S0 = __builtin_amdgcn_mfma_f32_32x32x16_bf16(k0_, qf[d0], S0, 0, 0, 0); S1 = __builtin_amdgcn_mfma_f32_32x32x16_bf16(k1_, qf[d0], S1, 0, 0, 0); } } while (0)
#define MAX3(a, b, c) __builtin_fmaxf(__builtin_fmaxf((a), (b)), (c))
#define MLA_STEP(C0, C1, N0, N1, HASN, NSLOT, NSUB, CSLOT, CSUB, FIRST) do { \
        if (HASN) MLA_QK(N0, N1, NSLOT, NSUB); \
        float ba = MAX3(C0[0], C0[1], C1[0]), bb = MAX3(C0[2], C0[3], C1[1]); ba = MAX3(ba, C1[2], C1[3]); \
        _Pragma("unroll") for (int r = 4; r < 16; r += 4) { ba = MAX3(ba, C0[r], C0[r + 1]); bb = MAX3(bb, C0[r + 2], C0[r + 3]); ba = MAX3(ba, C1[r], C1[r + 1]); bb = MAX3(bb, C1[r + 2], C1[r + 3]); } \
        float bm = xhalf_max(__builtin_fmaxf(ba, bb)); \
        if ((FIRST) || __any(bm > MLA_THR)) {                                \
            const float dl = (FIRST) ? bm : __builtin_fmaxf(bm, 0.f), f = fast_exp2(-dl); m += dl; l *= f; \
            _Pragma("unroll") for (int r = 0; r < 16; ++r) { o0[r] *= f; o1[r] *= f; C0[r] -= dl; C1[r] -= dl; negm[r] = -m; } \
            if (HASN) { _Pragma("unroll") for (int r = 0; r < 16; ++r) { N0[r] -= dl; N1[r] -= dl; } } } \
        float ps = 0.f; \
        _Pragma("unroll") for (int r = 0; r < 16; ++r) { C0[r] = fast_exp2(C0[r]); C1[r] = fast_exp2(C1[r]); ps += C0[r] + C1[r]; } \
        l += ps; \
        const bf16x8 p0 = pfrag(C0, 0), p1 = pfrag(C0, 8), p2 = pfrag(C1, 0), p3 = pfrag(C1, 8); \
        const LAS unsigned char* vb = lds + (CSLOT) * MLA_SLOT + (CSUB) * 64 * 64 + vro; \
        MLA_PV(0, p0); MLA_PV(1, p1); MLA_PV(2, p2); MLA_PV(3, p3); } while (0)
#define MLA_PV(S, P) do { const bf16x8 va = cat8(vtr(vb + (S) * 1024), vtr(vb + (S) * 1024 + 512)), vc = cat8(vtr(vb + MLA_TK * 64 + (S) * 1024), vtr(vb + MLA_TK * 64 + (S) * 1024 + 512)); \
            o0 = __builtin_amdgcn_mfma_f32_32x32x16_bf16(va, P, o0, 0, 0, 0); o1 = __builtin_amdgcn_mfma_f32_32x32x16_bf16(vc, P, o1, 0, 0, 0); } while (0)
    MLA_QK(sa0, sa1, 0, 0);
    int sc = 0, sn = 1, sw = 2;
    constexpr int NT = SEQ / MLA_TK;
    for (int T = 0; T < NT; ++T) {
        const bool has1 = T + 1 < NT, has2 = T + 2 < NT;
        if (has2) MLA_GLOAD(T + 2);
        MLA_STEP(sa0, sa1, sb0, sb1, true, sc, 1, sc, 0, T == 0);
        MLA_STEP(sb0, sb1, sa0, sa1, has1, sn, 0, sc, 1, false);
        if (has2) MLA_LSTORE(sw);
        __syncthreads();
        const int tmp = sc; sc = sn; sn = sw; sw = tmp;
    }
#undef MAX3
#undef MLA_GLOAD
#undef MLA_LSTORE
#undef MLA_QK
#undef MLA_STEP
#undef MLA_PV
    const float inv = 1.f / xhalf_sum(l);
    bf16_t* op = Y + (rb + qblk * 256 + wid * 32 + q) * 1536 + h * 64 + 4 * hi;
#pragma unroll
    for (int j = 0; j < 4; ++j) {
        u32x2 w0, w1; w0.x = cvt_pk_bf16(o0[4 * j] * inv, o0[4 * j + 1] * inv); w0.y = cvt_pk_bf16(o0[4 * j + 2] * inv, o0[4 * j + 3] * inv);
        w1.x = cvt_pk_bf16(o1[4 * j] * inv, o1[4 * j + 1] * inv); w1.y = cvt_pk_bf16(o1[4 * j + 2] * inv, o1[4 * j + 3] * inv);
        *(u32x2*)(op + 8 * j) = w0; *(u32x2*)(op + 32 + 8 * j) = w1;
    }
}
}
constexpr int NWAVES = 8, NTHREADS = 512;
constexpr int LDS_BYTES = 147456;
constexpr int MISC_OFF = 131072 + 320;
#define LDS_WAIT() asm volatile("s_waitcnt lgkmcnt(0)" ::: "memory")

struct Args { const float* in[22]; float* out; unsigned char* ws; int ph_lo, ph_hi; };

enum { MAP_ID = 0, MAP_WIN, MAP_WUQ, MAP_WUKV, MAP_GATE, MAP_UP, MAP_WIN8 };
__device__ __forceinline__ int map_row(int map, int n) {
    if (map == MAP_WIN || map == MAP_WIN8) {
        const int o = map == MAP_WIN8 ? P1_F8_FROM * 256 : 0;
        if (n < 384) return n - o;
        if (n < 416) { const int i = n - 384; return 384 + (i < 16 ? 2 * i : 2 * (i - 16) + 1) - o; }
        return n + 96 - o;
    }
    if (map == MAP_WUQ) { const int h = n / 96, j = n % 96; if (j < 64) return n; const int i = j - 64; return h * 96 + 64 + (i < 16 ? 2 * i : 2 * (i - 16) + 1); }
    if (map == MAP_WUKV) { const int h = n >> 7, j = n & 127; return j < 64 ? h * 64 + j : 512 + h * 64 + (j - 64); }
    if (map == MAP_GATE) return (n >> 7) * 256 + (n & 127);
    if (map == MAP_UP) return (n >> 7) * 256 + 128 + (n & 127);
    return n;
}
template <bool F8 = false>
__device__ __forceinline__ void cvt_item(const float* src, int ldsrc, int nblk, const float* gain, float scale, bf16_t* dst, int lddst, int kdst0, int map, LAS float* scr, int item, int lane) {
    const int kb = item / nblk, nb = item % nblk, k0 = 64 * kb, n0 = 32 * nb;
    f32x4 v[8]; float gs[8];
#pragma unroll
    for (int i = 0; i < 8; ++i) { const int idx = i * 64 + lane, kk = idx >> 3, c4 = idx & 7; v[i] = *(const f32x4*)(src + (size_t)(k0 + kk) * ldsrc + n0 + 4 * c4); gs[i] = gain ? gain[k0 + kk] * scale : scale; }
#pragma unroll
    for (int i = 0; i < 8; ++i) { const int idx = i * 64 + lane, kk = idx >> 3, c4 = idx & 7; LAS float* d = scr + kk * 33 + 4 * c4; d[0] = v[i].x * gs[i]; d[1] = v[i].y * gs[i]; d[2] = v[i].z * gs[i]; d[3] = v[i].w * gs[i]; }
    LDS_WAIT(); asm volatile("" ::: "memory");
    const int c = lane & 7;
#pragma unroll
    for (int j = 0; j < 4; ++j) { const int n = (lane >> 3) + 8 * j; const LAS float* s = scr + (8 * c) * 33 + n;
        u32x4 o; o.x = cvt_pk_bf16(s[0 * 33], s[1 * 33]); o.y = cvt_pk_bf16(s[2 * 33], s[3 * 33]); o.z = cvt_pk_bf16(s[4 * 33], s[5 * 33]); o.w = cvt_pk_bf16(s[6 * 33], s[7 * 33]);
        if constexpr (F8) { u32x2 o8; o8.x = pk_fp8x4(s[0 * 33], s[1 * 33], s[2 * 33], s[3 * 33]); o8.y = pk_fp8x4(s[4 * 33], s[5 * 33], s[6 * 33], s[7 * 33]);
            *(u32x2*)((unsigned char*)dst + (size_t)map_row(map, n0 + n) * lddst + kdst0 + k0 + 8 * c) = o8; }
        else *(u32x4*)(dst + (size_t)map_row(map, n0 + n) * lddst + kdst0 + k0 + 8 * c) = o; }
    LDS_WAIT(); asm volatile("" ::: "memory");
}

struct Ctx {
    LAS unsigned char* lds; int tid, lane, wave, vcu, G, gw, NGW;
    const float* const* in; float* out; unsigned char* ws;
};

__device__ __forceinline__ void phase_prologue(const Ctx& C) {
    LAS float* scr = (LAS float*)(C.lds + C.wave * 16384);
    unsigned char* ws = C.ws;
    constexpr int I_IN = 16 * 181, I_UQ = 4 * 24, I_UKV = 2 * 32, I_BR = 8 * 32, I_OUT = 16 * 32, I_L = I_IN + I_UQ + I_UKV + 3 * I_BR + I_OUT;
    constexpr int I_G = 16 * 88, I_D = 44 * 32, NIT = 2 * I_L + 2 * I_G + I_D;
    for (int it = C.gw; it < NIT; it += C.NGW) {
        int r = it;
        if (r < 2 * I_L) { const int l = r / I_L; r -= l * I_L;
            if (r < I_IN) { if (r % 181 >= (P1_F8_FROM <= 1 ? P1_F8_FROM * 8 : (P1_F8_FROM * 256 - 96) / 32)) cvt_item<true>(C.in[2] + (size_t)l * DM * INC, INC, 181, C.in[1] + l * DM, 256.f, (bf16_t*)(ws + WS_WIN8 + l * SZ_WIN8), DM, 0, MAP_WIN8, scr, r, C.lane);
                            else cvt_item(C.in[2] + (size_t)l * DM * INC, INC, 181, C.in[1] + l * DM, 1.f, (bf16_t*)(ws + WS_WIN + l * SZ_WIN), DM, 0, MAP_WIN, scr, r, C.lane); continue; } r -= I_IN;
            if (r < I_UQ) { cvt_item(C.in[4] + (size_t)l * 256 * 768, 768, 24, C.in[3] + l * 256, 0.10206207261596577f * LOG2E, (bf16_t*)(ws + WS_WUQ + l * SZ_WUQ), 256, 0, MAP_WUQ, scr, r, C.lane); continue; } r -= I_UQ;
            if (r < I_UKV) { cvt_item(C.in[6] + (size_t)l * 128 * 1024, 1024, 32, C.in[5] + l * 128, 1.f, (bf16_t*)(ws + WS_WUKV + l * SZ_WUKV), 256, 0, MAP_WUKV, scr, r, C.lane); continue; } r -= I_UKV;
            if (r < 3 * I_BR) { const int br = r / I_BR; r -= br * I_BR; cvt_item(C.in[9 + br] + (size_t)l * 512 * DM, DM, 32, nullptr, 1.f, (bf16_t*)(ws + WS_WBR + l * SZ_WBR), 1536, br * 512, MAP_ID, scr, r, C.lane); continue; } r -= 3 * I_BR;
            cvt_item(C.in[12] + (size_t)l * DM * DM, DM, 32, nullptr, 1.f, (bf16_t*)(ws + WS_WOUT + l * SZ_WOUT), DM, 0, MAP_ID, scr, r, C.lane); continue; }
        r -= 2 * I_L;
        if (r < I_G) { cvt_item(C.in[14], DFF, 88, C.in[13], 1.f, (bf16_t*)(ws + WS_WGU), DM, 0, MAP_GATE, scr, r, C.lane); continue; } r -= I_G;
        if (r < I_G) { cvt_item(C.in[15], DFF, 88, C.in[13], 1.f, (bf16_t*)(ws + WS_WGU), DM, 0, MAP_UP, scr, r, C.lane); continue; } r -= I_G;
        cvt_item(C.in[16], DM, 32, nullptr, 1.f, (bf16_t*)(ws + WS_WD), DFF, 0, MAP_ID, scr, r, C.lane);
    }
    const int gt = C.vcu * NTHREADS + C.tid, NGT = C.G * NTHREADS;
    if (P1_F8_FROM <= 1) for (int i = gt; i < 2 * 6144; i += NGT) { const int l = i / 6144, r = i % 6144; const u32x4 z = {0u, 0u, 0u, 0u}; *(u32x4*)(ws + WS_WIN8 + l * SZ_WIN8 + (size_t)(416 - P1_F8_FROM * 256) * DM + (size_t)r * 16) = z; }
    for (int i = gt; i < 2 * (12288 + 16384); i += NGT) { const int l = i / (12288 + 16384); int r = i % (12288 + 16384); const u32x4 z = {0u, 0u, 0u, 0u};
        if (r < 12288) *(u32x4*)(ws + WS_WIN + l * SZ_WIN + (size_t)416 * DM * 2 + (size_t)r * 16) = z;
        else { r -= 12288; *(u32x4*)(ws + WS_WUKV + l * SZ_WUKV + (size_t)(r >> 4) * 512 + 256 + (r & 15) * 16) = z; } }
    float* cosT = (float*)(ws + WS_TAB); float* sinT = cosT + SEQ * 16; float* tabb = sinT + SEQ * 16;
    for (int i = gt; i < SEQ * 16; i += NGT) { const int pos = i >> 4, k = i & 15; const float inv = powf(10000.f, -(float)k / 16.f); const float ang = (float)pos * inv; cosT[i] = cosf(ang); sinT[i] = sinf(ang); }
    for (int i = gt; i < 4 * 8 * att::TAB_STRIDE; i += NGT) { const int kind = i / (8 * att::TAB_STRIDE), h = (i / att::TAB_STRIDE) & 7, idx = i % att::TAB_STRIDE;
        const int R = kind == 3 ? 128 : 64, dil = kind == 1 ? 4 : (kind == 2 ? 16 : 1), rel = idx - (R + 31);
        float v = NEGB; if (rel >= -R && rel <= R) v = C.in[8][t5_bucket(rel * dil) * 16 + (kind == 3 ? 8 : 0) + h] * LOG2E;
        tabb[i] = v; }
    const float* x = C.in[0]; bf16_t* xb = (bf16_t*)(ws + WS_XB); float* st = (float*)(ws + WS_ST);
    for (int row = 2 * C.gw; row < MTOK; row += 2 * C.NGW) {
        const f32x4* xr = (const f32x4*)(x + (size_t)row * DM) + C.lane; f32x4 v[8];
#pragma unroll
        for (int j = 0; j < 8; ++j) v[j] = xr[64 * j];
        float s0 = 0.f, s1 = 0.f;
#pragma unroll
        for (int j = 0; j < 8; ++j) { const float q = (v[j].x * v[j].x + v[j].y * v[j].y) + (v[j].z * v[j].z + v[j].w * v[j].w); if (j < 4) s0 += q; else s1 += q;
            u32x2 w; w.x = cvt_pk_bf16(v[j].x, v[j].y); w.y = cvt_pk_bf16(v[j].z, v[j].w); *((u32x2*)(xb + (size_t)row * DM) + C.lane + 64 * j) = w;
            if (P1_F8_FROM < 23) *((unsigned*)(ws + WS_XB8P + (size_t)(row + (j >> 2)) * DM) + C.lane + 64 * (j & 3)) = pk_fp8x4(v[j].x * 16.f, v[j].y * 16.f, v[j].z * 16.f, v[j].w * 16.f); }
        s0 = wave_sum(s0); s1 = wave_sum(s1);
        if (C.lane < 32) st[(size_t)row * 16 + C.lane] = C.lane == 0 ? s0 : (C.lane == 16 ? s1 : 0.f);
    }
}

__device__ __forceinline__ void phase_moe_weights(const Ctx& C) {
    LAS float* scr = (LAS float*)(C.lds + 40960 + C.wave * 8704);
    constexpr int I_G = 16 * 112, I_D = 56 * 32, I_E = 2 * I_G + I_D;
    for (int it = C.gw; it < NEXP * I_E; it += C.NGW) {
        const int e = it / I_E; int r = it % I_E;
        if (r < I_G) { cvt_item<MOE_F8 != 0>(C.in[18] + (size_t)e * DM * DFE, DFE, 112, C.in[13] + DM, MOE_F8 ? 256.f : 1.f, (bf16_t*)(C.ws + WS_EGU + (size_t)e * 2 * DFE * DM * (MOE_F8 ? 1 : 2)), DM, 0, MAP_GATE, scr, r, C.lane); continue; } r -= I_G;
        if (r < I_G) { cvt_item<MOE_F8 != 0>(C.in[19] + (size_t)e * DM * DFE, DFE, 112, C.in[13] + DM, MOE_F8 ? 256.f : 1.f, (bf16_t*)(C.ws + WS_EGU + (size_t)e * 2 * DFE * DM * (MOE_F8 ? 1 : 2)), DM, 0, MAP_UP, scr, r, C.lane); continue; } r -= I_G;
        cvt_item<MOE_DN_F8 != 0>(C.in[20] + (size_t)e * DFE * DM, DM, 32, nullptr, MOE_DN_F8 ? 1024.f : 1.f, (bf16_t*)(C.ws + WS_ED + (size_t)e * DM * DFE * (MOE_DN_F8 ? 1 : 2)), DFE, 0, MAP_ID, scr, r, C.lane);
    }
}

template <bool SECOND>
__device__ __forceinline__ void phase_band(const Ctx& C, const bf16_t* HM, bf16_t* PB, float* PBS, bf16_t* Y, const float* sink) {
    constexpr int IPK = MC / 2048 * 64, NIT = (SECOND ? 1 : 3) * IPK;
    const float* tabg = (const float*)(C.ws + WS_TAB) + 2 * SEQ * 16;
    att::BandPre P; att::BandItem it, nx;
    int i = C.vcu;
#define BAND_IDX(IDX) (SECOND ? 2 * IPK + (IDX) : ((IDX) < 2 * IPK ? (IDX) : (IDX) + IPK))
    if (i < NIT) { it = att::band_decode(BAND_IDX(i), IPK); att::band_issue(P, it, HM, tabg, C.tid, C.wave, C.lane); }
    for (; i < NIT; i += C.G) {
        att::band_store(P, it, C.lds, C.tid);
        bf16x8 qf[4];
#pragma unroll
        for (int d0 = 0; d0 < 4; ++d0) qf[d0] = P.q[d0];
        __syncthreads();
        const bool more = i + C.G < NIT;
        if (more) { nx = att::band_decode(BAND_IDX(i + C.G), IPK); att::band_issue(P, nx, HM, tabg, C.tid, C.wave, C.lane); }
        const int q = C.lane & 31, hi = C.lane >> 5, w = C.wave;
        if (it.kind == 3) {
            const int h = it.hh * 4 + (w >> 1), a0w = it.a0 + 32 * (w & 1); const size_t rowq = (size_t)it.b * SEQ + a0w + q;
            att::band_compute<9, 1>(qf, C.lds, 128 - it.a0, a0w, SEQ, (const LAS float*)(C.lds + att::BW_TAB) + (w >> 1) * att::TAB_STRIDE, Y + rowq * 1536 + 1024 + h * 64 + 4 * hi, nullptr, sink[h] * LOG2E, C.lane);
        } else if (it.kind == 2) {
            const int a0w = 32 * (w & 3), g = it.g0 + (w >> 2); const size_t rowq = (size_t)it.b * SEQ + (size_t)(a0w + q) * 16 + g;
            const size_t po = rowq * 512 + it.hh * 64 + 4 * hi, so = (rowq * 8 + it.hh) * 2;
            att::band_compute<5, 2>(qf, C.lds, (w >> 2) * 128, a0w, 128, (const LAS float*)(C.lds + att::BW_TAB), Y + rowq * 1536 + 512 + it.hh * 64 + 4 * hi, nullptr, 0.f, C.lane,
                                    PB + po, PB + (size_t)MC * 512 + po, PBS + so, PBS + (size_t)MC * 16 + so);
        } else {
            const int a0w = it.a0 + 32 * w, dil = it.kind == 0 ? 1 : 4, L = SEQ / dil, rowoff = 64 - it.a0;
            const size_t rowq = (size_t)it.b * SEQ + (size_t)(a0w + q) * dil + it.g0;
            att::band_compute<5, 0>(qf, C.lds, rowoff, a0w, L, (const LAS float*)(C.lds + att::BW_TAB), PB + (size_t)it.kind * MC * 512 + rowq * 512 + it.hh * 64 + 4 * hi,
                                    PBS + (size_t)it.kind * MC * 16 + (rowq * 8 + it.hh) * 2, 0.f, C.lane);
        }
        __syncthreads();
        it = nx;
    }
#undef BAND_IDX
}

__device__ __forceinline__ void phase_mla(const Ctx& C, const bf16_t* Q, const bf16_t* KV, const bf16_t* Zc, bf16_t* Y) {
    constexpr int NU = MC / 256 * 8;
    for (int u = C.vcu; u < NU; u += C.G) { const int qblk = u & 7, bh = u >> 3; att::mla_unit(Q, KV, Zc, Y, bh >> 3, bh & 7, qblk, C.lds, C.tid, C.wave, C.lane); }
}

__device__ __forceinline__ void phase_route(const Ctx& C) {
    LAS float* wr = (LAS float*)C.lds; LAS int* cnt = (LAS int*)(C.lds + 32768);
    const float* g2 = C.in[13] + DM; const float* router = C.in[17];
    for (int i = C.tid; i < DM * 8; i += NTHREADS) wr[i] = router[i] * g2[i >> 3];
    if (C.tid < 16) cnt[C.tid] = 0;
    __syncthreads();
    int* sel = (int*)(C.ws + WS_SEL); float* gwp = (float*)(C.ws + WS_GW); float* rr = (float*)(C.ws + WS_RR);
    const int w = blockIdx.x;
    for (int j = 0; j < 16; ++j) {
        const int tok = w * 128 + C.wave * 16 + j;
        const u32x2* xr = (const u32x2*)((const bf16_t*)(C.ws + WS_XB) + (size_t)tok * DM) + C.lane;
        float lg[8], ss = 0.f;
#pragma unroll
        for (int e = 0; e < 8; ++e) lg[e] = 0.f;
#pragma unroll
        for (int q = 0; q < 4; ++q) { const u32x2 wv = xr[64 * q]; const f32x4 v = {bf_lo(wv.x), bf_hi(wv.x), bf_lo(wv.y), bf_hi(wv.y)}; ss += (v.x * v.x + v.y * v.y) + (v.z * v.z + v.w * v.w);
            const int k = 4 * C.lane + 256 * q;
            if (MOE_F8) *(unsigned*)(C.ws + WS_XB8 + (size_t)tok * DM + k) = pk_fp8x4(v.x * 16.f, v.y * 16.f, v.z * 16.f, v.w * 16.f);
#pragma unroll
            for (int c = 0; c < 4; ++c) { const float xv = v[c]; const f32x4 w0 = *(const LAS f32x4*)(wr + (k + c) * 8), w1 = *(const LAS f32x4*)(wr + (k + c) * 8 + 4);
                lg[0] += xv * w0.x; lg[1] += xv * w0.y; lg[2] += xv * w0.z; lg[3] += xv * w0.w; lg[4] += xv * w1.x; lg[5] += xv * w1.y; lg[6] += xv * w1.z; lg[7] += xv * w1.w; } }
        ss = wave_sum(ss);
#pragma unroll
        for (int e = 0; e < 8; ++e) lg[e] = wave_sum(lg[e]);
        const float r = rsqrtf(ss * (1.f / 1024.f) + EPS);
        if (C.lane == 0) {
            int i1 = 0; float v1 = lg[0];
#pragma unroll
            for (int e = 1; e < 8; ++e) if (lg[e] > v1) { v1 = lg[e]; i1 = e; }
            int i2 = -1; float v2 = -3e38f;
#pragma unroll
            for (int e = 0; e < 8; ++e) if (e != i1 && lg[e] > v2) { v2 = lg[e]; i2 = e; }
            const float e2 = expf((v2 - v1) * r);
            sel[tok * 2] = i1; sel[tok * 2 + 1] = i2; gwp[tok * 2] = 1.f / (1.f + e2); gwp[tok * 2 + 1] = e2 / (1.f + e2); rr[tok] = r;
            __hip_atomic_fetch_add(&cnt[i1], 1, __ATOMIC_RELAXED, __HIP_MEMORY_SCOPE_WORKGROUP); __hip_atomic_fetch_add(&cnt[8 + i2], 1, __ATOMIC_RELAXED, __HIP_MEMORY_SCOPE_WORKGROUP);
        }
    }
    __syncthreads();
    if (C.tid < 16) ((int*)(C.ws + WS_META))[MI_CNT + (C.tid >> 3) * 2048 + w * 8 + (C.tid & 7)] = cnt[C.tid];
}

__device__ __forceinline__ void phase_sort(const Ctx& C) {
    LAS int* tot = (LAS int*)C.lds; LAS int* pre = tot + 16; LAS int* base = tot + 32;
    int* meta = (int*)(C.ws + WS_META); const int w = blockIdx.x;
    if (C.tid < 16) { const int k = C.tid >> 3, e = C.tid & 7; int t = 0, p = 0;
        for (int w2 = 0; w2 < 256; ++w2) { const int c = meta[MI_CNT + k * 2048 + w2 * 8 + e]; t += c; if (w2 < w) p += c; }
        tot[C.tid] = t; pre[C.tid] = p; }
    __syncthreads();
    if (C.tid < 16) { const int k = C.tid >> 3, e = C.tid & 7; int b = 0; for (int e2 = 0; e2 < e; ++e2) b += (tot[k * 8 + e2] + 255) & ~255; base[C.tid] = b; }
    __syncthreads();
    const int* sel = (const int*)(C.ws + WS_SEL); const float* gwp = (const float*)(C.ws + WS_GW);
    int* rowtok = (int*)(C.ws + WS_ROWTOK); float* rowgw = (float*)(C.ws + WS_ROWGW); float* rowrr = (float*)(C.ws + WS_ROWRR); const float* rr = (const float*)(C.ws + WS_RR);
    if (C.wave < 2) { const int k = C.wave; LAS int* runL = tot + 48 + k * 8;
        if (C.lane < 8) runL[C.lane] = base[k * 8 + C.lane] + pre[k * 8 + C.lane];
        for (int j = 0; j < 2; ++j) { const int tok = w * 128 + j * 64 + C.lane; const int e = sel[tok * 2 + k]; int pos = 0;
#pragma unroll 1
            for (int e2 = 0; e2 < 8; ++e2) { const unsigned long long mk = __ballot(e == e2); const int r0 = runL[e2]; const int rank = __popcll(mk & ((1ull << C.lane) - 1ull));
                if (e == e2) pos = r0 + rank; if (C.lane == 0) runL[e2] = r0 + __popcll(mk); }
            rowtok[k * MOE_ROWS + pos] = tok; rowgw[k * MOE_ROWS + pos] = gwp[tok * 2 + k]; rowrr[k * MOE_ROWS + pos] = rr[tok]; } }
    if (w < 16) { const int k = w >> 3, e = w & 7; const int t = tot[k * 8 + e], b = base[k * 8 + e], pe = (t + 255) & ~255;
        for (int i = b + t + C.tid; i < b + pe; i += NTHREADS) { rowtok[k * MOE_ROWS + i] = -1; rowgw[k * MOE_ROWS + i] = 0.f; rowrr[k * MOE_ROWS + i] = 0.f; } }
    if (w == 16 && C.tid < 2) { const int k = C.tid; int nt = 0;
        for (int e = 0; e < 8; ++e) { const int n = (tot[k * 8 + e] + 255) >> 8; for (int i = 0; i < n; ++i) meta[MI_TILEE + k * 160 + nt + i] = e; nt += n; }
        meta[MI_NTILE + k] = nt; }
}

__device__ __forceinline__ void phase_final(const Ctx& C) {
    const float* g = C.in[21];
    for (int row = 2 * C.gw; row < MTOK; row += 2 * C.NGW) {
        f32x4 v[8]; float s0 = 0.f, s1 = 0.f;
#pragma unroll
        for (int j = 0; j < 8; ++j) { const u32x2 wv = ((const u32x2*)xm_row(C.ws, row + (j >> 2)))[C.lane + 64 * (j & 3)]; v[j] = (f32x4){bf_lo(wv.x), bf_hi(wv.x), bf_lo(wv.y), bf_hi(wv.y)}; }
#ifdef PROBE_NAN
#pragma unroll
        for (int j = 0; j < 8; ++j) { v[j].x = v[j].x == v[j].x && fabsf(v[j].x) < 1e30f ? v[j].x : 0.f; v[j].y = v[j].y == v[j].y && fabsf(v[j].y) < 1e30f ? v[j].y : 0.f; v[j].z = v[j].z == v[j].z && fabsf(v[j].z) < 1e30f ? v[j].z : 0.f; v[j].w = v[j].w == v[j].w && fabsf(v[j].w) < 1e30f ? v[j].w : 0.f; }
#endif
#pragma unroll
        for (int j = 0; j < 8; ++j) { const float q = (v[j].x * v[j].x + v[j].y * v[j].y) + (v[j].z * v[j].z + v[j].w * v[j].w); if (j < 4) s0 += q; else s1 += q; }
        const float r0 = rsqrtf(wave_sum(s0) * (1.f / 1024.f) + EPS), r1 = rsqrtf(wave_sum(s1) * (1.f / 1024.f) + EPS);
        f32x4* orow = (f32x4*)(C.out + (size_t)row * DM) + C.lane;
#pragma unroll
        for (int j = 0; j < 8; ++j) orow[64 * j] = v[j] * (j < 4 ? r0 : r1) * ((const f32x4*)g)[C.lane + 64 * (j & 3)];
    }
}
#ifndef MKP
#define MKP 0x1ffff
#endif
#ifndef ALEPI
#define ALEPI true
#endif
#ifndef ALEPI1
#define ALEPI1 ALEPI
#endif
#ifndef DUPK
#define DUPK 0
#endif
#ifdef PROBE_TIMER
#define PROBE_T0 __syncthreads(); const unsigned long long pt0_ = __builtin_amdgcn_s_memrealtime()
#define PROBE_T1(slot) __syncthreads(); if (threadIdx.x == 0) { const unsigned long long pt1_ = __builtin_amdgcn_s_memrealtime(); atomicAdd((unsigned*)(ws + WS_CTL) + CW_Q + 2048 + (slot), (unsigned)(pt1_ - pt0_)); }
#else
#define PROBE_T0
#define PROBE_T1(slot)
#endif
#define REP(bit) for (int rep_ = 0; rep_ < ((DUPK & (bit)) ? 2 : 1); ++rep_)
constexpr int PH_PER_CHUNK = 3, PH_LAYER_TAIL = 2;
constexpr int PH_L0 = 1, PH_FFN = PH_L0 + PH_PER_CHUNK * NCHUNK + PH_LAYER_TAIL, PH_L1 = PH_FFN + 2, PH_MOE = PH_L1 + PH_PER_CHUNK * NCHUNK + PH_LAYER_TAIL, PH_FINAL = PH_MOE + (MOE_NOSPLIT ? 5 : 7), PH_TOTAL = PH_FINAL + 1;

__global__ void __launch_bounds__(NTHREADS, 2) mega(Args args) {
    extern __shared__ __attribute__((aligned(16))) unsigned char lds_raw[];
#define MKCTX Ctx C; { int t_ = threadIdx.x; asm volatile("" : "+v"(t_)); C.lds = (LAS unsigned char*)lds_raw; C.tid = t_; C.lane = t_ & 63; C.wave = __builtin_amdgcn_readfirstlane(t_ >> 6); \
    C.G = gridDim.x; { const int bx = blockIdx.x; C.vcu = (C.G % 8 == 0) ? (bx % 8) * (C.G / 8) + bx / 8 : bx; } \
    C.gw = C.vcu * NWAVES + C.wave; C.NGW = C.G * NWAVES; C.in = args.in; C.out = args.out; C.ws = args.ws; }
    volatile LAS unsigned* MISC = (volatile LAS unsigned*)((LAS unsigned char*)lds_raw + MISC_OFF);
    if (threadIdx.x < 32) MISC[threadIdx.x] = 0u;
    __syncthreads();
    unsigned char* ws = args.ws;
    XcdBarrier bar; bar.bar = (unsigned*)(ws + WS_CTL) + CW_BAR; bar.x = 0; bar.st = nullptr;
    const int lo = args.ph_lo, hi = args.ph_hi;
    const bool use_bar = (hi - lo) > 1;
    if (use_bar) bar = xcd_barrier_post((unsigned*)(ws + WS_CTL) + CW_BAR, MISC + 8);
    int ph = 0;
#define IN_PH (ph >= lo && ph < hi)
#ifdef PROBE_BAR
    const unsigned long long pk0_ = __builtin_amdgcn_s_memrealtime();
#define END_PH do { if (ph >= lo && ph + 1 < hi) { __syncthreads(); const unsigned long long pb0_ = __builtin_amdgcn_s_memrealtime(); xcd_barrier(bar); \
        if (threadIdx.x == 0 && (((unsigned)(PROBE_BAR) >> ph) & 1u)) atomicAdd((unsigned*)(ws + WS_CTL) + CW_Q + 2048, (unsigned)(__builtin_amdgcn_s_memrealtime() - pb0_)); } ++ph; } while (0)
#else
#define END_PH do { if (ph >= lo && ph + 1 < hi) xcd_barrier(bar); ++ph; } while (0)
#endif

    bf16_t* xb = (bf16_t*)(ws + WS_XB); float* st = (float*)(ws + WS_ST);
    const float* cosT = (const float*)(ws + WS_TAB); const float* sinT = cosT + SEQ * 16;

    if (IN_PH) REP(1) { MKCTX; if (MKP & 1) phase_prologue(C); }
    END_PH;
#ifdef PROBE_SLEEP
    { const unsigned long long t0_ = __builtin_amdgcn_s_memrealtime(); while (__builtin_amdgcn_s_memrealtime() - t0_ < (unsigned long long)(PROBE_SLEEP) * 100ull) __builtin_amdgcn_s_sleep(64); }
#endif

#define CHUNK_BODY(l, c) \
{ \
            const int row0 = c * MC; \
            bf16_t* Z = (bf16_t*)(ws + WS_Z); bf16_t* Q = (bf16_t*)(ws + WS_Q); bf16_t* KV = TMP_IN_OUT ? (bf16_t*)args.out : (bf16_t*)(ws + WS_KV); bf16_t* Y = (bf16_t*)(ws + WS_Y) + (size_t)row0 * 1536; \
            bf16_t* PB = TMP_IN_OUT ? (bf16_t*)args.out + (size_t)MC * 1024 : (bf16_t*)(ws + WS_PB); float* PBS = (float*)(ws + WS_PBS); float* SQ = (float*)(ws + WS_SQ); float* SKV = SQ + (size_t)MC * 4; \
 \
            if (IN_PH && (MKP & 2)) REP(2) { MKCTX; \
                pg8::Gemm g{xb + (size_t)row0 * DM, (const bf16_t*)(ws + WS_WIN + l * SZ_WIN), DM, DM, DM, nullptr}; \
                pg8::StaticOrder S; S.init(MC, P1_F8_FROM * 256, C.G, (int)blockIdx.x); \
                pg8::EpiIn E{Z, st + (size_t)row0 * 16, SQ, SKV, cosT, sinT, ws + WS_GB + (size_t)row0 * 3072, (bf16_t*)(ws + WS_QKV), ws, 0, 1.f}; \
                pg8::gemm_phase<pg8::EpiIn, pg8::StaticOrder, ALEPI1, false>(C.lds, g, S, E); \
            } \
            if (IN_PH && (MKP & 2) && P1_F8_FROM < 23) REP(2) { MKCTX;                          \
                pg8::Gemm g{(const bf16_t*)(ws + WS_XB8P + (size_t)row0 * DM), (const bf16_t*)(ws + WS_WIN8 + l * SZ_WIN8), DM / 2, DM / 2, DM / 2, nullptr}; \
                pg8::StaticOrder S; S.init(MC, (23 - P1_F8_FROM) * 256, C.G, (int)((blockIdx.x + (P1_F8_FROM * (MC / 256)) % 256) % C.G)); \
                pg8::EpiIn E{Z, st + (size_t)row0 * 16, SQ, SKV, cosT, sinT, ws + WS_GB + (size_t)row0 * 3072, (bf16_t*)(ws + WS_QKV), ws, P1_F8_FROM, 1.f / 4096.f}; \
                pg8::gemm_phase<pg8::EpiIn, pg8::StaticOrder, ALEPI1, false, false, true>(C.lds, g, S, E); \
            } \
            END_PH; \
 \
            if (IN_PH) { \
                if (MKP & 4) REP(4) { MKCTX; pg8::Gemm g{Z + ZO_CQ, (const bf16_t*)(ws + WS_WUQ + l * SZ_WUQ), 256, ZW, 256, nullptr}; \
                  pg8::StaticOrder S; S.init(MC, 768, C.G, (int)blockIdx.x); \
                  pg8::EpiQ E{Q, SQ, cosT, sinT}; \
                  pg8::gemm_phase<pg8::EpiQ, pg8::StaticOrder, ALEPI, false>(C.lds, g, S, E); } \
                if (MKP & 8) REP(8) { MKCTX; pg8::Gemm g{Z + ZO_CKV, (const bf16_t*)(ws + WS_WUKV + l * SZ_WUKV), 256, ZW, 256, nullptr}; \
                  pg8::StaticOrder S; S.init(MC, 1024, C.G, (int)((blockIdx.x + 128) % C.G)); \
                  pg8::EpiKV E{KV, SKV}; \
                  pg8::gemm_phase<pg8::EpiKV, pg8::StaticOrder, ALEPI, false>(C.lds, g, S, E); } \
                if (MKP & 16) REP(16) { MKCTX; phase_band<false>(C, (const bf16_t*)(ws + WS_QKV), PB, PBS, Y, C.in[7] + l * 8); } \
            } \
            END_PH; \
 \
            if (IN_PH) { \
                if (MKP & 32) REP(32) { MKCTX; phase_band<true>(C, (const bf16_t*)(ws + WS_QKV), PB, PBS, Y, C.in[7] + l * 8); } \
                if (MKP & 64) REP(64) { MKCTX; PROBE_T0; phase_mla(C, Q, KV, Z, Y); PROBE_T1(rep_); } \
            } \
            END_PH; \
 \
}
#define LAYER_TAIL(l) \
{ const int row0 = 0; bf16_t* MG = (bf16_t*)(ws + WS_MG); bf16_t* Y = (bf16_t*)(ws + WS_Y); (void)Y; \
            if (IN_PH && (MKP & 128)) REP(128) { MKCTX; \
                pg8::Gemm g{Y, (const bf16_t*)(ws + WS_WBR + l * SZ_WBR), 1536, 1536, 1536, nullptr}; \
                pg8::StaticOrder S; S.init(MTOK, DM, C.G, (int)blockIdx.x); \
                pg8::EpiBr E{ws + WS_GB, MG, ws}; \
                pg8::gemm_phase<pg8::EpiBr, pg8::StaticOrder, ALEPI, false>(C.lds, g, S, E); \
            } \
            END_PH; \
 \
            if (IN_PH && (MKP & 256)) REP(l == 0 ? 256 : 0) { MKCTX; \
                pg8::Gemm g{MG, (const bf16_t*)(ws + WS_WOUT + l * SZ_WOUT), DM, DM, DM, nullptr}; \
                pg8::StaticOrder S; S.init(MTOK, DM, C.G, (int)blockIdx.x); \
                pg8::EpiRes<false> E{xb, st, row0, nullptr}; pg8::gemm_phase<pg8::EpiRes<false>, pg8::StaticOrder, ALEPI, false, true>(C.lds, g, S, E); \
            } \
            END_PH; \
}
#define FFN_BODY() \
{ \
            bf16_t* ACT = (bf16_t*)(ws + WS_ACT); \
            if (IN_PH && (MKP & 512)) REP(512) { MKCTX; \
                pg8::Gemm g{xb, (const bf16_t*)(ws + WS_WGU), DM, DM, DM, nullptr}; \
                pg8::StaticOrder S; S.init(MTOK, 2 * DFF, C.G, (int)blockIdx.x); \
                pg8::EpiGU E{ACT, st, DFF, ws}; \
                pg8::gemm_phase<pg8::EpiGU, pg8::StaticOrder, ALEPI, false>(C.lds, g, S, E); \
            } \
            END_PH; \
            if (IN_PH && (MKP & 1024)) { MKCTX; \
                pg8::Gemm g{ACT, (const bf16_t*)(ws + WS_WD), DFF, DFF, DFF, nullptr}; \
                pg8::StaticOrder S; S.init(MTOK, DM, C.G, (int)blockIdx.x); \
                pg8::EpiRes<(P1_F8_FROM < 23)> E{xb, st, 0, ws + WS_XB8P};                                \
                pg8::gemm_phase<pg8::EpiRes<(P1_F8_FROM < 23)>, pg8::StaticOrder, ALEPI, false, true>(C.lds, g, S, E); \
            } \
            END_PH; \
}
#define MOE_HEAD() \
{ \
            if (IN_PH) { if (MKP & 2048) REP(2048) { MKCTX; phase_route(C); } if (MKP & 4096) REP(4096) { MKCTX; phase_moe_weights(C); } } \
            END_PH; \
            if (IN_PH && (MKP & 8192)) { MKCTX; phase_sort(C); } \
            END_PH; \
}
#define MOE_GU(kh, dyn) { const int k = MOE_NOSPLIT ? (kh) : (kh) >> 1, half = MOE_NOSPLIT ? 0 : (kh) & 1; MKCTX; \
        const int* rowtok = (const int*)(ws + WS_ROWTOK) + k * MOE_ROWS; \
        bf16_t* MACT = (bf16_t*)(ws + WS_MACT + (MOE_NOSPLIT ? (size_t)k * MOE_ROWS * DFE : (size_t)half * MOE_ROWS * DF0 * (MOE_DN_F8 ? 1 : 2))); const int dfw = MOE_NOSPLIT ? DFE : (half ? DF1 : DF0); \
        pg8::Gemm g{MOE_F8 ? (const bf16_t*)(ws + WS_XB8) : xb, (const bf16_t*)(ws + WS_EGU), MOE_F8 ? DM / 2 : DM, MOE_F8 ? DM / 2 : DM, MOE_F8 ? DM / 2 : DM, rowtok}; \
        pg8::DynMoeOrder S{(unsigned*)(ws + WS_CTL) + CW_Q + 64 * (kh), (volatile LAS int*)(C.lds + MISC_OFF + 64), meta[MI_NTILE + k], dfw / 128, 28, half ? DF0 / 128 : 0, meta + MI_TILEE + k * 160, C.vcu}; \
        pg8::EpiGUMoe E{MACT, (const float*)(ws + WS_ROWRR) + k * MOE_ROWS, dfw, ws}; \
        pg8::gemm_phase<pg8::EpiGUMoe, pg8::DynMoeOrder, ALEPI, true, false, MOE_F8 != 0>(C.lds, g, S, E); }
#define MOE_DN(kh) { const int k = MOE_NOSPLIT ? (kh) : (kh) >> 1, half = MOE_NOSPLIT ? 0 : (kh) & 1; MKCTX; \
        const int* rowtok = (const int*)(ws + WS_ROWTOK) + k * MOE_ROWS; const float* rowgw = (const float*)(ws + WS_ROWGW) + k * MOE_ROWS; \
        bf16_t* MACT = (bf16_t*)(ws + WS_MACT + (MOE_NOSPLIT ? (size_t)k * MOE_ROWS * DFE : (size_t)half * MOE_ROWS * DF0 * (MOE_DN_F8 ? 1 : 2))); const int dfw = MOE_NOSPLIT ? DFE : (half ? DF1 : DF0); \
        pg8::Gemm g{MACT, (const bf16_t*)(ws + WS_ED + (size_t)half * DF0 * (MOE_DN_F8 ? 1 : 2)), MOE_DN_F8 ? dfw / 2 : dfw, MOE_DN_F8 ? dfw / 2 : dfw, MOE_DN_F8 ? DFE / 2 : DFE, nullptr}; \
        pg8::MoeOrder S{meta[MI_NTILE + k], 4, C.G, (int)blockIdx.x, 4, 0, meta + MI_TILEE + k * 160}; \
        if ((kh) == 0) { pg8::EpiDnMoe<true> E{ws, rowtok, rowgw}; pg8::gemm_phase<pg8::EpiDnMoe<true>, pg8::MoeOrder, ALEPI, false, true, MOE_DN_F8 != 0>(C.lds, g, S, E); } \
        else { pg8::EpiDnMoe<false> E{ws, rowtok, rowgw}; pg8::gemm_phase<pg8::EpiDnMoe<false>, pg8::MoeOrder, ALEPI, false, true, MOE_DN_F8 != 0>(C.lds, g, S, E); } }
    CHUNK_BODY(0, 0)
#if CHB < 16
    CHUNK_BODY(0, 1)
#endif
#if CHB < 8
    CHUNK_BODY(0, 2)
    CHUNK_BODY(0, 3)
#endif
    LAYER_TAIL(0)
    FFN_BODY()
    CHUNK_BODY(1, 0)
#if CHB < 16
    CHUNK_BODY(1, 1)
#endif
#if CHB < 8
    CHUNK_BODY(1, 2)
    CHUNK_BODY(1, 3)
#endif
    LAYER_TAIL(1)
    MOE_HEAD()
    { const int* meta = (const int*)(ws + WS_META);
    if (IN_PH) { if (MKP & 16384) REP(16384) MOE_GU(0, 1) }
    END_PH;
    if (IN_PH) { if (MKP & 32768) MOE_DN(0) if (MKP & 16384) MOE_GU(1, 1) }
    END_PH;
#if !MOE_NOSPLIT
    if (IN_PH) { if (MKP & 32768) MOE_DN(1) if (MKP & 16384) MOE_GU(2, 1) }
    END_PH;
    if (IN_PH) { if (MKP & 32768) MOE_DN(2) if (MKP & 16384) MOE_GU(3, 1) }
    END_PH;
    if (IN_PH) { if (MKP & 32768) MOE_DN(3) }
    END_PH;
#else
    if (IN_PH) { if (MKP & 32768) MOE_DN(1) }
    END_PH;
#endif
    }
    if (IN_PH && (MKP & 65536)) { MKCTX; phase_final(C); }
    END_PH;
#ifdef PROBE_BAR
    { if (threadIdx.x == 0) atomicAdd((unsigned*)(ws + WS_CTL) + CW_Q + 2049, (unsigned)(__builtin_amdgcn_s_memrealtime() - pk0_));
      xcd_barrier(bar);
      const unsigned* tim = (const unsigned*)(ws + WS_CTL) + CW_Q + 2048;
      const float ta = (float)__hip_atomic_load(tim, __ATOMIC_RELAXED, __HIP_MEMORY_SCOPE_AGENT), tb = (float)__hip_atomic_load(tim + 1, __ATOMIC_RELAXED, __HIP_MEMORY_SCOPE_AGENT);
      float code = (float)(PROBE_UNIT) * ta / tb;
      code = fminf(98.f, fmaxf(1.f, rintf(code))); const float v = sqrtf(code);
      for (size_t i = (size_t)blockIdx.x * NTHREADS + threadIdx.x; i < (size_t)MTOK * DM; i += (size_t)gridDim.x * NTHREADS) args.out[i] = v; }
#endif
#ifdef PROBE_TIMER
    { xcd_barrier(bar);
      const unsigned* tim = (const unsigned*)(ws + WS_CTL) + CW_Q + 2048;
      const float ta = (float)__hip_atomic_load(tim, __ATOMIC_RELAXED, __HIP_MEMORY_SCOPE_AGENT), tb = (float)__hip_atomic_load(tim + 1, __ATOMIC_RELAXED, __HIP_MEMORY_SCOPE_AGENT);
      float code = PROBE_TIMER == 1 ? 10.f * ta / tb : (PROBE_TIMER == 2 ? ta * (1.f / (256.f * 100.f * 10.f)) : tb * (1.f / (256.f * 100.f * 10.f)));
      code = fminf(98.f, fmaxf(1.f, rintf(code))); const float v = sqrtf(code);
      for (size_t i = (size_t)blockIdx.x * NTHREADS + threadIdx.x; i < (size_t)MTOK * DM; i += (size_t)gridDim.x * NTHREADS) args.out[i] = v; }
#endif
#undef IN_PH
#undef END_PH
}
#if !MK_DEBUG
extern "C" void kernel_launch(void* const* d_in, const int* in_sizes, int n_in, void* d_out, int out_size, void* d_ws, size_t ws_size, hipStream_t stream) {
    static int grid = 0;
    if (grid == 0) {
        if (n_in != 22 || out_size != MTOK * DM || ws_size < WS_NEED) { fprintf(stderr, "kernel_launch: unexpected shapes / workspace (%zu < %zu); nothing launched\n", ws_size, (size_t)WS_NEED); grid = -1; return; }
        int dev = 0, cus = 0, per_cu = 0;
        if (hipGetDevice(&dev) != hipSuccess || hipDeviceGetAttribute(&cus, hipDeviceAttributeMultiprocessorCount, dev) != hipSuccess) { grid = -1; return; }
        if (hipFuncSetAttribute((const void*)mega, hipFuncAttributeMaxDynamicSharedMemorySize, LDS_BYTES) != hipSuccess) { fprintf(stderr, "kernel_launch: hipFuncSetAttribute failed\n"); grid = -1; return; }
        if (hipOccupancyMaxActiveBlocksPerMultiprocessor(&per_cu, (const void*)mega, NTHREADS, LDS_BYTES) != hipSuccess || per_cu < 1) { fprintf(stderr, "kernel_launch: occupancy query says %d\n", per_cu); }
        (void)hipGetLastError();
        grid = cus;
        if (grid != 256) { fprintf(stderr, "kernel_launch: built for 256 CUs, device has %d; nothing launched\n", cus); grid = -1; return; }
    }
    if (grid < 0) return;
    if (hipMemsetAsync((char*)d_ws + WS_CTL, 0, CTL_ZERO_BYTES, stream) != hipSuccess) return;
    Args a{};
    for (int i = 0; i < 22; ++i) a.in[i] = (const float*)d_in[i];
    a.out = (float*)d_out; a.ws = (unsigned char*)d_ws; a.ph_lo = 0; a.ph_hi = PH_TOTAL;
    hipLaunchKernelGGL(mega, dim3(grid), dim3(NTHREADS), LDS_BYTES, stream, a);
}
#endif
```

```cpp
#include <hip/hip_runtime.h>
#include <cstdio>
#include <cstdint>
#include <cmath>

#ifndef MK_DEBUG
#define MK_DEBUG 0
#endif
#ifndef MOE_F8
#define MOE_F8 1
#endif
#ifndef MOE_DN_F8
#define MOE_DN_F8 1
#endif
#ifndef MOE_NOSPLIT
#define MOE_NOSPLIT 1
#endif
#ifndef P1_F8_FROM
#define P1_F8_FROM 0
#endif
#ifndef CHB
#define CHB 8
#endif

#define GAS __attribute__((address_space(1)))
#define LAS __attribute__((address_space(3)))
typedef unsigned short bf16_t;
typedef short bf16x8 __attribute__((ext_vector_type(8)));
typedef short s16x4 __attribute__((ext_vector_type(4)));
typedef float f32x4 __attribute__((ext_vector_type(4)));
typedef float f32x2 __attribute__((ext_vector_type(2)));
typedef float f32x16 __attribute__((ext_vector_type(16)));
typedef unsigned u32x4 __attribute__((ext_vector_type(4)));
typedef unsigned u32x2 __attribute__((ext_vector_type(2)));
typedef __bf16 bf16x2_t __attribute__((ext_vector_type(2)));

constexpr int SEQ = 2048, DM = 1024, NBATCH = 16, MTOK = NBATCH * SEQ;
constexpr int MC = CHB * SEQ, NCHUNK = NBATCH / CHB;
constexpr int INC = 5792, ZW = 512, ZN = 5888;
constexpr int ZO_CQ = 0, ZO_CKV = 256, ZO_KPE = 384, ZO_QB = 512, ZO_KB = 1024, ZO_VB = 1536, ZO_QC = 2048, ZO_KC = 2560, ZO_VC = 2688, ZO_G = 2816;
constexpr int DFF = 2816, DFE = 3584, NEXP = 8;
constexpr int DF0 = 1792, DF1 = DFE - DF0;
constexpr float EPS = 1e-6f, LOG2E = 1.4426950408889634f;
constexpr float NEGB = -1e30f;
constexpr int MOE_ROWS = MTOK + NEXP * 256;

constexpr size_t MiB = 1u << 20;
constexpr size_t WS_CTL = 0, CTL_ZERO_BYTES = 256 * 1024;
constexpr size_t WS_META = 256 * 1024;
constexpr size_t WS_TAB = 1 * MiB;
constexpr size_t WS_WIN = 2 * MiB;
constexpr size_t SZ_WIN = (size_t)ZN * DM * 2;
constexpr size_t WS_WUQ = WS_WIN + 2 * SZ_WIN;
constexpr size_t SZ_WUQ = (size_t)768 * 256 * 2;
constexpr size_t WS_WUKV = WS_WUQ + 2 * SZ_WUQ;
constexpr size_t SZ_WUKV = (size_t)1024 * 256 * 2;
constexpr size_t WS_WBR = WS_WUKV + 2 * SZ_WUKV;
constexpr size_t SZ_WBR = (size_t)1024 * 1536 * 2;
constexpr size_t WS_WOUT = WS_WBR + 2 * SZ_WBR;
constexpr size_t SZ_WOUT = (size_t)1024 * 1024 * 2;
constexpr size_t WS_WGU = WS_WOUT + 2 * SZ_WOUT;
constexpr size_t WS_WD = WS_WGU + (size_t)2 * DFF * DM * 2;
constexpr size_t WS_SMALL_END = WS_WD + (size_t)DM * DFF * 2;
static_assert(WS_SMALL_END <= 54 * MiB, "small weights");
constexpr size_t WS_XB = 54 * MiB;
constexpr size_t WS_ST = 118 * MiB;
constexpr size_t WS_RR = 120 * MiB;
constexpr size_t WS_SEL = WS_RR + (size_t)MTOK * 4;
constexpr size_t WS_GW = WS_SEL + (size_t)MTOK * 8;
constexpr size_t WS_ROWTOK = WS_GW + (size_t)MTOK * 8;
constexpr size_t WS_ROWGW = WS_ROWTOK + (size_t)2 * MOE_ROWS * 4;
constexpr size_t WS_ROWRR = WS_ROWGW + (size_t)2 * MOE_ROWS * 4;
constexpr size_t WS_T = 122 * MiB;
static_assert(WS_ROWRR + (size_t)2 * MOE_ROWS * 4 <= WS_T, "fixed region");
constexpr size_t WS_GB = WS_T;
constexpr size_t WS_Y = WS_GB + (size_t)MTOK * 3072;
constexpr size_t WS_CH = WS_Y + (size_t)MTOK * 1536 * 2;
constexpr size_t WS_Z = WS_CH;
constexpr size_t WS_QKV = WS_Z + (size_t)MC * ZW * 2;
constexpr size_t SZ_H8 = (size_t)MC * 512 * 2, SZ_H2 = (size_t)MC * 128 * 2;
constexpr size_t WS_Q = WS_QKV + 4 * SZ_H8 + 2 * SZ_H2;
constexpr bool TMP_IN_OUT = (CHB == 16);
constexpr size_t WS_KV = WS_Q + (size_t)MC * 768 * 2;
constexpr size_t WS_PB = WS_KV + (TMP_IN_OUT ? 0 : (size_t)MC * 1024 * 2);
constexpr size_t WS_PBS = WS_PB + (TMP_IN_OUT ? 0 : (size_t)2 * MC * 512 * 2);
constexpr size_t WS_SQ = WS_PBS + (size_t)2 * MC * 16 * 4;
constexpr size_t WS_MIX_END = WS_SQ + (size_t)2 * MC * 4 * 4;
constexpr size_t WS_XB8P = (size_t)496 * MiB;
constexpr size_t WS_WIN8 = WS_XB8P + (size_t)MTOK * DM;
constexpr size_t SZ_WIN8 = (size_t)(23 - P1_F8_FROM) * 256 * DM;
static_assert(WS_XB8P >= WS_MIX_END && WS_WIN8 + 2 * SZ_WIN8 <= (size_t)564 * MiB, "fp8 input-projection buffers");
constexpr size_t WS_MG = WS_CH;
static_assert(WS_MG + (size_t)MTOK * 1024 * 2 <= (size_t)564 * MiB, "MG placement");
constexpr size_t WS_ACT = WS_T;
constexpr size_t WS_EGU = WS_T;
constexpr size_t WS_XB8 = WS_EGU + (size_t)NEXP * 2 * DFE * DM;
constexpr size_t WS_ED = WS_EGU + (size_t)NEXP * 2 * DFE * DM * 2;
constexpr size_t WS_MACT = WS_ED + (size_t)NEXP * DM * DFE * 2;
constexpr size_t WS_MOE_END = WS_MACT + (size_t)MOE_ROWS * DFE * 2;
constexpr size_t WS_NEED_ = (WS_MOE_END > WS_MIX_END ? WS_MOE_END : WS_MIX_END);
constexpr size_t WS_NEED = WS_MOE_END + (size_t)(MTOK - 26624) * DM * 2 > WS_NEED_ ? WS_MOE_END + (size_t)(MTOK - 26624) * DM * 2 : WS_NEED_;
static_assert(WS_NEED <= (size_t)564 * MiB, "workspace budget");

constexpr int XM_SPLIT = 26624;
constexpr size_t WS_XM_HI = WS_MOE_END;
static_assert((size_t)XM_SPLIT * DM * 2 <= WS_XB - WS_WIN && WS_XM_HI + (size_t)(MTOK - XM_SPLIT) * DM * 2 <= (size_t)564 * MiB, "XM placement");
__device__ __forceinline__ bf16_t* xm_row(unsigned char* ws, int tok) { return tok < XM_SPLIT ? (bf16_t*)(ws + WS_WIN) + (size_t)tok * DM : (bf16_t*)(ws + WS_XM_HI) + (size_t)(tok - XM_SPLIT) * DM; }

constexpr int CW_BAR = 4096, CW_Q = 8192;
constexpr int MI_CNT = 0, MI_NTILE = 4120, MI_TILEE = 4128;

__device__ __forceinline__ unsigned cvt_pk_bf16(float lo, float hi) { f32x2 v = {lo, hi}; bf16x2_t b = __builtin_convertvector(v, bf16x2_t); return __builtin_bit_cast(unsigned, b); }
__device__ __forceinline__ unsigned pk_fp8x4(float a, float b, float c, float d) {
    a = __builtin_amdgcn_fmed3f(a, -448.f, 448.f); b = __builtin_amdgcn_fmed3f(b, -448.f, 448.f); c = __builtin_amdgcn_fmed3f(c, -448.f, 448.f); d = __builtin_amdgcn_fmed3f(d, -448.f, 448.f);
    int w = 0; w = __builtin_amdgcn_cvt_pk_fp8_f32(a, b, w, false); w = __builtin_amdgcn_cvt_pk_fp8_f32(c, d, w, true); return (unsigned)w; }
__device__ __forceinline__ float bf_lo(unsigned w) { return __builtin_bit_cast(float, w << 16); }
__device__ __forceinline__ float bf_hi(unsigned w) { return __builtin_bit_cast(float, w & 0xffff0000u); }
template <int O> __device__ __forceinline__ float swz_xor(float v) { return __builtin_bit_cast(float, __builtin_amdgcn_ds_swizzle(__builtin_bit_cast(int, v), (O << 10) | 0x1f)); }
__device__ __forceinline__ void swap32(float& a, float& b) { asm volatile("s_nop 1\n\tv_permlane32_swap_b32 %0, %1\n\ts_nop 1" : "+v"(a), "+v"(b)); }
__device__ __forceinline__ float xsum32(float v) { float a = v, b = v; swap32(a, b); return a + b; }
__device__ __forceinline__ float xmax32(float v) { float a = v, b = v; swap32(a, b); return fmaxf(a, b); }
__device__ __forceinline__ float wave_sum(float v) {
    v += swz_xor<1>(v); v += swz_xor<2>(v); v += swz_xor<4>(v); v += swz_xor<8>(v); v += swz_xor<16>(v);
    return xsum32(v);
}
__device__ __forceinline__ float fast_rcp(float x) { return __builtin_amdgcn_rcpf(x); }
__device__ __forceinline__ float fast_exp2(float x) { return __builtin_amdgcn_exp2f(x); }
__device__ __forceinline__ float sigmoidf_(float v) { return fast_rcp(1.f + fast_exp2(-v * LOG2E)); }
__device__ __forceinline__ int t5_bucket(int rel) {
    const int ret = rel > 0 ? 16 : 0; const int n = rel < 0 ? -rel : rel;
    if (n < 8) return ret + n;
    int large = 8 + (int)(logf((float)n / 8.f) / logf(128.f) * 8.f);
    if (large > 15) large = 15;
    return ret + large;
}

#define XB_TMO      128
#define XB_XCNT(j)  (256  + 64 * (j))
#define XB_XSUB(j)  (1280 + 64 * (j))
#define XB_XGEN(j)  (2304 + 64 * (j))
#define XB_TOP      3328
#define XB_TOPGEN   3392
#define XCD_BAR_WORDS 3456
#define XB_SPIN_CAP (1u << 18)
__device__ __forceinline__ unsigned xb_ld(unsigned* p)              { return __hip_atomic_load(p, __ATOMIC_RELAXED, __HIP_MEMORY_SCOPE_AGENT); }
__device__ __forceinline__ unsigned xb_add(unsigned* p, unsigned v) { return __hip_atomic_fetch_add(p, v, __ATOMIC_RELAXED, __HIP_MEMORY_SCOPE_AGENT); }
__device__ __forceinline__ unsigned xb_xcc_id() { return (unsigned)__builtin_amdgcn_s_getreg((3 << 11) | 20) & 0xFu; }
#define XB_SPIN(cond, bar) do { unsigned _sp = 0; while (cond) { __builtin_amdgcn_s_sleep(1); \
    if ((++_sp & 255u) == 0u) { if (xb_ld(&(bar)[XB_TMO])) break; if (_sp > XB_SPIN_CAP) { atomicAdd(&(bar)[XB_TMO], 1u); break; } } } } while (0)
struct XcdBarrier { unsigned* bar; unsigned x; volatile LAS unsigned* st; };
__device__ __forceinline__ XcdBarrier xcd_barrier_post(unsigned* bar, volatile LAS unsigned* st) {
    XcdBarrier b; b.bar = bar; b.x = xb_xcc_id(); b.st = st;
    if (threadIdx.x == 0) (void)xb_add(&bar[XB_XCNT(b.x)], 1u);
    return b;
}
__device__ __forceinline__ void xcd_barrier_complete(unsigned* bar, unsigned x, unsigned& nloc, unsigned& nx) {
    const unsigned G = gridDim.x * gridDim.y * gridDim.z;
    unsigned sum, cnt, mine, sp = 0u;
    for (;;) {
        sum = 0u; cnt = 0u; mine = 0u;
#pragma unroll
        for (unsigned j = 0; j < 16; ++j) { const unsigned c = xb_ld(&bar[XB_XCNT(j)]); sum += c; cnt += (c > 0u) ? 1u : 0u; mine = (j == x) ? c : mine; }
        if (sum == G) break;
        __builtin_amdgcn_s_sleep(1);
        if ((++sp & 255u) == 0u) { if (xb_ld(&bar[XB_TMO])) break; if (sp > XB_SPIN_CAP) { atomicAdd(&bar[XB_TMO], 1u); break; } }
    }
    nloc = mine > 0u ? mine : 1u; nx = cnt > 0u ? cnt : 1u;
}
__device__ __forceinline__ void xcd_barrier(const XcdBarrier& b) {
    asm volatile("s_waitcnt vmcnt(0)" ::: "memory");
    __syncthreads();
    if (threadIdx.x == 0) {
        unsigned* bar = b.bar;
        __builtin_amdgcn_s_waitcnt(0);
        unsigned nloc = b.st[0], nx = b.st[1];
        if (nloc == 0u) { xcd_barrier_complete(bar, b.x, nloc, nx); b.st[0] = nloc; b.st[1] = nx; }
        const unsigned old = xb_add(&bar[XB_XSUB(b.x)], 1u);
        const unsigned gen = old / nloc;
        if (old + 1u == (gen + 1u) * nloc) {
            __builtin_amdgcn_fence(__ATOMIC_RELEASE, "agent");
            asm volatile("s_waitcnt vmcnt(0)" ::: "memory");
            const unsigned og = xb_add(&bar[XB_TOP], 1u);
            const unsigned tg = og / nx;
            if (og + 1u == (tg + 1u) * nx) xb_add(&bar[XB_TOPGEN], 1u);
            else XB_SPIN(xb_ld(&bar[XB_TOPGEN]) == tg, bar);
            __builtin_amdgcn_fence(__ATOMIC_ACQUIRE, "agent");
            xb_add(&bar[XB_XGEN(b.x)], 1u);
            asm volatile("s_waitcnt vmcnt(0)" ::: "memory");
        } else {
            XB_SPIN(xb_ld(&bar[XB_XGEN(b.x)]) == gen, bar);
            __builtin_amdgcn_fence(__ATOMIC_ACQUIRE, "agent");
            asm volatile("s_waitcnt vmcnt(0)" ::: "memory");
        }
    }
    __syncthreads();
}
#ifndef MOE_RGS
#define MOE_RGS 4
#endif
#ifndef MOE_RG
#define MOE_RG 4
#endif
#ifndef RELAXW
#define RELAXW 0
#endif
namespace pg8 {
constexpr int BM = 256, BK = 64, HALF = 128, HTB = HALF * BK * 2, STAGE_BYTES = 8 * HTB, NXCD = 8, WGM = 8;
__host__ __device__ __forceinline__ int lds_byte(int r, int c) { const int st = (r >> 4) * 2 + (c >> 5), rr = r & 15, cc = c & 31, ob = rr * 64 + cc * 2; return st * 1024 + (ob ^ (((ob >> 9) & 1) << 5)); }
__host__ __device__ __forceinline__ void stage_rc(int b, int& R, int& C) { const int st = b / 1024, sb = b % 1024, swz = sb ^ (((sb >> 9) & 1) << 5); R = (st >> 1) * 16 + swz / 64; C = (st & 1) * 32 + (swz % 64) / 2; }
__host__ __device__ __forceinline__ int perm32(int rho) { const int n = rho >> 4, i = rho & 15; return 8 * (i >> 2) + 4 * n + (i & 3); }

struct Unit { int pm, pn, aux; };
struct Gemm { const bf16_t* A; const bf16_t* Bt; int K, lda, ldb; const int* gidx; };

struct StaticOrder {
    static constexpr bool DYN = false;
    int nM, nN, nwg, G, c;
    __host__ __device__ void init(int M, int N, int G_, int c_) { nM = M / BM; nN = N / BM; nwg = nM * nN; G = G_; c = c_; }
    __host__ __device__ bool next(int i, Unit& u) const {
        const int L = i * G + c; if (L >= nwg) return false;
        int wgid = L; { const int q = nwg / NXCD, r = nwg % NXCD, xcd = wgid % NXCD, off = wgid / NXCD; wgid = (xcd < r ? xcd * (q + 1) : r * (q + 1) + (xcd - r) * q) + off; }
        const int nig = WGM * nN, gid = wgid / nig, fm = gid * WGM, gsz = (nM - fm) < WGM ? (nM - fm) : WGM;
        u.pm = fm + ((wgid % nig) % gsz); u.pn = (wgid % nig) / gsz; u.aux = u.pn; return true;
    }
};
struct MoeOrder {
    static constexpr bool DYN = false;
    int ntile, nN, G, c, pne, pn0; const int* tile_e;
    __device__ bool next(int i, Unit& u) const {
        const int L = i * G + c; if (L >= ntile * nN) return false;
        int pm, pnl; { const int grp = L / (MOE_RGS * nN), fm = grp * MOE_RGS, gsz = (ntile - fm) < MOE_RGS ? (ntile - fm) : MOE_RGS, r = L - grp * (MOE_RGS * nN); pm = fm + r % gsz; pnl = r / gsz; }
        u.pm = pm; u.aux = pnl; u.pn = tile_e[pm] * pne + pn0 + pnl; return true;
    }
};

struct DynMoeOrder {
    static constexpr bool DYN = true;
    unsigned* ctr; volatile LAS int* slot; int ntile, nN, pne, pn0; const int* tile_e; int vcu;
    __device__ __forceinline__ void begin() const {
        if (threadIdx.x == 0) { slot[0] = vcu; slot[1] = vcu + (int)gridDim.x; }
        __syncthreads();
    }
    __device__ __forceinline__ bool next(int i, Unit& u) const {
        const int L = __builtin_amdgcn_readfirstlane(slot[i & 1]); if (L >= ntile * nN) return false;
        int pm, pnl; { const int grp = L / (MOE_RG * nN), fm = grp * MOE_RG, gsz = (ntile - fm) < MOE_RG ? (ntile - fm) : MOE_RG, r = L - grp * (MOE_RG * nN); pm = fm + r % gsz; pnl = r / gsz; }
        u.pm = pm; u.aux = pnl; u.pn = tile_e[pm] * pne + pn0 + pnl; return true;
    }
    __device__ __forceinline__ unsigned claim_issue() const { unsigned v = 0u; if (threadIdx.x == 0) v = 2u * gridDim.x + __hip_atomic_fetch_add(ctr, 1u, __ATOMIC_RELAXED, __HIP_MEMORY_SCOPE_AGENT); return v; }
    __device__ __forceinline__ void claim_commit(unsigned v, int i) const { if (threadIdx.x == 0) { slot[i & 1] = (int)v; asm volatile("s_waitcnt lgkmcnt(0)" ::: "memory"); } }
};

__host__ __device__ __forceinline__ size_t blk_off(int row, int col, int ld) { return ((size_t)(row >> 4) * (ld >> 5) + (col >> 5)) * 512 + (row & 15) * 32 + (col & 31); }
typedef int i32x4_t __attribute__((ext_vector_type(4))); typedef int i32x8_t __attribute__((ext_vector_type(8)));
template <bool F8> struct FragSel;
template <> struct FragSel<false> {
    struct P { bf16x8 k[2]; }; typedef P A[4]; typedef P B[2];
    static __device__ __forceinline__ void set(P& d, const i32x4_t& f0, const i32x4_t& f1) { d.k[0] = __builtin_bit_cast(bf16x8, f0); d.k[1] = __builtin_bit_cast(bf16x8, f1); }
    static __device__ __forceinline__ void mma(f32x4& c, const P& b, const P& a) { c = __builtin_amdgcn_mfma_f32_16x16x32_bf16(b.k[0], a.k[0], c, 0, 0, 0); c = __builtin_amdgcn_mfma_f32_16x16x32_bf16(b.k[1], a.k[1], c, 0, 0, 0); }
    static __device__ __forceinline__ void after_mma() {}
};
template <> struct FragSel<true> {
    typedef i32x8_t P; typedef P A[4]; typedef P B[2];
    static __device__ __forceinline__ void set(P& d, const i32x4_t& f0, const i32x4_t& f1) { d = __builtin_shufflevector(f0, f1, 0, 1, 2, 3, 4, 5, 6, 7); }
    static __device__ __forceinline__ void mma(f32x4& c, const P& b, const P& a) { int sc = 0x7f7f7f7f; asm volatile("v_mfma_scale_f32_16x16x128_f8f6f4 %0, %1, %2, %0, %3, %3 op_sel_hi:[0,0,0]" : "+v"(c) : "v"(b), "v"(a), "v"(sc)); }
    static __device__ __forceinline__ void after_mma() { asm volatile("s_nop 15\n\ts_nop 15" ::: "memory"); }
};
template <class Epi, class Sched, bool ALIGN_EPI, bool GATHER, bool ABLK = false, bool F8 = false>
__device__ __forceinline__ void gemm_phase(LAS unsigned char* lds, const Gemm g, const Sched& S, const Epi& E) {
    int tid_ = threadIdx.x; asm volatile("" : "+v"(tid_));
    const int tid = tid_, wid = __builtin_amdgcn_readfirstlane(tid >> 6), lane = tid & 63, wr = wid >> 2, wc = wid & 3, fr = lane & 15, fq = lane >> 4;
    int K_ = g.K; asm volatile("" : "+s"(K_));
    const int K = K_, nt = K / BK;
    static_assert(!(GATHER && ABLK), "gathered A is row-major");
    const size_t kstep = (size_t)(BK * 2), kstepA = ABLK ? (size_t)2048 : kstep;
    const size_t hstepA = ABLK ? (size_t)8 * (g.lda >> 5) * 1024 : (size_t)HALF * g.lda * 2, hstepB = (size_t)HALF * g.ldb * 2, tstepA = 2 * hstepA, tstepB = 2 * hstepB;
    int Rs[2], Cs[2]; unsigned voffB[2];
#pragma unroll
    for (int i = 0; i < 2; ++i) { int R, C; stage_rc(tid * 16 + i * 8192, R, C); Rs[i] = R; Cs[i] = C; const int Rb = Epi::PERM ? ((R & ~31) + perm32(R & 31)) : R;
        voffB[i] = (unsigned)(Rb * g.ldb + C) * 2u; }
    asm volatile("" : "+v"(voffB[0]), "+v"(voffB[1]), "+v"(Rs[0]), "+v"(Rs[1]), "+v"(Cs[0]), "+v"(Cs[1]));
    unsigned vA[2][2], nvA[2][2];
    const size_t hsA = GATHER ? (size_t)0 : hstepA;
#define PG8_SETV(V, U) do { _Pragma("unroll") for (int _h = 0; _h < 2; ++_h) _Pragma("unroll") for (int _i = 0; _i < 2; ++_i) { \
        if constexpr (GATHER) { int _t = g.gidx[(U).pm * BM + _h * HALF + Rs[_i]]; _t = _t < 0 ? 0 : _t; V[_h][_i] = (unsigned)(_t * g.lda + Cs[_i]) * 2u; } \
        else if constexpr (ABLK) V[_h][_i] = (unsigned)blk_off(Rs[_i], Cs[_i], g.lda) * 2u; \
        else V[_h][_i] = (unsigned)(Rs[_i] * g.lda + Cs[_i]) * 2u; } } while (0)
    const unsigned ldsw = (unsigned)wid * 1024u;
    const int aoff = lds_byte(wr * 64 + fr, fq * 8), boff = lds_byte(wc * 32 + fr, fq * 8);
#define PG8_SA(b, h) (((b) * 2 + (h)) * HTB)
#define PG8_SB(b, h) ((4 + (b) * 2 + (h)) * HTB)
#define PG8_STAGE(bufoff, gbase, voff) do { _Pragma("unroll") for (int _i = 0; _i < 2; ++_i) \
        __builtin_amdgcn_global_load_lds((const unsigned*)((const char*)(gbase) + (voff)[_i]), (LAS unsigned*)(lds + (bufoff) + ldsw + _i * 8192), 16, 0, 0); } while (0)
#define PG8_LDA(dst, b, h) do { _Pragma("unroll") for (int m = 0; m < 4; ++m) { const i32x4_t f0_ = *(const LAS i32x4_t*)(lds + PG8_SA(b, h) + aoff + m * 2048), f1_ = *(const LAS i32x4_t*)(lds + PG8_SA(b, h) + aoff + m * 2048 + 1024); FragSel<F8>::set(dst[m], f0_, f1_); } } while (0)
#define PG8_LDB(dst, b, h) do { _Pragma("unroll") for (int n = 0; n < 2; ++n) { const i32x4_t f0_ = *(const LAS i32x4_t*)(lds + PG8_SB(b, h) + boff + n * 2048), f1_ = *(const LAS i32x4_t*)(lds + PG8_SB(b, h) + boff + n * 2048 + 1024); FragSel<F8>::set(dst[n], f0_, f1_); } } while (0)
#define PG8_MMA(ai, bj, At, Bt) do { __builtin_amdgcn_s_setprio(1); _Pragma("unroll") for (int m = 0; m < 4; ++m) _Pragma("unroll") for (int n = 0; n < 2; ++n) FragSel<F8>::mma(acc[ai][bj][m][n], Bt[n], At[m]); __builtin_amdgcn_s_setprio(0); } while (0)
#define PG8_WAIT_V(n) asm volatile("s_waitcnt vmcnt(" #n ")" ::: "memory")
#define PG8_WAIT_VSEL(sel, n) asm volatile("s_cmp_eq_u32 %0, 0\n\ts_cbranch_scc1 1f\n\ts_waitcnt vmcnt(%1)\n\ts_branch 2f\n1:\n\ts_waitcnt vmcnt(8)\n2:" :: "s"(sel), "n"(n) : "memory", "scc")
#define PG8_WAIT_L(n) asm volatile("s_waitcnt lgkmcnt(" #n ")" ::: "memory")
#define PG8_BAR __builtin_amdgcn_s_barrier()
#define PG8_SCHED __builtin_amdgcn_sched_barrier(0)
    Unit cur, nxt; int ui = 0;
    if constexpr (Sched::DYN) S.begin();
    if (!S.next(0, cur)) return;
    f32x4 acc[2][2][4][2];
#pragma unroll
    for (int a = 0; a < 2; ++a)
#pragma unroll
        for (int b = 0; b < 2; ++b)
#pragma unroll
            for (int m = 0; m < 4; ++m)
#pragma unroll
                for (int n = 0; n < 2; ++n) acc[a][b][m][n] = (f32x4){0.f, 0.f, 0.f, 0.f};
    typename FragSel<F8>::A At; typename FragSel<F8>::B B0, B1;
    PG8_SETV(vA, cur);
    const char* cA = (const char*)g.A + (GATHER ? (size_t)0 : (size_t)cur.pm * tstepA); const char* cB = (const char*)g.Bt + (size_t)cur.pn * tstepB;
    PG8_STAGE(PG8_SB(0, 0), cB, voffB); PG8_STAGE(PG8_SB(0, 1), cB + hstepB, voffB); PG8_STAGE(PG8_SA(0, 0), cA, vA[0]); PG8_STAGE(PG8_SA(0, 1), cA + hsA, vA[1]);
    if (wr == 1) PG8_BAR;
    PG8_WAIT_V(2); PG8_BAR;
    PG8_STAGE(PG8_SB(1, 0), cB + kstep, voffB); PG8_STAGE(PG8_SA(1, 0), cA + kstepA, vA[0]); PG8_STAGE(PG8_SB(1, 1), cB + hstepB + kstep, voffB);
    PG8_WAIT_V(6); PG8_BAR;
    for (;;) {
        const bool has_next = S.next(ui + 1, nxt);
        unsigned claim_ = 0u; if constexpr (Sched::DYN) claim_ = S.claim_issue();
        const char* nA = has_next ? (const char*)g.A + (GATHER ? (size_t)0 : (size_t)nxt.pm * tstepA) : cA; const char* nB = has_next ? (const char*)g.Bt + (size_t)nxt.pn * tstepB : cB;
        if constexpr (GATHER) { if (has_next) PG8_SETV(nvA, nxt); else {
#pragma unroll
            for (int h = 0; h < 2; ++h) { nvA[h][0] = vA[h][0]; nvA[h][1] = vA[h][1]; } } }
        for (int t = 0; t < nt; t += 2) {
            if constexpr (Epi::MID) { if (t == 8 || t == 16) E.mid(acc, cur, t >> 3, wr, wc, fr, fq); }
            const bool last = (t == nt - 2);
            const char* a1 = cA + (size_t)(t + 1) * kstepA;
            const char* a2 = last ? nA : cA + (size_t)(t + 2) * kstepA; const char* b2 = last ? nB : cB + (size_t)(t + 2) * kstep;
            const char* a3 = a2 + kstepA; const char* b3 = b2 + kstep;
            unsigned v20[2], v21[2];
            if constexpr (GATHER) { v20[0] = last ? nvA[0][0] : vA[0][0]; v20[1] = last ? nvA[0][1] : vA[0][1]; v21[0] = last ? nvA[1][0] : vA[1][0]; v21[1] = last ? nvA[1][1] : vA[1][1]; }
            else { v20[0] = vA[0][0]; v20[1] = vA[0][1]; v21[0] = vA[1][0]; v21[1] = vA[1][1]; }
            const int relax_ = __builtin_amdgcn_readfirstlane((RELAXW && (t == 0) && (ui > 0)) ? 1 : 0);
            PG8_LDB(B0, 0, 0); PG8_LDB(B1, 0, 1); PG8_SCHED; PG8_LDA(At, 0, 0); PG8_STAGE(PG8_SA(1, 1), a1 + hsA, vA[1]);
            PG8_WAIT_VSEL(relax_, 8 + Epi::NVM);
            PG8_WAIT_L(0); PG8_BAR; PG8_MMA(0, 0, At, B0); PG8_MMA(0, 1, At, B1); PG8_BAR; PG8_SCHED;
            PG8_LDA(At, 0, 1); PG8_STAGE(PG8_SB(0, 0), b2, voffB); PG8_STAGE(PG8_SB(0, 1), b2 + hstepB, voffB); PG8_STAGE(PG8_SA(0, 0), a2, v20);
            PG8_WAIT_VSEL(relax_, 8 + Epi::NVM);
            PG8_WAIT_L(0); PG8_BAR; PG8_MMA(1, 0, At, B0); PG8_MMA(1, 1, At, B1); PG8_BAR; PG8_SCHED;
            PG8_LDB(B0, 1, 0); PG8_LDB(B1, 1, 1); PG8_SCHED; PG8_LDA(At, 1, 0); PG8_STAGE(PG8_SA(0, 1), a2 + hsA, v21);
            PG8_WAIT_V(8); PG8_WAIT_L(0); PG8_BAR; PG8_MMA(0, 0, At, B0); PG8_MMA(0, 1, At, B1); PG8_BAR; PG8_SCHED;
            PG8_LDA(At, 1, 1); PG8_STAGE(PG8_SB(1, 0), b3, voffB); PG8_STAGE(PG8_SB(1, 1), b3 + hstepB, voffB); PG8_STAGE(PG8_SA(1, 0), a3, v20);
            PG8_WAIT_V(8); PG8_WAIT_L(0); PG8_BAR; PG8_MMA(1, 0, At, B0); PG8_MMA(1, 1, At, B1); PG8_BAR; PG8_SCHED;
        }
        if constexpr (Sched::DYN) S.claim_commit(claim_, ui);
        if constexpr (ALIGN_EPI) { if (wr == 0) PG8_BAR; }
        FragSel<F8>::after_mma();
        E(acc, cur, wr, wc, fr, fq);
        if (!has_next) break;
#pragma unroll
        for (int a = 0; a < 2; ++a)
#pragma unroll
            for (int b = 0; b < 2; ++b)
#pragma unroll
                for (int m = 0; m < 4; ++m)
#pragma unroll
                    for (int n = 0; n < 2; ++n) acc[a][b][m][n] = (f32x4){0.f, 0.f, 0.f, 0.f};
        cur = nxt; cA = nA; cB = nB; ++ui;
        if constexpr (GATHER) {
#pragma unroll
            for (int h = 0; h < 2; ++h) { vA[h][0] = nvA[h][0]; vA[h][1] = nvA[h][1]; } }
        if constexpr (ALIGN_EPI) { if (wr == 1) PG8_BAR; }
    }
    PG8_WAIT_V(0);
    if constexpr (!ALIGN_EPI) { if (wr == 0) PG8_BAR; }
    PG8_BAR;
#undef PG8_SETV
#undef PG8_SA
#undef PG8_SB
#undef PG8_STAGE
#undef PG8_LDA
#undef PG8_LDB
#undef PG8_MMA
#undef PG8_WAIT_V
#undef PG8_WAIT_VSEL
#undef PG8_WAIT_L
#undef PG8_BAR
#undef PG8_SCHED
}

typedef f32x4 Acc[2][2][4][2];
#ifndef NT_Z
#define NT_Z 0
#endif
#ifndef NT_A
#define NT_A 1
#endif
#ifndef ST_SC1
#define ST_SC1 1
#endif
__device__ __forceinline__ void st16(unsigned char* wsb, u32x4* p, const u32x4& v) {
#if ST_SC1
    const __amdgpu_buffer_rsrc_t rsrc = __builtin_amdgcn_make_buffer_rsrc(wsb, 0, 0x7fffffff, 0x00020000);
    __builtin_amdgcn_raw_buffer_store_b128(v, rsrc, (int)((unsigned char*)p - wsb), 0, 16);
#else
    *p = v;
#endif
}
__device__ __forceinline__ void st8(unsigned char* wsb, u32x2* p, const u32x2& v) {
#if ST_SC1
    const __amdgpu_buffer_rsrc_t rsrc = __builtin_amdgcn_make_buffer_rsrc(wsb, 0, 0x7fffffff, 0x00020000);
    __builtin_amdgcn_raw_buffer_store_b64(v, rsrc, (int)((unsigned char*)p - wsb), 0, 16);
#else
    *p = v;
#endif
}
__device__ __forceinline__ float fq_sum(float s) { s += swz_xor<16>(s); return xsum32(s); }
__device__ __forceinline__ u32x4 pack8(const f32x4& a, const f32x4& b) { u32x4 w; w.x = cvt_pk_bf16(a.x, a.y); w.y = cvt_pk_bf16(a.z, a.w); w.z = cvt_pk_bf16(b.x, b.y); w.w = cvt_pk_bf16(b.z, b.w); return w; }
__device__ __forceinline__ void unpack8(const u32x4& w, f32x4& a, f32x4& b) { a = (f32x4){bf_lo(w.x), bf_hi(w.x), bf_lo(w.y), bf_hi(w.y)}; b = (f32x4){bf_lo(w.z), bf_hi(w.z), bf_lo(w.w), bf_hi(w.w)}; }
__device__ __forceinline__ unsigned g8pack(const f32x4& a) {
    const unsigned b0 = (unsigned)__builtin_fmaxf(a.x * 255.f + 0.5f, 1.f), b1 = (unsigned)__builtin_fmaxf(a.y * 255.f + 0.5f, 1.f), b2 = (unsigned)__builtin_fmaxf(a.z * 255.f + 0.5f, 1.f), b3 = (unsigned)__builtin_fmaxf(a.w * 255.f + 0.5f, 1.f);
    return b0 | (b1 << 8) | (b2 << 16) | (b3 << 24);
}
__device__ __forceinline__ f32x4 g8unpack(unsigned w) { return (f32x4){(float)(w & 0xffu), (float)((w >> 8) & 0xffu), (float)((w >> 16) & 0xffu), (float)(w >> 24)}; }
__device__ __forceinline__ float sq8(const f32x4& a, const f32x4& b) { return ((a.x * a.x + a.y * a.y) + (a.z * a.z + a.w * a.w)) + ((b.x * b.x + b.y * b.y) + (b.z * b.z + b.w * b.w)); }
__device__ __forceinline__ float sum4(const f32x4& a) { return (a.x + a.y) + (a.z + a.w); }
__device__ __forceinline__ void rope8(f32x4& a, f32x4& b, const float* cs, const float* sn) {
    const f32x4 c = *(const f32x4*)cs, s = *(const f32x4*)sn;
    const f32x4 ra = {a.x * c.x - a.y * s.x, a.x * s.x + a.y * c.x, a.z * c.y - a.w * s.y, a.z * s.y + a.w * c.y};
    const f32x4 rb = {b.x * c.z - b.y * s.z, b.x * s.z + b.y * c.z, b.z * c.w - b.w * s.w, b.z * s.w + b.w * c.w};
    a = ra; b = rb;
}
__device__ __forceinline__ void rowscale16(const float* st, int rbase, int fq, float (&r)[8]) {
    f32x4 p[8];
#pragma unroll
    for (int i = 0; i < 8; ++i) p[i] = *(const f32x4*)(st + (size_t)(rbase + (i >> 2) * HALF + (i & 3) * 16) * 16 + 4 * fq);
#pragma unroll
    for (int i = 0; i < 8; ++i) r[i] = rsqrtf(fq_sum(sum4(p[i])) * (1.f / 1024.f) + EPS);
}
__device__ __forceinline__ void rowscale4(const float* sq, int rbase, float inv_n, float (&r)[8]) {
    f32x4 p[8];
#pragma unroll
    for (int i = 0; i < 8; ++i) p[i] = *(const f32x4*)(sq + (size_t)(rbase + (i >> 2) * HALF + (i & 3) * 16) * 4);
#pragma unroll
    for (int i = 0; i < 8; ++i) r[i] = rsqrtf(sum4(p[i]) * inv_n + EPS);
}
#define EPI_ROWBASE int rl_ = wr * 64 + fr; asm volatile("" : "+v"(rl_)); const int rbase = u.pm * BM + rl_
#define EPI_LOOP _Pragma("unroll") for (int ai = 0; ai < 2; ++ai) _Pragma("unroll") for (int m = 0; m < 4; ++m)

__device__ __forceinline__ float sig2_(float t) { return fast_rcp(1.f + fast_exp2(t)); }
struct EpiIn {
    static constexpr bool PERM = true, MID = false; static constexpr int NVM = 24;
    bf16_t* Z; const float* st; float* sq; float* skv; const float* cosT; const float* sinT; unsigned char* GB; bf16_t* HM; unsigned char* wsb; int pnoff; float asc;
    __device__ __forceinline__ void operator()(const Acc& acc, const Unit& u, int wr, int wc, int fr, int fq) const {
        EPI_ROWBASE; const int pn = u.pn + pnoff;
        float r8[8]; rowscale16(st, rbase, fq, r8);
#pragma unroll
        for (int i = 0; i < 8; ++i) r8[i] *= (pn >= 11 ? -LOG2E * asc : asc);
        __builtin_amdgcn_sched_barrier(0);
        EPI_LOOP {
            const int row = rbase + ai * HALF + m * 16; const float r = r8[ai * 4 + m];
            bf16_t* zr = Z + (size_t)row * ZW + pn * BM + wc * 32 + 8 * fq;
            float ssq = 0.f;
#pragma unroll
            for (int bj = 0; bj < 2; ++bj) {
                f32x4 v0 = acc[ai][bj][m][0] * r, v1 = acc[ai][bj][m][1] * r;
#ifdef PROBE_ANOISE
                if (pn < 11 && ((PROBE_ANOISE_MASK >> pn) & 1)) { unsigned h_ = (unsigned)row * 2654435761u ^ (unsigned)(pn * 64 + bj * 32 + wc * 8 + fq) * 40503u; float nz[8];
#pragma unroll
                      for (int e_ = 0; e_ < 8; ++e_) { h_ = h_ * 1664525u + 1013904223u; nz[e_] = ((float)(h_ >> 8) * (1.f / 16777216.f) - 0.5f) * 3.4641f * 0.035f * (float)(PROBE_ANOISE); }
                      v0.x += nz[0]; v0.y += nz[1]; v0.z += nz[2]; v0.w += nz[3]; v1.x += nz[4]; v1.y += nz[5]; v1.z += nz[6]; v1.w += nz[7]; }
#endif
                if (pn == 0) ssq += sq8(v0, v1);
                else if (pn == 1) { if (bj == 0) ssq += sq8(v0, v1); else if (wc == 0) { const int pos = row & (SEQ - 1); rope8(v0, v1, cosT + pos * 16 + 4 * fq, sinT + pos * 16 + 4 * fq); } }
                else if (pn == 2 || pn == 3 || pn == 8 || pn == 9) { v0 = v0 * (0.125f * LOG2E); v1 = v1 * (0.125f * LOG2E); }
                else if (pn >= 11) {
#ifdef PROBE_GNOISE
                    { unsigned h_ = (unsigned)row * 2654435761u ^ (unsigned)(pn * 64 + bj * 32 + wc * 8 + fq) * 40503u; float nz[8];
#pragma unroll
                      for (int e_ = 0; e_ < 8; ++e_) { h_ = h_ * 1664525u + 1013904223u; nz[e_] = ((float)(h_ >> 8) * (1.f / 16777216.f) - 0.5f) * 3.4641f * 0.035f * (float)(PROBE_GNOISE); }
                      v0.x += nz[0]; v0.y += nz[1]; v0.z += nz[2]; v0.w += nz[3]; v1.x += nz[4]; v1.y += nz[5]; v1.z += nz[6]; v1.w += nz[7]; }
#endif
                    v0 = (f32x4){sig2_(v0.x), sig2_(v0.y), sig2_(v0.z), sig2_(v0.w)}; v1 = (f32x4){sig2_(v1.x), sig2_(v1.y), sig2_(v1.z), sig2_(v1.w)}; }
                if (pn >= 11) { u32x2 w8; w8.x = g8pack(v0); w8.y = g8pack(v1); *(u32x2*)(GB + blk_off(row, (pn - 11) * BM + bj * HALF + wc * 32 + 8 * fq, 3072)) = w8; }
                else if (pn >= 2) {
                    const int hc = (pn - 2) * BM + bj * HALF + wc * 32;
                    const int reg = hc < 1536 ? hc >> 9 : (hc < 2048 ? 3 : (hc < 2176 ? 4 : 5)), hin = hc < 1536 ? hc & 511 : (hc < 2048 ? hc - 1536 : (hc - 2048) & 127);
                    const size_t base = reg <= 3 ? (size_t)reg * (MC * 512) : (size_t)4 * (MC * 512) + (size_t)(reg - 4) * (MC * 128);
                    const int nh = reg <= 3 ? 8 : 2, b = row >> 11, s = row & (SEQ - 1);
                    st16(wsb, (u32x4*)(HM + base + (((size_t)(b * nh + (hin >> 6)) * SEQ + s) * 64 + (hin & 63) + 8 * fq)), pack8(v0, v1));
                }
                else st16(wsb, (u32x4*)(zr + bj * HALF), pack8(v0, v1));
            }
            if (pn <= 1) { ssq = fq_sum(ssq); if (fq == 0) (pn == 0 ? sq : skv)[(size_t)row * 4 + wc] = ssq; }
        }
    }
};
struct EpiQ {
    static constexpr bool PERM = true, MID = false; static constexpr int NVM = 24;
    bf16_t* Q; const float* sq; const float* cosT; const float* sinT;
    __device__ __forceinline__ void operator()(const Acc& acc, const Unit& u, int wr, int wc, int fr, int fq) const {
        EPI_ROWBASE;
        float r8[8]; rowscale4(sq, rbase, 1.f / 256.f, r8);
        __builtin_amdgcn_sched_barrier(0);
        EPI_LOOP {
            __builtin_amdgcn_sched_barrier(0);
            const int row = rbase + ai * HALF + m * 16; const float r = r8[ai * 4 + m]; const int pos = row & (SEQ - 1);
#pragma unroll
            for (int bj = 0; bj < 2; ++bj) {
                const int col = u.pn * BM + bj * HALF + wc * 32 + 8 * fq; const int j0 = col % 96;
                f32x4 v0 = acc[ai][bj][m][0] * r, v1 = acc[ai][bj][m][1] * r;
                if (j0 >= 64) { const int i0 = (j0 - 64) >> 1; rope8(v0, v1, cosT + pos * 16 + i0, sinT + pos * 16 + i0); }
                *(u32x4*)(Q + (size_t)row * 768 + col) = pack8(v0, v1);
            }
        }
    }
};
struct EpiKV {
    static constexpr bool PERM = true, MID = false; static constexpr int NVM = 24;
    bf16_t* KV; const float* skv;
    __device__ __forceinline__ void operator()(const Acc& acc, const Unit& u, int wr, int wc, int fr, int fq) const {
        EPI_ROWBASE;
        float r8[8]; rowscale4(skv, rbase, 1.f / 128.f, r8);
        __builtin_amdgcn_sched_barrier(0);
        EPI_LOOP {
            const int row = rbase + ai * HALF + m * 16; const float r = r8[ai * 4 + m];
#pragma unroll
            for (int bj = 0; bj < 2; ++bj) {
                const int col = u.pn * BM + bj * HALF + wc * 32 + 8 * fq;
                *(u32x4*)(KV + (size_t)row * 1024 + col) = pack8(acc[ai][bj][m][0] * r, acc[ai][bj][m][1] * r);
            }
        }
    }
};
struct EpiBr {
    static constexpr bool PERM = true, MID = true; static constexpr int NVM = 32;
    const unsigned char* G; bf16_t* MG; unsigned char* wsb;
    __device__ __forceinline__ void mid(Acc& acc, const Unit& u, int seg, int wr, int wc, int fr, int fq) const {
        EPI_ROWBASE; const int col = u.pn * BM + wc * 32 + 8 * fq;
#pragma unroll
        for (int ai = 0; ai < 2; ++ai) {
            __builtin_amdgcn_sched_barrier(0);
            u32x2 wn[4][2], wd[4][2];
#pragma unroll
            for (int m = 0; m < 4; ++m)
#pragma unroll
                for (int bj = 0; bj < 2; ++bj) { const int row = rbase + ai * HALF + m * 16; wn[m][bj] = *(const u32x2*)(G + blk_off(row, (seg - 1) * 1024 + col + bj * HALF, 3072)); wd[m][bj] = *(const u32x2*)(G + blk_off(row, seg * 1024 + col + bj * HALF, 3072)); }
#pragma unroll
            for (int m = 0; m < 4; ++m)
#pragma unroll
                for (int bj = 0; bj < 2; ++bj) {
                    const f32x4 n0 = g8unpack(wn[m][bj].x), n1 = g8unpack(wn[m][bj].y), d0 = g8unpack(wd[m][bj].x), d1 = g8unpack(wd[m][bj].y);
                    f32x4 r0, r1;
                    r0.x = n0.x * fast_rcp(d0.x); r0.y = n0.y * fast_rcp(d0.y); r0.z = n0.z * fast_rcp(d0.z); r0.w = n0.w * fast_rcp(d0.w);
                    r1.x = n1.x * fast_rcp(d1.x); r1.y = n1.y * fast_rcp(d1.y); r1.z = n1.z * fast_rcp(d1.z); r1.w = n1.w * fast_rcp(d1.w);
                    acc[ai][bj][m][0] = acc[ai][bj][m][0] * r0; acc[ai][bj][m][1] = acc[ai][bj][m][1] * r1;
                }
        }
    }
    __device__ __forceinline__ void operator()(const Acc& acc, const Unit& u, int wr, int wc, int fr, int fq) const {
        EPI_ROWBASE; const int col = u.pn * BM + wc * 32 + 8 * fq;
#pragma unroll
        for (int ai = 0; ai < 2; ++ai) {
            __builtin_amdgcn_sched_barrier(0);
            u32x2 wg[4][2];
#pragma unroll
            for (int m = 0; m < 4; ++m)
#pragma unroll
                for (int bj = 0; bj < 2; ++bj) wg[m][bj] = *(const u32x2*)(G + blk_off(rbase + ai * HALF + m * 16, 2048 + col + bj * HALF, 3072));
#pragma unroll
            for (int m = 0; m < 4; ++m)
#pragma unroll
                for (int bj = 0; bj < 2; ++bj) { const f32x4 g0 = g8unpack(wg[m][bj].x) * (1.f / 255.f), g1 = g8unpack(wg[m][bj].y) * (1.f / 255.f);
                    st16(wsb, (u32x4*)(MG + blk_off(rbase + ai * HALF + m * 16, col + bj * HALF, 1024)), pack8(acc[ai][bj][m][0] * g0, acc[ai][bj][m][1] * g1)); }
        }
    }
};
template <bool F8OUT> struct EpiRes {
    static constexpr bool PERM = true, MID = false; static constexpr int NVM = 40;
    bf16_t* xb; float* st; int row0; unsigned char* x8;
    __device__ __forceinline__ void operator()(const Acc& acc, const Unit& u, int wr, int wc, int fr, int fq) const {
        EPI_ROWBASE; const int col = u.pn * BM + wc * 32 + 8 * fq;
#pragma unroll
        for (int ai = 0; ai < 2; ++ai) {
            __builtin_amdgcn_sched_barrier(0);
            u32x4 xi[4][2];
#pragma unroll
            for (int m = 0; m < 4; ++m)
#pragma unroll
                for (int bj = 0; bj < 2; ++bj) xi[m][bj] = *(const u32x4*)(xb + (size_t)(row0 + rbase + ai * HALF + m * 16) * DM + col + bj * HALF);
#pragma unroll
            for (int m = 0; m < 4; ++m) {
                const int row = row0 + rbase + ai * HALF + m * 16; float ssq = 0.f;
#pragma unroll
                for (int bj = 0; bj < 2; ++bj) { f32x4 x0, x1; unpack8(xi[m][bj], x0, x1);
                    const f32x4 v0 = x0 + acc[ai][bj][m][0], v1 = x1 + acc[ai][bj][m][1];
                    *(u32x4*)(xb + (size_t)row * DM + col + bj * HALF) = pack8(v0, v1); ssq += sq8(v0, v1);
                    if constexpr (F8OUT) { u32x2 o8; o8.x = pk_fp8x4(v0.x * 16.f, v0.y * 16.f, v0.z * 16.f, v0.w * 16.f); o8.y = pk_fp8x4(v1.x * 16.f, v1.y * 16.f, v1.z * 16.f, v1.w * 16.f); *(u32x2*)(x8 + (size_t)row * DM + col + bj * HALF) = o8; } }
                ssq = fq_sum(ssq); if (fq == 0) st[(size_t)row * 16 + u.pn * 4 + wc] = ssq;
            }
        }
    }
};
__device__ __forceinline__ float silu_mul(float g, float u) { return g * sigmoidf_(g) * u; }
struct EpiGU {
    static constexpr bool PERM = true, MID = false; static constexpr int NVM = 16;
    bf16_t* ACT; const float* st; int ldact; unsigned char* wsb;
    __device__ __forceinline__ void operator()(const Acc& acc, const Unit& u, int wr, int wc, int fr, int fq) const {
        EPI_ROWBASE;
        float r8[8]; rowscale16(st, rbase, fq, r8);
        __builtin_amdgcn_sched_barrier(0);
        EPI_LOOP {
            const int row = rbase + ai * HALF + m * 16; const float r = r8[ai * 4 + m];
            f32x4 g0 = acc[ai][0][m][0] * r, g1 = acc[ai][0][m][1] * r, u0 = acc[ai][1][m][0] * r, u1 = acc[ai][1][m][1] * r;
#ifdef PROBE_P6NOISE
            { unsigned h_ = (unsigned)row * 2654435761u ^ (unsigned)(u.pn * 64 + wc * 8 + fq) * 40503u; float nz[16];
#pragma unroll
              for (int e_ = 0; e_ < 16; ++e_) { h_ = h_ * 1664525u + 1013904223u; nz[e_] = ((float)(h_ >> 8) * (1.f / 16777216.f) - 0.5f) * 3.4641f * 0.035f * (float)(PROBE_P6NOISE); }
              g0.x += nz[0]; g0.y += nz[1]; g0.z += nz[2]; g0.w += nz[3]; g1.x += nz[4]; g1.y += nz[5]; g1.z += nz[6]; g1.w += nz[7]; u0.x += nz[8]; u0.y += nz[9]; u0.z += nz[10]; u0.w += nz[11]; u1.x += nz[12]; u1.y += nz[13]; u1.z += nz[14]; u1.w += nz[15]; }
#endif
            const f32x4 a0 = {silu_mul(g0.x, u0.x), silu_mul(g0.y, u0.y), silu_mul(g0.z, u0.z), silu_mul(g0.w, u0.w)};
            const f32x4 a1 = {silu_mul(g1.x, u1.x), silu_mul(g1.y, u1.y), silu_mul(g1.z, u1.z), silu_mul(g1.w, u1.w)};
            st16(wsb, (u32x4*)(ACT + blk_off(row, u.aux * HALF + wc * 32 + 8 * fq, ldact)), pack8(a0, a1));
        }
    }
};
struct EpiGUMoe {
    static constexpr bool PERM = true, MID = false; static constexpr int NVM = 16;
    bf16_t* ACT; const float* rowrr; int ldact; unsigned char* wsb;
    __device__ __forceinline__ void operator()(const Acc& acc, const Unit& u, int wr, int wc, int fr, int fq) const {
        EPI_ROWBASE;
        float r8[8];
#pragma unroll
        for (int i = 0; i < 8; ++i) r8[i] = rowrr[rbase + (i >> 2) * HALF + (i & 3) * 16] * (MOE_F8 ? 1.f / 4096.f : 1.f);
        __builtin_amdgcn_sched_barrier(0);
        EPI_LOOP {
            const int row = rbase + ai * HALF + m * 16; const float r = r8[ai * 4 + m];
            const float ru = MOE_DN_F8 ? r * 8.f : r;
            const f32x4 g0 = acc[ai][0][m][0] * r, g1 = acc[ai][0][m][1] * r, u0 = acc[ai][1][m][0] * ru, u1 = acc[ai][1][m][1] * ru;
            const f32x4 a0 = {silu_mul(g0.x, u0.x), silu_mul(g0.y, u0.y), silu_mul(g0.z, u0.z), silu_mul(g0.w, u0.w)};
            const f32x4 a1 = {silu_mul(g1.x, u1.x), silu_mul(g1.y, u1.y), silu_mul(g1.z, u1.z), silu_mul(g1.w, u1.w)};
            if (MOE_DN_F8) { u32x2 o8; o8.x = pk_fp8x4(a0.x, a0.y, a0.z, a0.w); o8.y = pk_fp8x4(a1.x, a1.y, a1.z, a1.w);
                st8(wsb, (u32x2*)((unsigned char*)ACT + blk_off(row, (u.aux * HALF + wc * 32 + 8 * fq) >> 1, ldact >> 1) * 2), o8); }
            else st16(wsb, (u32x4*)(ACT + blk_off(row, u.aux * HALF + wc * 32 + 8 * fq, ldact)), pack8(a0, a1));
        }
    }
};
template <bool FIRST> struct EpiDnMoe {
    static constexpr bool PERM = true, MID = false; static constexpr int NVM = 32;
    unsigned char* ws; const int* rowtok; const float* rowgw;
    __device__ __forceinline__ void operator()(const Acc& acc, const Unit& u, int wr, int wc, int fr, int fq) const {
        EPI_ROWBASE; const int col = u.aux * BM + wc * 32 + 8 * fq;
        int tk[8]; float gw8[8];
#pragma unroll
        for (int i = 0; i < 8; ++i) { tk[i] = rowtok[rbase + (i >> 2) * HALF + (i & 3) * 16]; gw8[i] = rowgw[rbase + (i >> 2) * HALF + (i & 3) * 16] * (MOE_DN_F8 ? 1.f / 8192.f : 1.f); }
#pragma unroll
        for (int ai = 0; ai < 2; ++ai) {
            __builtin_amdgcn_sched_barrier(0);
            u32x4 xi[4][2]; bf16_t* xr[4];
#pragma unroll
            for (int m = 0; m < 4; ++m) { const int tok = tk[ai * 4 + m] < 0 ? 0 : tk[ai * 4 + m]; xr[m] = xm_row(ws, tok) + col;
                const bf16_t* src = FIRST ? (const bf16_t*)(ws + WS_XB) + (size_t)tok * DM + col : xr[m];
#pragma unroll
                for (int bj = 0; bj < 2; ++bj) xi[m][bj] = *(const u32x4*)(src + bj * HALF); }
#pragma unroll
            for (int m = 0; m < 4; ++m) { const float gwv = gw8[ai * 4 + m];
                if (tk[ai * 4 + m] >= 0) {
#pragma unroll
                    for (int bj = 0; bj < 2; ++bj) { f32x4 x0, x1; unpack8(xi[m][bj], x0, x1);
                        *(u32x4*)(xr[m] + bj * HALF) = pack8(x0 + acc[ai][bj][m][0] * gwv, x1 + acc[ai][bj][m][1] * gwv); } } }
        }
    }
};
}
namespace att {
constexpr float MLA_THR = 6.f;
__device__ __forceinline__ int crow(int r, int hi) { return (r & 3) + 8 * (r >> 2) + 4 * hi; }
__device__ __forceinline__ float xhalf_max(float m) { return xmax32(m); }
__device__ __forceinline__ float xhalf_sum(float m) { return xsum32(m); }
typedef short v4i16_t __attribute__((ext_vector_type(4)));
__device__ __forceinline__ s16x4 vtr(const LAS unsigned char* p) { return __builtin_bit_cast(s16x4, __builtin_amdgcn_ds_read_tr16_b64_v4i16((LAS v4i16_t*)p)); }
__device__ __forceinline__ bf16x8 cat8(s16x4 a, s16x4 b) { return (bf16x8){a[0], a[1], a[2], a[3], b[0], b[1], b[2], b[3]}; }
__device__ __forceinline__ bf16x8 pfrag(const f32x16& p, int s8) {
    u32x4 w; w.x = cvt_pk_bf16(p[s8 + 0], p[s8 + 1]); w.y = cvt_pk_bf16(p[s8 + 2], p[s8 + 3]); w.z = cvt_pk_bf16(p[s8 + 4], p[s8 + 5]); w.w = cvt_pk_bf16(p[s8 + 6], p[s8 + 7]);
    return __builtin_bit_cast(bf16x8, w);
}
constexpr int TAB_STRIDE = 320;

constexpr int BW_ROWS = 384, BW_KP = 144;
constexpr int BW_K = 0, BW_V = BW_ROWS * BW_KP, BW_VDH = BW_ROWS * 64, BW_TAB = BW_V + 2 * BW_VDH, BW_END = BW_TAB + 4 * TAB_STRIDE * 4;
struct BandPre { u32x4 k[6], v[6]; float t[4]; bf16x8 q[4]; };
struct BandItem { int kind, b, hh, g0, a0; };
__device__ __forceinline__ BandItem band_decode(int i, int items_per_kind) {
    BandItem it; it.kind = i / items_per_kind; const int w = i % items_per_kind;
    if (it.kind < 3) { const int sub = w & 7; it.hh = (w >> 3) & 7; it.b = w >> 6;
        if (it.kind == 0) { it.g0 = 0; it.a0 = 256 * sub; } else if (it.kind == 1) { it.g0 = sub >> 1; it.a0 = 256 * (sub & 1); } else { it.g0 = 2 * sub; it.a0 = 0; } }
    else { it.a0 = 64 * (w & 31); it.hh = (w >> 5) & 1; it.b = w >> 6; it.g0 = 0; }
    return it;
}
__device__ __forceinline__ bool band_row(const BandItem& it, int r, int& pos) {
    int key, g = it.g0, dil, L;
    if (it.kind == 3) { if (r >= 320) return false; key = it.a0 - 128 + r; dil = 1; L = SEQ; }
    else if (it.kind == 2) { if (r >= 256) return false; g += r >> 7; key = r & 127; dil = 16; L = 128; }
    else { dil = it.kind == 0 ? 1 : 4; L = SEQ / dil; key = it.a0 - 64 + r; }
    if (key < 0 || key >= L) return false;
    pos = key * dil + g; return true;
}
__device__ __forceinline__ void band_issue(BandPre& P, const BandItem& it, const bf16_t* HM, const float* tabg, int tid, int wid, int lane) {
    const bf16_t* kb = it.kind == 3 ? HM + (size_t)4 * MC * 512 + ((size_t)(it.b * 2 + it.hh) * SEQ) * 64 : HM + (size_t)MC * 512 + ((size_t)(it.b * 8 + it.hh) * SEQ) * 64;
    const bf16_t* vb = it.kind == 3 ? kb + (size_t)MC * 128 : kb + (size_t)MC * 512;
#pragma unroll
    for (int i = 0; i < 6; ++i) { const int id = i * 512 + tid, r = id >> 3, c = id & 7; int pos; P.k[i] = (u32x4){0u, 0u, 0u, 0u}; P.v[i] = P.k[i];
        if (band_row(it, r, pos)) { P.k[i] = *(const u32x4*)(kb + (size_t)pos * 64 + c * 8); P.v[i] = *(const u32x4*)(vb + (size_t)pos * 64 + c * 8); } }
#pragma unroll
    for (int j = 0; j < 4; ++j) { P.t[j] = 0.f; if (tid < TAB_STRIDE && (it.kind == 3 || j == 0)) P.t[j] = tabg[((it.kind == 3 ? 3 * 8 + it.hh * 4 + j : it.kind * 8 + it.hh)) * TAB_STRIDE + tid]; }
    int a0w, g = it.g0, dil, qh; const bf16_t* qbuf;
    if (it.kind == 3) { a0w = it.a0 + 32 * (wid & 1); dil = 1; qh = it.hh * 4 + (wid >> 1); qbuf = HM + (size_t)3 * MC * 512; }
    else if (it.kind == 2) { a0w = 32 * (wid & 3); g += wid >> 2; dil = 16; qh = it.hh; qbuf = HM; }
    else { a0w = it.a0 + 32 * wid; dil = it.kind == 0 ? 1 : 4; qh = it.hh; qbuf = HM; }
    const bf16_t* qp = qbuf + (((size_t)(it.b * 8 + qh) * SEQ) + (size_t)(a0w + (lane & 31)) * dil + g) * 64 + (lane >> 5) * 8;
#pragma unroll
    for (int d0 = 0; d0 < 4; ++d0) P.q[d0] = *(const bf16x8*)(qp + d0 * 16);
}
__device__ __forceinline__ void band_store(const BandPre& P, const BandItem& it, LAS unsigned char* lds, int tid) {
#pragma unroll
    for (int i = 0; i < 6; ++i) { const int id = i * 512 + tid, r = id >> 3, c = id & 7;
        *(LAS u32x4*)(lds + BW_K + r * BW_KP + c * 16) = P.k[i]; *(LAS u32x4*)(lds + BW_V + (c >> 2) * BW_VDH + r * 64 + (c & 3) * 16) = P.v[i]; }
    if (tid < TAB_STRIDE) {
#pragma unroll
        for (int j = 0; j < 4; ++j) if (it.kind == 3 || j == 0) ((LAS float*)(lds + BW_TAB))[j * TAB_STRIDE + tid] = P.t[j]; }
}
template <int NKB, int MODE>
__device__ __forceinline__ void band_compute(const bf16x8 (&qf)[4], const LAS unsigned char* lds, int rowoff, int a0w, int L, const LAS float* tab, bf16_t* op, float* stp, float sink2, int lane,
                                             const bf16_t* pb0 = nullptr, const bf16_t* pb1 = nullptr, const float* st0 = nullptr, const float* st1 = nullptr) {
    constexpr int R = 16 * (NKB - 1);
    const int q = lane & 31, hi = lane >> 5;
    f32x16 o0, o1;
#pragma unroll
    for (int r = 0; r < 16; ++r) { o0[r] = 0.f; o1[r] = 0.f; }
    float m = -3e38f, l = 0.f;
    const LAS float* tb = tab + (31 - q + 4 * hi);
    const int kro = q * BW_KP + hi * 16, vro = (4 * hi + ((lane & 15) >> 2)) * 64 + (16 * ((lane >> 4) & 1) + 4 * (lane & 3)) * 2;
#pragma unroll 1
    for (int kb = 0; kb < NKB; ++kb) {
        const int k0 = a0w - R + 32 * kb;
        if (k0 < 0 || k0 >= L) continue;
        const LAS unsigned char* kp = lds + BW_K + (rowoff + k0) * BW_KP + kro;
        f32x16 s;
#pragma unroll
        for (int r = 0; r < 16; ++r) s[r] = 0.f;
#pragma unroll
        for (int d0 = 0; d0 < 4; ++d0) s = __builtin_amdgcn_mfma_f32_32x32x16_bf16(*(const LAS bf16x8*)(kp + d0 * 32), qf[d0], s, 0, 0, 0);
#pragma unroll
        for (int r = 0; r < 16; ++r) s[r] += tb[32 * kb + (r & 3) + 8 * (r >> 2)];
        float bm = s[0];
#pragma unroll
        for (int r = 1; r < 16; ++r) bm = fmaxf(bm, s[r]);
        bm = xhalf_max(bm);
        if (__any(bm > m + MLA_THR)) {
            const float mn = fmaxf(m, bm), f = fast_exp2(m - mn); l *= f; m = mn;
#pragma unroll
            for (int r = 0; r < 16; ++r) { o0[r] *= f; o1[r] *= f; } }
        float ps = 0.f;
#pragma unroll
        for (int r = 0; r < 16; ++r) { s[r] = fast_exp2(s[r] - m); ps += s[r]; }
        l += ps;
        const bf16x8 p0 = pfrag(s, 0), p1 = pfrag(s, 8);
        const LAS unsigned char* vp = lds + BW_V + (rowoff + k0) * 64 + vro;
        { const bf16x8 v00 = cat8(vtr(vp), vtr(vp + 512)), v01 = cat8(vtr(vp + BW_VDH), vtr(vp + BW_VDH + 512));
          const bf16x8 v10 = cat8(vtr(vp + 1024), vtr(vp + 1024 + 512)), v11 = cat8(vtr(vp + BW_VDH + 1024), vtr(vp + BW_VDH + 1024 + 512));
          o0 = __builtin_amdgcn_mfma_f32_32x32x16_bf16(v00, p0, o0, 0, 0, 0); o1 = __builtin_amdgcn_mfma_f32_32x32x16_bf16(v01, p0, o1, 0, 0, 0);
          o0 = __builtin_amdgcn_mfma_f32_32x32x16_bf16(v10, p1, o0, 0, 0, 0); o1 = __builtin_amdgcn_mfma_f32_32x32x16_bf16(v11, p1, o1, 0, 0, 0); }
    }
    float lt = xhalf_sum(l);
    if (MODE == 2) {
        const f32x2 s0 = *(const f32x2*)st0, s1 = *(const f32x2*)st1;
        u32x2 a0[8], a1[8];
#pragma unroll
        for (int j = 0; j < 4; ++j) { a0[j] = *(const u32x2*)(pb0 + 8 * j); a0[4 + j] = *(const u32x2*)(pb0 + 32 + 8 * j); a1[j] = *(const u32x2*)(pb1 + 8 * j); a1[4 + j] = *(const u32x2*)(pb1 + 32 + 8 * j); }
        const float M = fmaxf(m, fmaxf(s0.x, s1.x));
        const float w0 = fast_exp2(s0.x - M) * s0.y, w1 = fast_exp2(s1.x - M) * s1.y, w2 = fast_exp2(m - M);
        const float inv = 1.f / (w0 + w1 + w2 * lt), c0 = w0 * inv, c1 = w1 * inv, c2 = w2 * inv;
#pragma unroll
        for (int j = 0; j < 4; ++j) {
            u32x2 w0_, w1_;
            { const float x0 = bf_lo(a0[j].x) * c0 + bf_lo(a1[j].x) * c1 + o0[4 * j] * c2, x1 = bf_hi(a0[j].x) * c0 + bf_hi(a1[j].x) * c1 + o0[4 * j + 1] * c2;
              const float x2 = bf_lo(a0[j].y) * c0 + bf_lo(a1[j].y) * c1 + o0[4 * j + 2] * c2, x3 = bf_hi(a0[j].y) * c0 + bf_hi(a1[j].y) * c1 + o0[4 * j + 3] * c2;
              w0_.x = cvt_pk_bf16(x0, x1); w0_.y = cvt_pk_bf16(x2, x3); }
            { const float x0 = bf_lo(a0[4 + j].x) * c0 + bf_lo(a1[4 + j].x) * c1 + o1[4 * j] * c2, x1 = bf_hi(a0[4 + j].x) * c0 + bf_hi(a1[4 + j].x) * c1 + o1[4 * j + 1] * c2;
              const float x2 = bf_lo(a0[4 + j].y) * c0 + bf_lo(a1[4 + j].y) * c1 + o1[4 * j + 2] * c2, x3 = bf_hi(a0[4 + j].y) * c0 + bf_hi(a1[4 + j].y) * c1 + o1[4 * j + 3] * c2;
              w1_.x = cvt_pk_bf16(x0, x1); w1_.y = cvt_pk_bf16(x2, x3); }
            *(u32x2*)(op + 8 * j) = w0_; *(u32x2*)(op + 32 + 8 * j) = w1_;
        }
        return;
    }
    if (MODE == 1) lt += fast_exp2(sink2 - m);
    else if (hi == 0) { stp[0] = m; stp[1] = lt; }
    const float inv = 1.f / lt;
#pragma unroll
    for (int j = 0; j < 4; ++j) {
        u32x2 w0, w1; w0.x = cvt_pk_bf16(o0[4 * j] * inv, o0[4 * j + 1] * inv); w0.y = cvt_pk_bf16(o0[4 * j + 2] * inv, o0[4 * j + 3] * inv);
        w1.x = cvt_pk_bf16(o1[4 * j] * inv, o1[4 * j + 1] * inv); w1.y = cvt_pk_bf16(o1[4 * j + 2] * inv, o1[4 * j + 3] * inv);
        *(u32x2*)(op + 8 * j) = w0; *(u32x2*)(op + 32 + 8 * j) = w1;
    }
}

constexpr int MLA_KP = 208;
constexpr int MLA_TK = 128;
constexpr int MLA_KTB = MLA_TK * MLA_KP;
constexpr int MLA_VTB = MLA_TK * 128;
constexpr int MLA_SLOT = MLA_KTB + MLA_VTB;
__device__ __forceinline__ void mla_unit(const bf16_t* Q, const bf16_t* KV, const bf16_t* Zc, bf16_t* Y, int b, int h, int qblk, LAS unsigned char* lds, int tid, int wid, int lane) {
    const int q = lane & 31, hi = lane >> 5;
    const size_t rb = (size_t)b * SEQ;
    bf16x8 qf[6];
    { const bf16_t* qp = Q + (rb + qblk * 256 + wid * 32 + q) * 768 + h * 96 + hi * 8;
#pragma unroll
      for (int d0 = 0; d0 < 6; ++d0) qf[d0] = *(const bf16x8*)(qp + d0 * 16); }
    const bf16_t* gk = KV + (rb + (tid >> 3)) * 1024 + h * 64 + (tid & 7) * 8;
    const bf16_t* gv = gk + 512;
    const bf16_t* gp = Zc + (rb + (tid >> 2)) * ZW + ZO_KPE + (tid & 3) * 8;
    const int lk = (tid >> 3) * MLA_KP + (tid & 7) * 16, lp = (tid >> 2) * MLA_KP + 128 + (tid & 3) * 16;
    const int lv = MLA_KTB + ((tid & 7) >> 2) * (MLA_TK * 64) + (tid >> 3) * 64 + (tid & 3) * 16;
    u32x4 rk0, rk1, rv0, rv1, rp;
#define MLA_GLOAD(T) do { const size_t go_ = (size_t)(T) * MLA_TK; rk0 = *(const u32x4*)(gk + go_ * 1024); rk1 = *(const u32x4*)(gk + (go_ + 64) * 1024); \
        rv0 = *(const u32x4*)(gv + go_ * 1024); rv1 = *(const u32x4*)(gv + (go_ + 64) * 1024); rp = *(const u32x4*)(gp + go_ * ZW); } while (0)
#define MLA_LSTORE(slot) do { LAS unsigned char* sb_ = lds + (slot) * MLA_SLOT; *(LAS u32x4*)(sb_ + lk) = rk0; *(LAS u32x4*)(sb_ + lk + 64 * MLA_KP) = rk1; \
        *(LAS u32x4*)(sb_ + lv) = rv0; *(LAS u32x4*)(sb_ + lv + 64 * 64) = rv1; *(LAS u32x4*)(sb_ + lp) = rp; } while (0)
    MLA_GLOAD(0); MLA_LSTORE(0); MLA_GLOAD(1); MLA_LSTORE(1);
    __syncthreads();
    f32x16 o0, o1;
#pragma unroll
    for (int r = 0; r < 16; ++r) { o0[r] = 0.f; o1[r] = 0.f; }
    float m = 0.f, l = 0.f;
    const int kro = q * MLA_KP + hi * 16;
    const int vro = MLA_KTB + (4 * hi + ((lane & 15) >> 2)) * 64 + (16 * ((lane >> 4) & 1) + 4 * (lane & 3)) * 2;
    f32x16 sa0, sa1, sb0, sb1, negm;
#pragma unroll
    for (int r = 0; r < 16; ++r) negm[r] = 0.f;
    m = 0.f;
#define MLA_QK(S0, S1, slot, sub) do { const LAS unsigned char* kb_ = lds + (slot) * MLA_SLOT + (sub) * 64 * MLA_KP + kro; \
        { const bf16x8 k0_ = *(const LAS bf16x8*)(kb_), k1_ = *(const LAS bf16x8*)(kb_ + 32 * MLA_KP); \
          S0 = __builtin_amdgcn_mfma_f32_32x32x16_bf16(k0_, qf[0], negm, 0, 0, 0); S1 = __builtin_amdgcn_mfma_f32_32x32x16_bf16(k1_, qf[0], negm, 0, 0, 0); } \
        _Pragma("unroll") for (int d0 = 1; d0 < 6; ++d0) { const bf16x8 k0_ = *(const LAS bf16x8*)(kb_ + d0 * 32), k1_ = *(const LAS bf16x8*)(kb_ + 32 * MLA_KP + d0 * 32); \
            S0 = __builtin_amdgcn_mfma_f32_32x32x16_bf16(k0_, qf[d0], S0, 0, 0, 0); S1 = __builtin_amdgcn_mfma_f32_32x32x16_bf16(k1_, qf[d0], S1, 0, 0, 0); } } while (0)
#define MAX3(a, b, c) __builtin_fmaxf(__builtin_fmaxf((a), (b)), (c))
#define MLA_STEP(C0, C1, N0, N1, HASN, NSLOT, NSUB, CSLOT, CSUB, FIRST) do { \
        if (HASN) MLA_QK(N0, N1, NSLOT, NSUB); \
        float ba = MAX3(C0[0], C0[1], C1[0]), bb = MAX3(C0[2], C0[3], C1[1]); ba = MAX3(ba, C1[2], C1[3]); \
        _Pragma("unroll") for (int r = 4; r < 16; r += 4) { ba = MAX3(ba, C0[r], C0[r + 1]); bb = MAX3(bb, C0[r + 2], C0[r + 3]); ba = MAX3(ba, C1[r], C1[r + 1]); bb = MAX3(bb, C1[r + 2], C1[r + 3]); } \
        float bm = xhalf_max(__builtin_fmaxf(ba, bb)); \
        if ((FIRST) || __any(bm > MLA_THR)) {                                \
            const float dl = (FIRST) ? bm : __builtin_fmaxf(bm, 0.f), f = fast_exp2(-dl); m += dl; l *= f; \
            _Pragma("unroll") for (int r = 0; r < 16; ++r) { o0[r] *= f; o1[r] *= f; C0[r] -= dl; C1[r] -= dl; negm[r] = -m; } \
            if (HASN) { _Pragma("unroll") for (int r = 0; r < 16; ++r) { N0[r] -= dl; N1[r] -= dl; } } } \
        float ps = 0.f; \
        _Pragma("unroll") for (int r = 0; r < 16; ++r) { C0[r] = fast_exp2(C0[r]); C1[r] = fast_exp2(C1[r]); ps += C0[r] + C1[r]; } \
        l += ps; \
        const bf16x8 p0 = pfrag(C0, 0), p1 = pfrag(C0, 8), p2 = pfrag(C1, 0), p3 = pfrag(C1, 8); \
        const LAS unsigned char* vb = lds + (CSLOT) * MLA_SLOT + (CSUB) * 64 * 64 + vro; \
        MLA_PV(0, p0); MLA_PV(1, p1); MLA_PV(2, p2); MLA_PV(3, p3); } while (0)
#define MLA_PV(S, P) do { const bf16x8 va = cat8(vtr(vb + (S) * 1024), vtr(vb + (S) * 1024 + 512)), vc = cat8(vtr(vb + MLA_TK * 64 + (S) * 1024), vtr(vb + MLA_TK * 64 + (S) * 1024 + 512)); \
            o0 = __builtin_amdgcn_mfma_f32_32x32x16_bf16(va, P, o0, 0, 0, 0); o1 = __builtin_amdgcn_mfma_f32_32x32x16_bf16(vc, P, o1, 0, 0, 0); } while (0)
    MLA_QK(sa0, sa1, 0, 0);
    int sc = 0, sn = 1, sw = 2;
    constexpr int NT = SEQ / MLA_TK;
    for (int T = 0; T < NT; ++T) {
        const bool has1 = T + 1 < NT, has2 = T + 2 < NT;
        if (has2) MLA_GLOAD(T + 2);
        MLA_STEP(sa0, sa1, sb0, sb1, true, sc, 1, sc, 0, T == 0);
        MLA_STEP(sb0, sb1, sa0, sa1, has1, sn, 0, sc, 1, false);
        if (has2) MLA_LSTORE(sw);
        __syncthreads();
        const int tmp = sc; sc = sn; sn = sw; sw = tmp;
    }
#undef MAX3
#undef MLA_GLOAD
#undef MLA_LSTORE
#undef MLA_QK
#undef MLA_STEP
#undef MLA_PV
    const float inv = 1.f / xhalf_sum(l);
    bf16_t* op = Y + (rb + qblk * 256 + wid * 32 + q) * 1536 + h * 64 + 4 * hi;
#pragma unroll
    for (int j = 0; j < 4; ++j) {
        u32x2 w0, w1; w0.x = cvt_pk_bf16(o0[4 * j] * inv, o0[4 * j + 1] * inv); w0.y = cvt_pk_bf16(o0[4 * j + 2] * inv, o0[4 * j + 3] * inv);
        w1.x = cvt_pk_bf16(o1[4 * j] * inv, o1[4 * j + 1] * inv); w1.y = cvt_pk_bf16(o1[4 * j + 2] * inv, o1[4 * j + 3] * inv);
        *(u32x2*)(op + 8 * j) = w0; *(u32x2*)(op + 32 + 8 * j) = w1;
    }
}
}
constexpr int NWAVES = 8, NTHREADS = 512;
constexpr int LDS_BYTES = 147456;
constexpr int MISC_OFF = 131072 + 320;
#define LDS_WAIT() asm volatile("s_waitcnt lgkmcnt(0)" ::: "memory")

struct Args { const float* in[22]; float* out; unsigned char* ws; int ph_lo, ph_hi; };

enum { MAP_ID = 0, MAP_WIN, MAP_WUQ, MAP_WUKV, MAP_GATE, MAP_UP, MAP_WIN8 };
__device__ __forceinline__ int map_row(int map, int n) {
    if (map == MAP_WIN || map == MAP_WIN8) {
        const int o = map == MAP_WIN8 ? P1_F8_FROM * 256 : 0;
        if (n < 384) return n - o;
        if (n < 416) { const int i = n - 384; return 384 + (i < 16 ? 2 * i : 2 * (i - 16) + 1) - o; }
        return n + 96 - o;
    }
    if (map == MAP_WUQ) { const int h = n / 96, j = n % 96; if (j < 64) return n; const int i = j - 64; return h * 96 + 64 + (i < 16 ? 2 * i : 2 * (i - 16) + 1); }
    if (map == MAP_WUKV) { const int h = n >> 7, j = n & 127; return j < 64 ? h * 64 + j : 512 + h * 64 + (j - 64); }
    if (map == MAP_GATE) return (n >> 7) * 256 + (n & 127);
    if (map == MAP_UP) return (n >> 7) * 256 + 128 + (n & 127);
    return n;
}
template <bool F8 = false>
__device__ __forceinline__ void cvt_item(const float* src, int ldsrc, int nblk, const float* gain, float scale, bf16_t* dst, int lddst, int kdst0, int map, LAS float* scr, int item, int lane) {
    const int kb = item / nblk, nb = item % nblk, k0 = 64 * kb, n0 = 32 * nb;
    f32x4 v[8]; float gs[8];
#pragma unroll
    for (int i = 0; i < 8; ++i) { const int idx = i * 64 + lane, kk = idx >> 3, c4 = idx & 7; v[i] = *(const f32x4*)(src + (size_t)(k0 + kk) * ldsrc + n0 + 4 * c4); gs[i] = gain ? gain[k0 + kk] * scale : scale; }
#pragma unroll
    for (int i = 0; i < 8; ++i) { const int idx = i * 64 + lane, kk = idx >> 3, c4 = idx & 7; LAS float* d = scr + kk * 33 + 4 * c4; d[0] = v[i].x * gs[i]; d[1] = v[i].y * gs[i]; d[2] = v[i].z * gs[i]; d[3] = v[i].w * gs[i]; }
    LDS_WAIT(); asm volatile("" ::: "memory");
    const int c = lane & 7;
#pragma unroll
    for (int j = 0; j < 4; ++j) { const int n = (lane >> 3) + 8 * j; const LAS float* s = scr + (8 * c) * 33 + n;
        u32x4 o; o.x = cvt_pk_bf16(s[0 * 33], s[1 * 33]); o.y = cvt_pk_bf16(s[2 * 33], s[3 * 33]); o.z = cvt_pk_bf16(s[4 * 33], s[5 * 33]); o.w = cvt_pk_bf16(s[6 * 33], s[7 * 33]);
        if constexpr (F8) { u32x2 o8; o8.x = pk_fp8x4(s[0 * 33], s[1 * 33], s[2 * 33], s[3 * 33]); o8.y = pk_fp8x4(s[4 * 33], s[5 * 33], s[6 * 33], s[7 * 33]);
            *(u32x2*)((unsigned char*)dst + (size_t)map_row(map, n0 + n) * lddst + kdst0 + k0 + 8 * c) = o8; }
        else *(u32x4*)(dst + (size_t)map_row(map, n0 + n) * lddst + kdst0 + k0 + 8 * c) = o; }
    LDS_WAIT(); asm volatile("" ::: "memory");
}

struct Ctx {
    LAS unsigned char* lds; int tid, lane, wave, vcu, G, gw, NGW;
    const float* const* in; float* out; unsigned char* ws;
};

__device__ __forceinline__ void phase_prologue(const Ctx& C) {
    LAS float* scr = (LAS float*)(C.lds + C.wave * 16384);
    unsigned char* ws = C.ws;
    constexpr int I_IN = 16 * 181, I_UQ = 4 * 24, I_UKV = 2 * 32, I_BR = 8 * 32, I_OUT = 16 * 32, I_L = I_IN + I_UQ + I_UKV + 3 * I_BR + I_OUT;
    constexpr int I_G = 16 * 88, I_D = 44 * 32, NIT = 2 * I_L + 2 * I_G + I_D;
    for (int it = C.gw; it < NIT; it += C.NGW) {
        int r = it;
        if (r < 2 * I_L) { const int l = r / I_L; r -= l * I_L;
            if (r < I_IN) { if (r % 181 >= (P1_F8_FROM <= 1 ? P1_F8_FROM * 8 : (P1_F8_FROM * 256 - 96) / 32)) cvt_item<true>(C.in[2] + (size_t)l * DM * INC, INC, 181, C.in[1] + l * DM, 256.f, (bf16_t*)(ws + WS_WIN8 + l * SZ_WIN8), DM, 0, MAP_WIN8, scr, r, C.lane);
                            else cvt_item(C.in[2] + (size_t)l * DM * INC, INC, 181, C.in[1] + l * DM, 1.f, (bf16_t*)(ws + WS_WIN + l * SZ_WIN), DM, 0, MAP_WIN, scr, r, C.lane); continue; } r -= I_IN;
            if (r < I_UQ) { cvt_item(C.in[4] + (size_t)l * 256 * 768, 768, 24, C.in[3] + l * 256, 0.10206207261596577f * LOG2E, (bf16_t*)(ws + WS_WUQ + l * SZ_WUQ), 256, 0, MAP_WUQ, scr, r, C.lane); continue; } r -= I_UQ;
            if (r < I_UKV) { cvt_item(C.in[6] + (size_t)l * 128 * 1024, 1024, 32, C.in[5] + l * 128, 1.f, (bf16_t*)(ws + WS_WUKV + l * SZ_WUKV), 256, 0, MAP_WUKV, scr, r, C.lane); continue; } r -= I_UKV;
            if (r < 3 * I_BR) { const int br = r / I_BR; r -= br * I_BR; cvt_item(C.in[9 + br] + (size_t)l * 512 * DM, DM, 32, nullptr, 1.f, (bf16_t*)(ws + WS_WBR + l * SZ_WBR), 1536, br * 512, MAP_ID, scr, r, C.lane); continue; } r -= 3 * I_BR;
            cvt_item(C.in[12] + (size_t)l * DM * DM, DM, 32, nullptr, 1.f, (bf16_t*)(ws + WS_WOUT + l * SZ_WOUT), DM, 0, MAP_ID, scr, r, C.lane); continue; }
        r -= 2 * I_L;
        if (r < I_G) { cvt_item(C.in[14], DFF, 88, C.in[13], 1.f, (bf16_t*)(ws + WS_WGU), DM, 0, MAP_GATE, scr, r, C.lane); continue; } r -= I_G;
        if (r < I_G) { cvt_item(C.in[15], DFF, 88, C.in[13], 1.f, (bf16_t*)(ws + WS_WGU), DM, 0, MAP_UP, scr, r, C.lane); continue; } r -= I_G;
        cvt_item(C.in[16], DM, 32, nullptr, 1.f, (bf16_t*)(ws + WS_WD), DFF, 0, MAP_ID, scr, r, C.lane);
    }
    const int gt = C.vcu * NTHREADS + C.tid, NGT = C.G * NTHREADS;
    if (P1_F8_FROM <= 1) for (int i = gt; i < 2 * 6144; i += NGT) { const int l = i / 6144, r = i % 6144; const u32x4 z = {0u, 0u, 0u, 0u}; *(u32x4*)(ws + WS_WIN8 + l * SZ_WIN8 + (size_t)(416 - P1_F8_FROM * 256) * DM + (size_t)r * 16) = z; }
    for (int i = gt; i < 2 * (12288 + 16384); i += NGT) { const int l = i / (12288 + 16384); int r = i % (12288 + 16384); const u32x4 z = {0u, 0u, 0u, 0u};
        if (r < 12288) *(u32x4*)(ws + WS_WIN + l * SZ_WIN + (size_t)416 * DM * 2 + (size_t)r * 16) = z;
        else { r -= 12288; *(u32x4*)(ws + WS_WUKV + l * SZ_WUKV + (size_t)(r >> 4) * 512 + 256 + (r & 15) * 16) = z; } }
    float* cosT = (float*)(ws + WS_TAB); float* sinT = cosT + SEQ * 16; float* tabb = sinT + SEQ * 16;
    for (int i = gt; i < SEQ * 16; i += NGT) { const int pos = i >> 4, k = i & 15; const float inv = powf(10000.f, -(float)k / 16.f); const float ang = (float)pos * inv; cosT[i] = cosf(ang); sinT[i] = sinf(ang); }
    for (int i = gt; i < 4 * 8 * att::TAB_STRIDE; i += NGT) { const int kind = i / (8 * att::TAB_STRIDE), h = (i / att::TAB_STRIDE) & 7, idx = i % att::TAB_STRIDE;
        const int R = kind == 3 ? 128 : 64, dil = kind == 1 ? 4 : (kind == 2 ? 16 : 1), rel = idx - (R + 31);
        float v = NEGB; if (rel >= -R && rel <= R) v = C.in[8][t5_bucket(rel * dil) * 16 + (kind == 3 ? 8 : 0) + h] * LOG2E;
        tabb[i] = v; }
    const float* x = C.in[0]; bf16_t* xb = (bf16_t*)(ws + WS_XB); float* st = (float*)(ws + WS_ST);
    for (int row = 2 * C.gw; row < MTOK; row += 2 * C.NGW) {
        const f32x4* xr = (const f32x4*)(x + (size_t)row * DM) + C.lane; f32x4 v[8];
#pragma unroll
        for (int j = 0; j < 8; ++j) v[j] = xr[64 * j];
        float s0 = 0.f, s1 = 0.f;
#pragma unroll
        for (int j = 0; j < 8; ++j) { const float q = (v[j].x * v[j].x + v[j].y * v[j].y) + (v[j].z * v[j].z + v[j].w * v[j].w); if (j < 4) s0 += q; else s1 += q;
            u32x2 w; w.x = cvt_pk_bf16(v[j].x, v[j].y); w.y = cvt_pk_bf16(v[j].z, v[j].w); *((u32x2*)(xb + (size_t)row * DM) + C.lane + 64 * j) = w;
            if (P1_F8_FROM < 23) *((unsigned*)(ws + WS_XB8P + (size_t)(row + (j >> 2)) * DM) + C.lane + 64 * (j & 3)) = pk_fp8x4(v[j].x * 16.f, v[j].y * 16.f, v[j].z * 16.f, v[j].w * 16.f); }
        s0 = wave_sum(s0); s1 = wave_sum(s1);
        if (C.lane < 32) st[(size_t)row * 16 + C.lane] = C.lane == 0 ? s0 : (C.lane == 16 ? s1 : 0.f);
    }
}

__device__ __forceinline__ void phase_moe_weights(const Ctx& C) {
    LAS float* scr = (LAS float*)(C.lds + 40960 + C.wave * 8704);
    constexpr int I_G = 16 * 112, I_D = 56 * 32, I_E = 2 * I_G + I_D;
    for (int it = C.gw; it < NEXP * I_E; it += C.NGW) {
        const int e = it / I_E; int r = it % I_E;
        if (r < I_G) { cvt_item<MOE_F8 != 0>(C.in[18] + (size_t)e * DM * DFE, DFE, 112, C.in[13] + DM, MOE_F8 ? 256.f : 1.f, (bf16_t*)(C.ws + WS_EGU + (size_t)e * 2 * DFE * DM * (MOE_F8 ? 1 : 2)), DM, 0, MAP_GATE, scr, r, C.lane); continue; } r -= I_G;
        if (r < I_G) { cvt_item<MOE_F8 != 0>(C.in[19] + (size_t)e * DM * DFE, DFE, 112, C.in[13] + DM, MOE_F8 ? 256.f : 1.f, (bf16_t*)(C.ws + WS_EGU + (size_t)e * 2 * DFE * DM * (MOE_F8 ? 1 : 2)), DM, 0, MAP_UP, scr, r, C.lane); continue; } r -= I_G;
        cvt_item<MOE_DN_F8 != 0>(C.in[20] + (size_t)e * DFE * DM, DM, 32, nullptr, MOE_DN_F8 ? 1024.f : 1.f, (bf16_t*)(C.ws + WS_ED + (size_t)e * DM * DFE * (MOE_DN_F8 ? 1 : 2)), DFE, 0, MAP_ID, scr, r, C.lane);
    }
}

template <bool SECOND>
__device__ __forceinline__ void phase_band(const Ctx& C, const bf16_t* HM, bf16_t* PB, float* PBS, bf16_t* Y, const float* sink) {
    constexpr int IPK = MC / 2048 * 64, NIT = (SECOND ? 1 : 3) * IPK;
    const float* tabg = (const float*)(C.ws + WS_TAB) + 2 * SEQ * 16;
    att::BandPre P; att::BandItem it, nx;
    int i = C.vcu;
#define BAND_IDX(IDX) (SECOND ? 2 * IPK + (IDX) : ((IDX) < 2 * IPK ? (IDX) : (IDX) + IPK))
    if (i < NIT) { it = att::band_decode(BAND_IDX(i), IPK); att::band_issue(P, it, HM, tabg, C.tid, C.wave, C.lane); }
    for (; i < NIT; i += C.G) {
        att::band_store(P, it, C.lds, C.tid);
        bf16x8 qf[4];
#pragma unroll
        for (int d0 = 0; d0 < 4; ++d0) qf[d0] = P.q[d0];
        __syncthreads();
        const bool more = i + C.G < NIT;
        if (more) { nx = att::band_decode(BAND_IDX(i + C.G), IPK); att::band_issue(P, nx, HM, tabg, C.tid, C.wave, C.lane); }
        const int q = C.lane & 31, hi = C.lane >> 5, w = C.wave;
        if (it.kind == 3) {
            const int h = it.hh * 4 + (w >> 1), a0w = it.a0 + 32 * (w & 1); const size_t rowq = (size_t)it.b * SEQ + a0w + q;
            att::band_compute<9, 1>(qf, C.lds, 128 - it.a0, a0w, SEQ, (const LAS float*)(C.lds + att::BW_TAB) + (w >> 1) * att::TAB_STRIDE, Y + rowq * 1536 + 1024 + h * 64 + 4 * hi, nullptr, sink[h] * LOG2E, C.lane);
        } else if (it.kind == 2) {
            const int a0w = 32 * (w & 3), g = it.g0 + (w >> 2); const size_t rowq = (size_t)it.b * SEQ + (size_t)(a0w + q) * 16 + g;
            const size_t po = rowq * 512 + it.hh * 64 + 4 * hi, so = (rowq * 8 + it.hh) * 2;
            att::band_compute<5, 2>(qf, C.lds, (w >> 2) * 128, a0w, 128, (const LAS float*)(C.lds + att::BW_TAB), Y + rowq * 1536 + 512 + it.hh * 64 + 4 * hi, nullptr, 0.f, C.lane,
                                    PB + po, PB + (size_t)MC * 512 + po, PBS + so, PBS + (size_t)MC * 16 + so);
        } else {
            const int a0w = it.a0 + 32 * w, dil = it.kind == 0 ? 1 : 4, L = SEQ / dil, rowoff = 64 - it.a0;
            const size_t rowq = (size_t)it.b * SEQ + (size_t)(a0w + q) * dil + it.g0;
            att::band_compute<5, 0>(qf, C.lds, rowoff, a0w, L, (const LAS float*)(C.lds + att::BW_TAB), PB + (size_t)it.kind * MC * 512 + rowq * 512 + it.hh * 64 + 4 * hi,
                                    PBS + (size_t)it.kind * MC * 16 + (rowq * 8 + it.hh) * 2, 0.f, C.lane);
        }
        __syncthreads();
        it = nx;
    }
#undef BAND_IDX
}

__device__ __forceinline__ void phase_mla(const Ctx& C, const bf16_t* Q, const bf16_t* KV, const bf16_t* Zc, bf16_t* Y) {
    constexpr int NU = MC / 256 * 8;
    for (int u = C.vcu; u < NU; u += C.G) { const int qblk = u & 7, bh = u >> 3; att::mla_unit(Q, KV, Zc, Y, bh >> 3, bh & 7, qblk, C.lds, C.tid, C.wave, C.lane); }
}

__device__ __forceinline__ void phase_route(const Ctx& C) {
    LAS float* wr = (LAS float*)C.lds; LAS int* cnt = (LAS int*)(C.lds + 32768);
    const float* g2 = C.in[13] + DM; const float* router = C.in[17];
    for (int i = C.tid; i < DM * 8; i += NTHREADS) wr[i] = router[i] * g2[i >> 3];
    if (C.tid < 16) cnt[C.tid] = 0;
    __syncthreads();
    int* sel = (int*)(C.ws + WS_SEL); float* gwp = (float*)(C.ws + WS_GW); float* rr = (float*)(C.ws + WS_RR);
    const int w = blockIdx.x;
    for (int j = 0; j < 16; ++j) {
        const int tok = w * 128 + C.wave * 16 + j;
        const u32x2* xr = (const u32x2*)((const bf16_t*)(C.ws + WS_XB) + (size_t)tok * DM) + C.lane;
        float lg[8], ss = 0.f;
#pragma unroll
        for (int e = 0; e < 8; ++e) lg[e] = 0.f;
#pragma unroll
        for (int q = 0; q < 4; ++q) { const u32x2 wv = xr[64 * q]; const f32x4 v = {bf_lo(wv.x), bf_hi(wv.x), bf_lo(wv.y), bf_hi(wv.y)}; ss += (v.x * v.x + v.y * v.y) + (v.z * v.z + v.w * v.w);
            const int k = 4 * C.lane + 256 * q;
            if (MOE_F8) *(unsigned*)(C.ws + WS_XB8 + (size_t)tok * DM + k) = pk_fp8x4(v.x * 16.f, v.y * 16.f, v.z * 16.f, v.w * 16.f);
#pragma unroll
            for (int c = 0; c < 4; ++c) { const float xv = v[c]; const f32x4 w0 = *(const LAS f32x4*)(wr + (k + c) * 8), w1 = *(const LAS f32x4*)(wr + (k + c) * 8 + 4);
                lg[0] += xv * w0.x; lg[1] += xv * w0.y; lg[2] += xv * w0.z; lg[3] += xv * w0.w; lg[4] += xv * w1.x; lg[5] += xv * w1.y; lg[6] += xv * w1.z; lg[7] += xv * w1.w; } }
        ss = wave_sum(ss);
#pragma unroll
        for (int e = 0; e < 8; ++e) lg[e] = wave_sum(lg[e]);
        const float r = rsqrtf(ss * (1.f / 1024.f) + EPS);
        if (C.lane == 0) {
            int i1 = 0; float v1 = lg[0];
#pragma unroll
            for (int e = 1; e < 8; ++e) if (lg[e] > v1) { v1 = lg[e]; i1 = e; }
            int i2 = -1; float v2 = -3e38f;
#pragma unroll
            for (int e = 0; e < 8; ++e) if (e != i1 && lg[e] > v2) { v2 = lg[e]; i2 = e; }
            const float e2 = expf((v2 - v1) * r);
            sel[tok * 2] = i1; sel[tok * 2 + 1] = i2; gwp[tok * 2] = 1.f / (1.f + e2); gwp[tok * 2 + 1] = e2 / (1.f + e2); rr[tok] = r;
            __hip_atomic_fetch_add(&cnt[i1], 1, __ATOMIC_RELAXED, __HIP_MEMORY_SCOPE_WORKGROUP); __hip_atomic_fetch_add(&cnt[8 + i2], 1, __ATOMIC_RELAXED, __HIP_MEMORY_SCOPE_WORKGROUP);
        }
    }
    __syncthreads();
    if (C.tid < 16) ((int*)(C.ws + WS_META))[MI_CNT + (C.tid >> 3) * 2048 + w * 8 + (C.tid & 7)] = cnt[C.tid];
}

__device__ __forceinline__ void phase_sort(const Ctx& C) {
    LAS int* tot = (LAS int*)C.lds; LAS int* pre = tot + 16; LAS int* base = tot + 32;
    int* meta = (int*)(C.ws + WS_META); const int w = blockIdx.x;
    if (C.tid < 16) { const int k = C.tid >> 3, e = C.tid & 7; int t = 0, p = 0;
        for (int w2 = 0; w2 < 256; ++w2) { const int c = meta[MI_CNT + k * 2048 + w2 * 8 + e]; t += c; if (w2 < w) p += c; }
        tot[C.tid] = t; pre[C.tid] = p; }
    __syncthreads();
    if (C.tid < 16) { const int k = C.tid >> 3, e = C.tid & 7; int b = 0; for (int e2 = 0; e2 < e; ++e2) b += (tot[k * 8 + e2] + 255) & ~255; base[C.tid] = b; }
    __syncthreads();
    const int* sel = (const int*)(C.ws + WS_SEL); const float* gwp = (const float*)(C.ws + WS_GW);
    int* rowtok = (int*)(C.ws + WS_ROWTOK); float* rowgw = (float*)(C.ws + WS_ROWGW); float* rowrr = (float*)(C.ws + WS_ROWRR); const float* rr = (const float*)(C.ws + WS_RR);
    if (C.wave < 2) { const int k = C.wave; LAS int* runL = tot + 48 + k * 8;
        if (C.lane < 8) runL[C.lane] = base[k * 8 + C.lane] + pre[k * 8 + C.lane];
        for (int j = 0; j < 2; ++j) { const int tok = w * 128 + j * 64 + C.lane; const int e = sel[tok * 2 + k]; int pos = 0;
#pragma unroll 1
            for (int e2 = 0; e2 < 8; ++e2) { const unsigned long long mk = __ballot(e == e2); const int r0 = runL[e2]; const int rank = __popcll(mk & ((1ull << C.lane) - 1ull));
                if (e == e2) pos = r0 + rank; if (C.lane == 0) runL[e2] = r0 + __popcll(mk); }
            rowtok[k * MOE_ROWS + pos] = tok; rowgw[k * MOE_ROWS + pos] = gwp[tok * 2 + k]; rowrr[k * MOE_ROWS + pos] = rr[tok]; } }
    if (w < 16) { const int k = w >> 3, e = w & 7; const int t = tot[k * 8 + e], b = base[k * 8 + e], pe = (t + 255) & ~255;
        for (int i = b + t + C.tid; i < b + pe; i += NTHREADS) { rowtok[k * MOE_ROWS + i] = -1; rowgw[k * MOE_ROWS + i] = 0.f; rowrr[k * MOE_ROWS + i] = 0.f; } }
    if (w == 16 && C.tid < 2) { const int k = C.tid; int nt = 0;
        for (int e = 0; e < 8; ++e) { const int n = (tot[k * 8 + e] + 255) >> 8; for (int i = 0; i < n; ++i) meta[MI_TILEE + k * 160 + nt + i] = e; nt += n; }
        meta[MI_NTILE + k] = nt; }
}

__device__ __forceinline__ void phase_final(const Ctx& C) {
    const float* g = C.in[21];
    for (int row = 2 * C.gw; row < MTOK; row += 2 * C.NGW) {
        f32x4 v[8]; float s0 = 0.f, s1 = 0.f;
#pragma unroll
        for (int j = 0; j < 8; ++j) { const u32x2 wv = ((const u32x2*)xm_row(C.ws, row + (j >> 2)))[C.lane + 64 * (j & 3)]; v[j] = (f32x4){bf_lo(wv.x), bf_hi(wv.x), bf_lo(wv.y), bf_hi(wv.y)}; }
#ifdef PROBE_NAN
#pragma unroll
        for (int j = 0; j < 8; ++j) { v[j].x = v[j].x == v[j].x && fabsf(v[j].x) < 1e30f ? v[j].x : 0.f; v[j].y = v[j].y == v[j].y && fabsf(v[j].y) < 1e30f ? v[j].y : 0.f; v[j].z = v[j].z == v[j].z && fabsf(v[j].z) < 1e30f ? v[j].z : 0.f; v[j].w = v[j].w == v[j].w && fabsf(v[j].w) < 1e30f ? v[j].w : 0.f; }
#endif
#pragma unroll
        for (int j = 0; j < 8; ++j) { const float q = (v[j].x * v[j].x + v[j].y * v[j].y) + (v[j].z * v[j].z + v[j].w * v[j].w); if (j < 4) s0 += q; else s1 += q; }
        const float r0 = rsqrtf(wave_sum(s0) * (1.f / 1024.f) + EPS), r1 = rsqrtf(wave_sum(s1) * (1.f / 1024.f) + EPS);
        f32x4* orow = (f32x4*)(C.out + (size_t)row * DM) + C.lane;
#pragma unroll
        for (int j = 0; j < 8; ++j) orow[64 * j] = v[j] * (j < 4 ? r0 : r1) * ((const f32x4*)g)[C.lane + 64 * (j & 3)];
    }
}
#ifndef MKP
#define MKP 0x1ffff
#endif
#ifndef ALEPI
#define ALEPI true
#endif
#ifndef ALEPI1
#define ALEPI1 ALEPI
#endif
#ifndef DUPK
#define DUPK 0
#endif
#ifdef PROBE_TIMER
#define PROBE_T0 __syncthreads(); const unsigned long long pt0_ = __builtin_amdgcn_s_memrealtime()
#define PROBE_T1(slot) __syncthreads(); if (threadIdx.x == 0) { const unsigned long long pt1_ = __builtin_amdgcn_s_memrealtime(); atomicAdd((unsigned*)(ws + WS_CTL) + CW_Q + 2048 + (slot), (unsigned)(pt1_ - pt0_)); }
#else
#define PROBE_T0
#define PROBE_T1(slot)
#endif
#define REP(bit) for (int rep_ = 0; rep_ < ((DUPK & (bit)) ? 2 : 1); ++rep_)
constexpr int PH_PER_CHUNK = 3, PH_LAYER_TAIL = 2;
constexpr int PH_L0 = 1, PH_FFN = PH_L0 + PH_PER_CHUNK * NCHUNK + PH_LAYER_TAIL, PH_L1 = PH_FFN + 2, PH_MOE = PH_L1 + PH_PER_CHUNK * NCHUNK + PH_LAYER_TAIL, PH_FINAL = PH_MOE + (MOE_NOSPLIT ? 5 : 7), PH_TOTAL = PH_FINAL + 1;

__global__ void __launch_bounds__(NTHREADS, 2) mega(Args args) {
    extern __shared__ __attribute__((aligned(16))) unsigned char lds_raw[];
#define MKCTX Ctx C; { int t_ = threadIdx.x; asm volatile("" : "+v"(t_)); C.lds = (LAS unsigned char*)lds_raw; C.tid = t_; C.lane = t_ & 63; C.wave = __builtin_amdgcn_readfirstlane(t_ >> 6); \
    C.G = gridDim.x; { const int bx = blockIdx.x; C.vcu = (C.G % 8 == 0) ? (bx % 8) * (C.G / 8) + bx / 8 : bx; } \
    C.gw = C.vcu * NWAVES + C.wave; C.NGW = C.G * NWAVES; C.in = args.in; C.out = args.out; C.ws = args.ws; }
    volatile LAS unsigned* MISC = (volatile LAS unsigned*)((LAS unsigned char*)lds_raw + MISC_OFF);
    if (threadIdx.x < 32) MISC[threadIdx.x] = 0u;
    __syncthreads();
    unsigned char* ws = args.ws;
    XcdBarrier bar; bar.bar = (unsigned*)(ws + WS_CTL) + CW_BAR; bar.x = 0; bar.st = nullptr;
    const int lo = args.ph_lo, hi = args.ph_hi;
    const bool use_bar = (hi - lo) > 1;
    if (use_bar) bar = xcd_barrier_post((unsigned*)(ws + WS_CTL) + CW_BAR, MISC + 8);
    int ph = 0;
#define IN_PH (ph >= lo && ph < hi)
#ifdef PROBE_BAR
    const unsigned long long pk0_ = __builtin_amdgcn_s_memrealtime();
#define END_PH do { if (ph >= lo && ph + 1 < hi) { __syncthreads(); const unsigned long long pb0_ = __builtin_amdgcn_s_memrealtime(); xcd_barrier(bar); \
        if (threadIdx.x == 0 && (((unsigned)(PROBE_BAR) >> ph) & 1u)) atomicAdd((unsigned*)(ws + WS_CTL) + CW_Q + 2048, (unsigned)(__builtin_amdgcn_s_memrealtime() - pb0_)); } ++ph; } while (0)
#else
#define END_PH do { if (ph >= lo && ph + 1 < hi) xcd_barrier(bar); ++ph; } while (0)
#endif

    bf16_t* xb = (bf16_t*)(ws + WS_XB); float* st = (float*)(ws + WS_ST);
    const float* cosT = (const float*)(ws + WS_TAB); const float* sinT = cosT + SEQ * 16;

    if (IN_PH) REP(1) { MKCTX; if (MKP & 1) phase_prologue(C); }
    END_PH;
#ifdef PROBE_SLEEP
    { const unsigned long long t0_ = __builtin_amdgcn_s_memrealtime(); while (__builtin_amdgcn_s_memrealtime() - t0_ < (unsigned long long)(PROBE_SLEEP) * 100ull) __builtin_amdgcn_s_sleep(64); }
#endif

#define CHUNK_BODY(l, c) \
{ \
            const int row0 = c * MC; \
            bf16_t* Z = (bf16_t*)(ws + WS_Z); bf16_t* Q = (bf16_t*)(ws + WS_Q); bf16_t* KV = TMP_IN_OUT ? (bf16_t*)args.out : (bf16_t*)(ws + WS_KV); bf16_t* Y = (bf16_t*)(ws + WS_Y) + (size_t)row0 * 1536; \
            bf16_t* PB = TMP_IN_OUT ? (bf16_t*)args.out + (size_t)MC * 1024 : (bf16_t*)(ws + WS_PB); float* PBS = (float*)(ws + WS_PBS); float* SQ = (float*)(ws + WS_SQ); float* SKV = SQ + (size_t)MC * 4; \
 \
            if (IN_PH && (MKP & 2)) REP(2) { MKCTX; \
                pg8::Gemm g{xb + (size_t)row0 * DM, (const bf16_t*)(ws + WS_WIN + l * SZ_WIN), DM, DM, DM, nullptr}; \
                pg8::StaticOrder S; S.init(MC, P1_F8_FROM * 256, C.G, (int)blockIdx.x); \
                pg8::EpiIn E{Z, st + (size_t)row0 * 16, SQ, SKV, cosT, sinT, ws + WS_GB + (size_t)row0 * 3072, (bf16_t*)(ws + WS_QKV), ws, 0, 1.f}; \
                pg8::gemm_phase<pg8::EpiIn, pg8::StaticOrder, ALEPI1, false>(C.lds, g, S, E); \
            } \
            if (IN_PH && (MKP & 2) && P1_F8_FROM < 23) REP(2) { MKCTX;                          \
                pg8::Gemm g{(const bf16_t*)(ws + WS_XB8P + (size_t)row0 * DM), (const bf16_t*)(ws + WS_WIN8 + l * SZ_WIN8), DM / 2, DM / 2, DM / 2, nullptr}; \
                pg8::StaticOrder S; S.init(MC, (23 - P1_F8_FROM) * 256, C.G, (int)((blockIdx.x + (P1_F8_FROM * (MC / 256)) % 256) % C.G)); \
                pg8::EpiIn E{Z, st + (size_t)row0 * 16, SQ, SKV, cosT, sinT, ws + WS_GB + (size_t)row0 * 3072, (bf16_t*)(ws + WS_QKV), ws, P1_F8_FROM, 1.f / 4096.f}; \
                pg8::gemm_phase<pg8::EpiIn, pg8::StaticOrder, ALEPI1, false, false, true>(C.lds, g, S, E); \
            } \
            END_PH; \
 \
            if (IN_PH) { \
                if (MKP & 4) REP(4) { MKCTX; pg8::Gemm g{Z + ZO_CQ, (const bf16_t*)(ws + WS_WUQ + l * SZ_WUQ), 256, ZW, 256, nullptr}; \
                  pg8::StaticOrder S; S.init(MC, 768, C.G, (int)blockIdx.x); \
                  pg8::EpiQ E{Q, SQ, cosT, sinT}; \
                  pg8::gemm_phase<pg8::EpiQ, pg8::StaticOrder, ALEPI, false>(C.lds, g, S, E); } \
                if (MKP & 8) REP(8) { MKCTX; pg8::Gemm g{Z + ZO_CKV, (const bf16_t*)(ws + WS_WUKV + l * SZ_WUKV), 256, ZW, 256, nullptr}; \
                  pg8::StaticOrder S; S.init(MC, 1024, C.G, (int)((blockIdx.x + 128) % C.G)); \
                  pg8::EpiKV E{KV, SKV}; \
                  pg8::gemm_phase<pg8::EpiKV, pg8::StaticOrder, ALEPI, false>(C.lds, g, S, E); } \
                if (MKP & 16) REP(16) { MKCTX; phase_band<false>(C, (const bf16_t*)(ws + WS_QKV), PB, PBS, Y, C.in[7] + l * 8); } \
            } \
            END_PH; \
 \
            if (IN_PH) { \
                if (MKP & 32) REP(32) { MKCTX; phase_band<true>(C, (const bf16_t*)(ws + WS_QKV), PB, PBS, Y, C.in[7] + l * 8); } \
                if (MKP & 64) REP(64) { MKCTX; PROBE_T0; phase_mla(C, Q, KV, Z, Y); PROBE_T1(rep_); } \
            } \
            END_PH; \
 \
}
#define LAYER_TAIL(l) \
{ const int row0 = 0; bf16_t* MG = (bf16_t*)(ws + WS_MG); bf16_t* Y = (bf16_t*)(ws + WS_Y); (void)Y; \
            if (IN_PH && (MKP & 128)) REP(128) { MKCTX; \
                pg8::Gemm g{Y, (const bf16_t*)(ws + WS_WBR + l * SZ_WBR), 1536, 1536, 1536, nullptr}; \
                pg8::StaticOrder S; S.init(MTOK, DM, C.G, (int)blockIdx.x); \
                pg8::EpiBr E{ws + WS_GB, MG, ws}; \
                pg8::gemm_phase<pg8::EpiBr, pg8::StaticOrder, ALEPI, false>(C.lds, g, S, E); \
            } \
            END_PH; \
 \
            if (IN_PH && (MKP & 256)) REP(l == 0 ? 256 : 0) { MKCTX; \
                pg8::Gemm g{MG, (const bf16_t*)(ws + WS_WOUT + l * SZ_WOUT), DM, DM, DM, nullptr}; \
                pg8::StaticOrder S; S.init(MTOK, DM, C.G, (int)blockIdx.x); \
                pg8::EpiRes<false> E{xb, st, row0, nullptr}; pg8::gemm_phase<pg8::EpiRes<false>, pg8::StaticOrder, ALEPI, false, true>(C.lds, g, S, E); \
            } \
            END_PH; \
}
#define FFN_BODY() \
{ \
            bf16_t* ACT = (bf16_t*)(ws + WS_ACT); \
            if (IN_PH && (MKP & 512)) REP(512) { MKCTX; \
                pg8::Gemm g{xb, (const bf16_t*)(ws + WS_WGU), DM, DM, DM, nullptr}; \
                pg8::StaticOrder S; S.init(MTOK, 2 * DFF, C.G, (int)blockIdx.x); \
                pg8::EpiGU E{ACT, st, DFF, ws}; \
                pg8::gemm_phase<pg8::EpiGU, pg8::StaticOrder, ALEPI, false>(C.lds, g, S, E); \
            } \
            END_PH; \
            if (IN_PH && (MKP & 1024)) { MKCTX; \
                pg8::Gemm g{ACT, (const bf16_t*)(ws + WS_WD), DFF, DFF, DFF, nullptr}; \
                pg8::StaticOrder S; S.init(MTOK, DM, C.G, (int)blockIdx.x); \
                pg8::EpiRes<(P1_F8_FROM < 23)> E{xb, st, 0, ws + WS_XB8P};                                \
                pg8::gemm_phase<pg8::EpiRes<(P1_F8_FROM < 23)>, pg8::StaticOrder, ALEPI, false, true>(C.lds, g, S, E); \
            } \
            END_PH; \
}
#define MOE_HEAD() \
{ \
            if (IN_PH) { if (MKP & 2048) REP(2048) { MKCTX; phase_route(C); } if (MKP & 4096) REP(4096) { MKCTX; phase_moe_weights(C); } } \
            END_PH; \
            if (IN_PH && (MKP & 8192)) { MKCTX; phase_sort(C); } \
            END_PH; \
}
#define MOE_GU(kh, dyn) { const int k = MOE_NOSPLIT ? (kh) : (kh) >> 1, half = MOE_NOSPLIT ? 0 : (kh) & 1; MKCTX; \
        const int* rowtok = (const int*)(ws + WS_ROWTOK) + k * MOE_ROWS; \
        bf16_t* MACT = (bf16_t*)(ws + WS_MACT + (MOE_NOSPLIT ? (size_t)k * MOE_ROWS * DFE : (size_t)half * MOE_ROWS * DF0 * (MOE_DN_F8 ? 1 : 2))); const int dfw = MOE_NOSPLIT ? DFE : (half ? DF1 : DF0); \
        pg8::Gemm g{MOE_F8 ? (const bf16_t*)(ws + WS_XB8) : xb, (const bf16_t*)(ws + WS_EGU), MOE_F8 ? DM / 2 : DM, MOE_F8 ? DM / 2 : DM, MOE_F8 ? DM / 2 : DM, rowtok}; \
        pg8::DynMoeOrder S{(unsigned*)(ws + WS_CTL) + CW_Q + 64 * (kh), (volatile LAS int*)(C.lds + MISC_OFF + 64), meta[MI_NTILE + k], dfw / 128, 28, half ? DF0 / 128 : 0, meta + MI_TILEE + k * 160, C.vcu}; \
        pg8::EpiGUMoe E{MACT, (const float*)(ws + WS_ROWRR) + k * MOE_ROWS, dfw, ws}; \
        pg8::gemm_phase<pg8::EpiGUMoe, pg8::DynMoeOrder, ALEPI, true, false, MOE_F8 != 0>(C.lds, g, S, E); }
#define MOE_DN(kh) { const int k = MOE_NOSPLIT ? (kh) : (kh) >> 1, half = MOE_NOSPLIT ? 0 : (kh) & 1; MKCTX; \
        const int* rowtok = (const int*)(ws + WS_ROWTOK) + k * MOE_ROWS; const float* rowgw = (const float*)(ws + WS_ROWGW) + k * MOE_ROWS; \
        bf16_t* MACT = (bf16_t*)(ws + WS_MACT + (MOE_NOSPLIT ? (size_t)k * MOE_ROWS * DFE : (size_t)half * MOE_ROWS * DF0 * (MOE_DN_F8 ? 1 : 2))); const int dfw = MOE_NOSPLIT ? DFE : (half ? DF1 : DF0); \
        pg8::Gemm g{MACT, (const bf16_t*)(ws + WS_ED + (size_t)half * DF0 * (MOE_DN_F8 ? 1 : 2)), MOE_DN_F8 ? dfw / 2 : dfw, MOE_DN_F8 ? dfw / 2 : dfw, MOE_DN_F8 ? DFE / 2 : DFE, nullptr}; \
        pg8::MoeOrder S{meta[MI_NTILE + k], 4, C.G, (int)blockIdx.x, 4, 0, meta + MI_TILEE + k * 160}; \
        if ((kh) == 0) { pg8::EpiDnMoe<true> E{ws, rowtok, rowgw}; pg8::gemm_phase<pg8::EpiDnMoe<true>, pg8::MoeOrder, ALEPI, false, true, MOE_DN_F8 != 0>(C.lds, g, S, E); } \
        else { pg8::EpiDnMoe<false> E{ws, rowtok, rowgw}; pg8::gemm_phase<pg8::EpiDnMoe<false>, pg8::MoeOrder, ALEPI, false, true, MOE_DN_F8 != 0>(C.lds, g, S, E); } }
    CHUNK_BODY(0, 0)
#if CHB < 16
    CHUNK_BODY(0, 1)
#endif
#if CHB < 8
    CHUNK_BODY(0, 2)
    CHUNK_BODY(0, 3)
#endif
    LAYER_TAIL(0)
    FFN_BODY()
    CHUNK_BODY(1, 0)
#if CHB < 16
    CHUNK_BODY(1, 1)
#endif
#if CHB < 8
    CHUNK_BODY(1, 2)
    CHUNK_BODY(1, 3)
#endif
    LAYER_TAIL(1)
    MOE_HEAD()
    { const int* meta = (const int*)(ws + WS_META);
    if (IN_PH) { if (MKP & 16384) REP(16384) MOE_GU(0, 1) }
    END_PH;
    if (IN_PH) { if (MKP & 32768) MOE_DN(0) if (MKP & 16384) MOE_GU(1, 1) }
    END_PH;
#if !MOE_NOSPLIT
    if (IN_PH) { if (MKP & 32768) MOE_DN(1) if (MKP & 16384) MOE_GU(2, 1) }
    END_PH;
    if (IN_PH) { if (MKP & 32768) MOE_DN(2) if (MKP & 16384) MOE_GU(3, 1) }
    END_PH;
    if (IN_PH) { if (MKP & 32768) MOE_DN(3) }
    END_PH;
#else
    if (IN_PH) { if (MKP & 32768) MOE_DN(1) }
    END_PH;
#endif
    }
    if (IN_PH && (MKP & 65536)) { MKCTX; phase_final(C); }
    END_PH;
#ifdef PROBE_BAR
    { if (threadIdx.x == 0) atomicAdd((unsigned*)(ws + WS_CTL) + CW_Q + 2049, (unsigned)(__builtin_amdgcn_s_memrealtime() - pk0_));
      xcd_barrier(bar);
      const unsigned* tim = (const unsigned*)(ws + WS_CTL) + CW_Q + 2048;
      const float ta = (float)__hip_atomic_load(tim, __ATOMIC_RELAXED, __HIP_MEMORY_SCOPE_AGENT), tb = (float)__hip_atomic_load(tim + 1, __ATOMIC_RELAXED, __HIP_MEMORY_SCOPE_AGENT);
      float code = (float)(PROBE_UNIT) * ta / tb;
      code = fminf(98.f, fmaxf(1.f, rintf(code))); const float v = sqrtf(code);
      for (size_t i = (size_t)blockIdx.x * NTHREADS + threadIdx.x; i < (size_t)MTOK * DM; i += (size_t)gridDim.x * NTHREADS) args.out[i] = v; }
#endif
#ifdef PROBE_TIMER
    { xcd_barrier(bar);
      const unsigned* tim = (const unsigned*)(ws + WS_CTL) + CW_Q + 2048;
      const float ta = (float)__hip_atomic_load(tim, __ATOMIC_RELAXED, __HIP_MEMORY_SCOPE_AGENT), tb = (float)__hip_atomic_load(tim + 1, __ATOMIC_RELAXED, __HIP_MEMORY_SCOPE_AGENT);
      float code = PROBE_TIMER == 1 ? 10.f * ta / tb : (PROBE_TIMER == 2 ? ta * (1.f / (256.f * 100.f * 10.f)) : tb * (1.f / (256.f * 100.f * 10.f)));
      code = fminf(98.f, fmaxf(1.f, rintf(code))); const float v = sqrtf(code);
      for (size_t i = (size_t)blockIdx.x * NTHREADS + threadIdx.x; i < (size_t)MTOK * DM; i += (size_t)gridDim.x * NTHREADS) args.out[i] = v; }
#endif
#undef IN_PH
#undef END_PH
}
#if !MK_DEBUG
extern "C" void kernel_launch(void* const* d_in, const int* in_sizes, int n_in, void* d_out, int out_size, void* d_ws, size_t ws_size, hipStream_t stream) {
    static int grid = 0;
    if (grid == 0) {
        if (n_in != 22 || out_size != MTOK * DM || ws_size < WS_NEED) { fprintf(stderr, "kernel_launch: unexpected shapes / workspace (%zu < %zu); nothing launched\n", ws_size, (size_t)WS_NEED); grid = -1; return; }
        int dev = 0, cus = 0, per_cu = 0;
        if (hipGetDevice(&dev) != hipSuccess || hipDeviceGetAttribute(&cus, hipDeviceAttributeMultiprocessorCount, dev) != hipSuccess) { grid = -1; return; }
        if (hipFuncSetAttribute((const void*)mega, hipFuncAttributeMaxDynamicSharedMemorySize, LDS_BYTES) != hipSuccess) { fprintf(stderr, "kernel_launch: hipFuncSetAttribute failed\n"); grid = -1; return; }
        if (hipOccupancyMaxActiveBlocksPerMultiprocessor(&per_cu, (const void*)mega, NTHREADS, LDS_BYTES) != hipSuccess || per_cu < 1) { fprintf(stderr, "kernel_launch: occupancy query says %d\n", per_cu); }
        (void)hipGetLastError();
        grid = cus;
        if (grid != 256) { fprintf(stderr, "kernel_launch: built for 256 CUs, device has %d; nothing launched\n", cus); grid = -1; return; }
    }
    if (grid < 0) return;
    if (hipMemsetAsync((char*)d_ws + WS_CTL, 0, CTL_ZERO_BYTES, stream) != hipSuccess) return;
    Args a{};
    for (int i = 0; i < 22; ++i) a.in[i] = (const float*)d_in[i];
    a.out = (float*)d_out; a.ws = (unsigned char*)d_ws; a.ph_lo = 0; a.ph_hi = PH_TOTAL;
    hipLaunchKernelGGL(mega, dim3(grid), dim3(NTHREADS), LDS_BYTES, stream, a);
}
#endif
```

```cpp
#include <hip/hip_runtime.h>
#include <cstdio>
#include <cstdint>
#include <cmath>

#ifndef MK_DEBUG
#define MK_DEBUG 0
#endif
#ifndef MOE_F8
#define MOE_F8 1
#endif
#ifndef MOE_DN_F8
#define MOE_DN_F8 1
#endif
#ifndef MOE_NOSPLIT
#define MOE_NOSPLIT 1
#endif
#ifndef P1_F8_FROM
#define P1_F8_FROM 0
#endif
#ifndef WGM_SET
#define WGM_SET 8
#endif
#ifndef P5_F8
#define P5_F8 1
#endif
#ifndef CHB
#define CHB 8
#endif

#define GAS __attribute__((address_space(1)))
#define LAS __attribute__((address_space(3)))
typedef unsigned short bf16_t;
typedef short bf16x8 __attribute__((ext_vector_type(8)));
typedef short s16x4 __attribute__((ext_vector_type(4)));
typedef float f32x4 __attribute__((ext_vector_type(4)));
typedef float f32x2 __attribute__((ext_vector_type(2)));
typedef float f32x16 __attribute__((ext_vector_type(16)));
typedef unsigned u32x4 __attribute__((ext_vector_type(4)));
typedef unsigned u32x2 __attribute__((ext_vector_type(2)));
typedef __bf16 bf16x2_t __attribute__((ext_vector_type(2)));

constexpr int SEQ = 2048, DM = 1024, NBATCH = 16, MTOK = NBATCH * SEQ;
constexpr int MC = CHB * SEQ, NCHUNK = NBATCH / CHB;
constexpr int INC = 5792, ZW = 512, ZN = 5888;
constexpr int ZO_CQ = 0, ZO_CKV = 256, ZO_KPE = 384, ZO_QB = 512, ZO_KB = 1024, ZO_VB = 1536, ZO_QC = 2048, ZO_KC = 2560, ZO_VC = 2688, ZO_G = 2816;
constexpr int DFF = 2816, DFE = 3584, NEXP = 8;
constexpr int DF0 = 1792, DF1 = DFE - DF0;
constexpr float EPS = 1e-6f, LOG2E = 1.4426950408889634f;
constexpr float NEGB = -1e30f;
constexpr int MOE_ROWS = MTOK + NEXP * 256;

constexpr size_t MiB = 1u << 20;
constexpr size_t WS_CTL = 0, CTL_ZERO_BYTES = 256 * 1024;
constexpr size_t WS_META = 256 * 1024;
constexpr size_t WS_TAB = 1 * MiB;
constexpr size_t WS_WIN = 2 * MiB;
constexpr size_t SZ_WIN = (size_t)ZN * DM * 2;
constexpr size_t WS_WUQ = WS_WIN + 2 * SZ_WIN;
constexpr size_t SZ_WUQ = (size_t)768 * 256 * 2;
constexpr size_t WS_WUKV = WS_WUQ + 2 * SZ_WUQ;
constexpr size_t SZ_WUKV = (size_t)1024 * 256 * 2;
constexpr size_t WS_WBR = WS_WUKV + 2 * SZ_WUKV;
constexpr size_t SZ_WBR = (size_t)1024 * 1536 * 2;
constexpr size_t WS_WOUT = WS_WBR + 2 * SZ_WBR;
constexpr size_t SZ_WOUT = (size_t)1024 * 1024 * 2;
constexpr size_t WS_WGU = WS_WOUT + 2 * SZ_WOUT;
constexpr size_t WS_WD = WS_WGU + (size_t)2 * DFF * DM * 2;
constexpr size_t WS_SMALL_END = WS_WD + (size_t)DM * DFF * 2;
static_assert(WS_SMALL_END <= 54 * MiB, "small weights");
constexpr size_t WS_XB = 54 * MiB;
constexpr size_t WS_ST = 118 * MiB;
constexpr size_t WS_RR = 120 * MiB;
constexpr size_t WS_SEL = WS_RR + (size_t)MTOK * 4;
constexpr size_t WS_GW = WS_SEL + (size_t)MTOK * 8;
constexpr size_t WS_ROWTOK = WS_GW + (size_t)MTOK * 8;
constexpr size_t WS_ROWGW = WS_ROWTOK + (size_t)2 * MOE_ROWS * 4;
constexpr size_t WS_ROWRR = WS_ROWGW + (size_t)2 * MOE_ROWS * 4;
constexpr size_t WS_T = 122 * MiB;
static_assert(WS_ROWRR + (size_t)2 * MOE_ROWS * 4 <= WS_T, "fixed region");
constexpr size_t WS_GB = WS_T;
constexpr size_t WS_Y = WS_GB + (size_t)MTOK * 3072;
constexpr size_t WS_CH = WS_Y + (size_t)MTOK * 1536 * 2;
constexpr size_t WS_Z = WS_CH;
constexpr size_t WS_QKV = WS_Z + (size_t)MC * ZW * 2;
constexpr size_t SZ_H8 = (size_t)MC * 512 * 2, SZ_H2 = (size_t)MC * 128 * 2;
constexpr size_t WS_Q = WS_QKV + 4 * SZ_H8 + 2 * SZ_H2;
constexpr bool TMP_IN_OUT = (CHB == 16);
constexpr size_t WS_KV = WS_Q + (size_t)MC * 768 * 2;
constexpr size_t WS_PB = WS_KV + (TMP_IN_OUT ? 0 : (size_t)MC * 1024 * 2);
constexpr size_t WS_PBS = WS_PB + (TMP_IN_OUT ? 0 : (size_t)2 * MC * 512 * 2);
constexpr size_t WS_SQ = WS_PBS + (size_t)2 * MC * 16 * 4;
constexpr size_t WS_MIX_END = WS_SQ + (size_t)2 * MC * 4 * 4;
constexpr size_t WS_XB8P = (size_t)496 * MiB;
constexpr size_t WS_WIN8 = WS_XB8P + (size_t)MTOK * DM;
constexpr size_t SZ_WIN8 = (size_t)(23 - P1_F8_FROM) * 256 * DM;
static_assert(WS_XB8P >= WS_MIX_END && WS_WIN8 + 2 * SZ_WIN8 <= (size_t)564 * MiB, "fp8 input-projection buffers");
constexpr size_t WS_MG = WS_CH;
static_assert(WS_MG + (size_t)MTOK * 1024 * 2 <= (size_t)564 * MiB, "MG placement");
constexpr size_t WS_ACT = WS_T;
constexpr size_t WS_EGU = WS_T;
constexpr size_t WS_XB8 = WS_EGU + (size_t)NEXP * 2 * DFE * DM;
constexpr size_t WS_ED = WS_EGU + (size_t)NEXP * 2 * DFE * DM * 2;
constexpr size_t WS_MACT = WS_ED + (size_t)NEXP * DM * DFE * 2;
constexpr size_t WS_MOE_END = WS_MACT + (size_t)MOE_ROWS * DFE * 2;
constexpr size_t WS_NEED_ = (WS_MOE_END > WS_MIX_END ? WS_MOE_END : WS_MIX_END);
constexpr size_t WS_NEED = WS_MOE_END + (size_t)(MTOK - 26624) * DM * 2 > WS_NEED_ ? WS_MOE_END + (size_t)(MTOK - 26624) * DM * 2 : WS_NEED_;
static_assert(WS_NEED <= (size_t)564 * MiB, "workspace budget");

constexpr int XM_SPLIT = 26624;
constexpr size_t WS_XM_HI = WS_MOE_END;
static_assert((size_t)XM_SPLIT * DM * 2 <= WS_XB - WS_WIN && WS_XM_HI + (size_t)(MTOK - XM_SPLIT) * DM * 2 <= (size_t)564 * MiB, "XM placement");
__device__ __forceinline__ bf16_t* xm_row(unsigned char* ws, int tok) { return tok < XM_SPLIT ? (bf16_t*)(ws + WS_WIN) + (size_t)tok * DM : (bf16_t*)(ws + WS_XM_HI) + (size_t)(tok - XM_SPLIT) * DM; }

constexpr int CW_BAR = 4096, CW_Q = 8192;
constexpr int MI_CNT = 0, MI_NTILE = 4120, MI_TILEE = 4128;

__device__ __forceinline__ unsigned cvt_pk_bf16(float lo, float hi) { f32x2 v = {lo, hi}; bf16x2_t b = __builtin_convertvector(v, bf16x2_t); return __builtin_bit_cast(unsigned, b); }
__device__ __forceinline__ unsigned pk_fp8x4(float a, float b, float c, float d) {
    a = __builtin_amdgcn_fmed3f(a, -448.f, 448.f); b = __builtin_amdgcn_fmed3f(b, -448.f, 448.f); c = __builtin_amdgcn_fmed3f(c, -448.f, 448.f); d = __builtin_amdgcn_fmed3f(d, -448.f, 448.f);
    int w = 0; w = __builtin_amdgcn_cvt_pk_fp8_f32(a, b, w, false); w = __builtin_amdgcn_cvt_pk_fp8_f32(c, d, w, true); return (unsigned)w; }
__device__ __forceinline__ float bf_lo(unsigned w) { return __builtin_bit_cast(float, w << 16); }
__device__ __forceinline__ float bf_hi(unsigned w) { return __builtin_bit_cast(float, w & 0xffff0000u); }
template <int O> __device__ __forceinline__ float swz_xor(float v) { return __builtin_bit_cast(float, __builtin_amdgcn_ds_swizzle(__builtin_bit_cast(int, v), (O << 10) | 0x1f)); }
__device__ __forceinline__ void swap32(float& a, float& b) { asm volatile("s_nop 1\n\tv_permlane32_swap_b32 %0, %1\n\ts_nop 1" : "+v"(a), "+v"(b)); }
__device__ __forceinline__ float xsum32(float v) { float a = v, b = v; swap32(a, b); return a + b; }
__device__ __forceinline__ float xmax32(float v) { float a = v, b = v; swap32(a, b); return fmaxf(a, b); }
__device__ __forceinline__ float wave_sum(float v) {
    v += swz_xor<1>(v); v += swz_xor<2>(v); v += swz_xor<4>(v); v += swz_xor<8>(v); v += swz_xor<16>(v);
    return xsum32(v);
}
__device__ __forceinline__ float fast_rcp(float x) { return __builtin_amdgcn_rcpf(x); }
__device__ __forceinline__ float fast_exp2(float x) { return __builtin_amdgcn_exp2f(x); }
__device__ __forceinline__ float sigmoidf_(float v) { return fast_rcp(1.f + fast_exp2(-v * LOG2E)); }
__device__ __forceinline__ int t5_bucket(int rel) {
    const int ret = rel > 0 ? 16 : 0; const int n = rel < 0 ? -rel : rel;
    if (n < 8) return ret + n;
    int large = 8 + (int)(logf((float)n / 8.f) / logf(128.f) * 8.f);
    if (large > 15) large = 15;
    return ret + large;
}

#define XB_TMO      128
#define XB_XCNT(j)  (256  + 64 * (j))
#define XB_XSUB(j)  (1280 + 64 * (j))
#define XB_XGEN(j)  (2304 + 64 * (j))
#define XB_TOP      3328
#define XB_TOPGEN   3392
#define XCD_BAR_WORDS 3456
#define XB_SPIN_CAP (1u << 18)
__device__ __forceinline__ unsigned xb_ld(unsigned* p)              { return __hip_atomic_load(p, __ATOMIC_RELAXED, __HIP_MEMORY_SCOPE_AGENT); }
__device__ __forceinline__ unsigned xb_add(unsigned* p, unsigned v) { return __hip_atomic_fetch_add(p, v, __ATOMIC_RELAXED, __HIP_MEMORY_SCOPE_AGENT); }
__device__ __forceinline__ unsigned xb_xcc_id() { return (unsigned)__builtin_amdgcn_s_getreg((3 << 11) | 20) & 0xFu; }
#define XB_SPIN(cond, bar) do { unsigned _sp = 0; while (cond) { __builtin_amdgcn_s_sleep(1); \
    if ((++_sp & 255u) == 0u) { if (xb_ld(&(bar)[XB_TMO])) break; if (_sp > XB_SPIN_CAP) { atomicAdd(&(bar)[XB_TMO], 1u); break; } } } } while (0)
struct XcdBarrier { unsigned* bar; unsigned x; volatile LAS unsigned* st; };
__device__ __forceinline__ XcdBarrier xcd_barrier_post(unsigned* bar, volatile LAS unsigned* st) {
    XcdBarrier b; b.bar = bar; b.x = xb_xcc_id(); b.st = st;
    if (threadIdx.x == 0) (void)xb_add(&bar[XB_XCNT(b.x)], 1u);
    return b;
}
__device__ __forceinline__ void xcd_barrier_complete(unsigned* bar, unsigned x, unsigned& nloc, unsigned& nx) {
    const unsigned G = gridDim.x * gridDim.y * gridDim.z;
    unsigned sum, cnt, mine, sp = 0u;
    for (;;) {
        sum = 0u; cnt = 0u; mine = 0u;
#pragma unroll
        for (unsigned j = 0; j < 16; ++j) { const unsigned c = xb_ld(&bar[XB_XCNT(j)]); sum += c; cnt += (c > 0u) ? 1u : 0u; mine = (j == x) ? c : mine; }
        if (sum == G) break;
        __builtin_amdgcn_s_sleep(1);
        if ((++sp & 255u) == 0u) { if (xb_ld(&bar[XB_TMO])) break; if (sp > XB_SPIN_CAP) { atomicAdd(&bar[XB_TMO], 1u); break; } }
    }
    nloc = mine > 0u ? mine : 1u; nx = cnt > 0u ? cnt : 1u;
}
__device__ __forceinline__ void xcd_barrier(const XcdBarrier& b) {
    asm volatile("s_waitcnt vmcnt(0)" ::: "memory");
    __syncthreads();
    if (threadIdx.x == 0) {
        unsigned* bar = b.bar;
        __builtin_amdgcn_s_waitcnt(0);
        unsigned nloc = b.st[0], nx = b.st[1];
        if (nloc == 0u) { xcd_barrier_complete(bar, b.x, nloc, nx); b.st[0] = nloc; b.st[1] = nx; }
        const unsigned old = xb_add(&bar[XB_XSUB(b.x)], 1u);
        const unsigned gen = old / nloc;
        if (old + 1u == (gen + 1u) * nloc) {
            __builtin_amdgcn_fence(__ATOMIC_RELEASE, "agent");
            asm volatile("s_waitcnt vmcnt(0)" ::: "memory");
            const unsigned og = xb_add(&bar[XB_TOP], 1u);
            const unsigned tg = og / nx;
            if (og + 1u == (tg + 1u) * nx) xb_add(&bar[XB_TOPGEN], 1u);
            else XB_SPIN(xb_ld(&bar[XB_TOPGEN]) == tg, bar);
            __builtin_amdgcn_fence(__ATOMIC_ACQUIRE, "agent");
            xb_add(&bar[XB_XGEN(b.x)], 1u);
            asm volatile("s_waitcnt vmcnt(0)" ::: "memory");
        } else {
            XB_SPIN(xb_ld(&bar[XB_XGEN(b.x)]) == gen, bar);
            __builtin_amdgcn_fence(__ATOMIC_ACQUIRE, "agent");
            asm volatile("s_waitcnt vmcnt(0)" ::: "memory");
        }
    }
    __syncthreads();
}
#ifndef MOE_RGS
#define MOE_RGS 4
#endif
#ifndef MOE_RG
#define MOE_RG 4
#endif
#ifndef RELAXW
#define RELAXW 0
#endif
namespace pg8 {
constexpr int BM = 256, BK = 64, HALF = 128, HTB = HALF * BK * 2, STAGE_BYTES = 8 * HTB, NXCD = 8, WGM = WGM_SET;
__host__ __device__ __forceinline__ int lds_byte(int r, int c) { const int st = (r >> 4) * 2 + (c >> 5), rr = r & 15, cc = c & 31, ob = rr * 64 + cc * 2; return st * 1024 + (ob ^ (((ob >> 9) & 1) << 5)); }
__host__ __device__ __forceinline__ void stage_rc(int b, int& R, int& C) { const int st = b / 1024, sb = b % 1024, swz = sb ^ (((sb >> 9) & 1) << 5); R = (st >> 1) * 16 + swz / 64; C = (st & 1) * 32 + (swz % 64) / 2; }
__host__ __device__ __forceinline__ int perm32(int rho) { const int n = rho >> 4, i = rho & 15; return 8 * (i >> 2) + 4 * n + (i & 3); }

struct Unit { int pm, pn, aux; };
struct Gemm { const bf16_t* A; const bf16_t* Bt; int K, lda, ldb; const int* gidx; };

struct StaticOrder {
    static constexpr bool DYN = false;
    int nM, nN, nwg, G, c;
    __host__ __device__ void init(int M, int N, int G_, int c_) { nM = M / BM; nN = N / BM; nwg = nM * nN; G = G_; c = c_; }
    __host__ __device__ bool next(int i, Unit& u) const {
        const int L = i * G + c; if (L >= nwg) return false;
        int wgid = L; { const int q = nwg / NXCD, r = nwg % NXCD, xcd = wgid % NXCD, off = wgid / NXCD; wgid = (xcd < r ? xcd * (q + 1) : r * (q + 1) + (xcd - r) * q) + off; }
        const int nig = WGM * nN, gid = wgid / nig, fm = gid * WGM, gsz = (nM - fm) < WGM ? (nM - fm) : WGM;
        u.pm = fm + ((wgid % nig) % gsz); u.pn = (wgid % nig) / gsz; u.aux = u.pn; return true;
    }
};
struct MoeOrder {
    static constexpr bool DYN = false;
    int ntile, nN, G, c, pne, pn0; const int* tile_e;
    __device__ bool next(int i, Unit& u) const {
        const int L = i * G + c; if (L >= ntile * nN) return false;
        int pm, pnl; { const int grp = L / (MOE_RGS * nN), fm = grp * MOE_RGS, gsz = (ntile - fm) < MOE_RGS ? (ntile - fm) : MOE_RGS, r = L - grp * (MOE_RGS * nN); pm = fm + r % gsz; pnl = r / gsz; }
        u.pm = pm; u.aux = pnl; u.pn = tile_e[pm] * pne + pn0 + pnl; return true;
    }
};

struct DynMoeOrder {
    static constexpr bool DYN = true;
    unsigned* ctr; volatile LAS int* slot; int ntile, nN, pne, pn0; const int* tile_e; int vcu;
    __device__ __forceinline__ void begin() const {
        if (threadIdx.x == 0) { slot[0] = vcu; slot[1] = vcu + (int)gridDim.x; }
        __syncthreads();
    }
    __device__ __forceinline__ bool next(int i, Unit& u) const {
        const int L = __builtin_amdgcn_readfirstlane(slot[i & 1]); if (L >= ntile * nN) return false;
        int pm, pnl; { const int grp = L / (MOE_RG * nN), fm = grp * MOE_RG, gsz = (ntile - fm) < MOE_RG ? (ntile - fm) : MOE_RG, r = L - grp * (MOE_RG * nN); pm = fm + r % gsz; pnl = r / gsz; }
        u.pm = pm; u.aux = pnl; u.pn = tile_e[pm] * pne + pn0 + pnl; return true;
    }
    __device__ __forceinline__ unsigned claim_issue() const { unsigned v = 0u; if (threadIdx.x == 0) v = 2u * gridDim.x + __hip_atomic_fetch_add(ctr, 1u, __ATOMIC_RELAXED, __HIP_MEMORY_SCOPE_AGENT); return v; }
    __device__ __forceinline__ void claim_commit(unsigned v, int i) const { if (threadIdx.x == 0) { slot[i & 1] = (int)v; asm volatile("s_waitcnt lgkmcnt(0)" ::: "memory"); } }
};

__host__ __device__ __forceinline__ size_t blk_off(int row, int col, int ld) { return ((size_t)(row >> 4) * (ld >> 5) + (col >> 5)) * 512 + (row & 15) * 32 + (col & 31); }
typedef int i32x4_t __attribute__((ext_vector_type(4))); typedef int i32x8_t __attribute__((ext_vector_type(8)));
template <bool F8> struct FragSel;
template <> struct FragSel<false> {
    struct P { bf16x8 k[2]; }; typedef P A[4]; typedef P B[2];
    static __device__ __forceinline__ void set(P& d, const i32x4_t& f0, const i32x4_t& f1) { d.k[0] = __builtin_bit_cast(bf16x8, f0); d.k[1] = __builtin_bit_cast(bf16x8, f1); }
    static __device__ __forceinline__ void mma(f32x4& c, const P& b, const P& a) { c = __builtin_amdgcn_mfma_f32_16x16x32_bf16(b.k[0], a.k[0], c, 0, 0, 0); c = __builtin_amdgcn_mfma_f32_16x16x32_bf16(b.k[1], a.k[1], c, 0, 0, 0); }
    static __device__ __forceinline__ void after_mma() {}
};
template <> struct FragSel<true> {
    typedef i32x8_t P; typedef P A[4]; typedef P B[2];
    static __device__ __forceinline__ void set(P& d, const i32x4_t& f0, const i32x4_t& f1) { d = __builtin_shufflevector(f0, f1, 0, 1, 2, 3, 4, 5, 6, 7); }
    static __device__ __forceinline__ void mma(f32x4& c, const P& b, const P& a) { int sc = 0x7f7f7f7f; asm volatile("v_mfma_scale_f32_16x16x128_f8f6f4 %0, %1, %2, %0, %3, %3 op_sel_hi:[0,0,0]" : "+v"(c) : "v"(b), "v"(a), "v"(sc)); }
    static __device__ __forceinline__ void after_mma() { asm volatile("s_nop 15\n\ts_nop 15" ::: "memory"); }
};
template <class Epi, class Sched, bool ALIGN_EPI, bool GATHER, bool ABLK = false, bool F8 = false>
__device__ __forceinline__ void gemm_phase(LAS unsigned char* lds, const Gemm g, const Sched& S, const Epi& E) {
    int tid_ = threadIdx.x; asm volatile("" : "+v"(tid_));
    const int tid = tid_, wid = __builtin_amdgcn_readfirstlane(tid >> 6), lane = tid & 63, wr = wid >> 2, wc = wid & 3, fr = lane & 15, fq = lane >> 4;
    int K_ = g.K; asm volatile("" : "+s"(K_));
    const int K = K_, nt = K / BK;
    static_assert(!(GATHER && ABLK), "gathered A is row-major");
    const size_t kstep = (size_t)(BK * 2), kstepA = ABLK ? (size_t)2048 : kstep;
    const size_t hstepA = ABLK ? (size_t)8 * (g.lda >> 5) * 1024 : (size_t)HALF * g.lda * 2, hstepB = (size_t)HALF * g.ldb * 2, tstepA = 2 * hstepA, tstepB = 2 * hstepB;
    int Rs[2], Cs[2]; unsigned voffB[2];
#pragma unroll
    for (int i = 0; i < 2; ++i) { int R, C; stage_rc(tid * 16 + i * 8192, R, C); Rs[i] = R; Cs[i] = C; const int Rb = Epi::PERM ? ((R & ~31) + perm32(R & 31)) : R;
        voffB[i] = (unsigned)(Rb * g.ldb + C) * 2u; }
    asm volatile("" : "+v"(voffB[0]), "+v"(voffB[1]), "+v"(Rs[0]), "+v"(Rs[1]), "+v"(Cs[0]), "+v"(Cs[1]));
    unsigned vA[2][2], nvA[2][2];
    const size_t hsA = GATHER ? (size_t)0 : hstepA;
#define PG8_SETV(V, U) do { _Pragma("unroll") for (int _h = 0; _h < 2; ++_h) _Pragma("unroll") for (int _i = 0; _i < 2; ++_i) { \
        if constexpr (GATHER) { int _t = g.gidx[(U).pm * BM + _h * HALF + Rs[_i]]; _t = _t < 0 ? 0 : _t; V[_h][_i] = (unsigned)(_t * g.lda + Cs[_i]) * 2u; } \
        else if constexpr (ABLK) V[_h][_i] = (unsigned)blk_off(Rs[_i], Cs[_i], g.lda) * 2u; \
        else V[_h][_i] = (unsigned)(Rs[_i] * g.lda + Cs[_i]) * 2u; } } while (0)
    const unsigned ldsw = (unsigned)wid * 1024u;
    const int aoff = lds_byte(wr * 64 + fr, fq * 8), boff = lds_byte(wc * 32 + fr, fq * 8);
#define PG8_SA(b, h) (((b) * 2 + (h)) * HTB)
#define PG8_SB(b, h) ((4 + (b) * 2 + (h)) * HTB)
#define PG8_STAGE(bufoff, gbase, voff) do { _Pragma("unroll") for (int _i = 0; _i < 2; ++_i) \
        __builtin_amdgcn_global_load_lds((const unsigned*)((const char*)(gbase) + (voff)[_i]), (LAS unsigned*)(lds + (bufoff) + ldsw + _i * 8192), 16, 0, 0); } while (0)
#define PG8_LDA(dst, b, h) do { _Pragma("unroll") for (int m = 0; m < 4; ++m) { const i32x4_t f0_ = *(const LAS i32x4_t*)(lds + PG8_SA(b, h) + aoff + m * 2048), f1_ = *(const LAS i32x4_t*)(lds + PG8_SA(b, h) + aoff + m * 2048 + 1024); FragSel<F8>::set(dst[m], f0_, f1_); } } while (0)
#define PG8_LDB(dst, b, h) do { _Pragma("unroll") for (int n = 0; n < 2; ++n) { const i32x4_t f0_ = *(const LAS i32x4_t*)(lds + PG8_SB(b, h) + boff + n * 2048), f1_ = *(const LAS i32x4_t*)(lds + PG8_SB(b, h) + boff + n * 2048 + 1024); FragSel<F8>::set(dst[n], f0_, f1_); } } while (0)
#define PG8_MMA(ai, bj, At, Bt) do { __builtin_amdgcn_s_setprio(1); _Pragma("unroll") for (int m = 0; m < 4; ++m) _Pragma("unroll") for (int n = 0; n < 2; ++n) FragSel<F8>::mma(acc[ai][bj][m][n], Bt[n], At[m]); __builtin_amdgcn_s_setprio(0); } while (0)
#define PG8_WAIT_V(n) asm volatile("s_waitcnt vmcnt(" #n ")" ::: "memory")
#define PG8_WAIT_VSEL(sel, n) asm volatile("s_cmp_eq_u32 %0, 0\n\ts_cbranch_scc1 1f\n\ts_waitcnt vmcnt(%1)\n\ts_branch 2f\n1:\n\ts_waitcnt vmcnt(8)\n2:" :: "s"(sel), "n"(n) : "memory", "scc")
#define PG8_WAIT_L(n) asm volatile("s_waitcnt lgkmcnt(" #n ")" ::: "memory")
#define PG8_BAR __builtin_amdgcn_s_barrier()
#define PG8_SCHED __builtin_amdgcn_sched_barrier(0)
    Unit cur, nxt; int ui = 0;
    if constexpr (Sched::DYN) S.begin();
    if (!S.next(0, cur)) return;
    f32x4 acc[2][2][4][2];
#pragma unroll
    for (int a = 0; a < 2; ++a)
#pragma unroll
        for (int b = 0; b < 2; ++b)
#pragma unroll
            for (int m = 0; m < 4; ++m)
#pragma unroll
                for (int n = 0; n < 2; ++n) acc[a][b][m][n] = (f32x4){0.f, 0.f, 0.f, 0.f};
    typename FragSel<F8>::A At; typename FragSel<F8>::B B0, B1;
    PG8_SETV(vA, cur);
    const char* cA = (const char*)g.A + (GATHER ? (size_t)0 : (size_t)cur.pm * tstepA); const char* cB = (const char*)g.Bt + (size_t)cur.pn * tstepB;
    PG8_STAGE(PG8_SB(0, 0), cB, voffB); PG8_STAGE(PG8_SB(0, 1), cB + hstepB, voffB); PG8_STAGE(PG8_SA(0, 0), cA, vA[0]); PG8_STAGE(PG8_SA(0, 1), cA + hsA, vA[1]);
    if (wr == 1) PG8_BAR;
    PG8_WAIT_V(2); PG8_BAR;
    PG8_STAGE(PG8_SB(1, 0), cB + kstep, voffB); PG8_STAGE(PG8_SA(1, 0), cA + kstepA, vA[0]); PG8_STAGE(PG8_SB(1, 1), cB + hstepB + kstep, voffB);
    PG8_WAIT_V(6); PG8_BAR;
    for (;;) {
        const bool has_next = S.next(ui + 1, nxt);
        unsigned claim_ = 0u; if constexpr (Sched::DYN) claim_ = S.claim_issue();
        const char* nA = has_next ? (const char*)g.A + (GATHER ? (size_t)0 : (size_t)nxt.pm * tstepA) : cA; const char* nB = has_next ? (const char*)g.Bt + (size_t)nxt.pn * tstepB : cB;
        if constexpr (GATHER) { if (has_next) PG8_SETV(nvA, nxt); else {
#pragma unroll
            for (int h = 0; h < 2; ++h) { nvA[h][0] = vA[h][0]; nvA[h][1] = vA[h][1]; } } }
        for (int t = 0; t < nt; t += 2) {
            if constexpr (Epi::MID) { if (t == 8 || t == 16) E.mid(acc, cur, t >> 3, wr, wc, fr, fq); }
            const bool last = (t == nt - 2);
            const char* a1 = cA + (size_t)(t + 1) * kstepA;
            const char* a2 = last ? nA : cA + (size_t)(t + 2) * kstepA; const char* b2 = last ? nB : cB + (size_t)(t + 2) * kstep;
            const char* a3 = a2 + kstepA; const char* b3 = b2 + kstep;
            unsigned v20[2], v21[2];
            if constexpr (GATHER) { v20[0] = last ? nvA[0][0] : vA[0][0]; v20[1] = last ? nvA[0][1] : vA[0][1]; v21[0] = last ? nvA[1][0] : vA[1][0]; v21[1] = last ? nvA[1][1] : vA[1][1]; }
            else { v20[0] = vA[0][0]; v20[1] = vA[0][1]; v21[0] = vA[1][0]; v21[1] = vA[1][1]; }
            const int relax_ = __builtin_amdgcn_readfirstlane((RELAXW && (t == 0) && (ui > 0)) ? 1 : 0);
            PG8_LDB(B0, 0, 0); PG8_LDB(B1, 0, 1); PG8_SCHED; PG8_LDA(At, 0, 0); PG8_STAGE(PG8_SA(1, 1), a1 + hsA, vA[1]);
            PG8_WAIT_VSEL(relax_, 8 + Epi::NVM);
            PG8_WAIT_L(0); PG8_BAR; PG8_MMA(0, 0, At, B0); PG8_MMA(0, 1, At, B1); PG8_BAR; PG8_SCHED;
            PG8_LDA(At, 0, 1); PG8_STAGE(PG8_SB(0, 0), b2, voffB); PG8_STAGE(PG8_SB(0, 1), b2 + hstepB, voffB); PG8_STAGE(PG8_SA(0, 0), a2, v20);
            PG8_WAIT_VSEL(relax_, 8 + Epi::NVM);
            PG8_WAIT_L(0); PG8_BAR; PG8_MMA(1, 0, At, B0); PG8_MMA(1, 1, At, B1); PG8_BAR; PG8_SCHED;
            PG8_LDB(B0, 1, 0); PG8_LDB(B1, 1, 1); PG8_SCHED; PG8_LDA(At, 1, 0); PG8_STAGE(PG8_SA(0, 1), a2 + hsA, v21);
            PG8_WAIT_V(8); PG8_WAIT_L(0); PG8_BAR; PG8_MMA(0, 0, At, B0); PG8_MMA(0, 1, At, B1); PG8_BAR; PG8_SCHED;
            PG8_LDA(At, 1, 1); PG8_STAGE(PG8_SB(1, 0), b3, voffB); PG8_STAGE(PG8_SB(1, 1), b3 + hstepB, voffB); PG8_STAGE(PG8_SA(1, 0), a3, v20);
            PG8_WAIT_V(8); PG8_WAIT_L(0); PG8_BAR; PG8_MMA(1, 0, At, B0); PG8_MMA(1, 1, At, B1); PG8_BAR; PG8_SCHED;
        }
        if constexpr (Sched::DYN) S.claim_commit(claim_, ui);
        if constexpr (ALIGN_EPI) { if (wr == 0) PG8_BAR; }
        FragSel<F8>::after_mma();
        E(acc, cur, wr, wc, fr, fq);
        if (!has_next) break;
#pragma unroll
        for (int a = 0; a < 2; ++a)
#pragma unroll
            for (int b = 0; b < 2; ++b)
#pragma unroll
                for (int m = 0; m < 4; ++m)
#pragma unroll
                    for (int n = 0; n < 2; ++n) acc[a][b][m][n] = (f32x4){0.f, 0.f, 0.f, 0.f};
        cur = nxt; cA = nA; cB = nB; ++ui;
        if constexpr (GATHER) {
#pragma unroll
            for (int h = 0; h < 2; ++h) { vA[h][0] = nvA[h][0]; vA[h][1] = nvA[h][1]; } }
        if constexpr (ALIGN_EPI) { if (wr == 1) PG8_BAR; }
    }
    PG8_WAIT_V(0);
    if constexpr (!ALIGN_EPI) { if (wr == 0) PG8_BAR; }
    PG8_BAR;
#undef PG8_SETV
#undef PG8_SA
#undef PG8_SB
#undef PG8_STAGE
#undef PG8_LDA
#undef PG8_LDB
#undef PG8_MMA
#undef PG8_WAIT_V
#undef PG8_WAIT_VSEL
#undef PG8_WAIT_L
#undef PG8_BAR
#undef PG8_SCHED
}

typedef f32x4 Acc[2][2][4][2];
#ifndef NT_Z
#define NT_Z 0
#endif
#ifndef NT_A
#define NT_A 1
#endif
#ifndef ST_SC1
#define ST_SC1 1
#endif
__device__ __forceinline__ void st16(unsigned char* wsb, u32x4* p, const u32x4& v) {
#if ST_SC1
    const __amdgpu_buffer_rsrc_t rsrc = __builtin_amdgcn_make_buffer_rsrc(wsb, 0, 0x7fffffff, 0x00020000);
    __builtin_amdgcn_raw_buffer_store_b128(v, rsrc, (int)((unsigned char*)p - wsb), 0, 16);
#else
    *p = v;
#endif
}
__device__ __forceinline__ void st8(unsigned char* wsb, u32x2* p, const u32x2& v) {
#if ST_SC1
    const __amdgpu_buffer_rsrc_t rsrc = __builtin_amdgcn_make_buffer_rsrc(wsb, 0, 0x7fffffff, 0x00020000);
    __builtin_amdgcn_raw_buffer_store_b64(v, rsrc, (int)((unsigned char*)p - wsb), 0, 16);
#else
    *p = v;
#endif
}
__device__ __forceinline__ float fq_sum(float s) { s += swz_xor<16>(s); return xsum32(s); }
__device__ __forceinline__ u32x4 pack8(const f32x4& a, const f32x4& b) { u32x4 w; w.x = cvt_pk_bf16(a.x, a.y); w.y = cvt_pk_bf16(a.z, a.w); w.z = cvt_pk_bf16(b.x, b.y); w.w = cvt_pk_bf16(b.z, b.w); return w; }
__device__ __forceinline__ void unpack8(const u32x4& w, f32x4& a, f32x4& b) { a = (f32x4){bf_lo(w.x), bf_hi(w.x), bf_lo(w.y), bf_hi(w.y)}; b = (f32x4){bf_lo(w.z), bf_hi(w.z), bf_lo(w.w), bf_hi(w.w)}; }
__device__ __forceinline__ unsigned g8pack(const f32x4& a) {
    const unsigned b0 = (unsigned)__builtin_fmaxf(a.x * 255.f + 0.5f, 1.f), b1 = (unsigned)__builtin_fmaxf(a.y * 255.f + 0.5f, 1.f), b2 = (unsigned)__builtin_fmaxf(a.z * 255.f + 0.5f, 1.f), b3 = (unsigned)__builtin_fmaxf(a.w * 255.f + 0.5f, 1.f);
    return b0 | (b1 << 8) | (b2 << 16) | (b3 << 24);
}
__device__ __forceinline__ f32x4 g8unpack(unsigned w) { return (f32x4){(float)(w & 0xffu), (float)((w >> 8) & 0xffu), (float)((w >> 16) & 0xffu), (float)(w >> 24)}; }
__device__ __forceinline__ float sq8(const f32x4& a, const f32x4& b) { return ((a.x * a.x + a.y * a.y) + (a.z * a.z + a.w * a.w)) + ((b.x * b.x + b.y * b.y) + (b.z * b.z + b.w * b.w)); }
__device__ __forceinline__ float sum4(const f32x4& a) { return (a.x + a.y) + (a.z + a.w); }
__device__ __forceinline__ void rope8(f32x4& a, f32x4& b, const float* cs, const float* sn) {
    const f32x4 c = *(const f32x4*)cs, s = *(const f32x4*)sn;
    const f32x4 ra = {a.x * c.x - a.y * s.x, a.x * s.x + a.y * c.x, a.z * c.y - a.w * s.y, a.z * s.y + a.w * c.y};
    const f32x4 rb = {b.x * c.z - b.y * s.z, b.x * s.z + b.y * c.z, b.z * c.w - b.w * s.w, b.z * s.w + b.w * c.w};
    a = ra; b = rb;
}
__device__ __forceinline__ void rowscale16(const float* st, int rbase, int fq, float (&r)[8]) {
    f32x4 p[8];
#pragma unroll
    for (int i = 0; i < 8; ++i) p[i] = *(const f32x4*)(st + (size_t)(rbase + (i >> 2) * HALF + (i & 3) * 16) * 16 + 4 * fq);
#pragma unroll
    for (int i = 0; i < 8; ++i) r[i] = rsqrtf(fq_sum(sum4(p[i])) * (1.f / 1024.f) + EPS);
}
__device__ __forceinline__ void rowscale4(const float* sq, int rbase, float inv_n, float (&r)[8]) {
    f32x4 p[8];
#pragma unroll
    for (int i = 0; i < 8; ++i) p[i] = *(const f32x4*)(sq + (size_t)(rbase + (i >> 2) * HALF + (i & 3) * 16) * 4);
#pragma unroll
    for (int i = 0; i < 8; ++i) r[i] = rsqrtf(sum4(p[i]) * inv_n + EPS);
}
#define EPI_ROWBASE int rl_ = wr * 64 + fr; asm volatile("" : "+v"(rl_)); const int rbase = u.pm * BM + rl_
#define EPI_LOOP _Pragma("unroll") for (int ai = 0; ai < 2; ++ai) _Pragma("unroll") for (int m = 0; m < 4; ++m)

__device__ __forceinline__ float sig2_(float t) { return fast_rcp(1.f + fast_exp2(t)); }
struct EpiIn {
    static constexpr bool PERM = true, MID = false; static constexpr int NVM = 24;
    bf16_t* Z; const float* st; float* sq; float* skv; const float* cosT; const float* sinT; unsigned char* GB; bf16_t* HM; unsigned char* wsb; int pnoff; float asc;
    __device__ __forceinline__ void operator()(const Acc& acc, const Unit& u, int wr, int wc, int fr, int fq) const {
        EPI_ROWBASE; const int pn = u.pn + pnoff;
        float r8[8]; rowscale16(st, rbase, fq, r8);
#pragma unroll
        for (int i = 0; i < 8; ++i) r8[i] *= (pn >= 11 ? -LOG2E * asc : asc);
        __builtin_amdgcn_sched_barrier(0);
        EPI_LOOP {
            const int row = rbase + ai * HALF + m * 16; const float r = r8[ai * 4 + m];
            bf16_t* zr = Z + (size_t)row * ZW + pn * BM + wc * 32 + 8 * fq;
            float ssq = 0.f;
#pragma unroll
            for (int bj = 0; bj < 2; ++bj) {
                f32x4 v0 = acc[ai][bj][m][0] * r, v1 = acc[ai][bj][m][1] * r;
#ifdef PROBE_ANOISE
                if (pn < 11 && ((PROBE_ANOISE_MASK >> pn) & 1)) { unsigned h_ = (unsigned)row * 2654435761u ^ (unsigned)(pn * 64 + bj * 32 + wc * 8 + fq) * 40503u; float nz[8];
#pragma unroll
                      for (int e_ = 0; e_ < 8; ++e_) { h_ = h_ * 1664525u + 1013904223u; nz[e_] = ((float)(h_ >> 8) * (1.f / 16777216.f) - 0.5f) * 3.4641f * 0.035f * (float)(PROBE_ANOISE); }
                      v0.x += nz[0]; v0.y += nz[1]; v0.z += nz[2]; v0.w += nz[3]; v1.x += nz[4]; v1.y += nz[5]; v1.z += nz[6]; v1.w += nz[7]; }
#endif
                if (pn == 0) ssq += sq8(v0, v1);
                else if (pn == 1) { if (bj == 0) ssq += sq8(v0, v1); else if (wc == 0) { const int pos = row & (SEQ - 1); rope8(v0, v1, cosT + pos * 16 + 4 * fq, sinT + pos * 16 + 4 * fq); } }
                else if (pn == 2 || pn == 3 || pn == 8 || pn == 9) { v0 = v0 * (0.125f * LOG2E); v1 = v1 * (0.125f * LOG2E); }
                else if (pn >= 11) {
#ifdef PROBE_GNOISE
                    { unsigned h_ = (unsigned)row * 2654435761u ^ (unsigned)(pn * 64 + bj * 32 + wc * 8 + fq) * 40503u; float nz[8];
#pragma unroll
                      for (int e_ = 0; e_ < 8; ++e_) { h_ = h_ * 1664525u + 1013904223u; nz[e_] = ((float)(h_ >> 8) * (1.f / 16777216.f) - 0.5f) * 3.4641f * 0.035f * (float)(PROBE_GNOISE); }
                      v0.x += nz[0]; v0.y += nz[1]; v0.z += nz[2]; v0.w += nz[3]; v1.x += nz[4]; v1.y += nz[5]; v1.z += nz[6]; v1.w += nz[7]; }
#endif
                    v0 = (f32x4){sig2_(v0.x), sig2_(v0.y), sig2_(v0.z), sig2_(v0.w)}; v1 = (f32x4){sig2_(v1.x), sig2_(v1.y), sig2_(v1.z), sig2_(v1.w)}; }
                if (pn >= 11) { u32x2 w8; w8.x = g8pack(v0); w8.y = g8pack(v1); *(u32x2*)(GB + blk_off(row, (pn - 11) * BM + bj * HALF + wc * 32 + 8 * fq, 3072)) = w8; }
                else if (pn >= 2) {
                    const int hc = (pn - 2) * BM + bj * HALF + wc * 32;
                    const int reg = hc < 1536 ? hc >> 9 : (hc < 2048 ? 3 : (hc < 2176 ? 4 : 5)), hin = hc < 1536 ? hc & 511 : (hc < 2048 ? hc - 1536 : (hc - 2048) & 127);
                    const size_t base = reg <= 3 ? (size_t)reg * (MC * 512) : (size_t)4 * (MC * 512) + (size_t)(reg - 4) * (MC * 128);
                    const int nh = reg <= 3 ? 8 : 2, b = row >> 11, s = row & (SEQ - 1);
                    st16(wsb, (u32x4*)(HM + base + (((size_t)(b * nh + (hin >> 6)) * SEQ + s) * 64 + (hin & 63) + 8 * fq)), pack8(v0, v1));
                }
                else st16(wsb, (u32x4*)(zr + bj * HALF), pack8(v0, v1));
            }
            if (pn <= 1) { ssq = fq_sum(ssq); if (fq == 0) (pn == 0 ? sq : skv)[(size_t)row * 4 + wc] = ssq; }
        }
    }
};
struct EpiQ {
    static constexpr bool PERM = true, MID = false; static constexpr int NVM = 24;
    bf16_t* Q; const float* sq; const float* cosT; const float* sinT;
    __device__ __forceinline__ void operator()(const Acc& acc, const Unit& u, int wr, int wc, int fr, int fq) const {
        EPI_ROWBASE;
        float r8[8]; rowscale4(sq, rbase, 1.f / 256.f, r8);
        __builtin_amdgcn_sched_barrier(0);
        EPI_LOOP {
            __builtin_amdgcn_sched_barrier(0);
            const int row = rbase + ai * HALF + m * 16; const float r = r8[ai * 4 + m]; const int pos = row & (SEQ - 1);
#pragma unroll
            for (int bj = 0; bj < 2; ++bj) {
                const int col = u.pn * BM + bj * HALF + wc * 32 + 8 * fq; const int j0 = col % 96;
                f32x4 v0 = acc[ai][bj][m][0] * r, v1 = acc[ai][bj][m][1] * r;
                if (j0 >= 64) { const int i0 = (j0 - 64) >> 1; rope8(v0, v1, cosT + pos * 16 + i0, sinT + pos * 16 + i0); }
                *(u32x4*)(Q + (size_t)row * 768 + col) = pack8(v0, v1);
            }
        }
    }
};
struct EpiKV {
    static constexpr bool PERM = true, MID = false; static constexpr int NVM = 24;
    bf16_t* KV; const float* skv;
    __device__ __forceinline__ void operator()(const Acc& acc, const Unit& u, int wr, int wc, int fr, int fq) const {
        EPI_ROWBASE;
        float r8[8]; rowscale4(skv, rbase, 1.f / 128.f, r8);
        __builtin_amdgcn_sched_barrier(0);
        EPI_LOOP {
            const int row = rbase + ai * HALF + m * 16; const float r = r8[ai * 4 + m];
#pragma unroll
            for (int bj = 0; bj < 2; ++bj) {
                const int col = u.pn * BM + bj * HALF + wc * 32 + 8 * fq;
                *(u32x4*)(KV + (size_t)row * 1024 + col) = pack8(acc[ai][bj][m][0] * r, acc[ai][bj][m][1] * r);
            }
        }
    }
};
struct EpiBr {
    static constexpr bool PERM = true, MID = true; static constexpr int NVM = 32;
    const unsigned char* G; bf16_t* MG; unsigned char* wsb;
    __device__ __forceinline__ void mid(Acc& acc, const Unit& u, int seg, int wr, int wc, int fr, int fq) const {
        EPI_ROWBASE; const int col = u.pn * BM + wc * 32 + 8 * fq;
#pragma unroll
        for (int ai = 0; ai < 2; ++ai) {
            __builtin_amdgcn_sched_barrier(0);
            u32x2 wn[4][2], wd[4][2];
#pragma unroll
            for (int m = 0; m < 4; ++m)
#pragma unroll
                for (int bj = 0; bj < 2; ++bj) { const int row = rbase + ai * HALF + m * 16; wn[m][bj] = *(const u32x2*)(G + blk_off(row, (seg - 1) * 1024 + col + bj * HALF, 3072)); wd[m][bj] = *(const u32x2*)(G + blk_off(row, seg * 1024 + col + bj * HALF, 3072)); }
#pragma unroll
            for (int m = 0; m < 4; ++m)
#pragma unroll
                for (int bj = 0; bj < 2; ++bj) {
                    const f32x4 n0 = g8unpack(wn[m][bj].x), n1 = g8unpack(wn[m][bj].y), d0 = g8unpack(wd[m][bj].x), d1 = g8unpack(wd[m][bj].y);
                    f32x4 r0, r1;
                    r0.x = n0.x * fast_rcp(d0.x); r0.y = n0.y * fast_rcp(d0.y); r0.z = n0.z * fast_rcp(d0.z); r0.w = n0.w * fast_rcp(d0.w);
                    r1.x = n1.x * fast_rcp(d1.x); r1.y = n1.y * fast_rcp(d1.y); r1.z = n1.z * fast_rcp(d1.z); r1.w = n1.w * fast_rcp(d1.w);
                    acc[ai][bj][m][0] = acc[ai][bj][m][0] * r0; acc[ai][bj][m][1] = acc[ai][bj][m][1] * r1;
                }
        }
    }
    __device__ __forceinline__ void operator()(const Acc& acc, const Unit& u, int wr, int wc, int fr, int fq) const {
        EPI_ROWBASE; const int col = u.pn * BM + wc * 32 + 8 * fq;
#pragma unroll
        for (int ai = 0; ai < 2; ++ai) {
            __builtin_amdgcn_sched_barrier(0);
            u32x2 wg[4][2];
#pragma unroll
            for (int m = 0; m < 4; ++m)
#pragma unroll
                for (int bj = 0; bj < 2; ++bj) wg[m][bj] = *(const u32x2*)(G + blk_off(rbase + ai * HALF + m * 16, 2048 + col + bj * HALF, 3072));
#pragma unroll
            for (int m = 0; m < 4; ++m)
#pragma unroll
                for (int bj = 0; bj < 2; ++bj) { const f32x4 g0 = g8unpack(wg[m][bj].x) * ((P5_F8 ? 16.f : 1.f) / 255.f), g1 = g8unpack(wg[m][bj].y) * ((P5_F8 ? 16.f : 1.f) / 255.f);
                    if (P5_F8) { const f32x4 v0 = acc[ai][bj][m][0] * g0, v1 = acc[ai][bj][m][1] * g1; u32x2 o8; o8.x = pk_fp8x4(v0.x, v0.y, v0.z, v0.w); o8.y = pk_fp8x4(v1.x, v1.y, v1.z, v1.w);
                        st8(wsb, (u32x2*)((unsigned char*)MG + blk_off(rbase + ai * HALF + m * 16, (col + bj * HALF) >> 1, 512) * 2), o8); }
                    else st16(wsb, (u32x4*)(MG + blk_off(rbase + ai * HALF + m * 16, col + bj * HALF, 1024)), pack8(acc[ai][bj][m][0] * g0, acc[ai][bj][m][1] * g1)); }
        }
    }
};
template <bool F8OUT> struct EpiRes {
    static constexpr bool PERM = true, MID = false; static constexpr int NVM = 40;
    bf16_t* xb; float* st; int row0; unsigned char* x8; float asc;
    __device__ __forceinline__ void operator()(const Acc& acc, const Unit& u, int wr, int wc, int fr, int fq) const {
        EPI_ROWBASE; const int col = u.pn * BM + wc * 32 + 8 * fq;
#pragma unroll
        for (int ai = 0; ai < 2; ++ai) {
            __builtin_amdgcn_sched_barrier(0);
            u32x4 xi[4][2];
#pragma unroll
            for (int m = 0; m < 4; ++m)
#pragma unroll
                for (int bj = 0; bj < 2; ++bj) xi[m][bj] = *(const u32x4*)(xb + (size_t)(row0 + rbase + ai * HALF + m * 16) * DM + col + bj * HALF);
#pragma unroll
            for (int m = 0; m < 4; ++m) {
                const int row = row0 + rbase + ai * HALF + m * 16; float ssq = 0.f;
#pragma unroll
                for (int bj = 0; bj < 2; ++bj) { f32x4 x0, x1; unpack8(xi[m][bj], x0, x1);
                    const f32x4 v0 = x0 + acc[ai][bj][m][0] * asc, v1 = x1 + acc[ai][bj][m][1] * asc;
                    *(u32x4*)(xb + (size_t)row * DM + col + bj * HALF) = pack8(v0, v1); ssq += sq8(v0, v1);
                    if constexpr (F8OUT) { u32x2 o8; o8.x = pk_fp8x4(v0.x * 16.f, v0.y * 16.f, v0.z * 16.f, v0.w * 16.f); o8.y = pk_fp8x4(v1.x * 16.f, v1.y * 16.f, v1.z * 16.f, v1.w * 16.f); *(u32x2*)(x8 + (size_t)row * DM + col + bj * HALF) = o8; } }
                ssq = fq_sum(ssq); if (fq == 0) st[(size_t)row * 16 + u.pn * 4 + wc] = ssq;
            }
        }
    }
};
__device__ __forceinline__ float silu_mul(float g, float u) { return g * sigmoidf_(g) * u; }
struct EpiGU {
    static constexpr bool PERM = true, MID = false; static constexpr int NVM = 16;
    bf16_t* ACT; const float* st; int ldact; unsigned char* wsb;
    __device__ __forceinline__ void operator()(const Acc& acc, const Unit& u, int wr, int wc, int fr, int fq) const {
        EPI_ROWBASE;
        float r8[8]; rowscale16(st, rbase, fq, r8);
        __builtin_amdgcn_sched_barrier(0);
        EPI_LOOP {
            const int row = rbase + ai * HALF + m * 16; const float r = r8[ai * 4 + m];
            f32x4 g0 = acc[ai][0][m][0] * r, g1 = acc[ai][0][m][1] * r, u0 = acc[ai][1][m][0] * r, u1 = acc[ai][1][m][1] * r;
#ifdef PROBE_P6NOISE
            { unsigned h_ = (unsigned)row * 2654435761u ^ (unsigned)(u.pn * 64 + wc * 8 + fq) * 40503u; float nz[16];
#pragma unroll
              for (int e_ = 0; e_ < 16; ++e_) { h_ = h_ * 1664525u + 1013904223u; nz[e_] = ((float)(h_ >> 8) * (1.f / 16777216.f) - 0.5f) * 3.4641f * 0.035f * (float)(PROBE_P6NOISE); }
              g0.x += nz[0]; g0.y += nz[1]; g0.z += nz[2]; g0.w += nz[3]; g1.x += nz[4]; g1.y += nz[5]; g1.z += nz[6]; g1.w += nz[7]; u0.x += nz[8]; u0.y += nz[9]; u0.z += nz[10]; u0.w += nz[11]; u1.x += nz[12]; u1.y += nz[13]; u1.z += nz[14]; u1.w += nz[15]; }
#endif
            const f32x4 a0 = {silu_mul(g0.x, u0.x), silu_mul(g0.y, u0.y), silu_mul(g0.z, u0.z), silu_mul(g0.w, u0.w)};
            const f32x4 a1 = {silu_mul(g1.x, u1.x), silu_mul(g1.y, u1.y), silu_mul(g1.z, u1.z), silu_mul(g1.w, u1.w)};
            st16(wsb, (u32x4*)(ACT + blk_off(row, u.aux * HALF + wc * 32 + 8 * fq, ldact)), pack8(a0, a1));
        }
    }
};
struct EpiGUMoe {
    static constexpr bool PERM = true, MID = false; static constexpr int NVM = 16;
    bf16_t* ACT; const float* rowrr; int ldact; unsigned char* wsb;
    __device__ __forceinline__ void operator()(const Acc& acc, const Unit& u, int wr, int wc, int fr, int fq) const {
        EPI_ROWBASE;
        float r8[8];
#pragma unroll
        for (int i = 0; i < 8; ++i) r8[i] = rowrr[rbase + (i >> 2) * HALF + (i & 3) * 16] * (MOE_F8 ? 1.f / 4096.f : 1.f);
        __builtin_amdgcn_sched_barrier(0);
        EPI_LOOP {
            const int row = rbase + ai * HALF + m * 16; const float r = r8[ai * 4 + m];
            const float ru = MOE_DN_F8 ? r * 8.f : r;
            const f32x4 g0 = acc[ai][0][m][0] * r, g1 = acc[ai][0][m][1] * r, u0 = acc[ai][1][m][0] * ru, u1 = acc[ai][1][m][1] * ru;
            const f32x4 a0 = {silu_mul(g0.x, u0.x), silu_mul(g0.y, u0.y), silu_mul(g0.z, u0.z), silu_mul(g0.w, u0.w)};
            const f32x4 a1 = {silu_mul(g1.x, u1.x), silu_mul(g1.y, u1.y), silu_mul(g1.z, u1.z), silu_mul(g1.w, u1.w)};
            if (MOE_DN_F8) { u32x2 o8; o8.x = pk_fp8x4(a0.x, a0.y, a0.z, a0.w); o8.y = pk_fp8x4(a1.x, a1.y, a1.z, a1.w);
                st8(wsb, (u32x2*)((unsigned char*)ACT + blk_off(row, (u.aux * HALF + wc * 32 + 8 * fq) >> 1, ldact >> 1) * 2), o8); }
            else st16(wsb, (u32x4*)(ACT + blk_off(row, u.aux * HALF + wc * 32 + 8 * fq, ldact)), pack8(a0, a1));
        }
    }
};
template <bool FIRST> struct EpiDnMoe {
    static constexpr bool PERM = true, MID = false; static constexpr int NVM = 32;
    unsigned char* ws; const int* rowtok; const float* rowgw;
    __device__ __forceinline__ void operator()(const Acc& acc, const Unit& u, int wr, int wc, int fr, int fq) const {
        EPI_ROWBASE; const int col = u.aux * BM + wc * 32 + 8 * fq;
        int tk[8]; float gw8[8];
#pragma unroll
        for (int i = 0; i < 8; ++i) { tk[i] = rowtok[rbase + (i >> 2) * HALF + (i & 3) * 16]; gw8[i] = rowgw[rbase + (i >> 2) * HALF + (i & 3) * 16] * (MOE_DN_F8 ? 1.f / 8192.f : 1.f); }
#pragma unroll
        for (int ai = 0; ai < 2; ++ai) {
            __builtin_amdgcn_sched_barrier(0);
            u32x4 xi[4][2]; bf16_t* xr[4];
#pragma unroll
            for (int m = 0; m < 4; ++m) { const int tok = tk[ai * 4 + m] < 0 ? 0 : tk[ai * 4 + m]; xr[m] = xm_row(ws, tok) + col;
                const bf16_t* src = FIRST ? (const bf16_t*)(ws + WS_XB) + (size_t)tok * DM + col : xr[m];
#pragma unroll
                for (int bj = 0; bj < 2; ++bj) xi[m][bj] = *(const u32x4*)(src + bj * HALF); }
#pragma unroll
            for (int m = 0; m < 4; ++m) { const float gwv = gw8[ai * 4 + m];
                if (tk[ai * 4 + m] >= 0) {
#pragma unroll
                    for (int bj = 0; bj < 2; ++bj) { f32x4 x0, x1; unpack8(xi[m][bj], x0, x1);
                        *(u32x4*)(xr[m] + bj * HALF) = pack8(x0 + acc[ai][bj][m][0] * gwv, x1 + acc[ai][bj][m][1] * gwv); } } }
        }
    }
};
}
namespace att {
constexpr float MLA_THR = 6.f;
__device__ __forceinline__ int crow(int r, int hi) { return (r & 3) + 8 * (r >> 2) + 4 * hi; }
__device__ __forceinline__ float xhalf_max(float m) { return xmax32(m); }
__device__ __forceinline__ float xhalf_sum(float m) { return xsum32(m); }
typedef short v4i16_t __attribute__((ext_vector_type(4)));
__device__ __forceinline__ s16x4 vtr(const LAS unsigned char* p) { return __builtin_bit_cast(s16x4, __builtin_amdgcn_ds_read_tr16_b64_v4i16((LAS v4i16_t*)p)); }
__device__ __forceinline__ bf16x8 cat8(s16x4 a, s16x4 b) { return (bf16x8){a[0], a[1], a[2], a[3], b[0], b[1], b[2], b[3]}; }
__device__ __forceinline__ bf16x8 pfrag(const f32x16& p, int s8) {
    u32x4 w; w.x = cvt_pk_bf16(p[s8 + 0], p[s8 + 1]); w.y = cvt_pk_bf16(p[s8 + 2], p[s8 + 3]); w.z = cvt_pk_bf16(p[s8 + 4], p[s8 + 5]); w.w = cvt_pk_bf16(p[s8 + 6], p[s8 + 7]);
    return __builtin_bit_cast(bf16x8, w);
}
constexpr int TAB_STRIDE = 320;

constexpr int BW_ROWS = 384, BW_KP = 144;
constexpr int BW_K = 0, BW_V = BW_ROWS * BW_KP, BW_VDH = BW_ROWS * 64, BW_TAB = BW_V + 2 * BW_VDH, BW_END = BW_TAB + 4 * TAB_STRIDE * 4;
struct BandPre { u32x4 k[6], v[6]; float t[4]; bf16x8 q[4]; };
struct BandItem { int kind, b, hh, g0, a0; };
__device__ __forceinline__ BandItem band_decode(int i, int items_per_kind) {
    BandItem it; it.kind = i / items_per_kind; const int w = i % items_per_kind;
    if (it.kind < 3) { const int sub = w & 7; it.hh = (w >> 3) & 7; it.b = w >> 6;
        if (it.kind == 0) { it.g0 = 0; it.a0 = 256 * sub; } else if (it.kind == 1) { it.g0 = sub >> 1; it.a0 = 256 * (sub & 1); } else { it.g0 = 2 * sub; it.a0 = 0; } }
    else { it.a0 = 64 * (w & 31); it.hh = (w >> 5) & 1; it.b = w >> 6; it.g0 = 0; }
    return it;
}
__device__ __forceinline__ bool band_row(const BandItem& it, int r, int& pos) {
    int key, g = it.g0, dil, L;
    if (it.kind == 3) { if (r >= 320) return false; key = it.a0 - 128 + r; dil = 1; L = SEQ; }
    else if (it.kind == 2) { if (r >= 256) return false; g += r >> 7; key = r & 127; dil = 16; L = 128; }
    else { dil = it.kind == 0 ? 1 : 4; L = SEQ / dil; key = it.a0 - 64 + r; }
    if (key < 0 || key >= L) return false;
    pos = key * dil + g; return true;
}
__device__ __forceinline__ void band_issue(BandPre& P, const BandItem& it, const bf16_t* HM, const float* tabg, int tid, int wid, int lane) {
    const bf16_t* kb = it.kind == 3 ? HM + (size_t)4 * MC * 512 + ((size_t)(it.b * 2 + it.hh) * SEQ) * 64 : HM + (size_t)MC * 512 + ((size_t)(it.b * 8 + it.hh) * SEQ) * 64;
    const bf16_t* vb = it.kind == 3 ? kb + (size_t)MC * 128 : kb + (size_t)MC * 512;
#pragma unroll
    for (int i = 0; i < 6; ++i) { const int id = i * 512 + tid, r = id >> 3, c = id & 7; int pos; P.k[i] = (u32x4){0u, 0u, 0u, 0u}; P.v[i] = P.k[i];
        if (band_row(it, r, pos)) { P.k[i] = *(const u32x4*)(kb + (size_t)pos * 64 + c * 8); P.v[i] = *(const u32x4*)(vb + (size_t)pos * 64 + c * 8); } }
#pragma unroll
    for (int j = 0; j < 4; ++j) { P.t[j] = 0.f; if (tid < TAB_STRIDE && (it.kind == 3 || j == 0)) P.t[j] = tabg[((it.kind == 3 ? 3 * 8 + it.hh * 4 + j : it.kind * 8 + it.hh)) * TAB_STRIDE + tid]; }
    int a0w, g = it.g0, dil, qh; const bf16_t* qbuf;
    if (it.kind == 3) { a0w = it.a0 + 32 * (wid & 1); dil = 1; qh = it.hh * 4 + (wid >> 1); qbuf = HM + (size_t)3 * MC * 512; }
    else if (it.kind == 2) { a0w = 32 * (wid & 3); g += wid >> 2; dil = 16; qh = it.hh; qbuf = HM; }
    else { a0w = it.a0 + 32 * wid; dil = it.kind == 0 ? 1 : 4; qh = it.hh; qbuf = HM; }
    const bf16_t* qp = qbuf + (((size_t)(it.b * 8 + qh) * SEQ) + (size_t)(a0w + (lane & 31)) * dil + g) * 64 + (lane >> 5) * 8;
#pragma unroll
    for (int d0 = 0; d0 < 4; ++d0) P.q[d0] = *(const bf16x8*)(qp + d0 * 16);
}
__device__ __forceinline__ void band_store(const BandPre& P, const BandItem& it, LAS unsigned char* lds, int tid) {
#pragma unroll
    for (int i = 0; i < 6; ++i) { const int id = i * 512 + tid, r = id >> 3, c = id & 7;
        *(LAS u32x4*)(lds + BW_K + r * BW_KP + c * 16) = P.k[i]; *(LAS u32x4*)(lds + BW_V + (c >> 2) * BW_VDH + r * 64 + (c & 3) * 16) = P.v[i]; }
    if (tid < TAB_STRIDE) {
#pragma unroll
        for (int j = 0; j < 4; ++j) if (it.kind == 3 || j == 0) ((LAS float*)(lds + BW_TAB))[j * TAB_STRIDE + tid] = P.t[j]; }
}
template <int NKB, int MODE>
__device__ __forceinline__ void band_compute(const bf16x8 (&qf)[4], const LAS unsigned char* lds, int rowoff, int a0w, int L, const LAS float* tab, bf16_t* op, float* stp, float sink2, int lane,
                                             const bf16_t* pb0 = nullptr, const bf16_t* pb1 = nullptr, const float* st0 = nullptr, const float* st1 = nullptr) {
    constexpr int R = 16 * (NKB - 1);
    const int q = lane & 31, hi = lane >> 5;
    f32x16 o0, o1;
#pragma unroll
    for (int r = 0; r < 16; ++r) { o0[r] = 0.f; o1[r] = 0.f; }
    float m = -3e38f, l = 0.f;
    const LAS float* tb = tab + (31 - q + 4 * hi);
    const int kro = q * BW_KP + hi * 16, vro = (4 * hi + ((lane & 15) >> 2)) * 64 + (16 * ((lane >> 4) & 1) + 4 * (lane & 3)) * 2;
#pragma unroll 1
    for (int kb = 0; kb < NKB; ++kb) {
        const int k0 = a0w - R + 32 * kb;
        if (k0 < 0 || k0 >= L) continue;
        const LAS unsigned char* kp = lds + BW_K + (rowoff + k0) * BW_KP + kro;
        f32x16 s;
#pragma unroll
        for (int r = 0; r < 16; ++r) s[r] = 0.f;
#pragma unroll
        for (int d0 = 0; d0 < 4; ++d0) s = __builtin_amdgcn_mfma_f32_32x32x16_bf16(*(const LAS bf16x8*)(kp + d0 * 32), qf[d0], s, 0, 0, 0);
#pragma unroll
        for (int r = 0; r < 16; ++r) s[r] += tb[32 * kb + (r & 3) + 8 * (r >> 2)];
        float bm = s[0];
#pragma unroll
        for (int r = 1; r < 16; ++r) bm = fmaxf(bm, s[r]);
        bm = xhalf_max(bm);
        if (__any(bm > m + MLA_THR)) {
            const float mn = fmaxf(m, bm), f = fast_exp2(m - mn); l *= f; m = mn;
#pragma unroll
            for (int r = 0; r < 16; ++r) { o0[r] *= f; o1[r] *= f; } }
        float ps = 0.f;
#pragma unroll
        for (int r = 0; r < 16; ++r) { s[r] = fast_exp2(s[r] - m); ps += s[r]; }
        l += ps;
        const bf16x8 p0 = pfrag(s, 0), p1 = pfrag(s, 8);
        const LAS unsigned char* vp = lds + BW_V + (rowoff + k0) * 64 + vro;
        { const bf16x8 v00 = cat8(vtr(vp), vtr(vp + 512)), v01 = cat8(vtr(vp + BW_VDH), vtr(vp + BW_VDH + 512));
          const bf16x8 v10 = cat8(vtr(vp + 1024), vtr(vp + 1024 + 512)), v11 = cat8(vtr(vp + BW_VDH + 1024), vtr(vp + BW_VDH + 1024 + 512));
          o0 = __builtin_amdgcn_mfma_f32_32x32x16_bf16(v00, p0, o0, 0, 0, 0); o1 = __builtin_amdgcn_mfma_f32_32x32x16_bf16(v01, p0, o1, 0, 0, 0);
          o0 = __builtin_amdgcn_mfma_f32_32x32x16_bf16(v10, p1, o0, 0, 0, 0); o1 = __builtin_amdgcn_mfma_f32_32x32x16_bf16(v11, p1, o1, 0, 0, 0); }
    }
    float lt = xhalf_sum(l);
    if (MODE == 2) {
        const f32x2 s0 = *(const f32x2*)st0, s1 = *(const f32x2*)st1;
        u32x2 a0[8], a1[8];
#pragma unroll
        for (int j = 0; j < 4; ++j) { a0[j] = *(const u32x2*)(pb0 + 8 * j); a0[4 + j] = *(const u32x2*)(pb0 + 32 + 8 * j); a1[j] = *(const u32x2*)(pb1 + 8 * j); a1[4 + j] = *(const u32x2*)(pb1 + 32 + 8 * j); }
        const float M = fmaxf(m, fmaxf(s0.x, s1.x));
        const float w0 = fast_exp2(s0.x - M) * s0.y, w1 = fast_exp2(s1.x - M) * s1.y, w2 = fast_exp2(m - M);
        const float inv = 1.f / (w0 + w1 + w2 * lt), c0 = w0 * inv, c1 = w1 * inv, c2 = w2 * inv;
#pragma unroll
        for (int j = 0; j < 4; ++j) {
            u32x2 w0_, w1_;
            { const float x0 = bf_lo(a0[j].x) * c0 + bf_lo(a1[j].x) * c1 + o0[4 * j] * c2, x1 = bf_hi(a0[j].x) * c0 + bf_hi(a1[j].x) * c1 + o0[4 * j + 1] * c2;
              const float x2 = bf_lo(a0[j].y) * c0 + bf_lo(a1[j].y) * c1 + o0[4 * j + 2] * c2, x3 = bf_hi(a0[j].y) * c0 + bf_hi(a1[j].y) * c1 + o0[4 * j + 3] * c2;
              w0_.x = cvt_pk_bf16(x0, x1); w0_.y = cvt_pk_bf16(x2, x3); }
            { const float x0 = bf_lo(a0[4 + j].x) * c0 + bf_lo(a1[4 + j].x) * c1 + o1[4 * j] * c2, x1 = bf_hi(a0[4 + j].x) * c0 + bf_hi(a1[4 + j].x) * c1 + o1[4 * j + 1] * c2;
              const float x2 = bf_lo(a0[4 + j].y) * c0 + bf_lo(a1[4 + j].y) * c1 + o1[4 * j + 2] * c2, x3 = bf_hi(a0[4 + j].y) * c0 + bf_hi(a1[4 + j].y) * c1 + o1[4 * j + 3] * c2;
              w1_.x = cvt_pk_bf16(x0, x1); w1_.y = cvt_pk_bf16(x2, x3); }
            *(u32x2*)(op + 8 * j) = w0_; *(u32x2*)(op + 32 + 8 * j) = w1_;
        }
        return;
    }
    if (MODE == 1) lt += fast_exp2(sink2 - m);
    else if (hi == 0) { stp[0] = m; stp[1] = lt; }
    const float inv = 1.f / lt;
#pragma unroll
    for (int j = 0; j < 4; ++j) {
        u32x2 w0, w1; w0.x = cvt_pk_bf16(o0[4 * j] * inv, o0[4 * j + 1] * inv); w0.y = cvt_pk_bf16(o0[4 * j + 2] * inv, o0[4 * j + 3] * inv);
        w1.x = cvt_pk_bf16(o1[4 * j] * inv, o1[4 * j + 1] * inv); w1.y = cvt_pk_bf16(o1[4 * j + 2] * inv, o1[4 * j + 3] * inv);
        *(u32x2*)(op + 8 * j) = w0; *(u32x2*)(op + 32 + 8 * j) = w1;
    }
}

constexpr int MLA_KP = 208;
constexpr int MLA_TK = 128;
constexpr int MLA_KTB = MLA_TK * MLA_KP;
constexpr int MLA_VTB = MLA_TK * 128;
constexpr int MLA_SLOT = MLA_KTB + MLA_VTB;
__device__ __forceinline__ void mla_unit(const bf16_t* Q, const bf16_t* KV, const bf16_t* Zc, bf16_t* Y, int b, int h, int qblk, LAS unsigned char* lds, int tid, int wid, int lane) {
    const int q = lane & 31, hi = lane >> 5;
    const size_t rb = (size_t)b * SEQ;
    bf16x8 qf[6];
    { const bf16_t* qp = Q + (rb + qblk * 256 + wid * 32 + q) * 768 + h * 96 + hi * 8;
#pragma unroll
      for (int d0 = 0; d0 < 6; ++d0) qf[d0] = *(const bf16x8*)(qp + d0 * 16); }
    const bf16_t* gk = KV + (rb + (tid >> 3)) * 1024 + h * 64 + (tid & 7) * 8;
    const bf16_t* gv = gk + 512;
    const bf16_t* gp = Zc + (rb + (tid >> 2)) * ZW + ZO_KPE + (tid & 3) * 8;
    const int lk = (tid >> 3) * MLA_KP + (tid & 7) * 16, lp = (tid >> 2) * MLA_KP + 128 + (tid & 3) * 16;
    const int lv = MLA_KTB + ((tid & 7) >> 2) * (MLA_TK * 64) + (tid >> 3) * 64 + (tid & 3) * 16;
    u32x4 rk0, rk1, rv0, rv1, rp;
#define MLA_GLOAD(T) do { const size_t go_ = (size_t)(T) * MLA_TK; rk0 = *(const u32x4*)(gk + go_ * 1024); rk1 = *(const u32x4*)(gk + (go_ + 64) * 1024); \
        rv0 = *(const u32x4*)(gv + go_ * 1024); rv1 = *(const u32x4*)(gv + (go_ + 64) * 1024); rp = *(const u32x4*)(gp + go_ * ZW); } while (0)
#define MLA_LSTORE(slot) do { LAS unsigned char* sb_ = lds + (slot) * MLA_SLOT; *(LAS u32x4*)(sb_ + lk) = rk0; *(LAS u32x4*)(sb_ + lk + 64 * MLA_KP) = rk1; \
        *(LAS u32x4*)(sb_ + lv) = rv0; *(LAS u32x4*)(sb_ + lv + 64 * 64) = rv1; *(LAS u32x4*)(sb_ + lp) = rp; } while (0)
    MLA_GLOAD(0); MLA_LSTORE(0); MLA_GLOAD(1); MLA_LSTORE(1);
    __syncthreads();
    f32x16 o0, o1;
#pragma unroll
    for (int r = 0; r < 16; ++r) { o0[r] = 0.f; o1[r] = 0.f; }
    float m = 0.f, l = 0.f;
    const int kro = q * MLA_KP + hi * 16;
    const int vro = MLA_KTB + (4 * hi + ((lane & 15) >> 2)) * 64 + (16 * ((lane >> 4) & 1) + 4 * (lane & 3)) * 2;
    f32x16 sa0, sa1, sb0, sb1, negm;
#pragma unroll
    for (int r = 0; r < 16; ++r) negm[r] = 0.f;
    m = 0.f;
#define MLA_QK(S0, S1, slot, sub) do { const LAS unsigned char* kb_ = lds + (slot) * MLA_SLOT + (sub) * 64 * MLA_KP + kro; \
        { const bf16x8 k0_ = *(const LAS bf16x8*)(kb_), k1_ = *(const LAS bf16x8*)(kb_ + 32 * MLA_KP); \
          S0 = __builtin_amdgcn_mfma_f32_32x32x16_bf16(k0_, qf[0], negm, 0, 0, 0); S1 = __builtin_amdgcn_mfma_f32_32x32x16_bf16(k1_, qf[0], negm, 0, 0, 0); } \
        _Pragma("unroll") for (int d0 = 1; d0 < 6; ++d0) { const bf16x8 k0_ = *(const LAS bf16x8*)(kb_ + d0 * 32), k1_ = *(const LAS bf16x8*)(kb_ + 32 * MLA_KP + d0 * 32); \
            S0 = __builtin_amdgcn_mfma_f32_32x32x16_bf16(k0_, qf[d0], S0, 0, 0, 0); S1 = __builtin_amdgcn_mfma_f32_32x32x16_bf16(k1_, qf[d0], S1, 0, 0, 0); } } while (0)
#define MAX3(a, b, c) __builtin_fmaxf(__builtin_fmaxf((a), (b)), (c))
#define MLA_STEP(C0, C1, N0, N1, HASN, NSLOT, NSUB, CSLOT, CSUB, FIRST) do { \
        if (HASN) MLA_QK(N0, N1, NSLOT, NSUB); \
        float ba = MAX3(C0[0], C0[1], C1[0]), bb = MAX3(C0[2], C0[3], C1[1]); ba = MAX3(ba, C1[2], C1[3]); \
        _Pragma("unroll") for (int r = 4; r < 16; r += 4) { ba = MAX3(ba, C0[r], C0[r + 1]); bb = MAX3(bb, C0[r + 2], C0[r + 3]); ba = MAX3(ba, C1[r], C1[r + 1]); bb = MAX3(bb, C1[r + 2], C1[r + 3]); } \
        float bm = xhalf_max(__builtin_fmaxf(ba, bb)); \
        if ((FIRST) || __any(bm > MLA_THR)) {                                \
            const float dl = (FIRST) ? bm : __builtin_fmaxf(bm, 0.f), f = fast_exp2(-dl); m += dl; l *= f; \
            _Pragma("unroll") for (int r = 0; r < 16; ++r) { o0[r] *= f; o1[r] *= f; C0[r] -= dl; C1[r] -= dl; negm[r] = -m; } \
            if (HASN) { _Pragma("unroll") for (int r = 0; r < 16; ++r) { N0[r] -= dl; N1[r] -= dl; } } } \
        float ps = 0.f; \
        _Pragma("unroll") for (int r = 0; r < 16; ++r) { C0[r] = fast_exp2(C0[r]); C1[r] = fast_exp2(C1[r]); ps += C0[r] + C1[r]; } \
        l += ps; \
        const bf16x8 p0 = pfrag(C0, 0), p1 = pfrag(C0, 8), p2 = pfrag(C1, 0), p3 = pfrag(C1, 8); \
        const LAS unsigned char* vb = lds + (CSLOT) * MLA_SLOT + (CSUB) * 64 * 64 + vro; \
        MLA_PV(0, p0); MLA_PV(1, p1); MLA_PV(2, p2); MLA_PV(3, p3); } while (0)
#define MLA_PV(S, P) do { const bf16x8 va = cat8(vtr(vb + (S) * 1024), vtr(vb + (S) * 1024 + 512)), vc = cat8(vtr(vb + MLA_TK * 64 + (S) * 1024), vtr(vb + MLA_TK * 64 + (S) * 1024 + 512)); \
            o0 = __builtin_amdgcn_mfma_f32_32x32x16_bf16(va, P, o0, 0, 0, 0); o1 = __builtin_amdgcn_mfma_f32_32x32x16_bf16(vc, P, o1, 0, 0, 0); } while (0)
    MLA_QK(sa0, sa1, 0, 0);
    int sc = 0, sn = 1, sw = 2;
    constexpr int NT = SEQ / MLA_TK;
    for (int T = 0; T < NT; ++T) {
        const bool has1 = T + 1 < NT, has2 = T + 2 < NT;
        if (has2) MLA_GLOAD(T + 2);
        MLA_STEP(sa0, sa1, sb0, sb1, true, sc, 1, sc, 0, T == 0);
        MLA_STEP(sb0, sb1, sa0, sa1, has1, sn, 0, sc, 1, false);
        if (has2) MLA_LSTORE(sw);
        __syncthreads();
        const int tmp = sc; sc = sn; sn = sw; sw = tmp;
    }
#undef MAX3
#undef MLA_GLOAD
#undef MLA_LSTORE
#undef MLA_QK
#undef MLA_STEP
#undef MLA_PV
    const float inv = 1.f / xhalf_sum(l);
    bf16_t* op = Y + (rb + qblk * 256 + wid * 32 + q) * 1536 + h * 64 + 4 * hi;
#pragma unroll
    for (int j = 0; j < 4; ++j) {
        u32x2 w0, w1; w0.x = cvt_pk_bf16(o0[4 * j] * inv, o0[4 * j + 1] * inv); w0.y = cvt_pk_bf16(o0[4 * j + 2] * inv, o0[4 * j + 3] * inv);
        w1.x = cvt_pk_bf16(o1[4 * j] * inv, o1[4 * j + 1] * inv); w1.y = cvt_pk_bf16(o1[4 * j + 2] * inv, o1[4 * j + 3] * inv);
        *(u32x2*)(op + 8 * j) = w0; *(u32x2*)(op + 32 + 8 * j) = w1;
    }
}
}
constexpr int NWAVES = 8, NTHREADS = 512;
constexpr int LDS_BYTES = 147456;
constexpr int MISC_OFF = 131072 + 320;
#define LDS_WAIT() asm volatile("s_waitcnt lgkmcnt(0)" ::: "memory")

struct Args { const float* in[22]; float* out; unsigned char* ws; int ph_lo, ph_hi; };

enum { MAP_ID = 0, MAP_WIN, MAP_WUQ, MAP_WUKV, MAP_GATE, MAP_UP, MAP_WIN8 };
__device__ __forceinline__ int map_row(int map, int n) {
    if (map == MAP_WIN || map == MAP_WIN8) {
        const int o = map == MAP_WIN8 ? P1_F8_FROM * 256 : 0;
        if (n < 384) return n - o;
        if (n < 416) { const int i = n - 384; return 384 + (i < 16 ? 2 * i : 2 * (i - 16) + 1) - o; }
        return n + 96 - o;
    }
    if (map == MAP_WUQ) { const int h = n / 96, j = n % 96; if (j < 64) return n; const int i = j - 64; return h * 96 + 64 + (i < 16 ? 2 * i : 2 * (i - 16) + 1); }
    if (map == MAP_WUKV) { const int h = n >> 7, j = n & 127; return j < 64 ? h * 64 + j : 512 + h * 64 + (j - 64); }
    if (map == MAP_GATE) return (n >> 7) * 256 + (n & 127);
    if (map == MAP_UP) return (n >> 7) * 256 + 128 + (n & 127);
    return n;
}
template <bool F8 = false>
__device__ __forceinline__ void cvt_item(const float* src, int ldsrc, int nblk, const float* gain, float scale, bf16_t* dst, int lddst, int kdst0, int map, LAS float* scr, int item, int lane) {
    const int kb = item / nblk, nb = item % nblk, k0 = 64 * kb, n0 = 32 * nb;
    f32x4 v[8]; float gs[8];
#pragma unroll
    for (int i = 0; i < 8; ++i) { const int idx = i * 64 + lane, kk = idx >> 3, c4 = idx & 7; v[i] = *(const f32x4*)(src + (size_t)(k0 + kk) * ldsrc + n0 + 4 * c4); gs[i] = gain ? gain[k0 + kk] * scale : scale; }
#pragma unroll
    for (int i = 0; i < 8; ++i) { const int idx = i * 64 + lane, kk = idx >> 3, c4 = idx & 7; LAS float* d = scr + kk * 33 + 4 * c4; d[0] = v[i].x * gs[i]; d[1] = v[i].y * gs[i]; d[2] = v[i].z * gs[i]; d[3] = v[i].w * gs[i]; }
    LDS_WAIT(); asm volatile("" ::: "memory");
    const int c = lane & 7;
#pragma unroll
    for (int j = 0; j < 4; ++j) { const int n = (lane >> 3) + 8 * j; const LAS float* s = scr + (8 * c) * 33 + n;
        u32x4 o; o.x = cvt_pk_bf16(s[0 * 33], s[1 * 33]); o.y = cvt_pk_bf16(s[2 * 33], s[3 * 33]); o.z = cvt_pk_bf16(s[4 * 33], s[5 * 33]); o.w = cvt_pk_bf16(s[6 * 33], s[7 * 33]);
        if constexpr (F8) { u32x2 o8; o8.x = pk_fp8x4(s[0 * 33], s[1 * 33], s[2 * 33], s[3 * 33]); o8.y = pk_fp8x4(s[4 * 33], s[5 * 33], s[6 * 33], s[7 * 33]);
            *(u32x2*)((unsigned char*)dst + (size_t)map_row(map, n0 + n) * lddst + kdst0 + k0 + 8 * c) = o8; }
        else *(u32x4*)(dst + (size_t)map_row(map, n0 + n) * lddst + kdst0 + k0 + 8 * c) = o; }
    LDS_WAIT(); asm volatile("" ::: "memory");
}

struct Ctx {
    LAS unsigned char* lds; int tid, lane, wave, vcu, G, gw, NGW;
    const float* const* in; float* out; unsigned char* ws;
};

__device__ __forceinline__ void phase_prologue(const Ctx& C) {
    LAS float* scr = (LAS float*)(C.lds + C.wave * 16384);
    unsigned char* ws = C.ws;
    constexpr int I_IN = 16 * 181, I_UQ = 4 * 24, I_UKV = 2 * 32, I_BR = 8 * 32, I_OUT = 16 * 32, I_L = I_IN + I_UQ + I_UKV + 3 * I_BR + I_OUT;
    constexpr int I_G = 16 * 88, I_D = 44 * 32, NIT = 2 * I_L + 2 * I_G + I_D;
    for (int it = C.gw; it < NIT; it += C.NGW) {
        int r = it;
        if (r < 2 * I_L) { const int l = r / I_L; r -= l * I_L;
            if (r < I_IN) { if (r % 181 >= (P1_F8_FROM <= 1 ? P1_F8_FROM * 8 : (P1_F8_FROM * 256 - 96) / 32)) cvt_item<true>(C.in[2] + (size_t)l * DM * INC, INC, 181, C.in[1] + l * DM, 256.f, (bf16_t*)(ws + WS_WIN8 + l * SZ_WIN8), DM, 0, MAP_WIN8, scr, r, C.lane);
                            else cvt_item(C.in[2] + (size_t)l * DM * INC, INC, 181, C.in[1] + l * DM, 1.f, (bf16_t*)(ws + WS_WIN + l * SZ_WIN), DM, 0, MAP_WIN, scr, r, C.lane); continue; } r -= I_IN;
            if (r < I_UQ) { cvt_item(C.in[4] + (size_t)l * 256 * 768, 768, 24, C.in[3] + l * 256, 0.10206207261596577f * LOG2E, (bf16_t*)(ws + WS_WUQ + l * SZ_WUQ), 256, 0, MAP_WUQ, scr, r, C.lane); continue; } r -= I_UQ;
            if (r < I_UKV) { cvt_item(C.in[6] + (size_t)l * 128 * 1024, 1024, 32, C.in[5] + l * 128, 1.f, (bf16_t*)(ws + WS_WUKV + l * SZ_WUKV), 256, 0, MAP_WUKV, scr, r, C.lane); continue; } r -= I_UKV;
            if (r < 3 * I_BR) { const int br = r / I_BR; r -= br * I_BR; cvt_item(C.in[9 + br] + (size_t)l * 512 * DM, DM, 32, nullptr, 1.f, (bf16_t*)(ws + WS_WBR + l * SZ_WBR), 1536, br * 512, MAP_ID, scr, r, C.lane); continue; } r -= 3 * I_BR;
            cvt_item<P5_F8 != 0>(C.in[12] + (size_t)l * DM * DM, DM, 32, nullptr, P5_F8 ? 256.f : 1.f, (bf16_t*)(ws + WS_WOUT + l * SZ_WOUT), DM, 0, MAP_ID, scr, r, C.lane); continue; }
        r -= 2 * I_L;
        if (r < I_G) { cvt_item(C.in[14], DFF, 88, C.in[13], 1.f, (bf16_t*)(ws + WS_WGU), DM, 0, MAP_GATE, scr, r, C.lane); continue; } r -= I_G;
        if (r < I_G) { cvt_item(C.in[15], DFF, 88, C.in[13], 1.f, (bf16_t*)(ws + WS_WGU), DM, 0, MAP_UP, scr, r, C.lane); continue; } r -= I_G;
        cvt_item(C.in[16], DM, 32, nullptr, 1.f, (bf16_t*)(ws + WS_WD), DFF, 0, MAP_ID, scr, r, C.lane);
    }
    const int gt = C.vcu * NTHREADS + C.tid, NGT = C.G * NTHREADS;
    if (P1_F8_FROM <= 1) for (int i = gt; i < 2 * 6144; i += NGT) { const int l = i / 6144, r = i % 6144; const u32x4 z = {0u, 0u, 0u, 0u}; *(u32x4*)(ws + WS_WIN8 + l * SZ_WIN8 + (size_t)(416 - P1_F8_FROM * 256) * DM + (size_t)r * 16) = z; }
    for (int i = gt; i < 2 * (12288 + 16384); i += NGT) { const int l = i / (12288 + 16384); int r = i % (12288 + 16384); const u32x4 z = {0u, 0u, 0u, 0u};
        if (r < 12288) *(u32x4*)(ws + WS_WIN + l * SZ_WIN + (size_t)416 * DM * 2 + (size_t)r * 16) = z;
        else { r -= 12288; *(u32x4*)(ws + WS_WUKV + l * SZ_WUKV + (size_t)(r >> 4) * 512 + 256 + (r & 15) * 16) = z; } }
    float* cosT = (float*)(ws + WS_TAB); float* sinT = cosT + SEQ * 16; float* tabb = sinT + SEQ * 16;
    for (int i = gt; i < SEQ * 16; i += NGT) { const int pos = i >> 4, k = i & 15; const float inv = powf(10000.f, -(float)k / 16.f); const float ang = (float)pos * inv; cosT[i] = cosf(ang); sinT[i] = sinf(ang); }
    for (int i = gt; i < 4 * 8 * att::TAB_STRIDE; i += NGT) { const int kind = i / (8 * att::TAB_STRIDE), h = (i / att::TAB_STRIDE) & 7, idx = i % att::TAB_STRIDE;
        const int R = kind == 3 ? 128 : 64, dil = kind == 1 ? 4 : (kind == 2 ? 16 : 1), rel = idx - (R + 31);
        float v = NEGB; if (rel >= -R && rel <= R) v = C.in[8][t5_bucket(rel * dil) * 16 + (kind == 3 ? 8 : 0) + h] * LOG2E;
        tabb[i] = v; }
    const float* x = C.in[0]; bf16_t* xb = (bf16_t*)(ws + WS_XB); float* st = (float*)(ws + WS_ST);
    for (int row = 2 * C.gw; row < MTOK; row += 2 * C.NGW) {
        const f32x4* xr = (const f32x4*)(x + (size_t)row * DM) + C.lane; f32x4 v[8];
#pragma unroll
        for (int j = 0; j < 8; ++j) v[j] = xr[64 * j];
        float s0 = 0.f, s1 = 0.f;
#pragma unroll
        for (int j = 0; j < 8; ++j) { const float q = (v[j].x * v[j].x + v[j].y * v[j].y) + (v[j].z * v[j].z + v[j].w * v[j].w); if (j < 4) s0 += q; else s1 += q;
            u32x2 w; w.x = cvt_pk_bf16(v[j].x, v[j].y); w.y = cvt_pk_bf16(v[j].z, v[j].w); *((u32x2*)(xb + (size_t)row * DM) + C.lane + 64 * j) = w;
            if (P1_F8_FROM < 23) *((unsigned*)(ws + WS_XB8P + (size_t)(row + (j >> 2)) * DM) + C.lane + 64 * (j & 3)) = pk_fp8x4(v[j].x * 16.f, v[j].y * 16.f, v[j].z * 16.f, v[j].w * 16.f); }
        s0 = wave_sum(s0); s1 = wave_sum(s1);
        if (C.lane < 32) st[(size_t)row * 16 + C.lane] = C.lane == 0 ? s0 : (C.lane == 16 ? s1 : 0.f);
    }
}

__device__ __forceinline__ void phase_moe_weights(const Ctx& C) {
    LAS float* scr = (LAS float*)(C.lds + 40960 + C.wave * 8704);
    constexpr int I_G = 16 * 112, I_D = 56 * 32, I_E = 2 * I_G + I_D;
    for (int it = C.gw; it < NEXP * I_E; it += C.NGW) {
        const int e = it / I_E; int r = it % I_E;
        if (r < I_G) { cvt_item<MOE_F8 != 0>(C.in[18] + (size_t)e * DM * DFE, DFE, 112, C.in[13] + DM, MOE_F8 ? 256.f : 1.f, (bf16_t*)(C.ws + WS_EGU + (size_t)e * 2 * DFE * DM * (MOE_F8 ? 1 : 2)), DM, 0, MAP_GATE, scr, r, C.lane); continue; } r -= I_G;
        if (r < I_G) { cvt_item<MOE_F8 != 0>(C.in[19] + (size_t)e * DM * DFE, DFE, 112, C.in[13] + DM, MOE_F8 ? 256.f : 1.f, (bf16_t*)(C.ws + WS_EGU + (size_t)e * 2 * DFE * DM * (MOE_F8 ? 1 : 2)), DM, 0, MAP_UP, scr, r, C.lane); continue; } r -= I_G;
        cvt_item<MOE_DN_F8 != 0>(C.in[20] + (size_t)e * DFE * DM, DM, 32, nullptr, MOE_DN_F8 ? 1024.f : 1.f, (bf16_t*)(C.ws + WS_ED + (size_t)e * DM * DFE * (MOE_DN_F8 ? 1 : 2)), DFE, 0, MAP_ID, scr, r, C.lane);
    }
}

template <bool SECOND>
__device__ __forceinline__ void phase_band(const Ctx& C, const bf16_t* HM, bf16_t* PB, float* PBS, bf16_t* Y, const float* sink) {
    constexpr int IPK = MC / 2048 * 64, NIT = (SECOND ? 1 : 3) * IPK;
    const float* tabg = (const float*)(C.ws + WS_TAB) + 2 * SEQ * 16;
    att::BandPre P; att::BandItem it, nx;
    int i = C.vcu;
#define BAND_IDX(IDX) (SECOND ? 2 * IPK + (IDX) : ((IDX) < 2 * IPK ? (IDX) : (IDX) + IPK))
    if (i < NIT) { it = att::band_decode(BAND_IDX(i), IPK); att::band_issue(P, it, HM, tabg, C.tid, C.wave, C.lane); }
    for (; i < NIT; i += C.G) {
        att::band_store(P, it, C.lds, C.tid);
        bf16x8 qf[4];
#pragma unroll
        for (int d0 = 0; d0 < 4; ++d0) qf[d0] = P.q[d0];
        __syncthreads();
        const bool more = i + C.G < NIT;
        if (more) { nx = att::band_decode(BAND_IDX(i + C.G), IPK); att::band_issue(P, nx, HM, tabg, C.tid, C.wave, C.lane); }
        const int q = C.lane & 31, hi = C.lane >> 5, w = C.wave;
        if (it.kind == 3) {
            const int h = it.hh * 4 + (w >> 1), a0w = it.a0 + 32 * (w & 1); const size_t rowq = (size_t)it.b * SEQ + a0w + q;
            att::band_compute<9, 1>(qf, C.lds, 128 - it.a0, a0w, SEQ, (const LAS float*)(C.lds + att::BW_TAB) + (w >> 1) * att::TAB_STRIDE, Y + rowq * 1536 + 1024 + h * 64 + 4 * hi, nullptr, sink[h] * LOG2E, C.lane);
        } else if (it.kind == 2) {
            const int a0w = 32 * (w & 3), g = it.g0 + (w >> 2); const size_t rowq = (size_t)it.b * SEQ + (size_t)(a0w + q) * 16 + g;
            const size_t po = rowq * 512 + it.hh * 64 + 4 * hi, so = (rowq * 8 + it.hh) * 2;
            att::band_compute<5, 2>(qf, C.lds, (w >> 2) * 128, a0w, 128, (const LAS float*)(C.lds + att::BW_TAB), Y + rowq * 1536 + 512 + it.hh * 64 + 4 * hi, nullptr, 0.f, C.lane,
                                    PB + po, PB + (size_t)MC * 512 + po, PBS + so, PBS + (size_t)MC * 16 + so);
        } else {
            const int a0w = it.a0 + 32 * w, dil = it.kind == 0 ? 1 : 4, L = SEQ / dil, rowoff = 64 - it.a0;
            const size_t rowq = (size_t)it.b * SEQ + (size_t)(a0w + q) * dil + it.g0;
            att::band_compute<5, 0>(qf, C.lds, rowoff, a0w, L, (const LAS float*)(C.lds + att::BW_TAB), PB + (size_t)it.kind * MC * 512 + rowq * 512 + it.hh * 64 + 4 * hi,
                                    PBS + (size_t)it.kind * MC * 16 + (rowq * 8 + it.hh) * 2, 0.f, C.lane);
        }
        __syncthreads();
        it = nx;
    }
#undef BAND_IDX
}

__device__ __forceinline__ void phase_mla(const Ctx& C, const bf16_t* Q, const bf16_t* KV, const bf16_t* Zc, bf16_t* Y) {
    constexpr int NU = MC / 256 * 8;
    for (int u = C.vcu; u < NU; u += C.G) { const int qblk = u & 7, bh = u >> 3; att::mla_unit(Q, KV, Zc, Y, bh >> 3, bh & 7, qblk, C.lds, C.tid, C.wave, C.lane); }
}

__device__ __forceinline__ void phase_route(const Ctx& C) {
    LAS float* wr = (LAS float*)C.lds; LAS int* cnt = (LAS int*)(C.lds + 32768);
    const float* g2 = C.in[13] + DM; const float* router = C.in[17];
    for (int i = C.tid; i < DM * 8; i += NTHREADS) wr[i] = router[i] * g2[i >> 3];
    if (C.tid < 16) cnt[C.tid] = 0;
    __syncthreads();
    int* sel = (int*)(C.ws + WS_SEL); float* gwp = (float*)(C.ws + WS_GW); float* rr = (float*)(C.ws + WS_RR);
    const int w = blockIdx.x;
    for (int j = 0; j < 16; ++j) {
        const int tok = w * 128 + C.wave * 16 + j;
        const u32x2* xr = (const u32x2*)((const bf16_t*)(C.ws + WS_XB) + (size_t)tok * DM) + C.lane;
        float lg[8], ss = 0.f;
#pragma unroll
        for (int e = 0; e < 8; ++e) lg[e] = 0.f;
#pragma unroll
        for (int q = 0; q < 4; ++q) { const u32x2 wv = xr[64 * q]; const f32x4 v = {bf_lo(wv.x), bf_hi(wv.x), bf_lo(wv.y), bf_hi(wv.y)}; ss += (v.x * v.x + v.y * v.y) + (v.z * v.z + v.w * v.w);
            const int k = 4 * C.lane + 256 * q;
            if (MOE_F8) *(unsigned*)(C.ws + WS_XB8 + (size_t)tok * DM + k) = pk_fp8x4(v.x * 16.f, v.y * 16.f, v.z * 16.f, v.w * 16.f);
#pragma unroll
            for (int c = 0; c < 4; ++c) { const float xv = v[c]; const f32x4 w0 = *(const LAS f32x4*)(wr + (k + c) * 8), w1 = *(const LAS f32x4*)(wr + (k + c) * 8 + 4);
                lg[0] += xv * w0.x; lg[1] += xv * w0.y; lg[2] += xv * w0.z; lg[3] += xv * w0.w; lg[4] += xv * w1.x; lg[5] += xv * w1.y; lg[6] += xv * w1.z; lg[7] += xv * w1.w; } }
        ss = wave_sum(ss);
#pragma unroll
        for (int e = 0; e < 8; ++e) lg[e] = wave_sum(lg[e]);
        const float r = rsqrtf(ss * (1.f / 1024.f) + EPS);
        if (C.lane == 0) {
            int i1 = 0; float v1 = lg[0];
#pragma unroll
            for (int e = 1; e < 8; ++e) if (lg[e] > v1) { v1 = lg[e]; i1 = e; }
            int i2 = -1; float v2 = -3e38f;
#pragma unroll
            for (int e = 0; e < 8; ++e) if (e != i1 && lg[e] > v2) { v2 = lg[e]; i2 = e; }
            const float e2 = expf((v2 - v1) * r);
            sel[tok * 2] = i1; sel[tok * 2 + 1] = i2; gwp[tok * 2] = 1.f / (1.f + e2); gwp[tok * 2 + 1] = e2 / (1.f + e2); rr[tok] = r;
            __hip_atomic_fetch_add(&cnt[i1], 1, __ATOMIC_RELAXED, __HIP_MEMORY_SCOPE_WORKGROUP); __hip_atomic_fetch_add(&cnt[8 + i2], 1, __ATOMIC_RELAXED, __HIP_MEMORY_SCOPE_WORKGROUP);
        }
    }
    __syncthreads();
    if (C.tid < 16) ((int*)(C.ws + WS_META))[MI_CNT + (C.tid >> 3) * 2048 + w * 8 + (C.tid & 7)] = cnt[C.tid];
}

__device__ __forceinline__ void phase_sort(const Ctx& C) {
    LAS int* tot = (LAS int*)C.lds; LAS int* pre = tot + 16; LAS int* base = tot + 32;
    int* meta = (int*)(C.ws + WS_META); const int w = blockIdx.x;
    if (C.tid < 16) { const int k = C.tid >> 3, e = C.tid & 7; int t = 0, p = 0;
        for (int w2 = 0; w2 < 256; ++w2) { const int c = meta[MI_CNT + k * 2048 + w2 * 8 + e]; t += c; if (w2 < w) p += c; }
        tot[C.tid] = t; pre[C.tid] = p; }
    __syncthreads();
    if (C.tid < 16) { const int k = C.tid >> 3, e = C.tid & 7; int b = 0; for (int e2 = 0; e2 < e; ++e2) b += (tot[k * 8 + e2] + 255) & ~255; base[C.tid] = b; }
    __syncthreads();
    const int* sel = (const int*)(C.ws + WS_SEL); const float* gwp = (const float*)(C.ws + WS_GW);
    int* rowtok = (int*)(C.ws + WS_ROWTOK); float* rowgw = (float*)(C.ws + WS_ROWGW); float* rowrr = (float*)(C.ws + WS_ROWRR); const float* rr = (const float*)(C.ws + WS_RR);
    if (C.wave < 2) { const int k = C.wave; LAS int* runL = tot + 48 + k * 8;
        if (C.lane < 8) runL[C.lane] = base[k * 8 + C.lane] + pre[k * 8 + C.lane];
        for (int j = 0; j < 2; ++j) { const int tok = w * 128 + j * 64 + C.lane; const int e = sel[tok * 2 + k]; int pos = 0;
#pragma unroll 1
            for (int e2 = 0; e2 < 8; ++e2) { const unsigned long long mk = __ballot(e == e2); const int r0 = runL[e2]; const int rank = __popcll(mk & ((1ull << C.lane) - 1ull));
                if (e == e2) pos = r0 + rank; if (C.lane == 0) runL[e2] = r0 + __popcll(mk); }
            rowtok[k * MOE_ROWS + pos] = tok; rowgw[k * MOE_ROWS + pos] = gwp[tok * 2 + k]; rowrr[k * MOE_ROWS + pos] = rr[tok]; } }
    if (w < 16) { const int k = w >> 3, e = w & 7; const int t = tot[k * 8 + e], b = base[k * 8 + e], pe = (t + 255) & ~255;
        for (int i = b + t + C.tid; i < b + pe; i += NTHREADS) { rowtok[k * MOE_ROWS + i] = -1; rowgw[k * MOE_ROWS + i] = 0.f; rowrr[k * MOE_ROWS + i] = 0.f; } }
    if (w == 16 && C.tid < 2) { const int k = C.tid; int nt = 0;
        for (int e = 0; e < 8; ++e) { const int n = (tot[k * 8 + e] + 255) >> 8; for (int i = 0; i < n; ++i) meta[MI_TILEE + k * 160 + nt + i] = e; nt += n; }
        meta[MI_NTILE + k] = nt; }
}

__device__ __forceinline__ void phase_final(const Ctx& C) {
    const float* g = C.in[21];
    for (int row = 2 * C.gw; row < MTOK; row += 2 * C.NGW) {
        f32x4 v[8]; float s0 = 0.f, s1 = 0.f;
#pragma unroll
        for (int j = 0; j < 8; ++j) { const u32x2 wv = ((const u32x2*)xm_row(C.ws, row + (j >> 2)))[C.lane + 64 * (j & 3)]; v[j] = (f32x4){bf_lo(wv.x), bf_hi(wv.x), bf_lo(wv.y), bf_hi(wv.y)}; }
#ifdef PROBE_NAN
#pragma unroll
        for (int j = 0; j < 8; ++j) { v[j].x = v[j].x == v[j].x && fabsf(v[j].x) < 1e30f ? v[j].x : 0.f; v[j].y = v[j].y == v[j].y && fabsf(v[j].y) < 1e30f ? v[j].y : 0.f; v[j].z = v[j].z == v[j].z && fabsf(v[j].z) < 1e30f ? v[j].z : 0.f; v[j].w = v[j].w == v[j].w && fabsf(v[j].w) < 1e30f ? v[j].w : 0.f; }
#endif
#pragma unroll
        for (int j = 0; j < 8; ++j) { const float q = (v[j].x * v[j].x + v[j].y * v[j].y) + (v[j].z * v[j].z + v[j].w * v[j].w); if (j < 4) s0 += q; else s1 += q; }
        const float r0 = rsqrtf(wave_sum(s0) * (1.f / 1024.f) + EPS), r1 = rsqrtf(wave_sum(s1) * (1.f / 1024.f) + EPS);
        f32x4* orow = (f32x4*)(C.out + (size_t)row * DM) + C.lane;
#pragma unroll
        for (int j = 0; j < 8; ++j) orow[64 * j] = v[j] * (j < 4 ? r0 : r1) * ((const f32x4*)g)[C.lane + 64 * (j & 3)];
    }
}
#ifndef MKP
#define MKP 0x1ffff
#endif
#ifndef ALEPI
#define ALEPI true
#endif
#ifndef ALEPI1
#define ALEPI1 ALEPI
#endif
#ifndef DUPK
#define DUPK 0
#endif
#ifdef PROBE_TIMER
#define PROBE_T0 __syncthreads(); const unsigned long long pt0_ = __builtin_amdgcn_s_memrealtime()
#define PROBE_T1(slot) __syncthreads(); if (threadIdx.x == 0) { const unsigned long long pt1_ = __builtin_amdgcn_s_memrealtime(); atomicAdd((unsigned*)(ws + WS_CTL) + CW_Q + 2048 + (slot), (unsigned)(pt1_ - pt0_)); }
#else
#define PROBE_T0
#define PROBE_T1(slot)
#endif
#define REP(bit) for (int rep_ = 0; rep_ < ((DUPK & (bit)) ? 2 : 1); ++rep_)
constexpr int PH_PER_CHUNK = 3, PH_LAYER_TAIL = 2;
constexpr int PH_L0 = 1, PH_FFN = PH_L0 + PH_PER_CHUNK * NCHUNK + PH_LAYER_TAIL, PH_L1 = PH_FFN + 2, PH_MOE = PH_L1 + PH_PER_CHUNK * NCHUNK + PH_LAYER_TAIL, PH_FINAL = PH_MOE + (MOE_NOSPLIT ? 5 : 7), PH_TOTAL = PH_FINAL + 1;

__global__ void __launch_bounds__(NTHREADS, 2) mega(Args args) {
    extern __shared__ __attribute__((aligned(16))) unsigned char lds_raw[];
#define MKCTX Ctx C; { int t_ = threadIdx.x; asm volatile("" : "+v"(t_)); C.lds = (LAS unsigned char*)lds_raw; C.tid = t_; C.lane = t_ & 63; C.wave = __builtin_amdgcn_readfirstlane(t_ >> 6); \
    C.G = gridDim.x; { const int bx = blockIdx.x; C.vcu = (C.G % 8 == 0) ? (bx % 8) * (C.G / 8) + bx / 8 : bx; } \
    C.gw = C.vcu * NWAVES + C.wave; C.NGW = C.G * NWAVES; C.in = args.in; C.out = args.out; C.ws = args.ws; }
    volatile LAS unsigned* MISC = (volatile LAS unsigned*)((LAS unsigned char*)lds_raw + MISC_OFF);
    if (threadIdx.x < 32) MISC[threadIdx.x] = 0u;
    __syncthreads();
    unsigned char* ws = args.ws;
    XcdBarrier bar; bar.bar = (unsigned*)(ws + WS_CTL) + CW_BAR; bar.x = 0; bar.st = nullptr;
    const int lo = args.ph_lo, hi = args.ph_hi;
    const bool use_bar = (hi - lo) > 1;
    if (use_bar) bar = xcd_barrier_post((unsigned*)(ws + WS_CTL) + CW_BAR, MISC + 8);
    int ph = 0;
#define IN_PH (ph >= lo && ph < hi)
#ifdef PROBE_BAR
    const unsigned long long pk0_ = __builtin_amdgcn_s_memrealtime();
#define END_PH do { if (ph >= lo && ph + 1 < hi) { __syncthreads(); const unsigned long long pb0_ = __builtin_amdgcn_s_memrealtime(); xcd_barrier(bar); \
        if (threadIdx.x == 0 && (((unsigned)(PROBE_BAR) >> ph) & 1u)) atomicAdd((unsigned*)(ws + WS_CTL) + CW_Q + 2048, (unsigned)(__builtin_amdgcn_s_memrealtime() - pb0_)); } ++ph; } while (0)
#else
#define END_PH do { if (ph >= lo && ph + 1 < hi) xcd_barrier(bar); ++ph; } while (0)
#endif

    bf16_t* xb = (bf16_t*)(ws + WS_XB); float* st = (float*)(ws + WS_ST);
    const float* cosT = (const float*)(ws + WS_TAB); const float* sinT = cosT + SEQ * 16;

    if (IN_PH) REP(1) { MKCTX; if (MKP & 1) phase_prologue(C); }
    END_PH;
#ifdef PROBE_SLEEP
    { const unsigned long long t0_ = __builtin_amdgcn_s_memrealtime(); while (__builtin_amdgcn_s_memrealtime() - t0_ < (unsigned long long)(PROBE_SLEEP) * 100ull) __builtin_amdgcn_s_sleep(64); }
#endif

#define CHUNK_BODY(l, c) \
{ \
            const int row0 = c * MC; \
            bf16_t* Z = (bf16_t*)(ws + WS_Z); bf16_t* Q = (bf16_t*)(ws + WS_Q); bf16_t* KV = TMP_IN_OUT ? (bf16_t*)args.out : (bf16_t*)(ws + WS_KV); bf16_t* Y = (bf16_t*)(ws + WS_Y) + (size_t)row0 * 1536; \
            bf16_t* PB = TMP_IN_OUT ? (bf16_t*)args.out + (size_t)MC * 1024 : (bf16_t*)(ws + WS_PB); float* PBS = (float*)(ws + WS_PBS); float* SQ = (float*)(ws + WS_SQ); float* SKV = SQ + (size_t)MC * 4; \
 \
            if (IN_PH && (MKP & 2)) REP(2) { MKCTX; \
                pg8::Gemm g{xb + (size_t)row0 * DM, (const bf16_t*)(ws + WS_WIN + l * SZ_WIN), DM, DM, DM, nullptr}; \
                pg8::StaticOrder S; S.init(MC, P1_F8_FROM * 256, C.G, (int)blockIdx.x); \
                pg8::EpiIn E{Z, st + (size_t)row0 * 16, SQ, SKV, cosT, sinT, ws + WS_GB + (size_t)row0 * 3072, (bf16_t*)(ws + WS_QKV), ws, 0, 1.f}; \
                pg8::gemm_phase<pg8::EpiIn, pg8::StaticOrder, ALEPI1, false>(C.lds, g, S, E); \
            } \
            if (IN_PH && (MKP & 2) && P1_F8_FROM < 23) REP(2) { MKCTX;                          \
                pg8::Gemm g{(const bf16_t*)(ws + WS_XB8P + (size_t)row0 * DM), (const bf16_t*)(ws + WS_WIN8 + l * SZ_WIN8), DM / 2, DM / 2, DM / 2, nullptr}; \
                pg8::StaticOrder S; S.init(MC, (23 - P1_F8_FROM) * 256, C.G, (int)((blockIdx.x + (P1_F8_FROM * (MC / 256)) % 256) % C.G)); \
                pg8::EpiIn E{Z, st + (size_t)row0 * 16, SQ, SKV, cosT, sinT, ws + WS_GB + (size_t)row0 * 3072, (bf16_t*)(ws + WS_QKV), ws, P1_F8_FROM, 1.f / 4096.f}; \
                pg8::gemm_phase<pg8::EpiIn, pg8::StaticOrder, ALEPI1, false, false, true>(C.lds, g, S, E); \
            } \
            END_PH; \
 \
            if (IN_PH) { \
                if (MKP & 4) REP(4) { MKCTX; pg8::Gemm g{Z + ZO_CQ, (const bf16_t*)(ws + WS_WUQ + l * SZ_WUQ), 256, ZW, 256, nullptr}; \
                  pg8::StaticOrder S; S.init(MC, 768, C.G, (int)blockIdx.x); \
                  pg8::EpiQ E{Q, SQ, cosT, sinT}; \
                  pg8::gemm_phase<pg8::EpiQ, pg8::StaticOrder, ALEPI, false>(C.lds, g, S, E); } \
                if (MKP & 8) REP(8) { MKCTX; pg8::Gemm g{Z + ZO_CKV, (const bf16_t*)(ws + WS_WUKV + l * SZ_WUKV), 256, ZW, 256, nullptr}; \
                  pg8::StaticOrder S; S.init(MC, 1024, C.G, (int)((blockIdx.x + 128) % C.G)); \
                  pg8::EpiKV E{KV, SKV}; \
                  pg8::gemm_phase<pg8::EpiKV, pg8::StaticOrder, ALEPI, false>(C.lds, g, S, E); } \
                if (MKP & 16) REP(16) { MKCTX; phase_band<false>(C, (const bf16_t*)(ws + WS_QKV), PB, PBS, Y, C.in[7] + l * 8); } \
            } \
            END_PH; \
 \
            if (IN_PH) { \
                if (MKP & 32) REP(32) { MKCTX; phase_band<true>(C, (const bf16_t*)(ws + WS_QKV), PB, PBS, Y, C.in[7] + l * 8); } \
                if (MKP & 64) REP(64) { MKCTX; PROBE_T0; phase_mla(C, Q, KV, Z, Y); PROBE_T1(rep_); } \
            } \
            END_PH; \
 \
}
#define LAYER_TAIL(l) \
{ const int row0 = 0; bf16_t* MG = (bf16_t*)(ws + WS_MG); bf16_t* Y = (bf16_t*)(ws + WS_Y); (void)Y; \
            if (IN_PH && (MKP & 128)) REP(128) { MKCTX; \
                pg8::Gemm g{Y, (const bf16_t*)(ws + WS_WBR + l * SZ_WBR), 1536, 1536, 1536, nullptr}; \
                pg8::StaticOrder S; S.init(MTOK, DM, C.G, (int)blockIdx.x); \
                pg8::EpiBr E{ws + WS_GB, MG, ws}; \
                pg8::gemm_phase<pg8::EpiBr, pg8::StaticOrder, ALEPI, false>(C.lds, g, S, E); \
            } \
            END_PH; \
 \
            if (IN_PH && (MKP & 256)) REP(l == 0 ? 256 : 0) { MKCTX; \
                pg8::Gemm g{MG, (const bf16_t*)(ws + WS_WOUT + l * SZ_WOUT), P5_F8 ? DM / 2 : DM, P5_F8 ? DM / 2 : DM, P5_F8 ? DM / 2 : DM, nullptr}; \
                pg8::StaticOrder S; S.init(MTOK, DM, C.G, (int)blockIdx.x); \
                pg8::EpiRes<false> E{xb, st, row0, nullptr, P5_F8 ? 1.f / 4096.f : 1.f}; pg8::gemm_phase<pg8::EpiRes<false>, pg8::StaticOrder, ALEPI, false, true, P5_F8 != 0>(C.lds, g, S, E); \
            } \
            END_PH; \
}
#define FFN_BODY() \
{ \
            bf16_t* ACT = (bf16_t*)(ws + WS_ACT); \
            if (IN_PH && (MKP & 512)) REP(512) { MKCTX; \
                pg8::Gemm g{xb, (const bf16_t*)(ws + WS_WGU), DM, DM, DM, nullptr}; \
                pg8::StaticOrder S; S.init(MTOK, 2 * DFF, C.G, (int)blockIdx.x); \
                pg8::EpiGU E{ACT, st, DFF, ws}; \
                pg8::gemm_phase<pg8::EpiGU, pg8::StaticOrder, ALEPI, false>(C.lds, g, S, E); \
            } \
            END_PH; \
            if (IN_PH && (MKP & 1024)) { MKCTX; \
                pg8::Gemm g{ACT, (const bf16_t*)(ws + WS_WD), DFF, DFF, DFF, nullptr}; \
                pg8::StaticOrder S; S.init(MTOK, DM, C.G, (int)blockIdx.x); \
                pg8::EpiRes<(P1_F8_FROM < 23)> E{xb, st, 0, ws + WS_XB8P, 1.f};                                \
                pg8::gemm_phase<pg8::EpiRes<(P1_F8_FROM < 23)>, pg8::StaticOrder, ALEPI, false, true>(C.lds, g, S, E); \
            } \
            END_PH; \
}
#define MOE_HEAD() \
{ \
            if (IN_PH) { if (MKP & 2048) REP(2048) { MKCTX; phase_route(C); } if (MKP & 4096) REP(4096) { MKCTX; phase_moe_weights(C); } } \
            END_PH; \
            if (IN_PH && (MKP & 8192)) { MKCTX; phase_sort(C); } \
            END_PH; \
}
#define MOE_GU(kh, dyn) { const int k = MOE_NOSPLIT ? (kh) : (kh) >> 1, half = MOE_NOSPLIT ? 0 : (kh) & 1; MKCTX; \
        const int* rowtok = (const int*)(ws + WS_ROWTOK) + k * MOE_ROWS; \
        bf16_t* MACT = (bf16_t*)(ws + WS_MACT + (MOE_NOSPLIT ? (size_t)k * MOE_ROWS * DFE : (size_t)half * MOE_ROWS * DF0 * (MOE_DN_F8 ? 1 : 2))); const int dfw = MOE_NOSPLIT ? DFE : (half ? DF1 : DF0); \
        pg8::Gemm g{MOE_F8 ? (const bf16_t*)(ws + WS_XB8) : xb, (const bf16_t*)(ws + WS_EGU), MOE_F8 ? DM / 2 : DM, MOE_F8 ? DM / 2 : DM, MOE_F8 ? DM / 2 : DM, rowtok}; \
        pg8::DynMoeOrder S{(unsigned*)(ws + WS_CTL) + CW_Q + 64 * (kh), (volatile LAS int*)(C.lds + MISC_OFF + 64), meta[MI_NTILE + k], dfw / 128, 28, half ? DF0 / 128 : 0, meta + MI_TILEE + k * 160, C.vcu}; \
        pg8::EpiGUMoe E{MACT, (const float*)(ws + WS_ROWRR) + k * MOE_ROWS, dfw, ws}; \
        pg8::gemm_phase<pg8::EpiGUMoe, pg8::DynMoeOrder, ALEPI, true, false, MOE_F8 != 0>(C.lds, g, S, E); }
#define MOE_DN(kh) { const int k = MOE_NOSPLIT ? (kh) : (kh) >> 1, half = MOE_NOSPLIT ? 0 : (kh) & 1; MKCTX; \
        const int* rowtok = (const int*)(ws + WS_ROWTOK) + k * MOE_ROWS; const float* rowgw = (const float*)(ws + WS_ROWGW) + k * MOE_ROWS; \
        bf16_t* MACT = (bf16_t*)(ws + WS_MACT + (MOE_NOSPLIT ? (size_t)k * MOE_ROWS * DFE : (size_t)half * MOE_ROWS * DF0 * (MOE_DN_F8 ? 1 : 2))); const int dfw = MOE_NOSPLIT ? DFE : (half ? DF1 : DF0); \
        pg8::Gemm g{MACT, (const bf16_t*)(ws + WS_ED + (size_t)half * DF0 * (MOE_DN_F8 ? 1 : 2)), MOE_DN_F8 ? dfw / 2 : dfw, MOE_DN_F8 ? dfw / 2 : dfw, MOE_DN_F8 ? DFE / 2 : DFE, nullptr}; \
        pg8::MoeOrder S{meta[MI_NTILE + k], 4, C.G, (int)blockIdx.x, 4, 0, meta + MI_TILEE + k * 160}; \
        if ((kh) == 0) { pg8::EpiDnMoe<true> E{ws, rowtok, rowgw}; pg8::gemm_phase<pg8::EpiDnMoe<true>, pg8::MoeOrder, ALEPI, false, true, MOE_DN_F8 != 0>(C.lds, g, S, E); } \
        else { pg8::EpiDnMoe<false> E{ws, rowtok, rowgw}; pg8::gemm_phase<pg8::EpiDnMoe<false>, pg8::MoeOrder, ALEPI, false, true, MOE_DN_F8 != 0>(C.lds, g, S, E); } }
    CHUNK_BODY(0, 0)
#if CHB < 16
    CHUNK_BODY(0, 1)
#endif
#if CHB < 8
    CHUNK_BODY(0, 2)
    CHUNK_BODY(0, 3)
#endif
    LAYER_TAIL(0)
    FFN_BODY()
    CHUNK_BODY(1, 0)
#if CHB < 16
    CHUNK_BODY(1, 1)
#endif
#if CHB < 8
    CHUNK_BODY(1, 2)
    CHUNK_BODY(1, 3)
#endif
    LAYER_TAIL(1)
    MOE_HEAD()
    { const int* meta = (const int*)(ws + WS_META);
    if (IN_PH) { if (MKP & 16384) REP(16384) MOE_GU(0, 1) }
    END_PH;
    if (IN_PH) { if (MKP & 32768) MOE_DN(0) if (MKP & 16384) MOE_GU(1, 1) }
    END_PH;
#if !MOE_NOSPLIT
    if (IN_PH) { if (MKP & 32768) MOE_DN(1) if (MKP & 16384) MOE_GU(2, 1) }
    END_PH;
    if (IN_PH) { if (MKP & 32768) MOE_DN(2) if (MKP & 16384) MOE_GU(3, 1) }
    END_PH;
    if (IN_PH) { if (MKP & 32768) MOE_DN(3) }
    END_PH;
#else
    if (IN_PH) { if (MKP & 32768) MOE_DN(1) }
    END_PH;
#endif
    }
    if (IN_PH && (MKP & 65536)) { MKCTX; phase_final(C); }
    END_PH;
#ifdef PROBE_BAR
    { if (threadIdx.x == 0) atomicAdd((unsigned*)(ws + WS_CTL) + CW_Q + 2049, (unsigned)(__builtin_amdgcn_s_memrealtime() - pk0_));
      xcd_barrier(bar);
      const unsigned* tim = (const unsigned*)(ws + WS_CTL) + CW_Q + 2048;
      const float ta = (float)__hip_atomic_load(tim, __ATOMIC_RELAXED, __HIP_MEMORY_SCOPE_AGENT), tb = (float)__hip_atomic_load(tim + 1, __ATOMIC_RELAXED, __HIP_MEMORY_SCOPE_AGENT);
      float code = (float)(PROBE_UNIT) * ta / tb;
      code = fminf(98.f, fmaxf(1.f, rintf(code))); const float v = sqrtf(code);
      for (size_t i = (size_t)blockIdx.x * NTHREADS + threadIdx.x; i < (size_t)MTOK * DM; i += (size_t)gridDim.x * NTHREADS) args.out[i] = v; }
#endif
#ifdef PROBE_TIMER
    { xcd_barrier(bar);
      const unsigned* tim = (const unsigned*)(ws + WS_CTL) + CW_Q + 2048;
      const float ta = (float)__hip_atomic_load(tim, __ATOMIC_RELAXED, __HIP_MEMORY_SCOPE_AGENT), tb = (float)__hip_atomic_load(tim + 1, __ATOMIC_RELAXED, __HIP_MEMORY_SCOPE_AGENT);
      float code = PROBE_TIMER == 1 ? 10.f * ta / tb : (PROBE_TIMER == 2 ? ta * (1.f / (256.f * 100.f * 10.f)) : tb * (1.f / (256.f * 100.f * 10.f)));
      code = fminf(98.f, fmaxf(1.f, rintf(code))); const float v = sqrtf(code);
      for (size_t i = (size_t)blockIdx.x * NTHREADS + threadIdx.x; i < (size_t)MTOK * DM; i += (size_t)gridDim.x * NTHREADS) args.out[i] = v; }
#endif
#undef IN_PH
#undef END_PH
}
#if !MK_DEBUG
extern "C" void kernel_launch(void* const* d_in, const int* in_sizes, int n_in, void* d_out, int out_size, void* d_ws, size_t ws_size, hipStream_t stream) {
    static int grid = 0;
    if (grid == 0) {
        if (n_in != 22 || out_size != MTOK * DM || ws_size < WS_NEED) { fprintf(stderr, "kernel_launch: unexpected shapes / workspace (%zu < %zu); nothing launched\n", ws_size, (size_t)WS_NEED); grid = -1; return; }
        int dev = 0, cus = 0, per_cu = 0;
        if (hipGetDevice(&dev) != hipSuccess || hipDeviceGetAttribute(&cus, hipDeviceAttributeMultiprocessorCount, dev) != hipSuccess) { grid = -1; return; }
        if (hipFuncSetAttribute((const void*)mega, hipFuncAttributeMaxDynamicSharedMemorySize, LDS_BYTES) != hipSuccess) { fprintf(stderr, "kernel_launch: hipFuncSetAttribute failed\n"); grid = -1; return; }
        if (hipOccupancyMaxActiveBlocksPerMultiprocessor(&per_cu, (const void*)mega, NTHREADS, LDS_BYTES) != hipSuccess || per_cu < 1) { fprintf(stderr, "kernel_launch: occupancy query says %d\n", per_cu); }
        (void)hipGetLastError();
        grid = cus;
        if (grid != 256) { fprintf(stderr, "kernel_launch: built for 256 CUs, device has %d; nothing launched\n", cus); grid = -1; return; }
    }
    if (grid < 0) return;
    if (hipMemsetAsync((char*)d_ws + WS_CTL, 0, CTL_ZERO_BYTES, stream) != hipSuccess) return;
    Args a{};
    for (int i = 0; i < 22; ++i) a.in[i] = (const float*)d_in[i];
    a.out = (float*)d_out; a.ws = (unsigned char*)d_ws; a.ph_lo = 0; a.ph_hi = PH_TOTAL;
    hipLaunchKernelGGL(mega, dim3(grid), dim3(NTHREADS), LDS_BYTES, stream, a);
}
#endif
```

```cpp
#include <hip/hip_runtime.h>
#include <cstdio>
#include <cstdint>
#include <cmath>

#ifndef MK_DEBUG
#define MK_DEBUG 0
#endif
#ifndef MOE_F8
#define MOE_F8 1
#endif
#ifndef MOE_DN_F8
#define MOE_DN_F8 1
#endif
#ifndef MOE_NOSPLIT
#define MOE_NOSPLIT 1
#endif
#ifndef P1_F8_FROM
#define P1_F8_FROM 0
#endif
#ifndef WGM_SET
#define WGM_SET 8
#endif
#ifndef P5_F8
#define P5_F8 1
#endif
#ifndef P4_F8
#define P4_F8 1
#endif
#ifndef CHB
#define CHB 8
#endif

#define GAS __attribute__((address_space(1)))
#define LAS __attribute__((address_space(3)))
typedef unsigned short bf16_t;
typedef short bf16x8 __attribute__((ext_vector_type(8)));
typedef short s16x4 __attribute__((ext_vector_type(4)));
typedef float f32x4 __attribute__((ext_vector_type(4)));
typedef float f32x2 __attribute__((ext_vector_type(2)));
typedef float f32x16 __attribute__((ext_vector_type(16)));
typedef unsigned u32x4 __attribute__((ext_vector_type(4)));
typedef unsigned u32x2 __attribute__((ext_vector_type(2)));
typedef __bf16 bf16x2_t __attribute__((ext_vector_type(2)));

constexpr int SEQ = 2048, DM = 1024, NBATCH = 16, MTOK = NBATCH * SEQ;
constexpr int MC = CHB * SEQ, NCHUNK = NBATCH / CHB;
constexpr int INC = 5792, ZW = 512, ZN = 5888;
constexpr int ZO_CQ = 0, ZO_CKV = 256, ZO_KPE = 384, ZO_QB = 512, ZO_KB = 1024, ZO_VB = 1536, ZO_QC = 2048, ZO_KC = 2560, ZO_VC = 2688, ZO_G = 2816;
constexpr int DFF = 2816, DFE = 3584, NEXP = 8;
constexpr int DF0 = 1792, DF1 = DFE - DF0;
constexpr float EPS = 1e-6f, LOG2E = 1.4426950408889634f;
constexpr float NEGB = -1e30f;
constexpr int MOE_ROWS = MTOK + NEXP * 256;

constexpr size_t MiB = 1u << 20;
constexpr size_t WS_CTL = 0, CTL_ZERO_BYTES = 256 * 1024;
constexpr size_t WS_META = 256 * 1024;
constexpr size_t WS_TAB = 1 * MiB;
constexpr size_t WS_WIN = 2 * MiB;
constexpr size_t SZ_WIN = (size_t)ZN * DM * 2;
constexpr size_t WS_WUQ = WS_WIN + 2 * SZ_WIN;
constexpr size_t SZ_WUQ = (size_t)768 * 256 * 2;
constexpr size_t WS_WUKV = WS_WUQ + 2 * SZ_WUQ;
constexpr size_t SZ_WUKV = (size_t)1024 * 256 * 2;
constexpr size_t WS_WBR = WS_WUKV + 2 * SZ_WUKV;
constexpr size_t SZ_WBR = (size_t)1024 * 1536 * 2;
constexpr size_t WS_WOUT = WS_WBR + 2 * SZ_WBR;
constexpr size_t SZ_WOUT = (size_t)1024 * 1024 * 2;
constexpr size_t WS_WGU = WS_WOUT + 2 * SZ_WOUT;
constexpr size_t WS_WD = WS_WGU + (size_t)2 * DFF * DM * 2;
constexpr size_t WS_SMALL_END = WS_WD + (size_t)DM * DFF * 2;
static_assert(WS_SMALL_END <= 54 * MiB, "small weights");
constexpr size_t WS_XB = 54 * MiB;
constexpr size_t WS_ST = 118 * MiB;
constexpr size_t WS_RR = 120 * MiB;
constexpr size_t WS_SEL = WS_RR + (size_t)MTOK * 4;
constexpr size_t WS_GW = WS_SEL + (size_t)MTOK * 8;
constexpr size_t WS_ROWTOK = WS_GW + (size_t)MTOK * 8;
constexpr size_t WS_ROWGW = WS_ROWTOK + (size_t)2 * MOE_ROWS * 4;
constexpr size_t WS_ROWRR = WS_ROWGW + (size_t)2 * MOE_ROWS * 4;
constexpr size_t WS_T = 122 * MiB;
static_assert(WS_ROWRR + (size_t)2 * MOE_ROWS * 4 <= WS_T, "fixed region");
constexpr size_t WS_GB = WS_T;
constexpr size_t WS_Y = WS_GB + (size_t)MTOK * 3072;
constexpr size_t WS_CH = WS_Y + (size_t)MTOK * 1536 * 2;
constexpr size_t WS_Z = WS_CH;
constexpr size_t WS_QKV = WS_Z + (size_t)MC * ZW * 2;
constexpr size_t SZ_H8 = (size_t)MC * 512 * 2, SZ_H2 = (size_t)MC * 128 * 2;
constexpr size_t WS_Q = WS_QKV + 4 * SZ_H8 + 2 * SZ_H2;
constexpr bool TMP_IN_OUT = (CHB == 16);
constexpr size_t WS_KV = WS_Q + (size_t)MC * 768 * 2;
constexpr size_t WS_PB = WS_KV + (TMP_IN_OUT ? 0 : (size_t)MC * 1024 * 2);
constexpr size_t WS_PBS = WS_PB + (TMP_IN_OUT ? 0 : (size_t)2 * MC * 512 * 2);
constexpr size_t WS_SQ = WS_PBS + (size_t)2 * MC * 16 * 4;
constexpr size_t WS_MIX_END = WS_SQ + (size_t)2 * MC * 4 * 4;
constexpr size_t WS_XB8P = (size_t)496 * MiB;
constexpr size_t WS_WIN8 = WS_XB8P + (size_t)MTOK * DM;
constexpr size_t SZ_WIN8 = (size_t)(23 - P1_F8_FROM) * 256 * DM;
static_assert(WS_XB8P >= WS_MIX_END && WS_WIN8 + 2 * SZ_WIN8 <= (size_t)564 * MiB, "fp8 input-projection buffers");
constexpr size_t WS_MG = WS_CH;
static_assert(WS_MG + (size_t)MTOK * 1024 * 2 <= (size_t)564 * MiB, "MG placement");
constexpr size_t WS_ACT = WS_T;
constexpr size_t WS_EGU = WS_T;
constexpr size_t WS_XB8 = WS_EGU + (size_t)NEXP * 2 * DFE * DM;
constexpr size_t WS_ED = WS_EGU + (size_t)NEXP * 2 * DFE * DM * 2;
constexpr size_t WS_MACT = WS_ED + (size_t)NEXP * DM * DFE * 2;
constexpr size_t WS_MOE_END = WS_MACT + (size_t)MOE_ROWS * DFE * 2;
constexpr size_t WS_NEED_ = (WS_MOE_END > WS_MIX_END ? WS_MOE_END : WS_MIX_END);
constexpr size_t WS_NEED = WS_MOE_END + (size_t)(MTOK - 26624) * DM * 2 > WS_NEED_ ? WS_MOE_END + (size_t)(MTOK - 26624) * DM * 2 : WS_NEED_;
static_assert(WS_NEED <= (size_t)564 * MiB, "workspace budget");

constexpr int XM_SPLIT = 26624;
constexpr size_t WS_XM_HI = WS_MOE_END;
static_assert((size_t)XM_SPLIT * DM * 2 <= WS_XB - WS_WIN && WS_XM_HI + (size_t)(MTOK - XM_SPLIT) * DM * 2 <= (size_t)564 * MiB, "XM placement");
__device__ __forceinline__ bf16_t* xm_row(unsigned char* ws, int tok) { return tok < XM_SPLIT ? (bf16_t*)(ws + WS_WIN) + (size_t)tok * DM : (bf16_t*)(ws + WS_XM_HI) + (size_t)(tok - XM_SPLIT) * DM; }

constexpr int CW_BAR = 4096, CW_Q = 8192;
constexpr int MI_CNT = 0, MI_NTILE = 4120, MI_TILEE = 4128;

__device__ __forceinline__ unsigned cvt_pk_bf16(float lo, float hi) { f32x2 v = {lo, hi}; bf16x2_t b = __builtin_convertvector(v, bf16x2_t); return __builtin_bit_cast(unsigned, b); }
__device__ __forceinline__ unsigned pk_fp8x4(float a, float b, float c, float d) {
    a = __builtin_amdgcn_fmed3f(a, -448.f, 448.f); b = __builtin_amdgcn_fmed3f(b, -448.f, 448.f); c = __builtin_amdgcn_fmed3f(c, -448.f, 448.f); d = __builtin_amdgcn_fmed3f(d, -448.f, 448.f);
    int w = 0; w = __builtin_amdgcn_cvt_pk_fp8_f32(a, b, w, false); w = __builtin_amdgcn_cvt_pk_fp8_f32(c, d, w, true); return (unsigned)w; }
__device__ __forceinline__ float bf_lo(unsigned w) { return __builtin_bit_cast(float, w << 16); }
__device__ __forceinline__ float bf_hi(unsigned w) { return __builtin_bit_cast(float, w & 0xffff0000u); }
template <int O> __device__ __forceinline__ float swz_xor(float v) { return __builtin_bit_cast(float, __builtin_amdgcn_ds_swizzle(__builtin_bit_cast(int, v), (O << 10) | 0x1f)); }
__device__ __forceinline__ void swap32(float& a, float& b) { asm volatile("s_nop 1\n\tv_permlane32_swap_b32 %0, %1\n\ts_nop 1" : "+v"(a), "+v"(b)); }
__device__ __forceinline__ float xsum32(float v) { float a = v, b = v; swap32(a, b); return a + b; }
__device__ __forceinline__ float xmax32(float v) { float a = v, b = v; swap32(a, b); return fmaxf(a, b); }
__device__ __forceinline__ float wave_sum(float v) {
    v += swz_xor<1>(v); v += swz_xor<2>(v); v += swz_xor<4>(v); v += swz_xor<8>(v); v += swz_xor<16>(v);
    return xsum32(v);
}
__device__ __forceinline__ float fast_rcp(float x) { return __builtin_amdgcn_rcpf(x); }
__device__ __forceinline__ float fast_exp2(float x) { return __builtin_amdgcn_exp2f(x); }
__device__ __forceinline__ float sigmoidf_(float v) { return fast_rcp(1.f + fast_exp2(-v * LOG2E)); }
__device__ __forceinline__ int t5_bucket(int rel) {
    const int ret = rel > 0 ? 16 : 0; const int n = rel < 0 ? -rel : rel;
    if (n < 8) return ret + n;
    int large = 8 + (int)(logf((float)n / 8.f) / logf(128.f) * 8.f);
    if (large > 15) large = 15;
    return ret + large;
}

#define XB_TMO      128
#define XB_XCNT(j)  (256  + 64 * (j))
#define XB_XSUB(j)  (1280 + 64 * (j))
#define XB_XGEN(j)  (2304 + 64 * (j))
#define XB_TOP      3328
#define XB_TOPGEN   3392
#define XCD_BAR_WORDS 3456
#define XB_SPIN_CAP (1u << 18)
__device__ __forceinline__ unsigned xb_ld(unsigned* p)              { return __hip_atomic_load(p, __ATOMIC_RELAXED, __HIP_MEMORY_SCOPE_AGENT); }
__device__ __forceinline__ unsigned xb_add(unsigned* p, unsigned v) { return __hip_atomic_fetch_add(p, v, __ATOMIC_RELAXED, __HIP_MEMORY_SCOPE_AGENT); }
__device__ __forceinline__ unsigned xb_xcc_id() { return (unsigned)__builtin_amdgcn_s_getreg((3 << 11) | 20) & 0xFu; }
#define XB_SPIN(cond, bar) do { unsigned _sp = 0; while (cond) { __builtin_amdgcn_s_sleep(1); \
    if ((++_sp & 255u) == 0u) { if (xb_ld(&(bar)[XB_TMO])) break; if (_sp > XB_SPIN_CAP) { atomicAdd(&(bar)[XB_TMO], 1u); break; } } } } while (0)
struct XcdBarrier { unsigned* bar; unsigned x; volatile LAS unsigned* st; };
__device__ __forceinline__ XcdBarrier xcd_barrier_post(unsigned* bar, volatile LAS unsigned* st) {
    XcdBarrier b; b.bar = bar; b.x = xb_xcc_id(); b.st = st;
    if (threadIdx.x == 0) (void)xb_add(&bar[XB_XCNT(b.x)], 1u);
    return b;
}
__device__ __forceinline__ void xcd_barrier_complete(unsigned* bar, unsigned x, unsigned& nloc, unsigned& nx) {
    const unsigned G = gridDim.x * gridDim.y * gridDim.z;
    unsigned sum, cnt, mine, sp = 0u;
    for (;;) {
        sum = 0u; cnt = 0u; mine = 0u;
#pragma unroll
        for (unsigned j = 0; j < 16; ++j) { const unsigned c = xb_ld(&bar[XB_XCNT(j)]); sum += c; cnt += (c > 0u) ? 1u : 0u; mine = (j == x) ? c : mine; }
        if (sum == G) break;
        __builtin_amdgcn_s_sleep(1);
        if ((++sp & 255u) == 0u) { if (xb_ld(&bar[XB_TMO])) break; if (sp > XB_SPIN_CAP) { atomicAdd(&bar[XB_TMO], 1u); break; } }
    }
    nloc = mine > 0u ? mine : 1u; nx = cnt > 0u ? cnt : 1u;
}
__device__ __forceinline__ void xcd_barrier(const XcdBarrier& b) {
    asm volatile("s_waitcnt vmcnt(0)" ::: "memory");
    __syncthreads();
    if (threadIdx.x == 0) {
        unsigned* bar = b.bar;
        __builtin_amdgcn_s_waitcnt(0);
        unsigned nloc = b.st[0], nx = b.st[1];
        if (nloc == 0u) { xcd_barrier_complete(bar, b.x, nloc, nx); b.st[0] = nloc; b.st[1] = nx; }
        const unsigned old = xb_add(&bar[XB_XSUB(b.x)], 1u);
        const unsigned gen = old / nloc;
        if (old + 1u == (gen + 1u) * nloc) {
            __builtin_amdgcn_fence(__ATOMIC_RELEASE, "agent");
            asm volatile("s_waitcnt vmcnt(0)" ::: "memory");
            const unsigned og = xb_add(&bar[XB_TOP], 1u);
            const unsigned tg = og / nx;
            if (og + 1u == (tg + 1u) * nx) xb_add(&bar[XB_TOPGEN], 1u);
            else XB_SPIN(xb_ld(&bar[XB_TOPGEN]) == tg, bar);
            __builtin_amdgcn_fence(__ATOMIC_ACQUIRE, "agent");
            xb_add(&bar[XB_XGEN(b.x)], 1u);
            asm volatile("s_waitcnt vmcnt(0)" ::: "memory");
        } else {
            XB_SPIN(xb_ld(&bar[XB_XGEN(b.x)]) == gen, bar);
            __builtin_amdgcn_fence(__ATOMIC_ACQUIRE, "agent");
            asm volatile("s_waitcnt vmcnt(0)" ::: "memory");
        }
    }
    __syncthreads();
}
#ifndef MOE_RGS
#define MOE_RGS 4
#endif
#ifndef MOE_RG
#define MOE_RG 4
#endif
#ifndef RELAXW
#define RELAXW 0
#endif
namespace pg8 {
constexpr int BM = 256, BK = 64, HALF = 128, HTB = HALF * BK * 2, STAGE_BYTES = 8 * HTB, NXCD = 8, WGM = WGM_SET;
__host__ __device__ __forceinline__ int lds_byte(int r, int c) { const int st = (r >> 4) * 2 + (c >> 5), rr = r & 15, cc = c & 31, ob = rr * 64 + cc * 2; return st * 1024 + (ob ^ (((ob >> 9) & 1) << 5)); }
__host__ __device__ __forceinline__ void stage_rc(int b, int& R, int& C) { const int st = b / 1024, sb = b % 1024, swz = sb ^ (((sb >> 9) & 1) << 5); R = (st >> 1) * 16 + swz / 64; C = (st & 1) * 32 + (swz % 64) / 2; }
__host__ __device__ __forceinline__ int perm32(int rho) { const int n = rho >> 4, i = rho & 15; return 8 * (i >> 2) + 4 * n + (i & 3); }

struct Unit { int pm, pn, aux; };
struct Gemm { const bf16_t* A; const bf16_t* Bt; int K, lda, ldb; const int* gidx; };

struct StaticOrder {
    static constexpr bool DYN = false;
    int nM, nN, nwg, G, c;
    __host__ __device__ void init(int M, int N, int G_, int c_) { nM = M / BM; nN = N / BM; nwg = nM * nN; G = G_; c = c_; }
    __host__ __device__ bool next(int i, Unit& u) const {
        const int L = i * G + c; if (L >= nwg) return false;
        int wgid = L; { const int q = nwg / NXCD, r = nwg % NXCD, xcd = wgid % NXCD, off = wgid / NXCD; wgid = (xcd < r ? xcd * (q + 1) : r * (q + 1) + (xcd - r) * q) + off; }
        const int nig = WGM * nN, gid = wgid / nig, fm = gid * WGM, gsz = (nM - fm) < WGM ? (nM - fm) : WGM;
        u.pm = fm + ((wgid % nig) % gsz); u.pn = (wgid % nig) / gsz; u.aux = u.pn; return true;
    }
};
struct MoeOrder {
    static constexpr bool DYN = false;
    int ntile, nN, G, c, pne, pn0; const int* tile_e;
    __device__ bool next(int i, Unit& u) const {
        const int L = i * G + c; if (L >= ntile * nN) return false;
        int pm, pnl; { const int grp = L / (MOE_RGS * nN), fm = grp * MOE_RGS, gsz = (ntile - fm) < MOE_RGS ? (ntile - fm) : MOE_RGS, r = L - grp * (MOE_RGS * nN); pm = fm + r % gsz; pnl = r / gsz; }
        u.pm = pm; u.aux = pnl; u.pn = tile_e[pm] * pne + pn0 + pnl; return true;
    }
};

struct DynMoeOrder {
    static constexpr bool DYN = true;
    unsigned* ctr; volatile LAS int* slot; int ntile, nN, pne, pn0; const int* tile_e; int vcu;
    __device__ __forceinline__ void begin() const {
        if (threadIdx.x == 0) { slot[0] = vcu; slot[1] = vcu + (int)gridDim.x; }
        __syncthreads();
    }
    __device__ __forceinline__ bool next(int i, Unit& u) const {
        const int L = __builtin_amdgcn_readfirstlane(slot[i & 1]); if (L >= ntile * nN) return false;
        int pm, pnl; { const int grp = L / (MOE_RG * nN), fm = grp * MOE_RG, gsz = (ntile - fm) < MOE_RG ? (ntile - fm) : MOE_RG, r = L - grp * (MOE_RG * nN); pm = fm + r % gsz; pnl = r / gsz; }
        u.pm = pm; u.aux = pnl; u.pn = tile_e[pm] * pne + pn0 + pnl; return true;
    }
    __device__ __forceinline__ unsigned claim_issue() const { unsigned v = 0u; if (threadIdx.x == 0) v = 2u * gridDim.x + __hip_atomic_fetch_add(ctr, 1u, __ATOMIC_RELAXED, __HIP_MEMORY_SCOPE_AGENT); return v; }
    __device__ __forceinline__ void claim_commit(unsigned v, int i) const { if (threadIdx.x == 0) { slot[i & 1] = (int)v; asm volatile("s_waitcnt lgkmcnt(0)" ::: "memory"); } }
};

__host__ __device__ __forceinline__ size_t blk_off(int row, int col, int ld) { return ((size_t)(row >> 4) * (ld >> 5) + (col >> 5)) * 512 + (row & 15) * 32 + (col & 31); }
typedef int i32x4_t __attribute__((ext_vector_type(4))); typedef int i32x8_t __attribute__((ext_vector_type(8)));
template <bool F8> struct FragSel;
template <> struct FragSel<false> {
    struct P { bf16x8 k[2]; }; typedef P A[4]; typedef P B[2];
    static __device__ __forceinline__ void set(P& d, const i32x4_t& f0, const i32x4_t& f1) { d.k[0] = __builtin_bit_cast(bf16x8, f0); d.k[1] = __builtin_bit_cast(bf16x8, f1); }
    static __device__ __forceinline__ void mma(f32x4& c, const P& b, const P& a) { c = __builtin_amdgcn_mfma_f32_16x16x32_bf16(b.k[0], a.k[0], c, 0, 0, 0); c = __builtin_amdgcn_mfma_f32_16x16x32_bf16(b.k[1], a.k[1], c, 0, 0, 0); }
    static __device__ __forceinline__ void after_mma() {}
};
template <> struct FragSel<true> {
    typedef i32x8_t P; typedef P A[4]; typedef P B[2];
    static __device__ __forceinline__ void set(P& d, const i32x4_t& f0, const i32x4_t& f1) { d = __builtin_shufflevector(f0, f1, 0, 1, 2, 3, 4, 5, 6, 7); }
    static __device__ __forceinline__ void mma(f32x4& c, const P& b, const P& a) { int sc = 0x7f7f7f7f; asm volatile("v_mfma_scale_f32_16x16x128_f8f6f4 %0, %1, %2, %0, %3, %3 op_sel_hi:[0,0,0]" : "+v"(c) : "v"(b), "v"(a), "v"(sc)); }
    static __device__ __forceinline__ void after_mma() { asm volatile("s_nop 15\n\ts_nop 15" ::: "memory"); }
};
template <class Epi, class Sched, bool ALIGN_EPI, bool GATHER, bool ABLK = false, bool F8 = false>
__device__ __forceinline__ void gemm_phase(LAS unsigned char* lds, const Gemm g, const Sched& S, const Epi& E) {
    int tid_ = threadIdx.x; asm volatile("" : "+v"(tid_));
    const int tid = tid_, wid = __builtin_amdgcn_readfirstlane(tid >> 6), lane = tid & 63, wr = wid >> 2, wc = wid & 3, fr = lane & 15, fq = lane >> 4;
    int K_ = g.K; asm volatile("" : "+s"(K_));
    const int K = K_, nt = K / BK;
    static_assert(!(GATHER && ABLK), "gathered A is row-major");
    const size_t kstep = (size_t)(BK * 2), kstepA = ABLK ? (size_t)2048 : kstep;
    const size_t hstepA = ABLK ? (size_t)8 * (g.lda >> 5) * 1024 : (size_t)HALF * g.lda * 2, hstepB = (size_t)HALF * g.ldb * 2, tstepA = 2 * hstepA, tstepB = 2 * hstepB;
    int Rs[2], Cs[2]; unsigned voffB[2];
#pragma unroll
    for (int i = 0; i < 2; ++i) { int R, C; stage_rc(tid * 16 + i * 8192, R, C); Rs[i] = R; Cs[i] = C; const int Rb = Epi::PERM ? ((R & ~31) + perm32(R & 31)) : R;
        voffB[i] = (unsigned)(Rb * g.ldb + C) * 2u; }
    asm volatile("" : "+v"(voffB[0]), "+v"(voffB[1]), "+v"(Rs[0]), "+v"(Rs[1]), "+v"(Cs[0]), "+v"(Cs[1]));
    unsigned vA[2][2], nvA[2][2];
    const size_t hsA = GATHER ? (size_t)0 : hstepA;
#define PG8_SETV(V, U) do { _Pragma("unroll") for (int _h = 0; _h < 2; ++_h) _Pragma("unroll") for (int _i = 0; _i < 2; ++_i) { \
        if constexpr (GATHER) { int _t = g.gidx[(U).pm * BM + _h * HALF + Rs[_i]]; _t = _t < 0 ? 0 : _t; V[_h][_i] = (unsigned)(_t * g.lda + Cs[_i]) * 2u; } \
        else if constexpr (ABLK) V[_h][_i] = (unsigned)blk_off(Rs[_i], Cs[_i], g.lda) * 2u; \
        else V[_h][_i] = (unsigned)(Rs[_i] * g.lda + Cs[_i]) * 2u; } } while (0)
    const unsigned ldsw = (unsigned)wid * 1024u;
    const int aoff = lds_byte(wr * 64 + fr, fq * 8), boff = lds_byte(wc * 32 + fr, fq * 8);
#define PG8_SA(b, h) (((b) * 2 + (h)) * HTB)
#define PG8_SB(b, h) ((4 + (b) * 2 + (h)) * HTB)
#define PG8_STAGE(bufoff, gbase, voff) do { _Pragma("unroll") for (int _i = 0; _i < 2; ++_i) \
        __builtin_amdgcn_global_load_lds((const unsigned*)((const char*)(gbase) + (voff)[_i]), (LAS unsigned*)(lds + (bufoff) + ldsw + _i * 8192), 16, 0, 0); } while (0)
#define PG8_LDA(dst, b, h) do { _Pragma("unroll") for (int m = 0; m < 4; ++m) { const i32x4_t f0_ = *(const LAS i32x4_t*)(lds + PG8_SA(b, h) + aoff + m * 2048), f1_ = *(const LAS i32x4_t*)(lds + PG8_SA(b, h) + aoff + m * 2048 + 1024); FragSel<F8>::set(dst[m], f0_, f1_); } } while (0)
#define PG8_LDB(dst, b, h) do { _Pragma("unroll") for (int n = 0; n < 2; ++n) { const i32x4_t f0_ = *(const LAS i32x4_t*)(lds + PG8_SB(b, h) + boff + n * 2048), f1_ = *(const LAS i32x4_t*)(lds + PG8_SB(b, h) + boff + n * 2048 + 1024); FragSel<F8>::set(dst[n], f0_, f1_); } } while (0)
#define PG8_MMA(ai, bj, At, Bt) do { __builtin_amdgcn_s_setprio(1); _Pragma("unroll") for (int m = 0; m < 4; ++m) _Pragma("unroll") for (int n = 0; n < 2; ++n) FragSel<F8>::mma(acc[ai][bj][m][n], Bt[n], At[m]); __builtin_amdgcn_s_setprio(0); } while (0)
#define PG8_WAIT_V(n) asm volatile("s_waitcnt vmcnt(" #n ")" ::: "memory")
#define PG8_WAIT_VSEL(sel, n) asm volatile("s_cmp_eq_u32 %0, 0\n\ts_cbranch_scc1 1f\n\ts_waitcnt vmcnt(%1)\n\ts_branch 2f\n1:\n\ts_waitcnt vmcnt(8)\n2:" :: "s"(sel), "n"(n) : "memory", "scc")
#define PG8_WAIT_L(n) asm volatile("s_waitcnt lgkmcnt(" #n ")" ::: "memory")
#define PG8_BAR __builtin_amdgcn_s_barrier()
#define PG8_SCHED __builtin_amdgcn_sched_barrier(0)
    Unit cur, nxt; int ui = 0;
    if constexpr (Sched::DYN) S.begin();
    if (!S.next(0, cur)) return;
    f32x4 acc[2][2][4][2];
#pragma unroll
    for (int a = 0; a < 2; ++a)
#pragma unroll
        for (int b = 0; b < 2; ++b)
#pragma unroll
            for (int m = 0; m < 4; ++m)
#pragma unroll
                for (int n = 0; n < 2; ++n) acc[a][b][m][n] = (f32x4){0.f, 0.f, 0.f, 0.f};
    typename FragSel<F8>::A At; typename FragSel<F8>::B B0, B1;
    PG8_SETV(vA, cur);
    const char* cA = (const char*)g.A + (GATHER ? (size_t)0 : (size_t)cur.pm * tstepA); const char* cB = (const char*)g.Bt + (size_t)cur.pn * tstepB;
    PG8_STAGE(PG8_SB(0, 0), cB, voffB); PG8_STAGE(PG8_SB(0, 1), cB + hstepB, voffB); PG8_STAGE(PG8_SA(0, 0), cA, vA[0]); PG8_STAGE(PG8_SA(0, 1), cA + hsA, vA[1]);
    if (wr == 1) PG8_BAR;
    PG8_WAIT_V(2); PG8_BAR;
    PG8_STAGE(PG8_SB(1, 0), cB + kstep, voffB); PG8_STAGE(PG8_SA(1, 0), cA + kstepA, vA[0]); PG8_STAGE(PG8_SB(1, 1), cB + hstepB + kstep, voffB);
    PG8_WAIT_V(6); PG8_BAR;
    for (;;) {
        const bool has_next = S.next(ui + 1, nxt);
        unsigned claim_ = 0u; if constexpr (Sched::DYN) claim_ = S.claim_issue();
        const char* nA = has_next ? (const char*)g.A + (GATHER ? (size_t)0 : (size_t)nxt.pm * tstepA) : cA; const char* nB = has_next ? (const char*)g.Bt + (size_t)nxt.pn * tstepB : cB;
        if constexpr (GATHER) { if (has_next) PG8_SETV(nvA, nxt); else {
#pragma unroll
            for (int h = 0; h < 2; ++h) { nvA[h][0] = vA[h][0]; nvA[h][1] = vA[h][1]; } } }
        for (int t = 0; t < nt; t += 2) {
            if constexpr (Epi::MID) { if (t == (F8 ? 4 : 8) || t == (F8 ? 8 : 16)) E.mid(acc, cur, F8 ? t >> 2 : t >> 3, wr, wc, fr, fq); }
            const bool last = (t == nt - 2);
            const char* a1 = cA + (size_t)(t + 1) * kstepA;
            const char* a2 = last ? nA : cA + (size_t)(t + 2) * kstepA; const char* b2 = last ? nB : cB + (size_t)(t + 2) * kstep;
            const char* a3 = a2 + kstepA; const char* b3 = b2 + kstep;
            unsigned v20[2], v21[2];
            if constexpr (GATHER) { v20[0] = last ? nvA[0][0] : vA[0][0]; v20[1] = last ? nvA[0][1] : vA[0][1]; v21[0] = last ? nvA[1][0] : vA[1][0]; v21[1] = last ? nvA[1][1] : vA[1][1]; }
            else { v20[0] = vA[0][0]; v20[1] = vA[0][1]; v21[0] = vA[1][0]; v21[1] = vA[1][1]; }
            const int relax_ = __builtin_amdgcn_readfirstlane((RELAXW && (t == 0) && (ui > 0)) ? 1 : 0);
            PG8_LDB(B0, 0, 0); PG8_LDB(B1, 0, 1); PG8_SCHED; PG8_LDA(At, 0, 0); PG8_STAGE(PG8_SA(1, 1), a1 + hsA, vA[1]);
            PG8_WAIT_VSEL(relax_, 8 + Epi::NVM);
            PG8_WAIT_L(0); PG8_BAR; PG8_MMA(0, 0, At, B0); PG8_MMA(0, 1, At, B1); PG8_BAR; PG8_SCHED;
            PG8_LDA(At, 0, 1); PG8_STAGE(PG8_SB(0, 0), b2, voffB); PG8_STAGE(PG8_SB(0, 1), b2 + hstepB, voffB); PG8_STAGE(PG8_SA(0, 0), a2, v20);
            PG8_WAIT_VSEL(relax_, 8 + Epi::NVM);
            PG8_WAIT_L(0); PG8_BAR; PG8_MMA(1, 0, At, B0); PG8_MMA(1, 1, At, B1); PG8_BAR; PG8_SCHED;
            PG8_LDB(B0, 1, 0); PG8_LDB(B1, 1, 1); PG8_SCHED; PG8_LDA(At, 1, 0); PG8_STAGE(PG8_SA(0, 1), a2 + hsA, v21);
            PG8_WAIT_V(8); PG8_WAIT_L(0); PG8_BAR; PG8_MMA(0, 0, At, B0); PG8_MMA(0, 1, At, B1); PG8_BAR; PG8_SCHED;
            PG8_LDA(At, 1, 1); PG8_STAGE(PG8_SB(1, 0), b3, voffB); PG8_STAGE(PG8_SB(1, 1), b3 + hstepB, voffB); PG8_STAGE(PG8_SA(1, 0), a3, v20);
            PG8_WAIT_V(8); PG8_WAIT_L(0); PG8_BAR; PG8_MMA(1, 0, At, B0); PG8_MMA(1, 1, At, B1); PG8_BAR; PG8_SCHED;
        }
        if constexpr (Sched::DYN) S.claim_commit(claim_, ui);
        if constexpr (ALIGN_EPI) { if (wr == 0) PG8_BAR; }
        FragSel<F8>::after_mma();
        E(acc, cur, wr, wc, fr, fq);
        if (!has_next) break;
#pragma unroll
        for (int a = 0; a < 2; ++a)
#pragma unroll
            for (int b = 0; b < 2; ++b)
#pragma unroll
                for (int m = 0; m < 4; ++m)
#pragma unroll
                    for (int n = 0; n < 2; ++n) acc[a][b][m][n] = (f32x4){0.f, 0.f, 0.f, 0.f};
        cur = nxt; cA = nA; cB = nB; ++ui;
        if constexpr (GATHER) {
#pragma unroll
            for (int h = 0; h < 2; ++h) { vA[h][0] = nvA[h][0]; vA[h][1] = nvA[h][1]; } }
        if constexpr (ALIGN_EPI) { if (wr == 1) PG8_BAR; }
    }
    PG8_WAIT_V(0);
    if constexpr (!ALIGN_EPI) { if (wr == 0) PG8_BAR; }
    PG8_BAR;
#undef PG8_SETV
#undef PG8_SA
#undef PG8_SB
#undef PG8_STAGE
#undef PG8_LDA
#undef PG8_LDB
#undef PG8_MMA
#undef PG8_WAIT_V
#undef PG8_WAIT_VSEL
#undef PG8_WAIT_L
#undef PG8_BAR
#undef PG8_SCHED
}

typedef f32x4 Acc[2][2][4][2];
#ifndef NT_Z
#define NT_Z 0
#endif
#ifndef NT_A
#define NT_A 1
#endif
#ifndef ST_SC1
#define ST_SC1 1
#endif
__device__ __forceinline__ void st16(unsigned char* wsb, u32x4* p, const u32x4& v) {
#if ST_SC1
    const __amdgpu_buffer_rsrc_t rsrc = __builtin_amdgcn_make_buffer_rsrc(wsb, 0, 0x7fffffff, 0x00020000);
    __builtin_amdgcn_raw_buffer_store_b128(v, rsrc, (int)((unsigned char*)p - wsb), 0, 16);
#else
    *p = v;
#endif
}
__device__ __forceinline__ void st8(unsigned char* wsb, u32x2* p, const u32x2& v) {
#if ST_SC1
    const __amdgpu_buffer_rsrc_t rsrc = __builtin_amdgcn_make_buffer_rsrc(wsb, 0, 0x7fffffff, 0x00020000);
    __builtin_amdgcn_raw_buffer_store_b64(v, rsrc, (int)((unsigned char*)p - wsb), 0, 16);
#else
    *p = v;
#endif
}
__device__ __forceinline__ float fq_sum(float s) { s += swz_xor<16>(s); return xsum32(s); }
__device__ __forceinline__ u32x4 pack8(const f32x4& a, const f32x4& b) { u32x4 w; w.x = cvt_pk_bf16(a.x, a.y); w.y = cvt_pk_bf16(a.z, a.w); w.z = cvt_pk_bf16(b.x, b.y); w.w = cvt_pk_bf16(b.z, b.w); return w; }
__device__ __forceinline__ void unpack8(const u32x4& w, f32x4& a, f32x4& b) { a = (f32x4){bf_lo(w.x), bf_hi(w.x), bf_lo(w.y), bf_hi(w.y)}; b = (f32x4){bf_lo(w.z), bf_hi(w.z), bf_lo(w.w), bf_hi(w.w)}; }
__device__ __forceinline__ unsigned g8pack(const f32x4& a) {
    const unsigned b0 = (unsigned)__builtin_fmaxf(a.x * 255.f + 0.5f, 1.f), b1 = (unsigned)__builtin_fmaxf(a.y * 255.f + 0.5f, 1.f), b2 = (unsigned)__builtin_fmaxf(a.z * 255.f + 0.5f, 1.f), b3 = (unsigned)__builtin_fmaxf(a.w * 255.f + 0.5f, 1.f);
    return b0 | (b1 << 8) | (b2 << 16) | (b3 << 24);
}
__device__ __forceinline__ f32x4 g8unpack(unsigned w) { return (f32x4){(float)(w & 0xffu), (float)((w >> 8) & 0xffu), (float)((w >> 16) & 0xffu), (float)(w >> 24)}; }
__device__ __forceinline__ float sq8(const f32x4& a, const f32x4& b) { return ((a.x * a.x + a.y * a.y) + (a.z * a.z + a.w * a.w)) + ((b.x * b.x + b.y * b.y) + (b.z * b.z + b.w * b.w)); }
__device__ __forceinline__ float sum4(const f32x4& a) { return (a.x + a.y) + (a.z + a.w); }
__device__ __forceinline__ void rope8(f32x4& a, f32x4& b, const float* cs, const float* sn) {
    const f32x4 c = *(const f32x4*)cs, s = *(const f32x4*)sn;
    const f32x4 ra = {a.x * c.x - a.y * s.x, a.x * s.x + a.y * c.x, a.z * c.y - a.w * s.y, a.z * s.y + a.w * c.y};
    const f32x4 rb = {b.x * c.z - b.y * s.z, b.x * s.z + b.y * c.z, b.z * c.w - b.w * s.w, b.z * s.w + b.w * c.w};
    a = ra; b = rb;
}
__device__ __forceinline__ void rowscale16(const float* st, int rbase, int fq, float (&r)[8]) {
    f32x4 p[8];
#pragma unroll
    for (int i = 0; i < 8; ++i) p[i] = *(const f32x4*)(st + (size_t)(rbase + (i >> 2) * HALF + (i & 3) * 16) * 16 + 4 * fq);
#pragma unroll
    for (int i = 0; i < 8; ++i) r[i] = rsqrtf(fq_sum(sum4(p[i])) * (1.f / 1024.f) + EPS);
}
__device__ __forceinline__ void rowscale4(const float* sq, int rbase, float inv_n, float (&r)[8]) {
    f32x4 p[8];
#pragma unroll
    for (int i = 0; i < 8; ++i) p[i] = *(const f32x4*)(sq + (size_t)(rbase + (i >> 2) * HALF + (i & 3) * 16) * 4);
#pragma unroll
    for (int i = 0; i < 8; ++i) r[i] = rsqrtf(sum4(p[i]) * inv_n + EPS);
}
#define EPI_ROWBASE int rl_ = wr * 64 + fr; asm volatile("" : "+v"(rl_)); const int rbase = u.pm * BM + rl_
#define EPI_LOOP _Pragma("unroll") for (int ai = 0; ai < 2; ++ai) _Pragma("unroll") for (int m = 0; m < 4; ++m)

__device__ __forceinline__ float sig2_(float t) { return fast_rcp(1.f + fast_exp2(t)); }
struct EpiIn {
    static constexpr bool PERM = true, MID = false; static constexpr int NVM = 24;
    bf16_t* Z; const float* st; float* sq; float* skv; const float* cosT; const float* sinT; unsigned char* GB; bf16_t* HM; unsigned char* wsb; int pnoff; float asc;
    __device__ __forceinline__ void operator()(const Acc& acc, const Unit& u, int wr, int wc, int fr, int fq) const {
        EPI_ROWBASE; const int pn = u.pn + pnoff;
        float r8[8]; rowscale16(st, rbase, fq, r8);
#pragma unroll
        for (int i = 0; i < 8; ++i) r8[i] *= (pn >= 11 ? -LOG2E * asc : asc);
        __builtin_amdgcn_sched_barrier(0);
        EPI_LOOP {
            const int row = rbase + ai * HALF + m * 16; const float r = r8[ai * 4 + m];
            bf16_t* zr = Z + (size_t)row * ZW + pn * BM + wc * 32 + 8 * fq;
            float ssq = 0.f;
#pragma unroll
            for (int bj = 0; bj < 2; ++bj) {
                f32x4 v0 = acc[ai][bj][m][0] * r, v1 = acc[ai][bj][m][1] * r;
#ifdef PROBE_ANOISE
                if (pn < 11 && ((PROBE_ANOISE_MASK >> pn) & 1)) { unsigned h_ = (unsigned)row * 2654435761u ^ (unsigned)(pn * 64 + bj * 32 + wc * 8 + fq) * 40503u; float nz[8];
#pragma unroll
                      for (int e_ = 0; e_ < 8; ++e_) { h_ = h_ * 1664525u + 1013904223u; nz[e_] = ((float)(h_ >> 8) * (1.f / 16777216.f) - 0.5f) * 3.4641f * 0.035f * (float)(PROBE_ANOISE); }
                      v0.x += nz[0]; v0.y += nz[1]; v0.z += nz[2]; v0.w += nz[3]; v1.x += nz[4]; v1.y += nz[5]; v1.z += nz[6]; v1.w += nz[7]; }
#endif
                if (pn == 0) ssq += sq8(v0, v1);
                else if (pn == 1) { if (bj == 0) ssq += sq8(v0, v1); else if (wc == 0) { const int pos = row & (SEQ - 1); rope8(v0, v1, cosT + pos * 16 + 4 * fq, sinT + pos * 16 + 4 * fq); } }
                else if (pn == 2 || pn == 3 || pn == 8 || pn == 9) { v0 = v0 * (0.125f * LOG2E); v1 = v1 * (0.125f * LOG2E); }
                else if (pn >= 11) {
#ifdef PROBE_GNOISE
                    { unsigned h_ = (unsigned)row * 2654435761u ^ (unsigned)(pn * 64 + bj * 32 + wc * 8 + fq) * 40503u; float nz[8];
#pragma unroll
                      for (int e_ = 0; e_ < 8; ++e_) { h_ = h_ * 1664525u + 1013904223u; nz[e_] = ((float)(h_ >> 8) * (1.f / 16777216.f) - 0.5f) * 3.4641f * 0.035f * (float)(PROBE_GNOISE); }
                      v0.x += nz[0]; v0.y += nz[1]; v0.z += nz[2]; v0.w += nz[3]; v1.x += nz[4]; v1.y += nz[5]; v1.z += nz[6]; v1.w += nz[7]; }
#endif
                    v0 = (f32x4){sig2_(v0.x), sig2_(v0.y), sig2_(v0.z), sig2_(v0.w)}; v1 = (f32x4){sig2_(v1.x), sig2_(v1.y), sig2_(v1.z), sig2_(v1.w)}; }
                if (pn >= 11) { u32x2 w8; w8.x = g8pack(v0); w8.y = g8pack(v1); *(u32x2*)(GB + blk_off(row, (pn - 11) * BM + bj * HALF + wc * 32 + 8 * fq, 3072)) = w8; }
                else if (pn >= 2) {
                    const int hc = (pn - 2) * BM + bj * HALF + wc * 32;
                    const int reg = hc < 1536 ? hc >> 9 : (hc < 2048 ? 3 : (hc < 2176 ? 4 : 5)), hin = hc < 1536 ? hc & 511 : (hc < 2048 ? hc - 1536 : (hc - 2048) & 127);
                    const size_t base = reg <= 3 ? (size_t)reg * (MC * 512) : (size_t)4 * (MC * 512) + (size_t)(reg - 4) * (MC * 128);
                    const int nh = reg <= 3 ? 8 : 2, b = row >> 11, s = row & (SEQ - 1);
                    st16(wsb, (u32x4*)(HM + base + (((size_t)(b * nh + (hin >> 6)) * SEQ + s) * 64 + (hin & 63) + 8 * fq)), pack8(v0, v1));
                }
                else st16(wsb, (u32x4*)(zr + bj * HALF), pack8(v0, v1));
            }
            if (pn <= 1) { ssq = fq_sum(ssq); if (fq == 0) (pn == 0 ? sq : skv)[(size_t)row * 4 + wc] = ssq; }
        }
    }
};
struct EpiQ {
    static constexpr bool PERM = true, MID = false; static constexpr int NVM = 24;
    bf16_t* Q; const float* sq; const float* cosT; const float* sinT;
    __device__ __forceinline__ void operator()(const Acc& acc, const Unit& u, int wr, int wc, int fr, int fq) const {
        EPI_ROWBASE;
        float r8[8]; rowscale4(sq, rbase, 1.f / 256.f, r8);
        __builtin_amdgcn_sched_barrier(0);
        EPI_LOOP {
            __builtin_amdgcn_sched_barrier(0);
            const int row = rbase + ai * HALF + m * 16; const float r = r8[ai * 4 + m]; const int pos = row & (SEQ - 1);
#pragma unroll
            for (int bj = 0; bj < 2; ++bj) {
                const int col = u.pn * BM + bj * HALF + wc * 32 + 8 * fq; const int j0 = col % 96;
                f32x4 v0 = acc[ai][bj][m][0] * r, v1 = acc[ai][bj][m][1] * r;
                if (j0 >= 64) { const int i0 = (j0 - 64) >> 1; rope8(v0, v1, cosT + pos * 16 + i0, sinT + pos * 16 + i0); }
                *(u32x4*)(Q + (size_t)row * 768 + col) = pack8(v0, v1);
            }
        }
    }
};
struct EpiKV {
    static constexpr bool PERM = true, MID = false; static constexpr int NVM = 24;
    bf16_t* KV; const float* skv;
    __device__ __forceinline__ void operator()(const Acc& acc, const Unit& u, int wr, int wc, int fr, int fq) const {
        EPI_ROWBASE;
        float r8[8]; rowscale4(skv, rbase, 1.f / 128.f, r8);
        __builtin_amdgcn_sched_barrier(0);
        EPI_LOOP {
            const int row = rbase + ai * HALF + m * 16; const float r = r8[ai * 4 + m];
#pragma unroll
            for (int bj = 0; bj < 2; ++bj) {
                const int col = u.pn * BM + bj * HALF + wc * 32 + 8 * fq;
                *(u32x4*)(KV + (size_t)row * 1024 + col) = pack8(acc[ai][bj][m][0] * r, acc[ai][bj][m][1] * r);
            }
        }
    }
};
struct EpiBr {
    static constexpr bool PERM = true, MID = true; static constexpr int NVM = 32;
    const unsigned char* G; bf16_t* MG; unsigned char* wsb;
    __device__ __forceinline__ void mid(Acc& acc, const Unit& u, int seg, int wr, int wc, int fr, int fq) const {
        EPI_ROWBASE; const int col = u.pn * BM + wc * 32 + 8 * fq;
#pragma unroll
        for (int ai = 0; ai < 2; ++ai) {
            __builtin_amdgcn_sched_barrier(0);
            u32x2 wn[4][2], wd[4][2];
#pragma unroll
            for (int m = 0; m < 4; ++m)
#pragma unroll
                for (int bj = 0; bj < 2; ++bj) { const int row = rbase + ai * HALF + m * 16; wn[m][bj] = *(const u32x2*)(G + blk_off(row, (seg - 1) * 1024 + col + bj * HALF, 3072)); wd[m][bj] = *(const u32x2*)(G + blk_off(row, seg * 1024 + col + bj * HALF, 3072)); }
#pragma unroll
            for (int m = 0; m < 4; ++m)
#pragma unroll
                for (int bj = 0; bj < 2; ++bj) {
                    const f32x4 n0 = g8unpack(wn[m][bj].x), n1 = g8unpack(wn[m][bj].y), d0 = g8unpack(wd[m][bj].x), d1 = g8unpack(wd[m][bj].y);
                    f32x4 r0, r1;
                    r0.x = n0.x * fast_rcp(d0.x); r0.y = n0.y * fast_rcp(d0.y); r0.z = n0.z * fast_rcp(d0.z); r0.w = n0.w * fast_rcp(d0.w);
                    r1.x = n1.x * fast_rcp(d1.x); r1.y = n1.y * fast_rcp(d1.y); r1.z = n1.z * fast_rcp(d1.z); r1.w = n1.w * fast_rcp(d1.w);
                    acc[ai][bj][m][0] = acc[ai][bj][m][0] * r0; acc[ai][bj][m][1] = acc[ai][bj][m][1] * r1;
                }
        }
    }
    __device__ __forceinline__ void operator()(const Acc& acc, const Unit& u, int wr, int wc, int fr, int fq) const {
        EPI_ROWBASE; const int col = u.pn * BM + wc * 32 + 8 * fq;
#pragma unroll
        for (int ai = 0; ai < 2; ++ai) {
            __builtin_amdgcn_sched_barrier(0);
            u32x2 wg[4][2];
#pragma unroll
            for (int m = 0; m < 4; ++m)
#pragma unroll
                for (int bj = 0; bj < 2; ++bj) wg[m][bj] = *(const u32x2*)(G + blk_off(rbase + ai * HALF + m * 16, 2048 + col + bj * HALF, 3072));
#pragma unroll
            for (int m = 0; m < 4; ++m)
#pragma unroll
                for (int bj = 0; bj < 2; ++bj) { const f32x4 g0 = g8unpack(wg[m][bj].x) * ((P5_F8 ? 16.f : 1.f) * (P4_F8 ? 1.f / 4096.f : 1.f) / 255.f), g1 = g8unpack(wg[m][bj].y) * ((P5_F8 ? 16.f : 1.f) * (P4_F8 ? 1.f / 4096.f : 1.f) / 255.f);
                    if (P5_F8) { const f32x4 v0 = acc[ai][bj][m][0] * g0, v1 = acc[ai][bj][m][1] * g1; u32x2 o8; o8.x = pk_fp8x4(v0.x, v0.y, v0.z, v0.w); o8.y = pk_fp8x4(v1.x, v1.y, v1.z, v1.w);
                        st8(wsb, (u32x2*)((unsigned char*)MG + blk_off(rbase + ai * HALF + m * 16, (col + bj * HALF) >> 1, 512) * 2), o8); }
                    else st16(wsb, (u32x4*)(MG + blk_off(rbase + ai * HALF + m * 16, col + bj * HALF, 1024)), pack8(acc[ai][bj][m][0] * g0, acc[ai][bj][m][1] * g1)); }
        }
    }
};
template <bool F8OUT> struct EpiRes {
    static constexpr bool PERM = true, MID = false; static constexpr int NVM = 40;
    bf16_t* xb; float* st; int row0; unsigned char* x8; float asc;
    __device__ __forceinline__ void operator()(const Acc& acc, const Unit& u, int wr, int wc, int fr, int fq) const {
        EPI_ROWBASE; const int col = u.pn * BM + wc * 32 + 8 * fq;
#pragma unroll
        for (int ai = 0; ai < 2; ++ai) {
            __builtin_amdgcn_sched_barrier(0);
            u32x4 xi[4][2];
#pragma unroll
            for (int m = 0; m < 4; ++m)
#pragma unroll
                for (int bj = 0; bj < 2; ++bj) xi[m][bj] = *(const u32x4*)(xb + (size_t)(row0 + rbase + ai * HALF + m * 16) * DM + col + bj * HALF);
#pragma unroll
            for (int m = 0; m < 4; ++m) {
                const int row = row0 + rbase + ai * HALF + m * 16; float ssq = 0.f;
#pragma unroll
                for (int bj = 0; bj < 2; ++bj) { f32x4 x0, x1; unpack8(xi[m][bj], x0, x1);
                    const f32x4 v0 = x0 + acc[ai][bj][m][0] * asc, v1 = x1 + acc[ai][bj][m][1] * asc;
                    *(u32x4*)(xb + (size_t)row * DM + col + bj * HALF) = pack8(v0, v1); ssq += sq8(v0, v1);
                    if constexpr (F8OUT) { u32x2 o8; o8.x = pk_fp8x4(v0.x * 16.f, v0.y * 16.f, v0.z * 16.f, v0.w * 16.f); o8.y = pk_fp8x4(v1.x * 16.f, v1.y * 16.f, v1.z * 16.f, v1.w * 16.f); *(u32x2*)(x8 + (size_t)row * DM + col + bj * HALF) = o8; } }
                ssq = fq_sum(ssq); if (fq == 0) st[(size_t)row * 16 + u.pn * 4 + wc] = ssq;
            }
        }
    }
};
__device__ __forceinline__ float silu_mul(float g, float u) { return g * sigmoidf_(g) * u; }
struct EpiGU {
    static constexpr bool PERM = true, MID = false; static constexpr int NVM = 16;
    bf16_t* ACT; const float* st; int ldact; unsigned char* wsb;
    __device__ __forceinline__ void operator()(const Acc& acc, const Unit& u, int wr, int wc, int fr, int fq) const {
        EPI_ROWBASE;
        float r8[8]; rowscale16(st, rbase, fq, r8);
        __builtin_amdgcn_sched_barrier(0);
        EPI_LOOP {
            const int row = rbase + ai * HALF + m * 16; const float r = r8[ai * 4 + m];
            f32x4 g0 = acc[ai][0][m][0] * r, g1 = acc[ai][0][m][1] * r, u0 = acc[ai][1][m][0] * r, u1 = acc[ai][1][m][1] * r;
#ifdef PROBE_P6NOISE
            { unsigned h_ = (unsigned)row * 2654435761u ^ (unsigned)(u.pn * 64 + wc * 8 + fq) * 40503u; float nz[16];
#pragma unroll
              for (int e_ = 0; e_ < 16; ++e_) { h_ = h_ * 1664525u + 1013904223u; nz[e_] = ((float)(h_ >> 8) * (1.f / 16777216.f) - 0.5f) * 3.4641f * 0.035f * (float)(PROBE_P6NOISE); }
              g0.x += nz[0]; g0.y += nz[1]; g0.z += nz[2]; g0.w += nz[3]; g1.x += nz[4]; g1.y += nz[5]; g1.z += nz[6]; g1.w += nz[7]; u0.x += nz[8]; u0.y += nz[9]; u0.z += nz[10]; u0.w += nz[11]; u1.x += nz[12]; u1.y += nz[13]; u1.z += nz[14]; u1.w += nz[15]; }
#endif
            const f32x4 a0 = {silu_mul(g0.x, u0.x), silu_mul(g0.y, u0.y), silu_mul(g0.z, u0.z), silu_mul(g0.w, u0.w)};
            const f32x4 a1 = {silu_mul(g1.x, u1.x), silu_mul(g1.y, u1.y), silu_mul(g1.z, u1.z), silu_mul(g1.w, u1.w)};
            st16(wsb, (u32x4*)(ACT + blk_off(row, u.aux * HALF + wc * 32 + 8 * fq, ldact)), pack8(a0, a1));
        }
    }
};
struct EpiGUMoe {
    static constexpr bool PERM = true, MID = false; static constexpr int NVM = 16;
    bf16_t* ACT; const float* rowrr; int ldact; unsigned char* wsb;
    __device__ __forceinline__ void operator()(const Acc& acc, const Unit& u, int wr, int wc, int fr, int fq) const {
        EPI_ROWBASE;
        float r8[8];
#pragma unroll
        for (int i = 0; i < 8; ++i) r8[i] = rowrr[rbase + (i >> 2) * HALF + (i & 3) * 16] * (MOE_F8 ? 1.f / 4096.f : 1.f);
        __builtin_amdgcn_sched_barrier(0);
        EPI_LOOP {
            const int row = rbase + ai * HALF + m * 16; const float r = r8[ai * 4 + m];
            const float ru = MOE_DN_F8 ? r * 8.f : r;
            const f32x4 g0 = acc[ai][0][m][0] * r, g1 = acc[ai][0][m][1] * r, u0 = acc[ai][1][m][0] * ru, u1 = acc[ai][1][m][1] * ru;
            const f32x4 a0 = {silu_mul(g0.x, u0.x), silu_mul(g0.y, u0.y), silu_mul(g0.z, u0.z), silu_mul(g0.w, u0.w)};
            const f32x4 a1 = {silu_mul(g1.x, u1.x), silu_mul(g1.y, u1.y), silu_mul(g1.z, u1.z), silu_mul(g1.w, u1.w)};
            if (MOE_DN_F8) { u32x2 o8; o8.x = pk_fp8x4(a0.x, a0.y, a0.z, a0.w); o8.y = pk_fp8x4(a1.x, a1.y, a1.z, a1.w);
                st8(wsb, (u32x2*)((unsigned char*)ACT + blk_off(row, (u.aux * HALF + wc * 32 + 8 * fq) >> 1, ldact >> 1) * 2), o8); }
            else st16(wsb, (u32x4*)(ACT + blk_off(row, u.aux * HALF + wc * 32 + 8 * fq, ldact)), pack8(a0, a1));
        }
    }
};
template <bool FIRST> struct EpiDnMoe {
    static constexpr bool PERM = true, MID = false; static constexpr int NVM = 32;
    unsigned char* ws; const int* rowtok; const float* rowgw;
    __device__ __forceinline__ void operator()(const Acc& acc, const Unit& u, int wr, int wc, int fr, int fq) const {
        EPI_ROWBASE; const int col = u.aux * BM + wc * 32 + 8 * fq;
        int tk[8]; float gw8[8];
#pragma unroll
        for (int i = 0; i < 8; ++i) { tk[i] = rowtok[rbase + (i >> 2) * HALF + (i & 3) * 16]; gw8[i] = rowgw[rbase + (i >> 2) * HALF + (i & 3) * 16] * (MOE_DN_F8 ? 1.f / 8192.f : 1.f); }
#pragma unroll
        for (int ai = 0; ai < 2; ++ai) {
            __builtin_amdgcn_sched_barrier(0);
            u32x4 xi[4][2]; bf16_t* xr[4];
#pragma unroll
            for (int m = 0; m < 4; ++m) { const int tok = tk[ai * 4 + m] < 0 ? 0 : tk[ai * 4 + m]; xr[m] = xm_row(ws, tok) + col;
                const bf16_t* src = FIRST ? (const bf16_t*)(ws + WS_XB) + (size_t)tok * DM + col : xr[m];
#pragma unroll
                for (int bj = 0; bj < 2; ++bj) xi[m][bj] = *(const u32x4*)(src + bj * HALF); }
#pragma unroll
            for (int m = 0; m < 4; ++m) { const float gwv = gw8[ai * 4 + m];
                if (tk[ai * 4 + m] >= 0) {
#pragma unroll
                    for (int bj = 0; bj < 2; ++bj) { f32x4 x0, x1; unpack8(xi[m][bj], x0, x1);
                        *(u32x4*)(xr[m] + bj * HALF) = pack8(x0 + acc[ai][bj][m][0] * gwv, x1 + acc[ai][bj][m][1] * gwv); } } }
        }
    }
};
}
namespace att {
constexpr float MLA_THR = 6.f;
__device__ __forceinline__ int crow(int r, int hi) { return (r & 3) + 8 * (r >> 2) + 4 * hi; }
__device__ __forceinline__ float xhalf_max(float m) { return xmax32(m); }
__device__ __forceinline__ float xhalf_sum(float m) { return xsum32(m); }
typedef short v4i16_t __attribute__((ext_vector_type(4)));
__device__ __forceinline__ s16x4 vtr(const LAS unsigned char* p) { return __builtin_bit_cast(s16x4, __builtin_amdgcn_ds_read_tr16_b64_v4i16((LAS v4i16_t*)p)); }
__device__ __forceinline__ bf16x8 cat8(s16x4 a, s16x4 b) { return (bf16x8){a[0], a[1], a[2], a[3], b[0], b[1], b[2], b[3]}; }
__device__ __forceinline__ bf16x8 pfrag(const f32x16& p, int s8) {
    u32x4 w; w.x = cvt_pk_bf16(p[s8 + 0], p[s8 + 1]); w.y = cvt_pk_bf16(p[s8 + 2], p[s8 + 3]); w.z = cvt_pk_bf16(p[s8 + 4], p[s8 + 5]); w.w = cvt_pk_bf16(p[s8 + 6], p[s8 + 7]);
    return __builtin_bit_cast(bf16x8, w);
}
constexpr int TAB_STRIDE = 320;

constexpr int BW_ROWS = 384, BW_KP = 144;
constexpr int BW_K = 0, BW_V = BW_ROWS * BW_KP, BW_VDH = BW_ROWS * 64, BW_TAB = BW_V + 2 * BW_VDH, BW_END = BW_TAB + 4 * TAB_STRIDE * 4;
struct BandPre { u32x4 k[6], v[6]; float t[4]; bf16x8 q[4]; };
struct BandItem { int kind, b, hh, g0, a0; };
__device__ __forceinline__ BandItem band_decode(int i, int items_per_kind) {
    BandItem it; it.kind = i / items_per_kind; const int w = i % items_per_kind;
    if (it.kind < 3) { const int sub = w & 7; it.hh = (w >> 3) & 7; it.b = w >> 6;
        if (it.kind == 0) { it.g0 = 0; it.a0 = 256 * sub; } else if (it.kind == 1) { it.g0 = sub >> 1; it.a0 = 256 * (sub & 1); } else { it.g0 = 2 * sub; it.a0 = 0; } }
    else { it.a0 = 64 * (w & 31); it.hh = (w >> 5) & 1; it.b = w >> 6; it.g0 = 0; }
    return it;
}
__device__ __forceinline__ bool band_row(const BandItem& it, int r, int& pos) {
    int key, g = it.g0, dil, L;
    if (it.kind == 3) { if (r >= 320) return false; key = it.a0 - 128 + r; dil = 1; L = SEQ; }
    else if (it.kind == 2) { if (r >= 256) return false; g += r >> 7; key = r & 127; dil = 16; L = 128; }
    else { dil = it.kind == 0 ? 1 : 4; L = SEQ / dil; key = it.a0 - 64 + r; }
    if (key < 0 || key >= L) return false;
    pos = key * dil + g; return true;
}
__device__ __forceinline__ void band_issue(BandPre& P, const BandItem& it, const bf16_t* HM, const float* tabg, int tid, int wid, int lane) {
    const bf16_t* kb = it.kind == 3 ? HM + (size_t)4 * MC * 512 + ((size_t)(it.b * 2 + it.hh) * SEQ) * 64 : HM + (size_t)MC * 512 + ((size_t)(it.b * 8 + it.hh) * SEQ) * 64;
    const bf16_t* vb = it.kind == 3 ? kb + (size_t)MC * 128 : kb + (size_t)MC * 512;
#pragma unroll
    for (int i = 0; i < 6; ++i) { const int id = i * 512 + tid, r = id >> 3, c = id & 7; int pos; P.k[i] = (u32x4){0u, 0u, 0u, 0u}; P.v[i] = P.k[i];
        if (band_row(it, r, pos)) { P.k[i] = *(const u32x4*)(kb + (size_t)pos * 64 + c * 8); P.v[i] = *(const u32x4*)(vb + (size_t)pos * 64 + c * 8); } }
#pragma unroll
    for (int j = 0; j < 4; ++j) { P.t[j] = 0.f; if (tid < TAB_STRIDE && (it.kind == 3 || j == 0)) P.t[j] = tabg[((it.kind == 3 ? 3 * 8 + it.hh * 4 + j : it.kind * 8 + it.hh)) * TAB_STRIDE + tid]; }
    int a0w, g = it.g0, dil, qh; const bf16_t* qbuf;
    if (it.kind == 3) { a0w = it.a0 + 32 * (wid & 1); dil = 1; qh = it.hh * 4 + (wid >> 1); qbuf = HM + (size_t)3 * MC * 512; }
    else if (it.kind == 2) { a0w = 32 * (wid & 3); g += wid >> 2; dil = 16; qh = it.hh; qbuf = HM; }
    else { a0w = it.a0 + 32 * wid; dil = it.kind == 0 ? 1 : 4; qh = it.hh; qbuf = HM; }
    const bf16_t* qp = qbuf + (((size_t)(it.b * 8 + qh) * SEQ) + (size_t)(a0w + (lane & 31)) * dil + g) * 64 + (lane >> 5) * 8;
#pragma unroll
    for (int d0 = 0; d0 < 4; ++d0) P.q[d0] = *(const bf16x8*)(qp + d0 * 16);
}
__device__ __forceinline__ void band_store(const BandPre& P, const BandItem& it, LAS unsigned char* lds, int tid) {
#pragma unroll
    for (int i = 0; i < 6; ++i) { const int id = i * 512 + tid, r = id >> 3, c = id & 7;
        *(LAS u32x4*)(lds + BW_K + r * BW_KP + c * 16) = P.k[i]; *(LAS u32x4*)(lds + BW_V + (c >> 2) * BW_VDH + r * 64 + (c & 3) * 16) = P.v[i]; }
    if (tid < TAB_STRIDE) {
#pragma unroll
        for (int j = 0; j < 4; ++j) if (it.kind == 3 || j == 0) ((LAS float*)(lds + BW_TAB))[j * TAB_STRIDE + tid] = P.t[j]; }
}
template <int NKB, int MODE>
__device__ __forceinline__ void band_compute(const bf16x8 (&qf)[4], const LAS unsigned char* lds, int rowoff, int a0w, int L, const LAS float* tab, bf16_t* op, float* stp, float sink2, int lane,
                                             const bf16_t* pb0 = nullptr, const bf16_t* pb1 = nullptr, const float* st0 = nullptr, const float* st1 = nullptr) {
    constexpr int R = 16 * (NKB - 1);
    const int q = lane & 31, hi = lane >> 5;
    f32x16 o0, o1;
#pragma unroll
    for (int r = 0; r < 16; ++r) { o0[r] = 0.f; o1[r] = 0.f; }
    float m = -3e38f, l = 0.f;
    const LAS float* tb = tab + (31 - q + 4 * hi);
    const int kro = q * BW_KP + hi * 16, vro = (4 * hi + ((lane & 15) >> 2)) * 64 + (16 * ((lane >> 4) & 1) + 4 * (lane & 3)) * 2;
#pragma unroll 1
    for (int kb = 0; kb < NKB; ++kb) {
        const int k0 = a0w - R + 32 * kb;
        if (k0 < 0 || k0 >= L) continue;
        const LAS unsigned char* kp = lds + BW_K + (rowoff + k0) * BW_KP + kro;
        f32x16 s;
#pragma unroll
        for (int r = 0; r < 16; ++r) s[r] = 0.f;
#pragma unroll
        for (int d0 = 0; d0 < 4; ++d0) s = __builtin_amdgcn_mfma_f32_32x32x16_bf16(*(const LAS bf16x8*)(kp + d0 * 32), qf[d0], s, 0, 0, 0);
#pragma unroll
        for (int r = 0; r < 16; ++r) s[r] += tb[32 * kb + (r & 3) + 8 * (r >> 2)];
        float bm = s[0];
#pragma unroll
        for (int r = 1; r < 16; ++r) bm = fmaxf(bm, s[r]);
        bm = xhalf_max(bm);
        if (__any(bm > m + MLA_THR)) {
            const float mn = fmaxf(m, bm), f = fast_exp2(m - mn); l *= f; m = mn;
#pragma unroll
            for (int r = 0; r < 16; ++r) { o0[r] *= f; o1[r] *= f; } }
        float ps = 0.f;
#pragma unroll
        for (int r = 0; r < 16; ++r) { s[r] = fast_exp2(s[r] - m); ps += s[r]; }
        l += ps;
        const bf16x8 p0 = pfrag(s, 0), p1 = pfrag(s, 8);
        const LAS unsigned char* vp = lds + BW_V + (rowoff + k0) * 64 + vro;
        { const bf16x8 v00 = cat8(vtr(vp), vtr(vp + 512)), v01 = cat8(vtr(vp + BW_VDH), vtr(vp + BW_VDH + 512));
          const bf16x8 v10 = cat8(vtr(vp + 1024), vtr(vp + 1024 + 512)), v11 = cat8(vtr(vp + BW_VDH + 1024), vtr(vp + BW_VDH + 1024 + 512));
          o0 = __builtin_amdgcn_mfma_f32_32x32x16_bf16(v00, p0, o0, 0, 0, 0); o1 = __builtin_amdgcn_mfma_f32_32x32x16_bf16(v01, p0, o1, 0, 0, 0);
          o0 = __builtin_amdgcn_mfma_f32_32x32x16_bf16(v10, p1, o0, 0, 0, 0); o1 = __builtin_amdgcn_mfma_f32_32x32x16_bf16(v11, p1, o1, 0, 0, 0); }
    }
    float lt = xhalf_sum(l);
    if (MODE == 2) {
        const f32x2 s0 = *(const f32x2*)st0, s1 = *(const f32x2*)st1;
        u32x2 a0[8], a1[8];
#pragma unroll
        for (int j = 0; j < 4; ++j) { a0[j] = *(const u32x2*)(pb0 + 8 * j); a0[4 + j] = *(const u32x2*)(pb0 + 32 + 8 * j); a1[j] = *(const u32x2*)(pb1 + 8 * j); a1[4 + j] = *(const u32x2*)(pb1 + 32 + 8 * j); }
        const float M = fmaxf(m, fmaxf(s0.x, s1.x));
        const float w0 = fast_exp2(s0.x - M) * s0.y, w1 = fast_exp2(s1.x - M) * s1.y, w2 = fast_exp2(m - M);
        const float inv = 1.f / (w0 + w1 + w2 * lt), c0 = w0 * inv, c1 = w1 * inv, c2 = w2 * inv;
#pragma unroll
        for (int j = 0; j < 4; ++j) {
            u32x2 w0_, w1_;
            { const float x0 = bf_lo(a0[j].x) * c0 + bf_lo(a1[j].x) * c1 + o0[4 * j] * c2, x1 = bf_hi(a0[j].x) * c0 + bf_hi(a1[j].x) * c1 + o0[4 * j + 1] * c2;
              const float x2 = bf_lo(a0[j].y) * c0 + bf_lo(a1[j].y) * c1 + o0[4 * j + 2] * c2, x3 = bf_hi(a0[j].y) * c0 + bf_hi(a1[j].y) * c1 + o0[4 * j + 3] * c2;
              w0_.x = cvt_pk_bf16(x0, x1); w0_.y = cvt_pk_bf16(x2, x3); }
            { const float x0 = bf_lo(a0[4 + j].x) * c0 + bf_lo(a1[4 + j].x) * c1 + o1[4 * j] * c2, x1 = bf_hi(a0[4 + j].x) * c0 + bf_hi(a1[4 + j].x) * c1 + o1[4 * j + 1] * c2;
              const float x2 = bf_lo(a0[4 + j].y) * c0 + bf_lo(a1[4 + j].y) * c1 + o1[4 * j + 2] * c2, x3 = bf_hi(a0[4 + j].y) * c0 + bf_hi(a1[4 + j].y) * c1 + o1[4 * j + 3] * c2;
              w1_.x = cvt_pk_bf16(x0, x1); w1_.y = cvt_pk_bf16(x2, x3); }
            if (P4_F8) { *(unsigned*)((unsigned char*)op + 8 * j) = pk_fp8x4(bf_lo(w0_.x) * 16.f, bf_hi(w0_.x) * 16.f, bf_lo(w0_.y) * 16.f, bf_hi(w0_.y) * 16.f); *(unsigned*)((unsigned char*)op + 32 + 8 * j) = pk_fp8x4(bf_lo(w1_.x) * 16.f, bf_hi(w1_.x) * 16.f, bf_lo(w1_.y) * 16.f, bf_hi(w1_.y) * 16.f); }
            else { *(u32x2*)(op + 8 * j) = w0_; *(u32x2*)(op + 32 + 8 * j) = w1_; }
        }
        return;
    }
    if (MODE == 1) lt += fast_exp2(sink2 - m);
    else if (hi == 0) { stp[0] = m; stp[1] = lt; }
    const float inv = 1.f / lt;
#pragma unroll
    for (int j = 0; j < 4; ++j) {
        u32x2 w0, w1; w0.x = cvt_pk_bf16(o0[4 * j] * inv, o0[4 * j + 1] * inv); w0.y = cvt_pk_bf16(o0[4 * j + 2] * inv, o0[4 * j + 3] * inv);
        w1.x = cvt_pk_bf16(o1[4 * j] * inv, o1[4 * j + 1] * inv); w1.y = cvt_pk_bf16(o1[4 * j + 2] * inv, o1[4 * j + 3] * inv);
        if (MODE == 1 && P4_F8) { const float i16 = inv * 16.f; *(unsigned*)((unsigned char*)op + 8 * j) = pk_fp8x4(o0[4 * j] * i16, o0[4 * j + 1] * i16, o0[4 * j + 2] * i16, o0[4 * j + 3] * i16); *(unsigned*)((unsigned char*)op + 32 + 8 * j) = pk_fp8x4(o1[4 * j] * i16, o1[4 * j + 1] * i16, o1[4 * j + 2] * i16, o1[4 * j + 3] * i16); }
        else { *(u32x2*)(op + 8 * j) = w0; *(u32x2*)(op + 32 + 8 * j) = w1; }
    }
}

constexpr int MLA_KP = 208;
constexpr int MLA_TK = 128;
constexpr int MLA_KTB = MLA_TK * MLA_KP;
constexpr int MLA_VTB = MLA_TK * 128;
constexpr int MLA_SLOT = MLA_KTB + MLA_VTB;
__device__ __forceinline__ void mla_unit(const bf16_t* Q, const bf16_t* KV, const bf16_t* Zc, bf16_t* Y, int b, int h, int qblk, LAS unsigned char* lds, int tid, int wid, int lane) {
    const int q = lane & 31, hi = lane >> 5;
    const size_t rb = (size_t)b * SEQ;
    bf16x8 qf[6];
    { const bf16_t* qp = Q + (rb + qblk * 256 + wid * 32 + q) * 768 + h * 96 + hi * 8;
#pragma unroll
      for (int d0 = 0; d0 < 6; ++d0) qf[d0] = *(const bf16x8*)(qp + d0 * 16); }
    const bf16_t* gk = KV + (rb + (tid >> 3)) * 1024 + h * 64 + (tid & 7) * 8;
    const bf16_t* gv = gk + 512;
    const bf16_t* gp = Zc + (rb + (tid >> 2)) * ZW + ZO_KPE + (tid & 3) * 8;
    const int lk = (tid >> 3) * MLA_KP + (tid & 7) * 16, lp = (tid >> 2) * MLA_KP + 128 + (tid & 3) * 16;
    const int lv = MLA_KTB + ((tid & 7) >> 2) * (MLA_TK * 64) + (tid >> 3) * 64 + (tid & 3) * 16;
    u32x4 rk0, rk1, rv0, rv1, rp;
#define MLA_GLOAD(T) do { const size_t go_ = (size_t)(T) * MLA_TK; rk0 = *(const u32x4*)(gk + go_ * 1024); rk1 = *(const u32x4*)(gk + (go_ + 64) * 1024); \
        rv0 = *(const u32x4*)(gv + go_ * 1024); rv1 = *(const u32x4*)(gv + (go_ + 64) * 1024); rp = *(const u32x4*)(gp + go_ * ZW); } while (0)
#define MLA_LSTORE(slot) do { LAS unsigned char* sb_ = lds + (slot) * MLA_SLOT; *(LAS u32x4*)(sb_ + lk) = rk0; *(LAS u32x4*)(sb_ + lk + 64 * MLA_KP) = rk1; \
        *(LAS u32x4*)(sb_ + lv) = rv0; *(LAS u32x4*)(sb_ + lv + 64 * 64) = rv1; *(LAS u32x4*)(sb_ + lp) = rp; } while (0)
    MLA_GLOAD(0); MLA_LSTORE(0); MLA_GLOAD(1); MLA_LSTORE(1);
    __syncthreads();
    f32x16 o0, o1;
#pragma unroll
    for (int r = 0; r < 16; ++r) { o0[r] = 0.f; o1[r] = 0.f; }
    float m = 0.f, l = 0.f;
    const int kro = q * MLA_KP + hi * 16;
    const int vro = MLA_KTB + (4 * hi + ((lane & 15) >> 2)) * 64 + (16 * ((lane >> 4) & 1) + 4 * (lane & 3)) * 2;
    f32x16 sa0, sa1, sb0, sb1, negm;
#pragma unroll
    for (int r = 0; r < 16; ++r) negm[r] = 0.f;
    m = 0.f;
#define MLA_QK(S0, S1, slot, sub) do { const LAS unsigned char* kb_ = lds + (slot) * MLA_SLOT + (sub) * 64 * MLA_KP + kro; \
        { const bf16x8 k0_ = *(const LAS bf16x8*)(kb_), k1_ = *(const LAS bf16x8*)(kb_ + 32 * MLA_KP); \
          S0 = __builtin_amdgcn_mfma_f32_32x32x16_bf16(k0_, qf[0], negm, 0, 0, 0); S1 = __builtin_amdgcn_mfma_f32_32x32x16_bf16(k1_, qf[0], negm, 0, 0, 0); } \
        _Pragma("unroll") for (int d0 = 1; d0 < 6; ++d0) { const bf16x8 k0_ = *(const LAS bf16x8*)(kb_ + d0 * 32), k1_ = *(const LAS bf16x8*)(kb_ + 32 * MLA_KP + d0 * 32); \
            S0 = __builtin_amdgcn_mfma_f32_32x32x16_bf16(k0_, qf[d0], S0, 0, 0, 0); S1 = __builtin_amdgcn_mfma_f32_32x32x16_bf16(k1_, qf[d0], S1, 0, 0, 0); } } while (0)
#define MAX3(a, b, c) __builtin_fmaxf(__builtin_fmaxf((a), (b)), (c))
#define MLA_STEP(C0, C1, N0, N1, HASN, NSLOT, NSUB, CSLOT, CSUB, FIRST) do { \
        if (HASN) MLA_QK(N0, N1, NSLOT, NSUB); \
        float ba = MAX3(C0[0], C0[1], C1[0]), bb = MAX3(C0[2], C0[3], C1[1]); ba = MAX3(ba, C1[2], C1[3]); \
        _Pragma("unroll") for (int r = 4; r < 16; r += 4) { ba = MAX3(ba, C0[r], C0[r + 1]); bb = MAX3(bb, C0[r + 2], C0[r + 3]); ba = MAX3(ba, C1[r], C1[r + 1]); bb = MAX3(bb, C1[r + 2], C1[r + 3]); } \
        float bm = xhalf_max(__builtin_fmaxf(ba, bb)); \
        if ((FIRST) || __any(bm > MLA_THR)) {                                \
            const float dl = (FIRST) ? bm : __builtin_fmaxf(bm, 0.f), f = fast_exp2(-dl); m += dl; l *= f; \
            _Pragma("unroll") for (int r = 0; r < 16; ++r) { o0[r] *= f; o1[r] *= f; C0[r] -= dl; C1[r] -= dl; negm[r] = -m; } \
            if (HASN) { _Pragma("unroll") for (int r = 0; r < 16; ++r) { N0[r] -= dl; N1[r] -= dl; } } } \
        float ps = 0.f; \
        _Pragma("unroll") for (int r = 0; r < 16; ++r) { C0[r] = fast_exp2(C0[r]); C1[r] = fast_exp2(C1[r]); ps += C0[r] + C1[r]; } \
        l += ps; \
        const bf16x8 p0 = pfrag(C0, 0), p1 = pfrag(C0, 8), p2 = pfrag(C1, 0), p3 = pfrag(C1, 8); \
        const LAS unsigned char* vb = lds + (CSLOT) * MLA_SLOT + (CSUB) * 64 * 64 + vro; \
        MLA_PV(0, p0); MLA_PV(1, p1); MLA_PV(2, p2); MLA_PV(3, p3); } while (0)
#define MLA_PV(S, P) do { const bf16x8 va = cat8(vtr(vb + (S) * 1024), vtr(vb + (S) * 1024 + 512)), vc = cat8(vtr(vb + MLA_TK * 64 + (S) * 1024), vtr(vb + MLA_TK * 64 + (S) * 1024 + 512)); \
            o0 = __builtin_amdgcn_mfma_f32_32x32x16_bf16(va, P, o0, 0, 0, 0); o1 = __builtin_amdgcn_mfma_f32_32x32x16_bf16(vc, P, o1, 0, 0, 0); } while (0)
    MLA_QK(sa0, sa1, 0, 0);
    int sc = 0, sn = 1, sw = 2;
    constexpr int NT = SEQ / MLA_TK;
    for (int T = 0; T < NT; ++T) {
        const bool has1 = T + 1 < NT, has2 = T + 2 < NT;
        if (has2) MLA_GLOAD(T + 2);
        MLA_STEP(sa0, sa1, sb0, sb1, true, sc, 1, sc, 0, T == 0);
        MLA_STEP(sb0, sb1, sa0, sa1, has1, sn, 0, sc, 1, false);
        if (has2) MLA_LSTORE(sw);
        __syncthreads();
        const int tmp = sc; sc = sn; sn = sw; sw = tmp;
    }
#undef MAX3
#undef MLA_GLOAD
#undef MLA_LSTORE
#undef MLA_QK
#undef MLA_STEP
#undef MLA_PV
    const float inv = 1.f / xhalf_sum(l);
    bf16_t* op = P4_F8 ? (bf16_t*)((unsigned char*)Y + (rb + qblk * 256 + wid * 32 + q) * 1536 + h * 64 + 4 * hi) : Y + (rb + qblk * 256 + wid * 32 + q) * 1536 + h * 64 + 4 * hi;
#pragma unroll
    for (int j = 0; j < 4; ++j) {
        u32x2 w0, w1; w0.x = cvt_pk_bf16(o0[4 * j] * inv, o0[4 * j + 1] * inv); w0.y = cvt_pk_bf16(o0[4 * j + 2] * inv, o0[4 * j + 3] * inv);
        w1.x = cvt_pk_bf16(o1[4 * j] * inv, o1[4 * j + 1] * inv); w1.y = cvt_pk_bf16(o1[4 * j + 2] * inv, o1[4 * j + 3] * inv);
        if (P4_F8) { const float i16 = inv * 16.f; *(unsigned*)((unsigned char*)op + 8 * j) = pk_fp8x4(o0[4 * j] * i16, o0[4 * j + 1] * i16, o0[4 * j + 2] * i16, o0[4 * j + 3] * i16); *(unsigned*)((unsigned char*)op + 32 + 8 * j) = pk_fp8x4(o1[4 * j] * i16, o1[4 * j + 1] * i16, o1[4 * j + 2] * i16, o1[4 * j + 3] * i16); }
        else { *(u32x2*)(op + 8 * j) = w0; *(u32x2*)(op + 32 + 8 * j) = w1; }
    }
}
}
constexpr int NWAVES = 8, NTHREADS = 512;
constexpr int LDS_BYTES = 147456;
constexpr int MISC_OFF = 131072 + 320;
#define LDS_WAIT() asm volatile("s_waitcnt lgkmcnt(0)" ::: "memory")

struct Args { const float* in[22]; float* out; unsigned char* ws; int ph_lo, ph_hi; };

enum { MAP_ID = 0, MAP_WIN, MAP_WUQ, MAP_WUKV, MAP_GATE, MAP_UP, MAP_WIN8 };
__device__ __forceinline__ int map_row(int map, int n) {
    if (map == MAP_WIN || map == MAP_WIN8) {
        const int o = map == MAP_WIN8 ? P1_F8_FROM * 256 : 0;
        if (n < 384) return n - o;
        if (n < 416) { const int i = n - 384; return 384 + (i < 16 ? 2 * i : 2 * (i - 16) + 1) - o; }
        return n + 96 - o;
    }
    if (map == MAP_WUQ) { const int h = n / 96, j = n % 96; if (j < 64) return n; const int i = j - 64; return h * 96 + 64 + (i < 16 ? 2 * i : 2 * (i - 16) + 1); }
    if (map == MAP_WUKV) { const int h = n >> 7, j = n & 127; return j < 64 ? h * 64 + j : 512 + h * 64 + (j - 64); }
    if (map == MAP_GATE) return (n >> 7) * 256 + (n & 127);
    if (map == MAP_UP) return (n >> 7) * 256 + 128 + (n & 127);
    return n;
}
template <bool F8 = false>
__device__ __forceinline__ void cvt_item(const float* src, int ldsrc, int nblk, const float* gain, float scale, bf16_t* dst, int lddst, int kdst0, int map, LAS float* scr, int item, int lane) {
    const int kb = item / nblk, nb = item % nblk, k0 = 64 * kb, n0 = 32 * nb;
    f32x4 v[8]; float gs[8];
#pragma unroll
    for (int i = 0; i < 8; ++i) { const int idx = i * 64 + lane, kk = idx >> 3, c4 = idx & 7; v[i] = *(const f32x4*)(src + (size_t)(k0 + kk) * ldsrc + n0 + 4 * c4); gs[i] = gain ? gain[k0 + kk] * scale : scale; }
#pragma unroll
    for (int i = 0; i < 8; ++i) { const int idx = i * 64 + lane, kk = idx >> 3, c4 = idx & 7; LAS float* d = scr + kk * 33 + 4 * c4; d[0] = v[i].x * gs[i]; d[1] = v[i].y * gs[i]; d[2] = v[i].z * gs[i]; d[3] = v[i].w * gs[i]; }
    LDS_WAIT(); asm volatile("" ::: "memory");
    const int c = lane & 7;
#pragma unroll
    for (int j = 0; j < 4; ++j) { const int n = (lane >> 3) + 8 * j; const LAS float* s = scr + (8 * c) * 33 + n;
        u32x4 o; o.x = cvt_pk_bf16(s[0 * 33], s[1 * 33]); o.y = cvt_pk_bf16(s[2 * 33], s[3 * 33]); o.z = cvt_pk_bf16(s[4 * 33], s[5 * 33]); o.w = cvt_pk_bf16(s[6 * 33], s[7 * 33]);
        if constexpr (F8) { u32x2 o8; o8.x = pk_fp8x4(s[0 * 33], s[1 * 33], s[2 * 33], s[3 * 33]); o8.y = pk_fp8x4(s[4 * 33], s[5 * 33], s[6 * 33], s[7 * 33]);
            *(u32x2*)((unsigned char*)dst + (size_t)map_row(map, n0 + n) * lddst + kdst0 + k0 + 8 * c) = o8; }
        else *(u32x4*)(dst + (size_t)map_row(map, n0 + n) * lddst + kdst0 + k0 + 8 * c) = o; }
    LDS_WAIT(); asm volatile("" ::: "memory");
}

struct Ctx {
    LAS unsigned char* lds; int tid, lane, wave, vcu, G, gw, NGW;
    const float* const* in; float* out; unsigned char* ws;
};

__device__ __forceinline__ void phase_prologue(const Ctx& C) {
    LAS float* scr = (LAS float*)(C.lds + C.wave * 16384);
    unsigned char* ws = C.ws;
    constexpr int I_IN = 16 * 181, I_UQ = 4 * 24, I_UKV = 2 * 32, I_BR = 8 * 32, I_OUT = 16 * 32, I_L = I_IN + I_UQ + I_UKV + 3 * I_BR + I_OUT;
    constexpr int I_G = 16 * 88, I_D = 44 * 32, NIT = 2 * I_L + 2 * I_G + I_D;
    for (int it = C.gw; it < NIT; it += C.NGW) {
        int r = it;
        if (r < 2 * I_L) { const int l = r / I_L; r -= l * I_L;
            if (r < I_IN) { if (r % 181 >= (P1_F8_FROM <= 1 ? P1_F8_FROM * 8 : (P1_F8_FROM * 256 - 96) / 32)) cvt_item<true>(C.in[2] + (size_t)l * DM * INC, INC, 181, C.in[1] + l * DM, 256.f, (bf16_t*)(ws + WS_WIN8 + l * SZ_WIN8), DM, 0, MAP_WIN8, scr, r, C.lane);
                            else cvt_item(C.in[2] + (size_t)l * DM * INC, INC, 181, C.in[1] + l * DM, 1.f, (bf16_t*)(ws + WS_WIN + l * SZ_WIN), DM, 0, MAP_WIN, scr, r, C.lane); continue; } r -= I_IN;
            if (r < I_UQ) { cvt_item(C.in[4] + (size_t)l * 256 * 768, 768, 24, C.in[3] + l * 256, 0.10206207261596577f * LOG2E, (bf16_t*)(ws + WS_WUQ + l * SZ_WUQ), 256, 0, MAP_WUQ, scr, r, C.lane); continue; } r -= I_UQ;
            if (r < I_UKV) { cvt_item(C.in[6] + (size_t)l * 128 * 1024, 1024, 32, C.in[5] + l * 128, 1.f, (bf16_t*)(ws + WS_WUKV + l * SZ_WUKV), 256, 0, MAP_WUKV, scr, r, C.lane); continue; } r -= I_UKV;
            if (r < 3 * I_BR) { const int br = r / I_BR; r -= br * I_BR; cvt_item<P4_F8 != 0>(C.in[9 + br] + (size_t)l * 512 * DM, DM, 32, nullptr, P4_F8 ? 256.f : 1.f, (bf16_t*)(ws + WS_WBR + l * SZ_WBR), 1536, br * 512, MAP_ID, scr, r, C.lane); continue; } r -= 3 * I_BR;
            cvt_item<P5_F8 != 0>(C.in[12] + (size_t)l * DM * DM, DM, 32, nullptr, P5_F8 ? 256.f : 1.f, (bf16_t*)(ws + WS_WOUT + l * SZ_WOUT), DM, 0, MAP_ID, scr, r, C.lane); continue; }
        r -= 2 * I_L;
        if (r < I_G) { cvt_item(C.in[14], DFF, 88, C.in[13], 1.f, (bf16_t*)(ws + WS_WGU), DM, 0, MAP_GATE, scr, r, C.lane); continue; } r -= I_G;
        if (r < I_G) { cvt_item(C.in[15], DFF, 88, C.in[13], 1.f, (bf16_t*)(ws + WS_WGU), DM, 0, MAP_UP, scr, r, C.lane); continue; } r -= I_G;
        cvt_item(C.in[16], DM, 32, nullptr, 1.f, (bf16_t*)(ws + WS_WD), DFF, 0, MAP_ID, scr, r, C.lane);
    }
    const int gt = C.vcu * NTHREADS + C.tid, NGT = C.G * NTHREADS;
    if (P1_F8_FROM <= 1) for (int i = gt; i < 2 * 6144; i += NGT) { const int l = i / 6144, r = i % 6144; const u32x4 z = {0u, 0u, 0u, 0u}; *(u32x4*)(ws + WS_WIN8 + l * SZ_WIN8 + (size_t)(416 - P1_F8_FROM * 256) * DM + (size_t)r * 16) = z; }
    for (int i = gt; i < 2 * (12288 + 16384); i += NGT) { const int l = i / (12288 + 16384); int r = i % (12288 + 16384); const u32x4 z = {0u, 0u, 0u, 0u};
        if (r < 12288) *(u32x4*)(ws + WS_WIN + l * SZ_WIN + (size_t)416 * DM * 2 + (size_t)r * 16) = z;
        else { r -= 12288; *(u32x4*)(ws + WS_WUKV + l * SZ_WUKV + (size_t)(r >> 4) * 512 + 256 + (r & 15) * 16) = z; } }
    float* cosT = (float*)(ws + WS_TAB); float* sinT = cosT + SEQ * 16; float* tabb = sinT + SEQ * 16;
    for (int i = gt; i < SEQ * 16; i += NGT) { const int pos = i >> 4, k = i & 15; const float inv = powf(10000.f, -(float)k / 16.f); const float ang = (float)pos * inv; cosT[i] = cosf(ang); sinT[i] = sinf(ang); }
    for (int i = gt; i < 4 * 8 * att::TAB_STRIDE; i += NGT) { const int kind = i / (8 * att::TAB_STRIDE), h = (i / att::TAB_STRIDE) & 7, idx = i % att::TAB_STRIDE;
        const int R = kind == 3 ? 128 : 64, dil = kind == 1 ? 4 : (kind == 2 ? 16 : 1), rel = idx - (R + 31);
        float v = NEGB; if (rel >= -R && rel <= R) v = C.in[8][t5_bucket(rel * dil) * 16 + (kind == 3 ? 8 : 0) + h] * LOG2E;
        tabb[i] = v; }
    const float* x = C.in[0]; bf16_t* xb = (bf16_t*)(ws + WS_XB); float* st = (float*)(ws + WS_ST);
    for (int row = 2 * C.gw; row < MTOK; row += 2 * C.NGW) {
        const f32x4* xr = (const f32x4*)(x + (size_t)row * DM) + C.lane; f32x4 v[8];
#pragma unroll
        for (int j = 0; j < 8; ++j) v[j] = xr[64 * j];
        float s0 = 0.f, s1 = 0.f;
#pragma unroll
        for (int j = 0; j < 8; ++j) { const float q = (v[j].x * v[j].x + v[j].y * v[j].y) + (v[j].z * v[j].z + v[j].w * v[j].w); if (j < 4) s0 += q; else s1 += q;
            u32x2 w; w.x = cvt_pk_bf16(v[j].x, v[j].y); w.y = cvt_pk_bf16(v[j].z, v[j].w); *((u32x2*)(xb + (size_t)row * DM) + C.lane + 64 * j) = w;
            if (P1_F8_FROM < 23) *((unsigned*)(ws + WS_XB8P + (size_t)(row + (j >> 2)) * DM) + C.lane + 64 * (j & 3)) = pk_fp8x4(v[j].x * 16.f, v[j].y * 16.f, v[j].z * 16.f, v[j].w * 16.f); }
        s0 = wave_sum(s0); s1 = wave_sum(s1);
        if (C.lane < 32) st[(size_t)row * 16 + C.lane] = C.lane == 0 ? s0 : (C.lane == 16 ? s1 : 0.f);
    }
}

__device__ __forceinline__ void phase_moe_weights(const Ctx& C) {
    LAS float* scr = (LAS float*)(C.lds + 40960 + C.wave * 8704);
    constexpr int I_G = 16 * 112, I_D = 56 * 32, I_E = 2 * I_G + I_D;
    for (int it = C.gw; it < NEXP * I_E; it += C.NGW) {
        const int e = it / I_E; int r = it % I_E;
        if (r < I_G) { cvt_item<MOE_F8 != 0>(C.in[18] + (size_t)e * DM * DFE, DFE, 112, C.in[13] + DM, MOE_F8 ? 256.f : 1.f, (bf16_t*)(C.ws + WS_EGU + (size_t)e * 2 * DFE * DM * (MOE_F8 ? 1 : 2)), DM, 0, MAP_GATE, scr, r, C.lane); continue; } r -= I_G;
        if (r < I_G) { cvt_item<MOE_F8 != 0>(C.in[19] + (size_t)e * DM * DFE, DFE, 112, C.in[13] + DM, MOE_F8 ? 256.f : 1.f, (bf16_t*)(C.ws + WS_EGU + (size_t)e * 2 * DFE * DM * (MOE_F8 ? 1 : 2)), DM, 0, MAP_UP, scr, r, C.lane); continue; } r -= I_G;
        cvt_item<MOE_DN_F8 != 0>(C.in[20] + (size_t)e * DFE * DM, DM, 32, nullptr, MOE_DN_F8 ? 1024.f : 1.f, (bf16_t*)(C.ws + WS_ED + (size_t)e * DM * DFE * (MOE_DN_F8 ? 1 : 2)), DFE, 0, MAP_ID, scr, r, C.lane);
    }
}

template <bool SECOND>
__device__ __forceinline__ void phase_band(const Ctx& C, const bf16_t* HM, bf16_t* PB, float* PBS, bf16_t* Y, const float* sink) {
    constexpr int IPK = MC / 2048 * 64, NIT = (SECOND ? 1 : 3) * IPK;
    const float* tabg = (const float*)(C.ws + WS_TAB) + 2 * SEQ * 16;
    att::BandPre P; att::BandItem it, nx;
    int i = C.vcu;
#define BAND_IDX(IDX) (SECOND ? 2 * IPK + (IDX) : ((IDX) < 2 * IPK ? (IDX) : (IDX) + IPK))
    if (i < NIT) { it = att::band_decode(BAND_IDX(i), IPK); att::band_issue(P, it, HM, tabg, C.tid, C.wave, C.lane); }
    for (; i < NIT; i += C.G) {
        att::band_store(P, it, C.lds, C.tid);
        bf16x8 qf[4];
#pragma unroll
        for (int d0 = 0; d0 < 4; ++d0) qf[d0] = P.q[d0];
        __syncthreads();
        const bool more = i + C.G < NIT;
        if (more) { nx = att::band_decode(BAND_IDX(i + C.G), IPK); att::band_issue(P, nx, HM, tabg, C.tid, C.wave, C.lane); }
        const int q = C.lane & 31, hi = C.lane >> 5, w = C.wave;
        if (it.kind == 3) {
            const int h = it.hh * 4 + (w >> 1), a0w = it.a0 + 32 * (w & 1); const size_t rowq = (size_t)it.b * SEQ + a0w + q;
            att::band_compute<9, 1>(qf, C.lds, 128 - it.a0, a0w, SEQ, (const LAS float*)(C.lds + att::BW_TAB) + (w >> 1) * att::TAB_STRIDE, (P4_F8 ? (bf16_t*)((unsigned char*)Y + rowq * 1536 + 1024 + h * 64 + 4 * hi) : Y + rowq * 1536 + 1024 + h * 64 + 4 * hi), nullptr, sink[h] * LOG2E, C.lane);
        } else if (it.kind == 2) {
            const int a0w = 32 * (w & 3), g = it.g0 + (w >> 2); const size_t rowq = (size_t)it.b * SEQ + (size_t)(a0w + q) * 16 + g;
            const size_t po = rowq * 512 + it.hh * 64 + 4 * hi, so = (rowq * 8 + it.hh) * 2;
            att::band_compute<5, 2>(qf, C.lds, (w >> 2) * 128, a0w, 128, (const LAS float*)(C.lds + att::BW_TAB), (P4_F8 ? (bf16_t*)((unsigned char*)Y + rowq * 1536 + 512 + it.hh * 64 + 4 * hi) : Y + rowq * 1536 + 512 + it.hh * 64 + 4 * hi), nullptr, 0.f, C.lane,
                                    PB + po, PB + (size_t)MC * 512 + po, PBS + so, PBS + (size_t)MC * 16 + so);
        } else {
            const int a0w = it.a0 + 32 * w, dil = it.kind == 0 ? 1 : 4, L = SEQ / dil, rowoff = 64 - it.a0;
            const size_t rowq = (size_t)it.b * SEQ + (size_t)(a0w + q) * dil + it.g0;
            att::band_compute<5, 0>(qf, C.lds, rowoff, a0w, L, (const LAS float*)(C.lds + att::BW_TAB), PB + (size_t)it.kind * MC * 512 + rowq * 512 + it.hh * 64 + 4 * hi,
                                    PBS + (size_t)it.kind * MC * 16 + (rowq * 8 + it.hh) * 2, 0.f, C.lane);
        }
        __syncthreads();
        it = nx;
    }
#undef BAND_IDX
}

__device__ __forceinline__ void phase_mla(const Ctx& C, const bf16_t* Q, const bf16_t* KV, const bf16_t* Zc, bf16_t* Y) {
    constexpr int NU = MC / 256 * 8;
    for (int u = C.vcu; u < NU; u += C.G) { const int qblk = u & 7, bh = u >> 3; att::mla_unit(Q, KV, Zc, Y, bh >> 3, bh & 7, qblk, C.lds, C.tid, C.wave, C.lane); }
}

__device__ __forceinline__ void phase_route(const Ctx& C) {
    LAS float* wr = (LAS float*)C.lds; LAS int* cnt = (LAS int*)(C.lds + 32768);
    const float* g2 = C.in[13] + DM; const float* router = C.in[17];
    for (int i = C.tid; i < DM * 8; i += NTHREADS) wr[i] = router[i] * g2[i >> 3];
    if (C.tid < 16) cnt[C.tid] = 0;
    __syncthreads();
    int* sel = (int*)(C.ws + WS_SEL); float* gwp = (float*)(C.ws + WS_GW); float* rr = (float*)(C.ws + WS_RR);
    const int w = blockIdx.x;
    for (int j = 0; j < 16; ++j) {
        const int tok = w * 128 + C.wave * 16 + j;
        const u32x2* xr = (const u32x2*)((const bf16_t*)(C.ws + WS_XB) + (size_t)tok * DM) + C.lane;
        float lg[8], ss = 0.f;
#pragma unroll
        for (int e = 0; e < 8; ++e) lg[e] = 0.f;
#pragma unroll
        for (int q = 0; q < 4; ++q) { const u32x2 wv = xr[64 * q]; const f32x4 v = {bf_lo(wv.x), bf_hi(wv.x), bf_lo(wv.y), bf_hi(wv.y)}; ss += (v.x * v.x + v.y * v.y) + (v.z * v.z + v.w * v.w);
            const int k = 4 * C.lane + 256 * q;
            if (MOE_F8) *(unsigned*)(C.ws + WS_XB8 + (size_t)tok * DM + k) = pk_fp8x4(v.x * 16.f, v.y * 16.f, v.z * 16.f, v.w * 16.f);
#pragma unroll
            for (int c = 0; c < 4; ++c) { const float xv = v[c]; const f32x4 w0 = *(const LAS f32x4*)(wr + (k + c) * 8), w1 = *(const LAS f32x4*)(wr + (k + c) * 8 + 4);
                lg[0] += xv * w0.x; lg[1] += xv * w0.y; lg[2] += xv * w0.z; lg[3] += xv * w0.w; lg[4] += xv * w1.x; lg[5] += xv * w1.y; lg[6] += xv * w1.z; lg[7] += xv * w1.w; } }
        ss = wave_sum(ss);
#pragma unroll
        for (int e = 0; e < 8; ++e) lg[e] = wave_sum(lg[e]);
        const float r = rsqrtf(ss * (1.f / 1024.f) + EPS);
        if (C.lane == 0) {
            int i1 = 0; float v1 = lg[0];
#pragma unroll
            for (int e = 1; e < 8; ++e) if (lg[e] > v1) { v1 = lg[e]; i1 = e; }
            int i2 = -1; float v2 = -3e38f;
#pragma unroll
            for (int e = 0; e < 8; ++e) if (e != i1 && lg[e] > v2) { v2 = lg[e]; i2 = e; }
            const float e2 = expf((v2 - v1) * r);
            sel[tok * 2] = i1; sel[tok * 2 + 1] = i2; gwp[tok * 2] = 1.f / (1.f + e2); gwp[tok * 2 + 1] = e2 / (1.f + e2); rr[tok] = r;
            __hip_atomic_fetch_add(&cnt[i1], 1, __ATOMIC_RELAXED, __HIP_MEMORY_SCOPE_WORKGROUP); __hip_atomic_fetch_add(&cnt[8 + i2], 1, __ATOMIC_RELAXED, __HIP_MEMORY_SCOPE_WORKGROUP);
        }
    }
    __syncthreads();
    if (C.tid < 16) ((int*)(C.ws + WS_META))[MI_CNT + (C.tid >> 3) * 2048 + w * 8 + (C.tid & 7)] = cnt[C.tid];
}

__device__ __forceinline__ void phase_sort(const Ctx& C) {
    LAS int* tot = (LAS int*)C.lds; LAS int* pre = tot + 16; LAS int* base = tot + 32;
    int* meta = (int*)(C.ws + WS_META); const int w = blockIdx.x;
    if (C.tid < 16) { const int k = C.tid >> 3, e = C.tid & 7; int t = 0, p = 0;
        for (int w2 = 0; w2 < 256; ++w2) { const int c = meta[MI_CNT + k * 2048 + w2 * 8 + e]; t += c; if (w2 < w) p += c; }
        tot[C.tid] = t; pre[C.tid] = p; }
    __syncthreads();
    if (C.tid < 16) { const int k = C.tid >> 3, e = C.tid & 7; int b = 0; for (int e2 = 0; e2 < e; ++e2) b += (tot[k * 8 + e2] + 255) & ~255; base[C.tid] = b; }
    __syncthreads();
    const int* sel = (const int*)(C.ws + WS_SEL); const float* gwp = (const float*)(C.ws + WS_GW);
    int* rowtok = (int*)(C.ws + WS_ROWTOK); float* rowgw = (float*)(C.ws + WS_ROWGW); float* rowrr = (float*)(C.ws + WS_ROWRR); const float* rr = (const float*)(C.ws + WS_RR);
    if (C.wave < 2) { const int k = C.wave; LAS int* runL = tot + 48 + k * 8;
        if (C.lane < 8) runL[C.lane] = base[k * 8 + C.lane] + pre[k * 8 + C.lane];
        for (int j = 0; j < 2; ++j) { const int tok = w * 128 + j * 64 + C.lane; const int e = sel[tok * 2 + k]; int pos = 0;
#pragma unroll 1
            for (int e2 = 0; e2 < 8; ++e2) { const unsigned long long mk = __ballot(e == e2); const int r0 = runL[e2]; const int rank = __popcll(mk & ((1ull << C.lane) - 1ull));
                if (e == e2) pos = r0 + rank; if (C.lane == 0) runL[e2] = r0 + __popcll(mk); }
            rowtok[k * MOE_ROWS + pos] = tok; rowgw[k * MOE_ROWS + pos] = gwp[tok * 2 + k]; rowrr[k * MOE_ROWS + pos] = rr[tok]; } }
    if (w < 16) { const int k = w >> 3, e = w & 7; const int t = tot[k * 8 + e], b = base[k * 8 + e], pe = (t + 255) & ~255;
        for (int i = b + t + C.tid; i < b + pe; i += NTHREADS) { rowtok[k * MOE_ROWS + i] = -1; rowgw[k * MOE_ROWS + i] = 0.f; rowrr[k * MOE_ROWS + i] = 0.f; } }
    if (w == 16 && C.tid < 2) { const int k = C.tid; int nt = 0;
        for (int e = 0; e < 8; ++e) { const int n = (tot[k * 8 + e] + 255) >> 8; for (int i = 0; i < n; ++i) meta[MI_TILEE + k * 160 + nt + i] = e; nt += n; }
        meta[MI_NTILE + k] = nt; }
}

__device__ __forceinline__ void phase_final(const Ctx& C) {
    const float* g = C.in[21];
    for (int row = 2 * C.gw; row < MTOK; row += 2 * C.NGW) {
        f32x4 v[8]; float s0 = 0.f, s1 = 0.f;
#pragma unroll
        for (int j = 0; j < 8; ++j) { const u32x2 wv = ((const u32x2*)xm_row(C.ws, row + (j >> 2)))[C.lane + 64 * (j & 3)]; v[j] = (f32x4){bf_lo(wv.x), bf_hi(wv.x), bf_lo(wv.y), bf_hi(wv.y)}; }
#ifdef PROBE_NAN
#pragma unroll
        for (int j = 0; j < 8; ++j) { v[j].x = v[j].x == v[j].x && fabsf(v[j].x) < 1e30f ? v[j].x : 0.f; v[j].y = v[j].y == v[j].y && fabsf(v[j].y) < 1e30f ? v[j].y : 0.f; v[j].z = v[j].z == v[j].z && fabsf(v[j].z) < 1e30f ? v[j].z : 0.f; v[j].w = v[j].w == v[j].w && fabsf(v[j].w) < 1e30f ? v[j].w : 0.f; }
#endif
#pragma unroll
        for (int j = 0; j < 8; ++j) { const float q = (v[j].x * v[j].x + v[j].y * v[j].y) + (v[j].z * v[j].z + v[j].w * v[j].w); if (j < 4) s0 += q; else s1 += q; }
        const float r0 = rsqrtf(wave_sum(s0) * (1.f / 1024.f) + EPS), r1 = rsqrtf(wave_sum(s1) * (1.f / 1024.f) + EPS);
        f32x4* orow = (f32x4*)(C.out + (size_t)row * DM) + C.lane;
#pragma unroll
        for (int j = 0; j < 8; ++j) orow[64 * j] = v[j] * (j < 4 ? r0 : r1) * ((const f32x4*)g)[C.lane + 64 * (j & 3)];
    }
}
#ifndef MKP
#define MKP 0x1ffff
#endif
#ifndef ALEPI
#define ALEPI true
#endif
#ifndef ALEPI1
#define ALEPI1 ALEPI
#endif
#ifndef DUPK
#define DUPK 0
#endif
#ifdef PROBE_TIMER
#define PROBE_T0 __syncthreads(); const unsigned long long pt0_ = __builtin_amdgcn_s_memrealtime()
#define PROBE_T1(slot) __syncthreads(); if (threadIdx.x == 0) { const unsigned long long pt1_ = __builtin_amdgcn_s_memrealtime(); atomicAdd((unsigned*)(ws + WS_CTL) + CW_Q + 2048 + (slot), (unsigned)(pt1_ - pt0_)); }
#else
#define PROBE_T0
#define PROBE_T1(slot)
#endif
#define REP(bit) for (int rep_ = 0; rep_ < ((DUPK & (bit)) ? 2 : 1); ++rep_)
constexpr int PH_PER_CHUNK = 3, PH_LAYER_TAIL = 2;
constexpr int PH_L0 = 1, PH_FFN = PH_L0 + PH_PER_CHUNK * NCHUNK + PH_LAYER_TAIL, PH_L1 = PH_FFN + 2, PH_MOE = PH_L1 + PH_PER_CHUNK * NCHUNK + PH_LAYER_TAIL, PH_FINAL = PH_MOE + (MOE_NOSPLIT ? 5 : 7), PH_TOTAL = PH_FINAL + 1;

__global__ void __launch_bounds__(NTHREADS, 2) mega(Args args) {
    extern __shared__ __attribute__((aligned(16))) unsigned char lds_raw[];
#define MKCTX Ctx C; { int t_ = threadIdx.x; asm volatile("" : "+v"(t_)); C.lds = (LAS unsigned char*)lds_raw; C.tid = t_; C.lane = t_ & 63; C.wave = __builtin_amdgcn_readfirstlane(t_ >> 6); \
    C.G = gridDim.x; { const int bx = blockIdx.x; C.vcu = (C.G % 8 == 0) ? (bx % 8) * (C.G / 8) + bx / 8 : bx; } \
    C.gw = C.vcu * NWAVES + C.wave; C.NGW = C.G * NWAVES; C.in = args.in; C.out = args.out; C.ws = args.ws; }
    volatile LAS unsigned* MISC = (volatile LAS unsigned*)((LAS unsigned char*)lds_raw + MISC_OFF);
    if (threadIdx.x < 32) MISC[threadIdx.x] = 0u;
    __syncthreads();
    unsigned char* ws = args.ws;
    XcdBarrier bar; bar.bar = (unsigned*)(ws + WS_CTL) + CW_BAR; bar.x = 0; bar.st = nullptr;
    const int lo = args.ph_lo, hi = args.ph_hi;
    const bool use_bar = (hi - lo) > 1;
    if (use_bar) bar = xcd_barrier_post((unsigned*)(ws + WS_CTL) + CW_BAR, MISC + 8);
    int ph = 0;
#define IN_PH (ph >= lo && ph < hi)
#ifdef PROBE_BAR
    const unsigned long long pk0_ = __builtin_amdgcn_s_memrealtime();
#define END_PH do { if (ph >= lo && ph + 1 < hi) { __syncthreads(); const unsigned long long pb0_ = __builtin_amdgcn_s_memrealtime(); xcd_barrier(bar); \
        if (threadIdx.x == 0 && (((unsigned)(PROBE_BAR) >> ph) & 1u)) atomicAdd((unsigned*)(ws + WS_CTL) + CW_Q + 2048, (unsigned)(__builtin_amdgcn_s_memrealtime() - pb0_)); } ++ph; } while (0)
#else
#define END_PH do { if (ph >= lo && ph + 1 < hi) xcd_barrier(bar); ++ph; } while (0)
#endif

    bf16_t* xb = (bf16_t*)(ws + WS_XB); float* st = (float*)(ws + WS_ST);
    const float* cosT = (const float*)(ws + WS_TAB); const float* sinT = cosT + SEQ * 16;

    if (IN_PH) REP(1) { MKCTX; if (MKP & 1) phase_prologue(C); }
    END_PH;
#ifdef PROBE_SLEEP
    { const unsigned long long t0_ = __builtin_amdgcn_s_memrealtime(); while (__builtin_amdgcn_s_memrealtime() - t0_ < (unsigned long long)(PROBE_SLEEP) * 100ull) __builtin_amdgcn_s_sleep(64); }
#endif

#define CHUNK_BODY(l, c) \
{ \
            const int row0 = c * MC; \
            bf16_t* Z = (bf16_t*)(ws + WS_Z); bf16_t* Q = (bf16_t*)(ws + WS_Q); bf16_t* KV = TMP_IN_OUT ? (bf16_t*)args.out : (bf16_t*)(ws + WS_KV); bf16_t* Y = (bf16_t*)(ws + WS_Y + (size_t)row0 * 1536 * (P4_F8 ? 1 : 2)); \
            bf16_t* PB = TMP_IN_OUT ? (bf16_t*)args.out + (size_t)MC * 1024 : (bf16_t*)(ws + WS_PB); float* PBS = (float*)(ws + WS_PBS); float* SQ = (float*)(ws + WS_SQ); float* SKV = SQ + (size_t)MC * 4; \
 \
            if (IN_PH && (MKP & 2)) REP(2) { MKCTX; \
                pg8::Gemm g{xb + (size_t)row0 * DM, (const bf16_t*)(ws + WS_WIN + l * SZ_WIN), DM, DM, DM, nullptr}; \
                pg8::StaticOrder S; S.init(MC, P1_F8_FROM * 256, C.G, (int)blockIdx.x); \
                pg8::EpiIn E{Z, st + (size_t)row0 * 16, SQ, SKV, cosT, sinT, ws + WS_GB + (size_t)row0 * 3072, (bf16_t*)(ws + WS_QKV), ws, 0, 1.f}; \
                pg8::gemm_phase<pg8::EpiIn, pg8::StaticOrder, ALEPI1, false>(C.lds, g, S, E); \
            } \
            if (IN_PH && (MKP & 2) && P1_F8_FROM < 23) REP(2) { MKCTX;                          \
                pg8::Gemm g{(const bf16_t*)(ws + WS_XB8P + (size_t)row0 * DM), (const bf16_t*)(ws + WS_WIN8 + l * SZ_WIN8), DM / 2, DM / 2, DM / 2, nullptr}; \
                pg8::StaticOrder S; S.init(MC, (23 - P1_F8_FROM) * 256, C.G, (int)((blockIdx.x + (P1_F8_FROM * (MC / 256)) % 256) % C.G)); \
                pg8::EpiIn E{Z, st + (size_t)row0 * 16, SQ, SKV, cosT, sinT, ws + WS_GB + (size_t)row0 * 3072, (bf16_t*)(ws + WS_QKV), ws, P1_F8_FROM, 1.f / 4096.f}; \
                pg8::gemm_phase<pg8::EpiIn, pg8::StaticOrder, ALEPI1, false, false, true>(C.lds, g, S, E); \
            } \
            END_PH; \
 \
            if (IN_PH) { \
                if (MKP & 4) REP(4) { MKCTX; pg8::Gemm g{Z + ZO_CQ, (const bf16_t*)(ws + WS_WUQ + l * SZ_WUQ), 256, ZW, 256, nullptr}; \
                  pg8::StaticOrder S; S.init(MC, 768, C.G, (int)blockIdx.x); \
                  pg8::EpiQ E{Q, SQ, cosT, sinT}; \
                  pg8::gemm_phase<pg8::EpiQ, pg8::StaticOrder, ALEPI, false>(C.lds, g, S, E); } \
                if (MKP & 8) REP(8) { MKCTX; pg8::Gemm g{Z + ZO_CKV, (const bf16_t*)(ws + WS_WUKV + l * SZ_WUKV), 256, ZW, 256, nullptr}; \
                  pg8::StaticOrder S; S.init(MC, 1024, C.G, (int)((blockIdx.x + 128) % C.G)); \
                  pg8::EpiKV E{KV, SKV}; \
                  pg8::gemm_phase<pg8::EpiKV, pg8::StaticOrder, ALEPI, false>(C.lds, g, S, E); } \
                if (MKP & 16) REP(16) { MKCTX; phase_band<false>(C, (const bf16_t*)(ws + WS_QKV), PB, PBS, Y, C.in[7] + l * 8); } \
            } \
            END_PH; \
 \
            if (IN_PH) { \
                if (MKP & 32) REP(32) { MKCTX; phase_band<true>(C, (const bf16_t*)(ws + WS_QKV), PB, PBS, Y, C.in[7] + l * 8); } \
                if (MKP & 64) REP(64) { MKCTX; PROBE_T0; phase_mla(C, Q, KV, Z, Y); PROBE_T1(rep_); } \
            } \
            END_PH; \
 \
}
#define LAYER_TAIL(l) \
{ const int row0 = 0; bf16_t* MG = (bf16_t*)(ws + WS_MG); bf16_t* Y = (bf16_t*)(ws + WS_Y); (void)Y; \
            if (IN_PH && (MKP & 128)) REP(128) { MKCTX; \
                pg8::Gemm g{Y, (const bf16_t*)(ws + WS_WBR + l * SZ_WBR), P4_F8 ? 768 : 1536, P4_F8 ? 768 : 1536, P4_F8 ? 768 : 1536, nullptr}; \
                pg8::StaticOrder S; S.init(MTOK, DM, C.G, (int)blockIdx.x); \
                pg8::EpiBr E{ws + WS_GB, MG, ws}; \
                pg8::gemm_phase<pg8::EpiBr, pg8::StaticOrder, ALEPI, false, false, P4_F8 != 0>(C.lds, g, S, E); \
            } \
            END_PH; \
 \
            if (IN_PH && (MKP & 256)) REP(l == 0 ? 256 : 0) { MKCTX; \
                pg8::Gemm g{MG, (const bf16_t*)(ws + WS_WOUT + l * SZ_WOUT), P5_F8 ? DM / 2 : DM, P5_F8 ? DM / 2 : DM, P5_F8 ? DM / 2 : DM, nullptr}; \
                pg8::StaticOrder S; S.init(MTOK, DM, C.G, (int)blockIdx.x); \
                pg8::EpiRes<false> E{xb, st, row0, nullptr, P5_F8 ? 1.f / 4096.f : 1.f}; pg8::gemm_phase<pg8::EpiRes<false>, pg8::StaticOrder, ALEPI, false, true, P5_F8 != 0>(C.lds, g, S, E); \
            } \
            END_PH; \
}
#define FFN_BODY() \
{ \
            bf16_t* ACT = (bf16_t*)(ws + WS_ACT); \
            if (IN_PH && (MKP & 512)) REP(512) { MKCTX; \
                pg8::Gemm g{xb, (const bf16_t*)(ws + WS_WGU), DM, DM, DM, nullptr}; \
                pg8::StaticOrder S; S.init(MTOK, 2 * DFF, C.G, (int)blockIdx.x); \
                pg8::EpiGU E{ACT, st, DFF, ws}; \
                pg8::gemm_phase<pg8::EpiGU, pg8::StaticOrder, ALEPI, false>(C.lds, g, S, E); \
            } \
            END_PH; \
            if (IN_PH && (MKP & 1024)) { MKCTX; \
                pg8::Gemm g{ACT, (const bf16_t*)(ws + WS_WD), DFF, DFF, DFF, nullptr}; \
                pg8::StaticOrder S; S.init(MTOK, DM, C.G, (int)blockIdx.x); \
                pg8::EpiRes<(P1_F8_FROM < 23)> E{xb, st, 0, ws + WS_XB8P, 1.f};                                \
                pg8::gemm_phase<pg8::EpiRes<(P1_F8_FROM < 23)>, pg8::StaticOrder, ALEPI, false, true>(C.lds, g, S, E); \
            } \
            END_PH; \
}
#define MOE_HEAD() \
{ \
            if (IN_PH) { if (MKP & 2048) REP(2048) { MKCTX; phase_route(C); } if (MKP & 4096) REP(4096) { MKCTX; phase_moe_weights(C); } } \
            END_PH; \
            if (IN_PH && (MKP & 8192)) { MKCTX; phase_sort(C); } \
            END_PH; \
}
#define MOE_GU(kh, dyn) { const int k = MOE_NOSPLIT ? (kh) : (kh) >> 1, half = MOE_NOSPLIT ? 0 : (kh) & 1; MKCTX; \
        const int* rowtok = (const int*)(ws + WS_ROWTOK) + k * MOE_ROWS; \
        bf16_t* MACT = (bf16_t*)(ws + WS_MACT + (MOE_NOSPLIT ? (size_t)k * MOE_ROWS * DFE : (size_t)half * MOE_ROWS * DF0 * (MOE_DN_F8 ? 1 : 2))); const int dfw = MOE_NOSPLIT ? DFE : (half ? DF1 : DF0); \
        pg8::Gemm g{MOE_F8 ? (const bf16_t*)(ws + WS_XB8) : xb, (const bf16_t*)(ws + WS_EGU), MOE_F8 ? DM / 2 : DM, MOE_F8 ? DM / 2 : DM, MOE_F8 ? DM / 2 : DM, rowtok}; \
        pg8::DynMoeOrder S{(unsigned*)(ws + WS_CTL) + CW_Q + 64 * (kh), (volatile LAS int*)(C.lds + MISC_OFF + 64), meta[MI_NTILE + k], dfw / 128, 28, half ? DF0 / 128 : 0, meta + MI_TILEE + k * 160, C.vcu}; \
        pg8::EpiGUMoe E{MACT, (const float*)(ws + WS_ROWRR) + k * MOE_ROWS, dfw, ws}; \
        pg8::gemm_phase<pg8::EpiGUMoe, pg8::DynMoeOrder, ALEPI, true, false, MOE_F8 != 0>(C.lds, g, S, E); }
#define MOE_DN(kh) { const int k = MOE_NOSPLIT ? (kh) : (kh) >> 1, half = MOE_NOSPLIT ? 0 : (kh) & 1; MKCTX; \
        const int* rowtok = (const int*)(ws + WS_ROWTOK) + k * MOE_ROWS; const float* rowgw = (const float*)(ws + WS_ROWGW) + k * MOE_ROWS; \
        bf16_t* MACT = (bf16_t*)(ws + WS_MACT + (MOE_NOSPLIT ? (size_t)k * MOE_ROWS * DFE : (size_t)half * MOE_ROWS * DF0 * (MOE_DN_F8 ? 1 : 2))); const int dfw = MOE_NOSPLIT ? DFE : (half ? DF1 : DF0); \
        pg8::Gemm g{MACT, (const bf16_t*)(ws + WS_ED + (size_t)half * DF0 * (MOE_DN_F8 ? 1 : 2)), MOE_DN_F8 ? dfw / 2 : dfw, MOE_DN_F8 ? dfw / 2 : dfw, MOE_DN_F8 ? DFE / 2 : DFE, nullptr}; \
        pg8::MoeOrder S{meta[MI_NTILE + k], 4, C.G, (int)blockIdx.x, 4, 0, meta + MI_TILEE + k * 160}; \
        if ((kh) == 0) { pg8::EpiDnMoe<true> E{ws, rowtok, rowgw}; pg8::gemm_phase<pg8::EpiDnMoe<true>, pg8::MoeOrder, ALEPI, false, true, MOE_DN_F8 != 0>(C.lds, g, S, E); } \
        else { pg8::EpiDnMoe<false> E{ws, rowtok, rowgw}; pg8::gemm_phase<pg8::EpiDnMoe<false>, pg8::MoeOrder, ALEPI, false, true, MOE_DN_F8 != 0>(C.lds, g, S, E); } }
    CHUNK_BODY(0, 0)
#if CHB < 16
    CHUNK_BODY(0, 1)
#endif
#if CHB < 8
    CHUNK_BODY(0, 2)
    CHUNK_BODY(0, 3)
#endif
    LAYER_TAIL(0)
    FFN_BODY()
    CHUNK_BODY(1, 0)
#if CHB < 16
    CHUNK_BODY(1, 1)
#endif
#if CHB < 8
    CHUNK_BODY(1, 2)
    CHUNK_BODY(1, 3)
#endif
    LAYER_TAIL(1)
    MOE_HEAD()
    { const int* meta = (const int*)(ws + WS_META);
    if (IN_PH) { if (MKP & 16384) REP(16384) MOE_GU(0, 1) }
    END_PH;
    if (IN_PH) { if (MKP & 32768) MOE_DN(0) if (MKP & 16384) MOE_GU(1, 1) }
    END_PH;
#if !MOE_NOSPLIT
    if (IN_PH) { if (MKP & 32768) MOE_DN(1) if (MKP & 16384) MOE_GU(2, 1) }
    END_PH;
    if (IN_PH) { if (MKP & 32768) MOE_DN(2) if (MKP & 16384) MOE_GU(3, 1) }
    END_PH;
    if (IN_PH) { if (MKP & 32768) MOE_DN(3) }
    END_PH;
#else
    if (IN_PH) { if (MKP & 32768) MOE_DN(1) }
    END_PH;
#endif
    }
    if (IN_PH && (MKP & 65536)) { MKCTX; phase_final(C); }
    END_PH;
#ifdef PROBE_BAR
    { if (threadIdx.x == 0) atomicAdd((unsigned*)(ws + WS_CTL) + CW_Q + 2049, (unsigned)(__builtin_amdgcn_s_memrealtime() - pk0_));
      xcd_barrier(bar);
      const unsigned* tim = (const unsigned*)(ws + WS_CTL) + CW_Q + 2048;
      const float ta = (float)__hip_atomic_load(tim, __ATOMIC_RELAXED, __HIP_MEMORY_SCOPE_AGENT), tb = (float)__hip_atomic_load(tim + 1, __ATOMIC_RELAXED, __HIP_MEMORY_SCOPE_AGENT);
      float code = (float)(PROBE_UNIT) * ta / tb;
      code = fminf(98.f, fmaxf(1.f, rintf(code))); const float v = sqrtf(code);
      for (size_t i = (size_t)blockIdx.x * NTHREADS + threadIdx.x; i < (size_t)MTOK * DM; i += (size_t)gridDim.x * NTHREADS) args.out[i] = v; }
#endif
#ifdef PROBE_TIMER
    { xcd_barrier(bar);
      const unsigned* tim = (const unsigned*)(ws + WS_CTL) + CW_Q + 2048;
      const float ta = (float)__hip_atomic_load(tim, __ATOMIC_RELAXED, __HIP_MEMORY_SCOPE_AGENT), tb = (float)__hip_atomic_load(tim + 1, __ATOMIC_RELAXED, __HIP_MEMORY_SCOPE_AGENT);
      float code = PROBE_TIMER == 1 ? 10.f * ta / tb : (PROBE_TIMER == 2 ? ta * (1.f / (256.f * 100.f * 10.f)) : tb * (1.f / (256.f * 100.f * 10.f)));
      code = fminf(98.f, fmaxf(1.f, rintf(code))); const float v = sqrtf(code);
      for (size_t i = (size_t)blockIdx.x * NTHREADS + threadIdx.x; i < (size_t)MTOK * DM; i += (size_t)gridDim.x * NTHREADS) args.out[i] = v; }
#endif
#undef IN_PH
#undef END_PH
}
#if !MK_DEBUG
extern "C" void kernel_launch(void* const* d_in, const int* in_sizes, int n_in, void* d_out, int out_size, void* d_ws, size_t ws_size, hipStream_t stream) {
    static int grid = 0;
    if (grid == 0) {
        if (n_in != 22 || out_size != MTOK * DM || ws_size < WS_NEED) { fprintf(stderr, "kernel_launch: unexpected shapes / workspace (%zu < %zu); nothing launched\n", ws_size, (size_t)WS_NEED); grid = -1; return; }
        int dev = 0, cus = 0, per_cu = 0;
        if (hipGetDevice(&dev) != hipSuccess || hipDeviceGetAttribute(&cus, hipDeviceAttributeMultiprocessorCount, dev) != hipSuccess) { grid = -1; return; }
        if (hipFuncSetAttribute((const void*)mega, hipFuncAttributeMaxDynamicSharedMemorySize, LDS_BYTES) != hipSuccess) { fprintf(stderr, "kernel_launch: hipFuncSetAttribute failed\n"); grid = -1; return; }
        if (hipOccupancyMaxActiveBlocksPerMultiprocessor(&per_cu, (const void*)mega, NTHREADS, LDS_BYTES) != hipSuccess || per_cu < 1) { fprintf(stderr, "kernel_launch: occupancy query says %d\n", per_cu); }
        (void)hipGetLastError();
        grid = cus;
        if (grid != 256) { fprintf(stderr, "kernel_launch: built for 256 CUs, device has %d; nothing launched\n", cus); grid = -1; return; }
    }
    if (grid < 0) return;
    if (hipMemsetAsync((char*)d_ws + WS_CTL, 0, CTL_ZERO_BYTES, stream) != hipSuccess) return;
    Args a{};
    for (int i = 0; i < 22; ++i) a.in[i] = (const float*)d_in[i];
    a.out = (float*)d_out; a.ws = (unsigned char*)d_ws; a.ph_lo = 0; a.ph_hi = PH_TOTAL;
    hipLaunchKernelGGL(mega, dim3(grid), dim3(NTHREADS), LDS_BYTES, stream, a);
}
#endif
```

```cpp
#define CHB 16
#include <hip/hip_runtime.h>
#include <cstdio>
#include <cstdint>
#include <cmath>

#ifndef MK_DEBUG
#define MK_DEBUG 0
#endif
#ifndef MOE_F8
#define MOE_F8 1
#endif
#ifndef MOE_DN_F8
#define MOE_DN_F8 1
#endif
#ifndef MOE_NOSPLIT
#define MOE_NOSPLIT 1
#endif
#ifndef P1_F8_FROM
#define P1_F8_FROM 0
#endif
#ifndef WGM_SET
#define WGM_SET 8
#endif
#ifndef P5_F8
#define P5_F8 1
#endif
#ifndef P4_F8
#define P4_F8 1
#endif
#ifndef CHB
#define CHB 8
#endif

#define GAS __attribute__((address_space(1)))
#define LAS __attribute__((address_space(3)))
typedef unsigned short bf16_t;
typedef short bf16x8 __attribute__((ext_vector_type(8)));
typedef short s16x4 __attribute__((ext_vector_type(4)));
typedef float f32x4 __attribute__((ext_vector_type(4)));
typedef float f32x2 __attribute__((ext_vector_type(2)));
typedef float f32x16 __attribute__((ext_vector_type(16)));
typedef unsigned u32x4 __attribute__((ext_vector_type(4)));
typedef unsigned u32x2 __attribute__((ext_vector_type(2)));
typedef __bf16 bf16x2_t __attribute__((ext_vector_type(2)));

constexpr int SEQ = 2048, DM = 1024, NBATCH = 16, MTOK = NBATCH * SEQ;
constexpr int MC = CHB * SEQ, NCHUNK = NBATCH / CHB;
constexpr int INC = 5792, ZW = 512, ZN = 5888;
constexpr int ZO_CQ = 0, ZO_CKV = 256, ZO_KPE = 384, ZO_QB = 512, ZO_KB = 1024, ZO_VB = 1536, ZO_QC = 2048, ZO_KC = 2560, ZO_VC = 2688, ZO_G = 2816;
constexpr int DFF = 2816, DFE = 3584, NEXP = 8;
constexpr int DF0 = 1792, DF1 = DFE - DF0;
constexpr float EPS = 1e-6f, LOG2E = 1.4426950408889634f;
constexpr float NEGB = -1e30f;
constexpr int MOE_ROWS = MTOK + NEXP * 256;

constexpr size_t MiB = 1u << 20;
constexpr size_t WS_CTL = 0, CTL_ZERO_BYTES = 256 * 1024;
constexpr size_t WS_META = 256 * 1024;
constexpr size_t WS_TAB = 1 * MiB;
constexpr size_t WS_WIN = 2 * MiB;
constexpr size_t SZ_WIN = (size_t)ZN * DM * 2;
constexpr size_t WS_WUQ = WS_WIN + 2 * SZ_WIN;
constexpr size_t SZ_WUQ = (size_t)768 * 256 * 2;
constexpr size_t WS_WUKV = WS_WUQ + 2 * SZ_WUQ;
constexpr size_t SZ_WUKV = (size_t)1024 * 256 * 2;
constexpr size_t WS_WBR = WS_WUKV + 2 * SZ_WUKV;
constexpr size_t SZ_WBR = (size_t)1024 * 1536 * 2;
constexpr size_t WS_WOUT = WS_WBR + 2 * SZ_WBR;
constexpr size_t SZ_WOUT = (size_t)1024 * 1024 * 2;
constexpr size_t WS_WGU = WS_WOUT + 2 * SZ_WOUT;
constexpr size_t WS_WD = WS_WGU + (size_t)2 * DFF * DM * 2;
constexpr size_t WS_SMALL_END = WS_WD + (size_t)DM * DFF * 2;
static_assert(WS_SMALL_END <= 54 * MiB, "small weights");
constexpr size_t WS_XB = 54 * MiB;
constexpr size_t WS_ST = 118 * MiB;
constexpr size_t WS_RR = 120 * MiB;
constexpr size_t WS_SEL = WS_RR + (size_t)MTOK * 4;
constexpr size_t WS_GW = WS_SEL + (size_t)MTOK * 8;
constexpr size_t WS_ROWTOK = WS_GW + (size_t)MTOK * 8;
constexpr size_t WS_ROWGW = WS_ROWTOK + (size_t)2 * MOE_ROWS * 4;
constexpr size_t WS_ROWRR = WS_ROWGW + (size_t)2 * MOE_ROWS * 4;
constexpr size_t WS_T = 122 * MiB;
static_assert(WS_ROWRR + (size_t)2 * MOE_ROWS * 4 <= WS_T, "fixed region");
constexpr size_t WS_GB = WS_T;
constexpr size_t WS_Y = WS_GB + (size_t)MTOK * 3072;
constexpr size_t WS_CH = WS_Y + (size_t)MTOK * 1536 * (CHB == 16 && P4_F8 ? 1 : 2);
constexpr size_t WS_Z = WS_CH;
constexpr size_t WS_QKV = WS_Z + (size_t)MC * ZW * 2;
constexpr size_t SZ_H8 = (size_t)MC * 512 * 2, SZ_H2 = (size_t)MC * 128 * 2;
constexpr size_t WS_Q = WS_QKV + 4 * SZ_H8 + 2 * SZ_H2;
constexpr bool TMP_IN_OUT = (CHB == 16);
constexpr size_t WS_KV = WS_Q + (size_t)MC * 768 * 2;
constexpr size_t WS_PB = WS_KV + (TMP_IN_OUT ? 0 : (size_t)MC * 1024 * 2);
constexpr size_t WS_PBS = WS_PB + (TMP_IN_OUT ? 0 : (size_t)2 * MC * 512 * 2);
constexpr size_t WS_SQ = WS_PBS + (size_t)2 * MC * 16 * 4;
constexpr size_t WS_MIX_END = WS_SQ + (size_t)2 * MC * 4 * 4;
constexpr size_t WS_XB8P = (size_t)496 * MiB;
constexpr size_t WS_WIN8 = WS_XB8P + (size_t)MTOK * DM;
constexpr size_t SZ_WIN8 = (size_t)(23 - P1_F8_FROM) * 256 * DM;
static_assert(WS_XB8P >= WS_MIX_END && WS_WIN8 + 2 * SZ_WIN8 <= (size_t)564 * MiB, "fp8 input-projection buffers");
constexpr size_t WS_MG = WS_CH;
static_assert(WS_MG + (size_t)MTOK * 1024 * 2 <= (size_t)564 * MiB, "MG placement");
constexpr size_t WS_ACT = WS_T;
constexpr size_t WS_EGU = WS_T;
constexpr size_t WS_XB8 = WS_EGU + (size_t)NEXP * 2 * DFE * DM;
constexpr size_t WS_ED = WS_EGU + (size_t)NEXP * 2 * DFE * DM * 2;
constexpr size_t WS_MACT = WS_ED + (size_t)NEXP * DM * DFE * 2;
constexpr size_t WS_MOE_END = WS_MACT + (size_t)MOE_ROWS * DFE * 2;
constexpr size_t WS_NEED_ = (WS_MOE_END > WS_MIX_END ? WS_MOE_END : WS_MIX_END);
constexpr size_t WS_NEED = WS_MOE_END + (size_t)(MTOK - 26624) * DM * 2 > WS_NEED_ ? WS_MOE_END + (size_t)(MTOK - 26624) * DM * 2 : WS_NEED_;
static_assert(WS_NEED <= (size_t)564 * MiB, "workspace budget");

constexpr int XM_SPLIT = 26624;
constexpr size_t WS_XM_HI = WS_MOE_END;
static_assert((size_t)XM_SPLIT * DM * 2 <= WS_XB - WS_WIN && WS_XM_HI + (size_t)(MTOK - XM_SPLIT) * DM * 2 <= (size_t)564 * MiB, "XM placement");
__device__ __forceinline__ bf16_t* xm_row(unsigned char* ws, int tok) { return tok < XM_SPLIT ? (bf16_t*)(ws + WS_WIN) + (size_t)tok * DM : (bf16_t*)(ws + WS_XM_HI) + (size_t)(tok - XM_SPLIT) * DM; }

constexpr int CW_BAR = 4096, CW_Q = 8192;
constexpr int MI_CNT = 0, MI_NTILE = 4120, MI_TILEE = 4128;

__device__ __forceinline__ unsigned cvt_pk_bf16(float lo, float hi) { f32x2 v = {lo, hi}; bf16x2_t b = __builtin_convertvector(v, bf16x2_t); return __builtin_bit_cast(unsigned, b); }
__device__ __forceinline__ unsigned pk_fp8x4(float a, float b, float c, float d) {
    a = __builtin_amdgcn_fmed3f(a, -448.f, 448.f); b = __builtin_amdgcn_fmed3f(b, -448.f, 448.f); c = __builtin_amdgcn_fmed3f(c, -448.f, 448.f); d = __builtin_amdgcn_fmed3f(d, -448.f, 448.f);
    int w = 0; w = __builtin_amdgcn_cvt_pk_fp8_f32(a, b, w, false); w = __builtin_amdgcn_cvt_pk_fp8_f32(c, d, w, true); return (unsigned)w; }
__device__ __forceinline__ float bf_lo(unsigned w) { return __builtin_bit_cast(float, w << 16); }
__device__ __forceinline__ float bf_hi(unsigned w) { return __builtin_bit_cast(float, w & 0xffff0000u); }
template <int O> __device__ __forceinline__ float swz_xor(float v) { return __builtin_bit_cast(float, __builtin_amdgcn_ds_swizzle(__builtin_bit_cast(int, v), (O << 10) | 0x1f)); }
__device__ __forceinline__ void swap32(float& a, float& b) { asm volatile("s_nop 1\n\tv_permlane32_swap_b32 %0, %1\n\ts_nop 1" : "+v"(a), "+v"(b)); }
__device__ __forceinline__ float xsum32(float v) { float a = v, b = v; swap32(a, b); return a + b; }
__device__ __forceinline__ float xmax32(float v) { float a = v, b = v; swap32(a, b); return fmaxf(a, b); }
__device__ __forceinline__ float wave_sum(float v) {
    v += swz_xor<1>(v); v += swz_xor<2>(v); v += swz_xor<4>(v); v += swz_xor<8>(v); v += swz_xor<16>(v);
    return xsum32(v);
}
__device__ __forceinline__ float fast_rcp(float x) { return __builtin_amdgcn_rcpf(x); }
__device__ __forceinline__ float fast_exp2(float x) { return __builtin_amdgcn_exp2f(x); }
__device__ __forceinline__ float sigmoidf_(float v) { return fast_rcp(1.f + fast_exp2(-v * LOG2E)); }
__device__ __forceinline__ int t5_bucket(int rel) {
    const int ret = rel > 0 ? 16 : 0; const int n = rel < 0 ? -rel : rel;
    if (n < 8) return ret + n;
    int large = 8 + (int)(logf((float)n / 8.f) / logf(128.f) * 8.f);
    if (large > 15) large = 15;
    return ret + large;
}

#define XB_TMO      128
#define XB_XCNT(j)  (256  + 64 * (j))
#define XB_XSUB(j)  (1280 + 64 * (j))
#define XB_XGEN(j)  (2304 + 64 * (j))
#define XB_TOP      3328
#define XB_TOPGEN   3392
#define XCD_BAR_WORDS 3456
#define XB_SPIN_CAP (1u << 18)
__device__ __forceinline__ unsigned xb_ld(unsigned* p)              { return __hip_atomic_load(p, __ATOMIC_RELAXED, __HIP_MEMORY_SCOPE_AGENT); }
__device__ __forceinline__ unsigned xb_add(unsigned* p, unsigned v) { return __hip_atomic_fetch_add(p, v, __ATOMIC_RELAXED, __HIP_MEMORY_SCOPE_AGENT); }
__device__ __forceinline__ unsigned xb_xcc_id() { return (unsigned)__builtin_amdgcn_s_getreg((3 << 11) | 20) & 0xFu; }
#define XB_SPIN(cond, bar) do { unsigned _sp = 0; while (cond) { __builtin_amdgcn_s_sleep(1); \
    if ((++_sp & 255u) == 0u) { if (xb_ld(&(bar)[XB_TMO])) break; if (_sp > XB_SPIN_CAP) { atomicAdd(&(bar)[XB_TMO], 1u); break; } } } } while (0)
struct XcdBarrier { unsigned* bar; unsigned x; volatile LAS unsigned* st; };
__device__ __forceinline__ XcdBarrier xcd_barrier_post(unsigned* bar, volatile LAS unsigned* st) {
    XcdBarrier b; b.bar = bar; b.x = xb_xcc_id(); b.st = st;
    if (threadIdx.x == 0) (void)xb_add(&bar[XB_XCNT(b.x)], 1u);
    return b;
}
__device__ __forceinline__ void xcd_barrier_complete(unsigned* bar, unsigned x, unsigned& nloc, unsigned& nx) {
    const unsigned G = gridDim.x * gridDim.y * gridDim.z;
    unsigned sum, cnt, mine, sp = 0u;
    for (;;) {
        sum = 0u; cnt = 0u; mine = 0u;
#pragma unroll
        for (unsigned j = 0; j < 16; ++j) { const unsigned c = xb_ld(&bar[XB_XCNT(j)]); sum += c; cnt += (c > 0u) ? 1u : 0u; mine = (j == x) ? c : mine; }
        if (sum == G) break;
        __builtin_amdgcn_s_sleep(1);
        if ((++sp & 255u) == 0u) { if (xb_ld(&bar[XB_TMO])) break; if (sp > XB_SPIN_CAP) { atomicAdd(&bar[XB_TMO], 1u); break; } }
    }
    nloc = mine > 0u ? mine : 1u; nx = cnt > 0u ? cnt : 1u;
}
__device__ __forceinline__ void xcd_barrier(const XcdBarrier& b) {
    asm volatile("s_waitcnt vmcnt(0)" ::: "memory");
    __syncthreads();
    if (threadIdx.x == 0) {
        unsigned* bar = b.bar;
        __builtin_amdgcn_s_waitcnt(0);
        unsigned nloc = b.st[0], nx = b.st[1];
        if (nloc == 0u) { xcd_barrier_complete(bar, b.x, nloc, nx); b.st[0] = nloc; b.st[1] = nx; }
        const unsigned old = xb_add(&bar[XB_XSUB(b.x)], 1u);
        const unsigned gen = old / nloc;
        if (old + 1u == (gen + 1u) * nloc) {
            __builtin_amdgcn_fence(__ATOMIC_RELEASE, "agent");
            asm volatile("s_waitcnt vmcnt(0)" ::: "memory");
            const unsigned og = xb_add(&bar[XB_TOP], 1u);
            const unsigned tg = og / nx;
            if (og + 1u == (tg + 1u) * nx) xb_add(&bar[XB_TOPGEN], 1u);
            else XB_SPIN(xb_ld(&bar[XB_TOPGEN]) == tg, bar);
            __builtin_amdgcn_fence(__ATOMIC_ACQUIRE, "agent");
            xb_add(&bar[XB_XGEN(b.x)], 1u);
            asm volatile("s_waitcnt vmcnt(0)" ::: "memory");
        } else {
            XB_SPIN(xb_ld(&bar[XB_XGEN(b.x)]) == gen, bar);
            __builtin_amdgcn_fence(__ATOMIC_ACQUIRE, "agent");
            asm volatile("s_waitcnt vmcnt(0)" ::: "memory");
        }
    }
    __syncthreads();
}
#ifndef MOE_RGS
#define MOE_RGS 4
#endif
#ifndef MOE_RG
#define MOE_RG 4
#endif
#ifndef RELAXW
#define RELAXW 0
#endif
namespace pg8 {
constexpr int BM = 256, BK = 64, HALF = 128, HTB = HALF * BK * 2, STAGE_BYTES = 8 * HTB, NXCD = 8, WGM = WGM_SET;
__host__ __device__ __forceinline__ int lds_byte(int r, int c) { const int st = (r >> 4) * 2 + (c >> 5), rr = r & 15, cc = c & 31, ob = rr * 64 + cc * 2; return st * 1024 + (ob ^ (((ob >> 9) & 1) << 5)); }
__host__ __device__ __forceinline__ void stage_rc(int b, int& R, int& C) { const int st = b / 1024, sb = b % 1024, swz = sb ^ (((sb >> 9) & 1) << 5); R = (st >> 1) * 16 + swz / 64; C = (st & 1) * 32 + (swz % 64) / 2; }
__host__ __device__ __forceinline__ int perm32(int rho) { const int n = rho >> 4, i = rho & 15; return 8 * (i >> 2) + 4 * n + (i & 3); }

struct Unit { int pm, pn, aux; };
struct Gemm { const bf16_t* A; const bf16_t* Bt; int K, lda, ldb; const int* gidx; };

struct StaticOrder {
    static constexpr bool DYN = false;
    int nM, nN, nwg, G, c;
    __host__ __device__ void init(int M, int N, int G_, int c_) { nM = M / BM; nN = N / BM; nwg = nM * nN; G = G_; c = c_; }
    __host__ __device__ bool next(int i, Unit& u) const {
        const int L = i * G + c; if (L >= nwg) return false;
        int wgid = L; { const int q = nwg / NXCD, r = nwg % NXCD, xcd = wgid % NXCD, off = wgid / NXCD; wgid = (xcd < r ? xcd * (q + 1) : r * (q + 1) + (xcd - r) * q) + off; }
        const int nig = WGM * nN, gid = wgid / nig, fm = gid * WGM, gsz = (nM - fm) < WGM ? (nM - fm) : WGM;
        u.pm = fm + ((wgid % nig) % gsz); u.pn = (wgid % nig) / gsz; u.aux = u.pn; return true;
    }
};
struct MoeOrder {
    static constexpr bool DYN = false;
    int ntile, nN, G, c, pne, pn0; const int* tile_e;
    __device__ bool next(int i, Unit& u) const {
        const int L = i * G + c; if (L >= ntile * nN) return false;
        int pm, pnl; { const int grp = L / (MOE_RGS * nN), fm = grp * MOE_RGS, gsz = (ntile - fm) < MOE_RGS ? (ntile - fm) : MOE_RGS, r = L - grp * (MOE_RGS * nN); pm = fm + r % gsz; pnl = r / gsz; }
        u.pm = pm; u.aux = pnl; u.pn = tile_e[pm] * pne + pn0 + pnl; return true;
    }
};

struct DynMoeOrder {
    static constexpr bool DYN = true;
    unsigned* ctr; volatile LAS int* slot; int ntile, nN, pne, pn0; const int* tile_e; int vcu;
    __device__ __forceinline__ void begin() const {
        if (threadIdx.x == 0) { slot[0] = vcu; slot[1] = vcu + (int)gridDim.x; }
        __syncthreads();
    }
    __device__ __forceinline__ bool next(int i, Unit& u) const {
        const int L = __builtin_amdgcn_readfirstlane(slot[i & 1]); if (L >= ntile * nN) return false;
        int pm, pnl; { const int grp = L / (MOE_RG * nN), fm = grp * MOE_RG, gsz = (ntile - fm) < MOE_RG ? (ntile - fm) : MOE_RG, r = L - grp * (MOE_RG * nN); pm = fm + r % gsz; pnl = r / gsz; }
        u.pm = pm; u.aux = pnl; u.pn = tile_e[pm] * pne + pn0 + pnl; return true;
    }
    __device__ __forceinline__ unsigned claim_issue() const { unsigned v = 0u; if (threadIdx.x == 0) v = 2u * gridDim.x + __hip_atomic_fetch_add(ctr, 1u, __ATOMIC_RELAXED, __HIP_MEMORY_SCOPE_AGENT); return v; }
    __device__ __forceinline__ void claim_commit(unsigned v, int i) const { if (threadIdx.x == 0) { slot[i & 1] = (int)v; asm volatile("s_waitcnt lgkmcnt(0)" ::: "memory"); } }
};

__host__ __device__ __forceinline__ size_t blk_off(int row, int col, int ld) { return ((size_t)(row >> 4) * (ld >> 5) + (col >> 5)) * 512 + (row & 15) * 32 + (col & 31); }
typedef int i32x4_t __attribute__((ext_vector_type(4))); typedef int i32x8_t __attribute__((ext_vector_type(8)));
template <bool F8> struct FragSel;
template <> struct FragSel<false> {
    struct P { bf16x8 k[2]; }; typedef P A[4]; typedef P B[2];
    static __device__ __forceinline__ void set(P& d, const i32x4_t& f0, const i32x4_t& f1) { d.k[0] = __builtin_bit_cast(bf16x8, f0); d.k[1] = __builtin_bit_cast(bf16x8, f1); }
    static __device__ __forceinline__ void mma(f32x4& c, const P& b, const P& a) { c = __builtin_amdgcn_mfma_f32_16x16x32_bf16(b.k[0], a.k[0], c, 0, 0, 0); c = __builtin_amdgcn_mfma_f32_16x16x32_bf16(b.k[1], a.k[1], c, 0, 0, 0); }
    static __device__ __forceinline__ void after_mma() {}
};
template <> struct FragSel<true> {
    typedef i32x8_t P; typedef P A[4]; typedef P B[2];
    static __device__ __forceinline__ void set(P& d, const i32x4_t& f0, const i32x4_t& f1) { d = __builtin_shufflevector(f0, f1, 0, 1, 2, 3, 4, 5, 6, 7); }
    static __device__ __forceinline__ void mma(f32x4& c, const P& b, const P& a) { int sc = 0x7f7f7f7f; asm volatile("v_mfma_scale_f32_16x16x128_f8f6f4 %0, %1, %2, %0, %3, %3 op_sel_hi:[0,0,0]" : "+v"(c) : "v"(b), "v"(a), "v"(sc)); }
    static __device__ __forceinline__ void after_mma() { asm volatile("s_nop 15\n\ts_nop 15" ::: "memory"); }
};
template <class Epi, class Sched, bool ALIGN_EPI, bool GATHER, bool ABLK = false, bool F8 = false>
__device__ __forceinline__ void gemm_phase(LAS unsigned char* lds, const Gemm g, const Sched& S, const Epi& E) {
    int tid_ = threadIdx.x; asm volatile("" : "+v"(tid_));
    const int tid = tid_, wid = __builtin_amdgcn_readfirstlane(tid >> 6), lane = tid & 63, wr = wid >> 2, wc = wid & 3, fr = lane & 15, fq = lane >> 4;
    int K_ = g.K; asm volatile("" : "+s"(K_));
    const int K = K_, nt = K / BK;
    static_assert(!(GATHER && ABLK), "gathered A is row-major");
    const size_t kstep = (size_t)(BK * 2), kstepA = ABLK ? (size_t)2048 : kstep;
    const size_t hstepA = ABLK ? (size_t)8 * (g.lda >> 5) * 1024 : (size_t)HALF * g.lda * 2, hstepB = (size_t)HALF * g.ldb * 2, tstepA = 2 * hstepA, tstepB = 2 * hstepB;
    int Rs[2], Cs[2]; unsigned voffB[2];
#pragma unroll
    for (int i = 0; i < 2; ++i) { int R, C; stage_rc(tid * 16 + i * 8192, R, C); Rs[i] = R; Cs[i] = C; const int Rb = Epi::PERM ? ((R & ~31) + perm32(R & 31)) : R;
        voffB[i] = (unsigned)(Rb * g.ldb + C) * 2u; }
    asm volatile("" : "+v"(voffB[0]), "+v"(voffB[1]), "+v"(Rs[0]), "+v"(Rs[1]), "+v"(Cs[0]), "+v"(Cs[1]));
    unsigned vA[2][2], nvA[2][2];
    const size_t hsA = GATHER ? (size_t)0 : hstepA;
#define PG8_SETV(V, U) do { _Pragma("unroll") for (int _h = 0; _h < 2; ++_h) _Pragma("unroll") for (int _i = 0; _i < 2; ++_i) { \
        if constexpr (GATHER) { int _t = g.gidx[(U).pm * BM + _h * HALF + Rs[_i]]; _t = _t < 0 ? 0 : _t; V[_h][_i] = (unsigned)(_t * g.lda + Cs[_i]) * 2u; } \
        else if constexpr (ABLK) V[_h][_i] = (unsigned)blk_off(Rs[_i], Cs[_i], g.lda) * 2u; \
        else V[_h][_i] = (unsigned)(Rs[_i] * g.lda + Cs[_i]) * 2u; } } while (0)
    const unsigned ldsw = (unsigned)wid * 1024u;
    const int aoff = lds_byte(wr * 64 + fr, fq * 8), boff = lds_byte(wc * 32 + fr, fq * 8);
#define PG8_SA(b, h) (((b) * 2 + (h)) * HTB)
#define PG8_SB(b, h) ((4 + (b) * 2 + (h)) * HTB)
#define PG8_STAGE(bufoff, gbase, voff) do { _Pragma("unroll") for (int _i = 0; _i < 2; ++_i) \
        __builtin_amdgcn_global_load_lds((const unsigned*)((const char*)(gbase) + (voff)[_i]), (LAS unsigned*)(lds + (bufoff) + ldsw + _i * 8192), 16, 0, 0); } while (0)
#define PG8_LDA(dst, b, h) do { _Pragma("unroll") for (int m = 0; m < 4; ++m) { const i32x4_t f0_ = *(const LAS i32x4_t*)(lds + PG8_SA(b, h) + aoff + m * 2048), f1_ = *(const LAS i32x4_t*)(lds + PG8_SA(b, h) + aoff + m * 2048 + 1024); FragSel<F8>::set(dst[m], f0_, f1_); } } while (0)
#define PG8_LDB(dst, b, h) do { _Pragma("unroll") for (int n = 0; n < 2; ++n) { const i32x4_t f0_ = *(const LAS i32x4_t*)(lds + PG8_SB(b, h) + boff + n * 2048), f1_ = *(const LAS i32x4_t*)(lds + PG8_SB(b, h) + boff + n * 2048 + 1024); FragSel<F8>::set(dst[n], f0_, f1_); } } while (0)
#define PG8_MMA(ai, bj, At, Bt) do { __builtin_amdgcn_s_setprio(1); _Pragma("unroll") for (int m = 0; m < 4; ++m) _Pragma("unroll") for (int n = 0; n < 2; ++n) FragSel<F8>::mma(acc[ai][bj][m][n], Bt[n], At[m]); __builtin_amdgcn_s_setprio(0); } while (0)
#define PG8_WAIT_V(n) asm volatile("s_waitcnt vmcnt(" #n ")" ::: "memory")
#define PG8_WAIT_VSEL(sel, n) asm volatile("s_cmp_eq_u32 %0, 0\n\ts_cbranch_scc1 1f\n\ts_waitcnt vmcnt(%1)\n\ts_branch 2f\n1:\n\ts_waitcnt vmcnt(8)\n2:" :: "s"(sel), "n"(n) : "memory", "scc")
#define PG8_WAIT_L(n) asm volatile("s_waitcnt lgkmcnt(" #n ")" ::: "memory")
#define PG8_BAR __builtin_amdgcn_s_barrier()
#define PG8_SCHED __builtin_amdgcn_sched_barrier(0)
    Unit cur, nxt; int ui = 0;
    if constexpr (Sched::DYN) S.begin();
    if (!S.next(0, cur)) return;
    f32x4 acc[2][2][4][2];
#pragma unroll
    for (int a = 0; a < 2; ++a)
#pragma unroll
        for (int b = 0; b < 2; ++b)
#pragma unroll
            for (int m = 0; m < 4; ++m)
#pragma unroll
                for (int n = 0; n < 2; ++n) acc[a][b][m][n] = (f32x4){0.f, 0.f, 0.f, 0.f};
    typename FragSel<F8>::A At; typename FragSel<F8>::B B0, B1;
    PG8_SETV(vA, cur);
    const char* cA = (const char*)g.A + (GATHER ? (size_t)0 : (size_t)cur.pm * tstepA); const char* cB = (const char*)g.Bt + (size_t)cur.pn * tstepB;
    PG8_STAGE(PG8_SB(0, 0), cB, voffB); PG8_STAGE(PG8_SB(0, 1), cB + hstepB, voffB); PG8_STAGE(PG8_SA(0, 0), cA, vA[0]); PG8_STAGE(PG8_SA(0, 1), cA + hsA, vA[1]);
    if (wr == 1) PG8_BAR;
    PG8_WAIT_V(2); PG8_BAR;
    PG8_STAGE(PG8_SB(1, 0), cB + kstep, voffB); PG8_STAGE(PG8_SA(1, 0), cA + kstepA, vA[0]); PG8_STAGE(PG8_SB(1, 1), cB + hstepB + kstep, voffB);
    PG8_WAIT_V(6); PG8_BAR;
    for (;;) {
        const bool has_next = S.next(ui + 1, nxt);
        unsigned claim_ = 0u; if constexpr (Sched::DYN) claim_ = S.claim_issue();
        const char* nA = has_next ? (const char*)g.A + (GATHER ? (size_t)0 : (size_t)nxt.pm * tstepA) : cA; const char* nB = has_next ? (const char*)g.Bt + (size_t)nxt.pn * tstepB : cB;
        if constexpr (GATHER) { if (has_next) PG8_SETV(nvA, nxt); else {
#pragma unroll
            for (int h = 0; h < 2; ++h) { nvA[h][0] = vA[h][0]; nvA[h][1] = vA[h][1]; } } }
        for (int t = 0; t < nt; t += 2) {
            if constexpr (Epi::MID) { if (t == (F8 ? 4 : 8) || t == (F8 ? 8 : 16)) E.mid(acc, cur, F8 ? t >> 2 : t >> 3, wr, wc, fr, fq); }
            const bool last = (t == nt - 2);
            const char* a1 = cA + (size_t)(t + 1) * kstepA;
            const char* a2 = last ? nA : cA + (size_t)(t + 2) * kstepA; const char* b2 = last ? nB : cB + (size_t)(t + 2) * kstep;
            const char* a3 = a2 + kstepA; const char* b3 = b2 + kstep;
            unsigned v20[2], v21[2];
            if constexpr (GATHER) { v20[0] = last ? nvA[0][0] : vA[0][0]; v20[1] = last ? nvA[0][1] : vA[0][1]; v21[0] = last ? nvA[1][0] : vA[1][0]; v21[1] = last ? nvA[1][1] : vA[1][1]; }
            else { v20[0] = vA[0][0]; v20[1] = vA[0][1]; v21[0] = vA[1][0]; v21[1] = vA[1][1]; }
            const int relax_ = __builtin_amdgcn_readfirstlane((RELAXW && (t == 0) && (ui > 0)) ? 1 : 0);
            PG8_LDB(B0, 0, 0); PG8_LDB(B1, 0, 1); PG8_SCHED; PG8_LDA(At, 0, 0); PG8_STAGE(PG8_SA(1, 1), a1 + hsA, vA[1]);
            PG8_WAIT_VSEL(relax_, 8 + Epi::NVM);
            PG8_WAIT_L(0); PG8_BAR; PG8_MMA(0, 0, At, B0); PG8_MMA(0, 1, At, B1); PG8_BAR; PG8_SCHED;
            PG8_LDA(At, 0, 1); PG8_STAGE(PG8_SB(0, 0), b2, voffB); PG8_STAGE(PG8_SB(0, 1), b2 + hstepB, voffB); PG8_STAGE(PG8_SA(0, 0), a2, v20);
            PG8_WAIT_VSEL(relax_, 8 + Epi::NVM);
            PG8_WAIT_L(0); PG8_BAR; PG8_MMA(1, 0, At, B0); PG8_MMA(1, 1, At, B1); PG8_BAR; PG8_SCHED;
            PG8_LDB(B0, 1, 0); PG8_LDB(B1, 1, 1); PG8_SCHED; PG8_LDA(At, 1, 0); PG8_STAGE(PG8_SA(0, 1), a2 + hsA, v21);
            PG8_WAIT_V(8); PG8_WAIT_L(0); PG8_BAR; PG8_MMA(0, 0, At, B0); PG8_MMA(0, 1, At, B1); PG8_BAR; PG8_SCHED;
            PG8_LDA(At, 1, 1); PG8_STAGE(PG8_SB(1, 0), b3, voffB); PG8_STAGE(PG8_SB(1, 1), b3 + hstepB, voffB); PG8_STAGE(PG8_SA(1, 0), a3, v20);
            PG8_WAIT_V(8); PG8_WAIT_L(0); PG8_BAR; PG8_MMA(1, 0, At, B0); PG8_MMA(1, 1, At, B1); PG8_BAR; PG8_SCHED;
        }
        if constexpr (Sched::DYN) S.claim_commit(claim_, ui);
        if constexpr (ALIGN_EPI) { if (wr == 0) PG8_BAR; }
        FragSel<F8>::after_mma();
        E(acc, cur, wr, wc, fr, fq);
        if (!has_next) break;
#pragma unroll
        for (int a = 0; a < 2; ++a)
#pragma unroll
            for (int b = 0; b < 2; ++b)
#pragma unroll
                for (int m = 0; m < 4; ++m)
#pragma unroll
                    for (int n = 0; n < 2; ++n) acc[a][b][m][n] = (f32x4){0.f, 0.f, 0.f, 0.f};
        cur = nxt; cA = nA; cB = nB; ++ui;
        if constexpr (GATHER) {
#pragma unroll
            for (int h = 0; h < 2; ++h) { vA[h][0] = nvA[h][0]; vA[h][1] = nvA[h][1]; } }
        if constexpr (ALIGN_EPI) { if (wr == 1) PG8_BAR; }
    }
    PG8_WAIT_V(0);
    if constexpr (!ALIGN_EPI) { if (wr == 0) PG8_BAR; }
    PG8_BAR;
#undef PG8_SETV
#undef PG8_SA
#undef PG8_SB
#undef PG8_STAGE
#undef PG8_LDA
#undef PG8_LDB
#undef PG8_MMA
#undef PG8_WAIT_V
#undef PG8_WAIT_VSEL
#undef PG8_WAIT_L
#undef PG8_BAR
#undef PG8_SCHED
}

typedef f32x4 Acc[2][2][4][2];
#ifndef NT_Z
#define NT_Z 0
#endif
#ifndef NT_A
#define NT_A 1
#endif
#ifndef ST_SC1
#define ST_SC1 1
#endif
__device__ __forceinline__ void st16(unsigned char* wsb, u32x4* p, const u32x4& v) {
#if ST_SC1
    const __amdgpu_buffer_rsrc_t rsrc = __builtin_amdgcn_make_buffer_rsrc(wsb, 0, 0x7fffffff, 0x00020000);
    __builtin_amdgcn_raw_buffer_store_b128(v, rsrc, (int)((unsigned char*)p - wsb), 0, 16);
#else
    *p = v;
#endif
}
__device__ __forceinline__ void st8(unsigned char* wsb, u32x2* p, const u32x2& v) {
#if ST_SC1
    const __amdgpu_buffer_rsrc_t rsrc = __builtin_amdgcn_make_buffer_rsrc(wsb, 0, 0x7fffffff, 0x00020000);
    __builtin_amdgcn_raw_buffer_store_b64(v, rsrc, (int)((unsigned char*)p - wsb), 0, 16);
#else
    *p = v;
#endif
}
__device__ __forceinline__ float fq_sum(float s) { s += swz_xor<16>(s); return xsum32(s); }
__device__ __forceinline__ u32x4 pack8(const f32x4& a, const f32x4& b) { u32x4 w; w.x = cvt_pk_bf16(a.x, a.y); w.y = cvt_pk_bf16(a.z, a.w); w.z = cvt_pk_bf16(b.x, b.y); w.w = cvt_pk_bf16(b.z, b.w); return w; }
__device__ __forceinline__ void unpack8(const u32x4& w, f32x4& a, f32x4& b) { a = (f32x4){bf_lo(w.x), bf_hi(w.x), bf_lo(w.y), bf_hi(w.y)}; b = (f32x4){bf_lo(w.z), bf_hi(w.z), bf_lo(w.w), bf_hi(w.w)}; }
__device__ __forceinline__ unsigned g8pack(const f32x4& a) {
    const unsigned b0 = (unsigned)__builtin_fmaxf(a.x * 255.f + 0.5f, 1.f), b1 = (unsigned)__builtin_fmaxf(a.y * 255.f + 0.5f, 1.f), b2 = (unsigned)__builtin_fmaxf(a.z * 255.f + 0.5f, 1.f), b3 = (unsigned)__builtin_fmaxf(a.w * 255.f + 0.5f, 1.f);
    return b0 | (b1 << 8) | (b2 << 16) | (b3 << 24);
}
__device__ __forceinline__ f32x4 g8unpack(unsigned w) { return (f32x4){(float)(w & 0xffu), (float)((w >> 8) & 0xffu), (float)((w >> 16) & 0xffu), (float)(w >> 24)}; }
__device__ __forceinline__ float sq8(const f32x4& a, const f32x4& b) { return ((a.x * a.x + a.y * a.y) + (a.z * a.z + a.w * a.w)) + ((b.x * b.x + b.y * b.y) + (b.z * b.z + b.w * b.w)); }
__device__ __forceinline__ float sum4(const f32x4& a) { return (a.x + a.y) + (a.z + a.w); }
__device__ __forceinline__ void rope8(f32x4& a, f32x4& b, const float* cs, const float* sn) {
    const f32x4 c = *(const f32x4*)cs, s = *(const f32x4*)sn;
    const f32x4 ra = {a.x * c.x - a.y * s.x, a.x * s.x + a.y * c.x, a.z * c.y - a.w * s.y, a.z * s.y + a.w * c.y};
    const f32x4 rb = {b.x * c.z - b.y * s.z, b.x * s.z + b.y * c.z, b.z * c.w - b.w * s.w, b.z * s.w + b.w * c.w};
    a = ra; b = rb;
}
__device__ __forceinline__ void rowscale16(const float* st, int rbase, int fq, float (&r)[8]) {
    f32x4 p[8];
#pragma unroll
    for (int i = 0; i < 8; ++i) p[i] = *(const f32x4*)(st + (size_t)(rbase + (i >> 2) * HALF + (i & 3) * 16) * 16 + 4 * fq);
#pragma unroll
    for (int i = 0; i < 8; ++i) r[i] = rsqrtf(fq_sum(sum4(p[i])) * (1.f / 1024.f) + EPS);
}
__device__ __forceinline__ void rowscale4(const float* sq, int rbase, float inv_n, float (&r)[8]) {
    f32x4 p[8];
#pragma unroll
    for (int i = 0; i < 8; ++i) p[i] = *(const f32x4*)(sq + (size_t)(rbase + (i >> 2) * HALF + (i & 3) * 16) * 4);
#pragma unroll
    for (int i = 0; i < 8; ++i) r[i] = rsqrtf(sum4(p[i]) * inv_n + EPS);
}
#define EPI_ROWBASE int rl_ = wr * 64 + fr; asm volatile("" : "+v"(rl_)); const int rbase = u.pm * BM + rl_
#define EPI_LOOP _Pragma("unroll") for (int ai = 0; ai < 2; ++ai) _Pragma("unroll") for (int m = 0; m < 4; ++m)

__device__ __forceinline__ float sig2_(float t) { return fast_rcp(1.f + fast_exp2(t)); }
struct EpiIn {
    static constexpr bool PERM = true, MID = false; static constexpr int NVM = 24;
    bf16_t* Z; const float* st; float* sq; float* skv; const float* cosT; const float* sinT; unsigned char* GB; bf16_t* HM; unsigned char* wsb; int pnoff; float asc;
    __device__ __forceinline__ void operator()(const Acc& acc, const Unit& u, int wr, int wc, int fr, int fq) const {
        EPI_ROWBASE; const int pn = u.pn + pnoff;
        float r8[8]; rowscale16(st, rbase, fq, r8);
#pragma unroll
        for (int i = 0; i < 8; ++i) r8[i] *= (pn >= 11 ? -LOG2E * asc : asc);
        __builtin_amdgcn_sched_barrier(0);
        EPI_LOOP {
            const int row = rbase + ai * HALF + m * 16; const float r = r8[ai * 4 + m];
            bf16_t* zr = Z + (size_t)row * ZW + pn * BM + wc * 32 + 8 * fq;
            float ssq = 0.f;
#pragma unroll
            for (int bj = 0; bj < 2; ++bj) {
                f32x4 v0 = acc[ai][bj][m][0] * r, v1 = acc[ai][bj][m][1] * r;
#ifdef PROBE_ANOISE
                if (pn < 11 && ((PROBE_ANOISE_MASK >> pn) & 1)) { unsigned h_ = (unsigned)row * 2654435761u ^ (unsigned)(pn * 64 + bj * 32 + wc * 8 + fq) * 40503u; float nz[8];
#pragma unroll
                      for (int e_ = 0; e_ < 8; ++e_) { h_ = h_ * 1664525u + 1013904223u; nz[e_] = ((float)(h_ >> 8) * (1.f / 16777216.f) - 0.5f) * 3.4641f * 0.035f * (float)(PROBE_ANOISE); }
                      v0.x += nz[0]; v0.y += nz[1]; v0.z += nz[2]; v0.w += nz[3]; v1.x += nz[4]; v1.y += nz[5]; v1.z += nz[6]; v1.w += nz[7]; }
#endif
                if (pn == 0) ssq += sq8(v0, v1);
                else if (pn == 1) { if (bj == 0) ssq += sq8(v0, v1); else if (wc == 0) { const int pos = row & (SEQ - 1); rope8(v0, v1, cosT + pos * 16 + 4 * fq, sinT + pos * 16 + 4 * fq); } }
                else if (pn == 2 || pn == 3 || pn == 8 || pn == 9) { v0 = v0 * (0.125f * LOG2E); v1 = v1 * (0.125f * LOG2E); }
                else if (pn >= 11) {
#ifdef PROBE_GNOISE
                    { unsigned h_ = (unsigned)row * 2654435761u ^ (unsigned)(pn * 64 + bj * 32 + wc * 8 + fq) * 40503u; float nz[8];
#pragma unroll
                      for (int e_ = 0; e_ < 8; ++e_) { h_ = h_ * 1664525u + 1013904223u; nz[e_] = ((float)(h_ >> 8) * (1.f / 16777216.f) - 0.5f) * 3.4641f * 0.035f * (float)(PROBE_GNOISE); }
                      v0.x += nz[0]; v0.y += nz[1]; v0.z += nz[2]; v0.w += nz[3]; v1.x += nz[4]; v1.y += nz[5]; v1.z += nz[6]; v1.w += nz[7]; }
#endif
                    v0 = (f32x4){sig2_(v0.x), sig2_(v0.y), sig2_(v0.z), sig2_(v0.w)}; v1 = (f32x4){sig2_(v1.x), sig2_(v1.y), sig2_(v1.z), sig2_(v1.w)}; }
                if (pn >= 11) { u32x2 w8; w8.x = g8pack(v0); w8.y = g8pack(v1); *(u32x2*)(GB + blk_off(row, (pn - 11) * BM + bj * HALF + wc * 32 + 8 * fq, 3072)) = w8; }
                else if (pn >= 2) {
                    const int hc = (pn - 2) * BM + bj * HALF + wc * 32;
                    const int reg = hc < 1536 ? hc >> 9 : (hc < 2048 ? 3 : (hc < 2176 ? 4 : 5)), hin = hc < 1536 ? hc & 511 : (hc < 2048 ? hc - 1536 : (hc - 2048) & 127);
                    const size_t base = reg <= 3 ? (size_t)reg * (MC * 512) : (size_t)4 * (MC * 512) + (size_t)(reg - 4) * (MC * 128);
                    const int nh = reg <= 3 ? 8 : 2, b = row >> 11, s = row & (SEQ - 1);
                    st16(wsb, (u32x4*)(HM + base + (((size_t)(b * nh + (hin >> 6)) * SEQ + s) * 64 + (hin & 63) + 8 * fq)), pack8(v0, v1));
                }
                else st16(wsb, (u32x4*)(zr + bj * HALF), pack8(v0, v1));
            }
            if (pn <= 1) { ssq = fq_sum(ssq); if (fq == 0) (pn == 0 ? sq : skv)[(size_t)row * 4 + wc] = ssq; }
        }
    }
};
struct EpiQ {
    static constexpr bool PERM = true, MID = false; static constexpr int NVM = 24;
    bf16_t* Q; const float* sq; const float* cosT; const float* sinT;
    __device__ __forceinline__ void operator()(const Acc& acc, const Unit& u, int wr, int wc, int fr, int fq) const {
        EPI_ROWBASE;
        float r8[8]; rowscale4(sq, rbase, 1.f / 256.f, r8);
        __builtin_amdgcn_sched_barrier(0);
        EPI_LOOP {
            __builtin_amdgcn_sched_barrier(0);
            const int row = rbase + ai * HALF + m * 16; const float r = r8[ai * 4 + m]; const int pos = row & (SEQ - 1);
#pragma unroll
            for (int bj = 0; bj < 2; ++bj) {
                const int col = u.pn * BM + bj * HALF + wc * 32 + 8 * fq; const int j0 = col % 96;
                f32x4 v0 = acc[ai][bj][m][0] * r, v1 = acc[ai][bj][m][1] * r;
                if (j0 >= 64) { const int i0 = (j0 - 64) >> 1; rope8(v0, v1, cosT + pos * 16 + i0, sinT + pos * 16 + i0); }
                *(u32x4*)(Q + (size_t)row * 768 + col) = pack8(v0, v1);
            }
        }
    }
};
struct EpiKV {
    static constexpr bool PERM = true, MID = false; static constexpr int NVM = 24;
    bf16_t* KV; const float* skv;
    __device__ __forceinline__ void operator()(const Acc& acc, const Unit& u, int wr, int wc, int fr, int fq) const {
        EPI_ROWBASE;
        float r8[8]; rowscale4(skv, rbase, 1.f / 128.f, r8);
        __builtin_amdgcn_sched_barrier(0);
        EPI_LOOP {
            const int row = rbase + ai * HALF + m * 16; const float r = r8[ai * 4 + m];
#pragma unroll
            for (int bj = 0; bj < 2; ++bj) {
                const int col = u.pn * BM + bj * HALF + wc * 32 + 8 * fq;
                *(u32x4*)(KV + (size_t)row * 1024 + col) = pack8(acc[ai][bj][m][0] * r, acc[ai][bj][m][1] * r);
            }
        }
    }
};
struct EpiBr {
    static constexpr bool PERM = true, MID = true; static constexpr int NVM = 32;
    const unsigned char* G; bf16_t* MG; unsigned char* wsb;
    __device__ __forceinline__ void mid(Acc& acc, const Unit& u, int seg, int wr, int wc, int fr, int fq) const {
        EPI_ROWBASE; const int col = u.pn * BM + wc * 32 + 8 * fq;
#pragma unroll
        for (int ai = 0; ai < 2; ++ai) {
            __builtin_amdgcn_sched_barrier(0);
            u32x2 wn[4][2], wd[4][2];
#pragma unroll
            for (int m = 0; m < 4; ++m)
#pragma unroll
                for (int bj = 0; bj < 2; ++bj) { const int row = rbase + ai * HALF + m * 16; wn[m][bj] = *(const u32x2*)(G + blk_off(row, (seg - 1) * 1024 + col + bj * HALF, 3072)); wd[m][bj] = *(const u32x2*)(G + blk_off(row, seg * 1024 + col + bj * HALF, 3072)); }
#pragma unroll
            for (int m = 0; m < 4; ++m)
#pragma unroll
                for (int bj = 0; bj < 2; ++bj) {
                    const f32x4 n0 = g8unpack(wn[m][bj].x), n1 = g8unpack(wn[m][bj].y), d0 = g8unpack(wd[m][bj].x), d1 = g8unpack(wd[m][bj].y);
                    f32x4 r0, r1;
                    r0.x = n0.x * fast_rcp(d0.x); r0.y = n0.y * fast_rcp(d0.y); r0.z = n0.z * fast_rcp(d0.z); r0.w = n0.w * fast_rcp(d0.w);
                    r1.x = n1.x * fast_rcp(d1.x); r1.y = n1.y * fast_rcp(d1.y); r1.z = n1.z * fast_rcp(d1.z); r1.w = n1.w * fast_rcp(d1.w);
                    acc[ai][bj][m][0] = acc[ai][bj][m][0] * r0; acc[ai][bj][m][1] = acc[ai][bj][m][1] * r1;
                }
        }
    }
    __device__ __forceinline__ void operator()(const Acc& acc, const Unit& u, int wr, int wc, int fr, int fq) const {
        EPI_ROWBASE; const int col = u.pn * BM + wc * 32 + 8 * fq;
#pragma unroll
        for (int ai = 0; ai < 2; ++ai) {
            __builtin_amdgcn_sched_barrier(0);
            u32x2 wg[4][2];
#pragma unroll
            for (int m = 0; m < 4; ++m)
#pragma unroll
                for (int bj = 0; bj < 2; ++bj) wg[m][bj] = *(const u32x2*)(G + blk_off(rbase + ai * HALF + m * 16, 2048 + col + bj * HALF, 3072));
#pragma unroll
            for (int m = 0; m < 4; ++m)
#pragma unroll
                for (int bj = 0; bj < 2; ++bj) { const f32x4 g0 = g8unpack(wg[m][bj].x) * ((P5_F8 ? 16.f : 1.f) * (P4_F8 ? 1.f / 4096.f : 1.f) / 255.f), g1 = g8unpack(wg[m][bj].y) * ((P5_F8 ? 16.f : 1.f) * (P4_F8 ? 1.f / 4096.f : 1.f) / 255.f);
                    if (P5_F8) { const f32x4 v0 = acc[ai][bj][m][0] * g0, v1 = acc[ai][bj][m][1] * g1; u32x2 o8; o8.x = pk_fp8x4(v0.x, v0.y, v0.z, v0.w); o8.y = pk_fp8x4(v1.x, v1.y, v1.z, v1.w);
                        st8(wsb, (u32x2*)((unsigned char*)MG + blk_off(rbase + ai * HALF + m * 16, (col + bj * HALF) >> 1, 512) * 2), o8); }
                    else st16(wsb, (u32x4*)(MG + blk_off(rbase + ai * HALF + m * 16, col + bj * HALF, 1024)), pack8(acc[ai][bj][m][0] * g0, acc[ai][bj][m][1] * g1)); }
        }
    }
};
template <bool F8OUT> struct EpiRes {
    static constexpr bool PERM = true, MID = false; static constexpr int NVM = 40;
    bf16_t* xb; float* st; int row0; unsigned char* x8; float asc;
    __device__ __forceinline__ void operator()(const Acc& acc, const Unit& u, int wr, int wc, int fr, int fq) const {
        EPI_ROWBASE; const int col = u.pn * BM + wc * 32 + 8 * fq;
#pragma unroll
        for (int ai = 0; ai < 2; ++ai) {
            __builtin_amdgcn_sched_barrier(0);
            u32x4 xi[4][2];
#pragma unroll
            for (int m = 0; m < 4; ++m)
#pragma unroll
                for (int bj = 0; bj < 2; ++bj) xi[m][bj] = *(const u32x4*)(xb + (size_t)(row0 + rbase + ai * HALF + m * 16) * DM + col + bj * HALF);
#pragma unroll
            for (int m = 0; m < 4; ++m) {
                const int row = row0 + rbase + ai * HALF + m * 16; float ssq = 0.f;
#pragma unroll
                for (int bj = 0; bj < 2; ++bj) { f32x4 x0, x1; unpack8(xi[m][bj], x0, x1);
                    const f32x4 v0 = x0 + acc[ai][bj][m][0] * asc, v1 = x1 + acc[ai][bj][m][1] * asc;
                    *(u32x4*)(xb + (size_t)row * DM + col + bj * HALF) = pack8(v0, v1); ssq += sq8(v0, v1);
                    if constexpr (F8OUT) { u32x2 o8; o8.x = pk_fp8x4(v0.x * 16.f, v0.y * 16.f, v0.z * 16.f, v0.w * 16.f); o8.y = pk_fp8x4(v1.x * 16.f, v1.y * 16.f, v1.z * 16.f, v1.w * 16.f); *(u32x2*)(x8 + (size_t)row * DM + col + bj * HALF) = o8; } }
                ssq = fq_sum(ssq); if (fq == 0) st[(size_t)row * 16 + u.pn * 4 + wc] = ssq;
            }
        }
    }
};
__device__ __forceinline__ float silu_mul(float g, float u) { return g * sigmoidf_(g) * u; }
struct EpiGU {
    static constexpr bool PERM = true, MID = false; static constexpr int NVM = 16;
    bf16_t* ACT; const float* st; int ldact; unsigned char* wsb;
    __device__ __forceinline__ void operator()(const Acc& acc, const Unit& u, int wr, int wc, int fr, int fq) const {
        EPI_ROWBASE;
        float r8[8]; rowscale16(st, rbase, fq, r8);
        __builtin_amdgcn_sched_barrier(0);
        EPI_LOOP {
            const int row = rbase + ai * HALF + m * 16; const float r = r8[ai * 4 + m];
            f32x4 g0 = acc[ai][0][m][0] * r, g1 = acc[ai][0][m][1] * r, u0 = acc[ai][1][m][0] * r, u1 = acc[ai][1][m][1] * r;
#ifdef PROBE_P6NOISE
            { unsigned h_ = (unsigned)row * 2654435761u ^ (unsigned)(u.pn * 64 + wc * 8 + fq) * 40503u; float nz[16];
#pragma unroll
              for (int e_ = 0; e_ < 16; ++e_) { h_ = h_ * 1664525u + 1013904223u; nz[e_] = ((float)(h_ >> 8) * (1.f / 16777216.f) - 0.5f) * 3.4641f * 0.035f * (float)(PROBE_P6NOISE); }
              g0.x += nz[0]; g0.y += nz[1]; g0.z += nz[2]; g0.w += nz[3]; g1.x += nz[4]; g1.y += nz[5]; g1.z += nz[6]; g1.w += nz[7]; u0.x += nz[8]; u0.y += nz[9]; u0.z += nz[10]; u0.w += nz[11]; u1.x += nz[12]; u1.y += nz[13]; u1.z += nz[14]; u1.w += nz[15]; }
#endif
            const f32x4 a0 = {silu_mul(g0.x, u0.x), silu_mul(g0.y, u0.y), silu_mul(g0.z, u0.z), silu_mul(g0.w, u0.w)};
            const f32x4 a1 = {silu_mul(g1.x, u1.x), silu_mul(g1.y, u1.y), silu_mul(g1.z, u1.z), silu_mul(g1.w, u1.w)};
            st16(wsb, (u32x4*)(ACT + blk_off(row, u.aux * HALF + wc * 32 + 8 * fq, ldact)), pack8(a0, a1));
        }
    }
};
struct EpiGUMoe {
    static constexpr bool PERM = true, MID = false; static constexpr int NVM = 16;
    bf16_t* ACT; const float* rowrr; int ldact; unsigned char* wsb;
    __device__ __forceinline__ void operator()(const Acc& acc, const Unit& u, int wr, int wc, int fr, int fq) const {
        EPI_ROWBASE;
        float r8[8];
#pragma unroll
        for (int i = 0; i < 8; ++i) r8[i] = rowrr[rbase + (i >> 2) * HALF + (i & 3) * 16] * (MOE_F8 ? 1.f / 4096.f : 1.f);
        __builtin_amdgcn_sched_barrier(0);
        EPI_LOOP {
            const int row = rbase + ai * HALF + m * 16; const float r = r8[ai * 4 + m];
            const float ru = MOE_DN_F8 ? r * 8.f : r;
            const f32x4 g0 = acc[ai][0][m][0] * r, g1 = acc[ai][0][m][1] * r, u0 = acc[ai][1][m][0] * ru, u1 = acc[ai][1][m][1] * ru;
            const f32x4 a0 = {silu_mul(g0.x, u0.x), silu_mul(g0.y, u0.y), silu_mul(g0.z, u0.z), silu_mul(g0.w, u0.w)};
            const f32x4 a1 = {silu_mul(g1.x, u1.x), silu_mul(g1.y, u1.y), silu_mul(g1.z, u1.z), silu_mul(g1.w, u1.w)};
            if (MOE_DN_F8) { u32x2 o8; o8.x = pk_fp8x4(a0.x, a0.y, a0.z, a0.w); o8.y = pk_fp8x4(a1.x, a1.y, a1.z, a1.w);
                st8(wsb, (u32x2*)((unsigned char*)ACT + blk_off(row, (u.aux * HALF + wc * 32 + 8 * fq) >> 1, ldact >> 1) * 2), o8); }
            else st16(wsb, (u32x4*)(ACT + blk_off(row, u.aux * HALF + wc * 32 + 8 * fq, ldact)), pack8(a0, a1));
        }
    }
};
template <bool FIRST> struct EpiDnMoe {
    static constexpr bool PERM = true, MID = false; static constexpr int NVM = 32;
    unsigned char* ws; const int* rowtok; const float* rowgw;
    __device__ __forceinline__ void operator()(const Acc& acc, const Unit& u, int wr, int wc, int fr, int fq) const {
        EPI_ROWBASE; const int col = u.aux * BM + wc * 32 + 8 * fq;
        int tk[8]; float gw8[8];
#pragma unroll
        for (int i = 0; i < 8; ++i) { tk[i] = rowtok[rbase + (i >> 2) * HALF + (i & 3) * 16]; gw8[i] = rowgw[rbase + (i >> 2) * HALF + (i & 3) * 16] * (MOE_DN_F8 ? 1.f / 8192.f : 1.f); }
#pragma unroll
        for (int ai = 0; ai < 2; ++ai) {
            __builtin_amdgcn_sched_barrier(0);
            u32x4 xi[4][2]; bf16_t* xr[4];
#pragma unroll
            for (int m = 0; m < 4; ++m) { const int tok = tk[ai * 4 + m] < 0 ? 0 : tk[ai * 4 + m]; xr[m] = xm_row(ws, tok) + col;
                const bf16_t* src = FIRST ? (const bf16_t*)(ws + WS_XB) + (size_t)tok * DM + col : xr[m];
#pragma unroll
                for (int bj = 0; bj < 2; ++bj) xi[m][bj] = *(const u32x4*)(src + bj * HALF); }
#pragma unroll
            for (int m = 0; m < 4; ++m) { const float gwv = gw8[ai * 4 + m];
                if (tk[ai * 4 + m] >= 0) {
#pragma unroll
                    for (int bj = 0; bj < 2; ++bj) { f32x4 x0, x1; unpack8(xi[m][bj], x0, x1);
                        *(u32x4*)(xr[m] + bj * HALF) = pack8(x0 + acc[ai][bj][m][0] * gwv, x1 + acc[ai][bj][m][1] * gwv); } } }
        }
    }
};
}
namespace att {
constexpr float MLA_THR = 6.f;
__device__ __forceinline__ int crow(int r, int hi) { return (r & 3) + 8 * (r >> 2) + 4 * hi; }
__device__ __forceinline__ float xhalf_max(float m) { return xmax32(m); }
__device__ __forceinline__ float xhalf_sum(float m) { return xsum32(m); }
typedef short v4i16_t __attribute__((ext_vector_type(4)));
__device__ __forceinline__ s16x4 vtr(const LAS unsigned char* p) { return __builtin_bit_cast(s16x4, __builtin_amdgcn_ds_read_tr16_b64_v4i16((LAS v4i16_t*)p)); }
__device__ __forceinline__ bf16x8 cat8(s16x4 a, s16x4 b) { return (bf16x8){a[0], a[1], a[2], a[3], b[0], b[1], b[2], b[3]}; }
__device__ __forceinline__ bf16x8 pfrag(const f32x16& p, int s8) {
    u32x4 w; w.x = cvt_pk_bf16(p[s8 + 0], p[s8 + 1]); w.y = cvt_pk_bf16(p[s8 + 2], p[s8 + 3]); w.z = cvt_pk_bf16(p[s8 + 4], p[s8 + 5]); w.w = cvt_pk_bf16(p[s8 + 6], p[s8 + 7]);
    return __builtin_bit_cast(bf16x8, w);
}
constexpr int TAB_STRIDE = 320;

constexpr int BW_ROWS = 384, BW_KP = 144;
constexpr int BW_K = 0, BW_V = BW_ROWS * BW_KP, BW_VDH = BW_ROWS * 64, BW_TAB = BW_V + 2 * BW_VDH, BW_END = BW_TAB + 4 * TAB_STRIDE * 4;
struct BandPre { u32x4 k[6], v[6]; float t[4]; bf16x8 q[4]; };
struct BandItem { int kind, b, hh, g0, a0; };
__device__ __forceinline__ BandItem band_decode(int i, int items_per_kind) {
    BandItem it; it.kind = i / items_per_kind; const int w = i % items_per_kind;
    if (it.kind < 3) { const int sub = w & 7; it.hh = (w >> 3) & 7; it.b = w >> 6;
        if (it.kind == 0) { it.g0 = 0; it.a0 = 256 * sub; } else if (it.kind == 1) { it.g0 = sub >> 1; it.a0 = 256 * (sub & 1); } else { it.g0 = 2 * sub; it.a0 = 0; } }
    else { it.a0 = 64 * (w & 31); it.hh = (w >> 5) & 1; it.b = w >> 6; it.g0 = 0; }
    return it;
}
__device__ __forceinline__ bool band_row(const BandItem& it, int r, int& pos) {
    int key, g = it.g0, dil, L;
    if (it.kind == 3) { if (r >= 320) return false; key = it.a0 - 128 + r; dil = 1; L = SEQ; }
    else if (it.kind == 2) { if (r >= 256) return false; g += r >> 7; key = r & 127; dil = 16; L = 128; }
    else { dil = it.kind == 0 ? 1 : 4; L = SEQ / dil; key = it.a0 - 64 + r; }
    if (key < 0 || key >= L) return false;
    pos = key * dil + g; return true;
}
__device__ __forceinline__ void band_issue(BandPre& P, const BandItem& it, const bf16_t* HM, const float* tabg, int tid, int wid, int lane) {
    const bf16_t* kb = it.kind == 3 ? HM + (size_t)4 * MC * 512 + ((size_t)(it.b * 2 + it.hh) * SEQ) * 64 : HM + (size_t)MC * 512 + ((size_t)(it.b * 8 + it.hh) * SEQ) * 64;
    const bf16_t* vb = it.kind == 3 ? kb + (size_t)MC * 128 : kb + (size_t)MC * 512;
#pragma unroll
    for (int i = 0; i < 6; ++i) { const int id = i * 512 + tid, r = id >> 3, c = id & 7; int pos; P.k[i] = (u32x4){0u, 0u, 0u, 0u}; P.v[i] = P.k[i];
        if (band_row(it, r, pos)) { P.k[i] = *(const u32x4*)(kb + (size_t)pos * 64 + c * 8); P.v[i] = *(const u32x4*)(vb + (size_t)pos * 64 + c * 8); } }
#pragma unroll
    for (int j = 0; j < 4; ++j) { P.t[j] = 0.f; if (tid < TAB_STRIDE && (it.kind == 3 || j == 0)) P.t[j] = tabg[((it.kind == 3 ? 3 * 8 + it.hh * 4 + j : it.kind * 8 + it.hh)) * TAB_STRIDE + tid]; }
    int a0w, g = it.g0, dil, qh; const bf16_t* qbuf;
    if (it.kind == 3) { a0w = it.a0 + 32 * (wid & 1); dil = 1; qh = it.hh * 4 + (wid >> 1); qbuf = HM + (size_t)3 * MC * 512; }
    else if (it.kind == 2) { a0w = 32 * (wid & 3); g += wid >> 2; dil = 16; qh = it.hh; qbuf = HM; }
    else { a0w = it.a0 + 32 * wid; dil = it.kind == 0 ? 1 : 4; qh = it.hh; qbuf = HM; }
    const bf16_t* qp = qbuf + (((size_t)(it.b * 8 + qh) * SEQ) + (size_t)(a0w + (lane & 31)) * dil + g) * 64 + (lane >> 5) * 8;
#pragma unroll
    for (int d0 = 0; d0 < 4; ++d0) P.q[d0] = *(const bf16x8*)(qp + d0 * 16);
}
__device__ __forceinline__ void band_store(const BandPre& P, const BandItem& it, LAS unsigned char* lds, int tid) {
#pragma unroll
    for (int i = 0; i < 6; ++i) { const int id = i * 512 + tid, r = id >> 3, c = id & 7;
        *(LAS u32x4*)(lds + BW_K + r * BW_KP + c * 16) = P.k[i]; *(LAS u32x4*)(lds + BW_V + (c >> 2) * BW_VDH + r * 64 + (c & 3) * 16) = P.v[i]; }
    if (tid < TAB_STRIDE) {
#pragma unroll
        for (int j = 0; j < 4; ++j) if (it.kind == 3 || j == 0) ((LAS float*)(lds + BW_TAB))[j * TAB_STRIDE + tid] = P.t[j]; }
}
template <int NKB, int MODE>
__device__ __forceinline__ void band_compute(const bf16x8 (&qf)[4], const LAS unsigned char* lds, int rowoff, int a0w, int L, const LAS float* tab, bf16_t* op, float* stp, float sink2, int lane,
                                             const bf16_t* pb0 = nullptr, const bf16_t* pb1 = nullptr, const float* st0 = nullptr, const float* st1 = nullptr) {
    constexpr int R = 16 * (NKB - 1);
    const int q = lane & 31, hi = lane >> 5;
    f32x16 o0, o1;
#pragma unroll
    for (int r = 0; r < 16; ++r) { o0[r] = 0.f; o1[r] = 0.f; }
    float m = -3e38f, l = 0.f;
    const LAS float* tb = tab + (31 - q + 4 * hi);
    const int kro = q * BW_KP + hi * 16, vro = (4 * hi + ((lane & 15) >> 2)) * 64 + (16 * ((lane >> 4) & 1) + 4 * (lane & 3)) * 2;
#pragma unroll 1
    for (int kb = 0; kb < NKB; ++kb) {
        const int k0 = a0w - R + 32 * kb;
        if (k0 < 0 || k0 >= L) continue;
        const LAS unsigned char* kp = lds + BW_K + (rowoff + k0) * BW_KP + kro;
        f32x16 s;
#pragma unroll
        for (int r = 0; r < 16; ++r) s[r] = 0.f;
#pragma unroll
        for (int d0 = 0; d0 < 4; ++d0) s = __builtin_amdgcn_mfma_f32_32x32x16_bf16(*(const LAS bf16x8*)(kp + d0 * 32), qf[d0], s, 0, 0, 0);
#pragma unroll
        for (int r = 0; r < 16; ++r) s[r] += tb[32 * kb + (r & 3) + 8 * (r >> 2)];
        float bm = s[0];
#pragma unroll
        for (int r = 1; r < 16; ++r) bm = fmaxf(bm, s[r]);
        bm = xhalf_max(bm);
        if (__any(bm > m + MLA_THR)) {
            const float mn = fmaxf(m, bm), f = fast_exp2(m - mn); l *= f; m = mn;
#pragma unroll
            for (int r = 0; r < 16; ++r) { o0[r] *= f; o1[r] *= f; } }
        float ps = 0.f;
#pragma unroll
        for (int r = 0; r < 16; ++r) { s[r] = fast_exp2(s[r] - m); ps += s[r]; }
        l += ps;
        const bf16x8 p0 = pfrag(s, 0), p1 = pfrag(s, 8);
        const LAS unsigned char* vp = lds + BW_V + (rowoff + k0) * 64 + vro;
        { const bf16x8 v00 = cat8(vtr(vp), vtr(vp + 512)), v01 = cat8(vtr(vp + BW_VDH), vtr(vp + BW_VDH + 512));
          const bf16x8 v10 = cat8(vtr(vp + 1024), vtr(vp + 1024 + 512)), v11 = cat8(vtr(vp + BW_VDH + 1024), vtr(vp + BW_VDH + 1024 + 512));
          o0 = __builtin_amdgcn_mfma_f32_32x32x16_bf16(v00, p0, o0, 0, 0, 0); o1 = __builtin_amdgcn_mfma_f32_32x32x16_bf16(v01, p0, o1, 0, 0, 0);
          o0 = __builtin_amdgcn_mfma_f32_32x32x16_bf16(v10, p1, o0, 0, 0, 0); o1 = __builtin_amdgcn_mfma_f32_32x32x16_bf16(v11, p1, o1, 0, 0, 0); }
    }
    float lt = xhalf_sum(l);
    if (MODE == 2) {
        const f32x2 s0 = *(const f32x2*)st0, s1 = *(const f32x2*)st1;
        u32x2 a0[8], a1[8];
#pragma unroll
        for (int j = 0; j < 4; ++j) { a0[j] = *(const u32x2*)(pb0 + 8 * j); a0[4 + j] = *(const u32x2*)(pb0 + 32 + 8 * j); a1[j] = *(const u32x2*)(pb1 + 8 * j); a1[4 + j] = *(const u32x2*)(pb1 + 32 + 8 * j); }
        const float M = fmaxf(m, fmaxf(s0.x, s1.x));
        const float w0 = fast_exp2(s0.x - M) * s0.y, w1 = fast_exp2(s1.x - M) * s1.y, w2 = fast_exp2(m - M);
        const float inv = 1.f / (w0 + w1 + w2 * lt), c0 = w0 * inv, c1 = w1 * inv, c2 = w2 * inv;
#pragma unroll
        for (int j = 0; j < 4; ++j) {
            u32x2 w0_, w1_;
            { const float x0 = bf_lo(a0[j].x) * c0 + bf_lo(a1[j].x) * c1 + o0[4 * j] * c2, x1 = bf_hi(a0[j].x) * c0 + bf_hi(a1[j].x) * c1 + o0[4 * j + 1] * c2;
              const float x2 = bf_lo(a0[j].y) * c0 + bf_lo(a1[j].y) * c1 + o0[4 * j + 2] * c2, x3 = bf_hi(a0[j].y) * c0 + bf_hi(a1[j].y) * c1 + o0[4 * j + 3] * c2;
              w0_.x = cvt_pk_bf16(x0, x1); w0_.y = cvt_pk_bf16(x2, x3); }
            { const float x0 = bf_lo(a0[4 + j].x) * c0 + bf_lo(a1[4 + j].x) * c1 + o1[4 * j] * c2, x1 = bf_hi(a0[4 + j].x) * c0 + bf_hi(a1[4 + j].x) * c1 + o1[4 * j + 1] * c2;
              const float x2 = bf_lo(a0[4 + j].y) * c0 + bf_lo(a1[4 + j].y) * c1 + o1[4 * j + 2] * c2, x3 = bf_hi(a0[4 + j].y) * c0 + bf_hi(a1[4 + j].y) * c1 + o1[4 * j + 3] * c2;
              w1_.x = cvt_pk_bf16(x0, x1); w1_.y = cvt_pk_bf16(x2, x3); }
            if (P4_F8) { *(unsigned*)((unsigned char*)op + 8 * j) = pk_fp8x4(bf_lo(w0_.x) * 16.f, bf_hi(w0_.x) * 16.f, bf_lo(w0_.y) * 16.f, bf_hi(w0_.y) * 16.f); *(unsigned*)((unsigned char*)op + 32 + 8 * j) = pk_fp8x4(bf_lo(w1_.x) * 16.f, bf_hi(w1_.x) * 16.f, bf_lo(w1_.y) * 16.f, bf_hi(w1_.y) * 16.f); }
            else { *(u32x2*)(op + 8 * j) = w0_; *(u32x2*)(op + 32 + 8 * j) = w1_; }
        }
        return;
    }
    if (MODE == 1) lt += fast_exp2(sink2 - m);
    else if (hi == 0) { stp[0] = m; stp[1] = lt; }
    const float inv = 1.f / lt;
#pragma unroll
    for (int j = 0; j < 4; ++j) {
        u32x2 w0, w1; w0.x = cvt_pk_bf16(o0[4 * j] * inv, o0[4 * j + 1] * inv); w0.y = cvt_pk_bf16(o0[4 * j + 2] * inv, o0[4 * j + 3] * inv);
        w1.x = cvt_pk_bf16(o1[4 * j] * inv, o1[4 * j + 1] * inv); w1.y = cvt_pk_bf16(o1[4 * j + 2] * inv, o1[4 * j + 3] * inv);
        if (MODE == 1 && P4_F8) { const float i16 = inv * 16.f; *(unsigned*)((unsigned char*)op + 8 * j) = pk_fp8x4(o0[4 * j] * i16, o0[4 * j + 1] * i16, o0[4 * j + 2] * i16, o0[4 * j + 3] * i16); *(unsigned*)((unsigned char*)op + 32 + 8 * j) = pk_fp8x4(o1[4 * j] * i16, o1[4 * j + 1] * i16, o1[4 * j + 2] * i16, o1[4 * j + 3] * i16); }
        else { *(u32x2*)(op + 8 * j) = w0; *(u32x2*)(op + 32 + 8 * j) = w1; }
    }
}

constexpr int MLA_KP = 208;
constexpr int MLA_TK = 128;
constexpr int MLA_KTB = MLA_TK * MLA_KP;
constexpr int MLA_VTB = MLA_TK * 128;
constexpr int MLA_SLOT = MLA_KTB + MLA_VTB;
__device__ __forceinline__ void mla_unit(const bf16_t* Q, const bf16_t* KV, const bf16_t* Zc, bf16_t* Y, int b, int h, int qblk, LAS unsigned char* lds, int tid, int wid, int lane) {
    const int q = lane & 31, hi = lane >> 5;
    const size_t rb = (size_t)b * SEQ;
    bf16x8 qf[6];
    { const bf16_t* qp = Q + (rb + qblk * 256 + wid * 32 + q) * 768 + h * 96 + hi * 8;
#pragma unroll
      for (int d0 = 0; d0 < 6; ++d0) qf[d0] = *(const bf16x8*)(qp + d0 * 16); }
    const bf16_t* gk = KV + (rb + (tid >> 3)) * 1024 + h * 64 + (tid & 7) * 8;
    const bf16_t* gv = gk + 512;
    const bf16_t* gp = Zc + (rb + (tid >> 2)) * ZW + ZO_KPE + (tid & 3) * 8;
    const int lk = (tid >> 3) * MLA_KP + (tid & 7) * 16, lp = (tid >> 2) * MLA_KP + 128 + (tid & 3) * 16;
    const int lv = MLA_KTB + ((tid & 7) >> 2) * (MLA_TK * 64) + (tid >> 3) * 64 + (tid & 3) * 16;
    u32x4 rk0, rk1, rv0, rv1, rp;
#define MLA_GLOAD(T) do { const size_t go_ = (size_t)(T) * MLA_TK; rk0 = *(const u32x4*)(gk + go_ * 1024); rk1 = *(const u32x4*)(gk + (go_ + 64) * 1024); \
        rv0 = *(const u32x4*)(gv + go_ * 1024); rv1 = *(const u32x4*)(gv + (go_ + 64) * 1024); rp = *(const u32x4*)(gp + go_ * ZW); } while (0)
#define MLA_LSTORE(slot) do { LAS unsigned char* sb_ = lds + (slot) * MLA_SLOT; *(LAS u32x4*)(sb_ + lk) = rk0; *(LAS u32x4*)(sb_ + lk + 64 * MLA_KP) = rk1; \
        *(LAS u32x4*)(sb_ + lv) = rv0; *(LAS u32x4*)(sb_ + lv + 64 * 64) = rv1; *(LAS u32x4*)(sb_ + lp) = rp; } while (0)
    MLA_GLOAD(0); MLA_LSTORE(0); MLA_GLOAD(1); MLA_LSTORE(1);
    __syncthreads();
    f32x16 o0, o1;
#pragma unroll
    for (int r = 0; r < 16; ++r) { o0[r] = 0.f; o1[r] = 0.f; }
    float m = 0.f, l = 0.f;
    const int kro = q * MLA_KP + hi * 16;
    const int vro = MLA_KTB + (4 * hi + ((lane & 15) >> 2)) * 64 + (16 * ((lane >> 4) & 1) + 4 * (lane & 3)) * 2;
    f32x16 sa0, sa1, sb0, sb1, negm;
#pragma unroll
    for (int r = 0; r < 16; ++r) negm[r] = 0.f;
    m = 0.f;
#define MLA_QK(S0, S1, slot, sub) do { const LAS unsigned char* kb_ = lds + (slot) * MLA_SLOT + (sub) * 64 * MLA_KP + kro; \
        { const bf16x8 k0_ = *(const LAS bf16x8*)(kb_), k1_ = *(const LAS bf16x8*)(kb_ + 32 * MLA_KP); \
          S0 = __builtin_amdgcn_mfma_f32_32x32x16_bf16(k0_, qf[0], negm, 0, 0, 0); S1 = __builtin_amdgcn_mfma_f32_32x32x16_bf16(k1_, qf[0], negm, 0, 0, 0); } \
        _Pragma("unroll") for (int d0 = 1; d0 < 6; ++d0) { const bf16x8 k0_ = *(const LAS bf16x8*)(kb_ + d0 * 32), k1_ = *(const LAS bf16x8*)(kb_ + 32 * MLA_KP + d0 * 32); \
            S0 = __builtin_amdgcn_mfma_f32_32x32x16_bf16(k0_, qf[d0], S0, 0, 0, 0); S1 = __builtin_amdgcn_mfma_f32_32x32x16_bf16(k1_, qf[d0], S1, 0, 0, 0); } } while (0)
#define MAX3(a, b, c) __builtin_fmaxf(__builtin_fmaxf((a), (b)), (c))
#define MLA_STEP(C0, C1, N0, N1, HASN, NSLOT, NSUB, CSLOT, CSUB, FIRST) do { \
        if (HASN) MLA_QK(N0, N1, NSLOT, NSUB); \
        float ba = MAX3(C0[0], C0[1], C1[0]), bb = MAX3(C0[2], C0[3], C1[1]); ba = MAX3(ba, C1[2], C1[3]); \
        _Pragma("unroll") for (int r = 4; r < 16; r += 4) { ba = MAX3(ba, C0[r], C0[r + 1]); bb = MAX3(bb, C0[r + 2], C0[r + 3]); ba = MAX3(ba, C1[r], C1[r + 1]); bb = MAX3(bb, C1[r + 2], C1[r + 3]); } \
        float bm = xhalf_max(__builtin_fmaxf(ba, bb)); \
        if ((FIRST) || __any(bm > MLA_THR)) {                                \
            const float dl = (FIRST) ? bm : __builtin_fmaxf(bm, 0.f), f = fast_exp2(-dl); m += dl; l *= f; \
            _Pragma("unroll") for (int r = 0; r < 16; ++r) { o0[r] *= f; o1[r] *= f; C0[r] -= dl; C1[r] -= dl; negm[r] = -m; } \
            if (HASN) { _Pragma("unroll") for (int r = 0; r < 16; ++r) { N0[r] -= dl; N1[r] -= dl; } } } \
        float ps = 0.f; \
        _Pragma("unroll") for (int r = 0; r < 16; ++r) { C0[r] = fast_exp2(C0[r]); C1[r] = fast_exp2(C1[r]); ps += C0[r] + C1[r]; } \
        l += ps; \
        const bf16x8 p0 = pfrag(C0, 0), p1 = pfrag(C0, 8), p2 = pfrag(C1, 0), p3 = pfrag(C1, 8); \
        const LAS unsigned char* vb = lds + (CSLOT) * MLA_SLOT + (CSUB) * 64 * 64 + vro; \
        MLA_PV(0, p0); MLA_PV(1, p1); MLA_PV(2, p2); MLA_PV(3, p3); } while (0)
#define MLA_PV(S, P) do { const bf16x8 va = cat8(vtr(vb + (S) * 1024), vtr(vb + (S) * 1024 + 512)), vc = cat8(vtr(vb + MLA_TK * 64 + (S) * 1024), vtr(vb + MLA_TK * 64 + (S) * 1024 + 512)); \
            o0 = __builtin_amdgcn_mfma_f32_32x32x16_bf16(va, P, o0, 0, 0, 0); o1 = __builtin_amdgcn_mfma_f32_32x32x16_bf16(vc, P, o1, 0, 0, 0); } while (0)
    MLA_QK(sa0, sa1, 0, 0);
    int sc = 0, sn = 1, sw = 2;
    constexpr int NT = SEQ / MLA_TK;
    for (int T = 0; T < NT; ++T) {
        const bool has1 = T + 1 < NT, has2 = T + 2 < NT;
        if (has2) MLA_GLOAD(T + 2);
        MLA_STEP(sa0, sa1, sb0, sb1, true, sc, 1, sc, 0, T == 0);
        MLA_STEP(sb0, sb1, sa0, sa1, has1, sn, 0, sc, 1, false);
        if (has2) MLA_LSTORE(sw);
        __syncthreads();
        const int tmp = sc; sc = sn; sn = sw; sw = tmp;
    }
#undef MAX3
#undef MLA_GLOAD
#undef MLA_LSTORE
#undef MLA_QK
#undef MLA_STEP
#undef MLA_PV
    const float inv = 1.f / xhalf_sum(l);
    bf16_t* op = P4_F8 ? (bf16_t*)((unsigned char*)Y + (rb + qblk * 256 + wid * 32 + q) * 1536 + h * 64 + 4 * hi) : Y + (rb + qblk * 256 + wid * 32 + q) * 1536 + h * 64 + 4 * hi;
#pragma unroll
    for (int j = 0; j < 4; ++j) {
        u32x2 w0, w1; w0.x = cvt_pk_bf16(o0[4 * j] * inv, o0[4 * j + 1] * inv); w0.y = cvt_pk_bf16(o0[4 * j + 2] * inv, o0[4 * j + 3] * inv);
        w1.x = cvt_pk_bf16(o1[4 * j] * inv, o1[4 * j + 1] * inv); w1.y = cvt_pk_bf16(o1[4 * j + 2] * inv, o1[4 * j + 3] * inv);
        if (P4_F8) { const float i16 = inv * 16.f; *(unsigned*)((unsigned char*)op + 8 * j) = pk_fp8x4(o0[4 * j] * i16, o0[4 * j + 1] * i16, o0[4 * j + 2] * i16, o0[4 * j + 3] * i16); *(unsigned*)((unsigned char*)op + 32 + 8 * j) = pk_fp8x4(o1[4 * j] * i16, o1[4 * j + 1] * i16, o1[4 * j + 2] * i16, o1[4 * j + 3] * i16); }
        else { *(u32x2*)(op + 8 * j) = w0; *(u32x2*)(op + 32 + 8 * j) = w1; }
    }
}
}
constexpr int NWAVES = 8, NTHREADS = 512;
constexpr int LDS_BYTES = 147456;
constexpr int MISC_OFF = 131072 + 320;
#define LDS_WAIT() asm volatile("s_waitcnt lgkmcnt(0)" ::: "memory")

struct Args { const float* in[22]; float* out; unsigned char* ws; int ph_lo, ph_hi; };

enum { MAP_ID = 0, MAP_WIN, MAP_WUQ, MAP_WUKV, MAP_GATE, MAP_UP, MAP_WIN8 };
__device__ __forceinline__ int map_row(int map, int n) {
    if (map == MAP_WIN || map == MAP_WIN8) {
        const int o = map == MAP_WIN8 ? P1_F8_FROM * 256 : 0;
        if (n < 384) return n - o;
        if (n < 416) { const int i = n - 384; return 384 + (i < 16 ? 2 * i : 2 * (i - 16) + 1) - o; }
        return n + 96 - o;
    }
    if (map == MAP_WUQ) { const int h = n / 96, j = n % 96; if (j < 64) return n; const int i = j - 64; return h * 96 + 64 + (i < 16 ? 2 * i : 2 * (i - 16) + 1); }
    if (map == MAP_WUKV) { const int h = n >> 7, j = n & 127; return j < 64 ? h * 64 + j : 512 + h * 64 + (j - 64); }
    if (map == MAP_GATE) return (n >> 7) * 256 + (n & 127);
    if (map == MAP_UP) return (n >> 7) * 256 + 128 + (n & 127);
    return n;
}
template <bool F8 = false>
__device__ __forceinline__ void cvt_item(const float* src, int ldsrc, int nblk, const float* gain, float scale, bf16_t* dst, int lddst, int kdst0, int map, LAS float* scr, int item, int lane) {
    const int kb = item / nblk, nb = item % nblk, k0 = 64 * kb, n0 = 32 * nb;
    f32x4 v[8]; float gs[8];
#pragma unroll
    for (int i = 0; i < 8; ++i) { const int idx = i * 64 + lane, kk = idx >> 3, c4 = idx & 7; v[i] = *(const f32x4*)(src + (size_t)(k0 + kk) * ldsrc + n0 + 4 * c4); gs[i] = gain ? gain[k0 + kk] * scale : scale; }
#pragma unroll
    for (int i = 0; i < 8; ++i) { const int idx = i * 64 + lane, kk = idx >> 3, c4 = idx & 7; LAS float* d = scr + kk * 33 + 4 * c4; d[0] = v[i].x * gs[i]; d[1] = v[i].y * gs[i]; d[2] = v[i].z * gs[i]; d[3] = v[i].w * gs[i]; }
    LDS_WAIT(); asm volatile("" ::: "memory");
    const int c = lane & 7;
#pragma unroll
    for (int j = 0; j < 4; ++j) { const int n = (lane >> 3) + 8 * j; const LAS float* s = scr + (8 * c) * 33 + n;
        u32x4 o; o.x = cvt_pk_bf16(s[0 * 33], s[1 * 33]); o.y = cvt_pk_bf16(s[2 * 33], s[3 * 33]); o.z = cvt_pk_bf16(s[4 * 33], s[5 * 33]); o.w = cvt_pk_bf16(s[6 * 33], s[7 * 33]);
        if constexpr (F8) { u32x2 o8; o8.x = pk_fp8x4(s[0 * 33], s[1 * 33], s[2 * 33], s[3 * 33]); o8.y = pk_fp8x4(s[4 * 33], s[5 * 33], s[6 * 33], s[7 * 33]);
            *(u32x2*)((unsigned char*)dst + (size_t)map_row(map, n0 + n) * lddst + kdst0 + k0 + 8 * c) = o8; }
        else *(u32x4*)(dst + (size_t)map_row(map, n0 + n) * lddst + kdst0 + k0 + 8 * c) = o; }
    LDS_WAIT(); asm volatile("" ::: "memory");
}

struct Ctx {
    LAS unsigned char* lds; int tid, lane, wave, vcu, G, gw, NGW;
    const float* const* in; float* out; unsigned char* ws;
};

__device__ __forceinline__ void phase_prologue(const Ctx& C) {
    LAS float* scr = (LAS float*)(C.lds + C.wave * 16384);
    unsigned char* ws = C.ws;
    constexpr int I_IN = 16 * 181, I_UQ = 4 * 24, I_UKV = 2 * 32, I_BR = 8 * 32, I_OUT = 16 * 32, I_L = I_IN + I_UQ + I_UKV + 3 * I_BR + I_OUT;
    constexpr int I_G = 16 * 88, I_D = 44 * 32, NIT = 2 * I_L + 2 * I_G + I_D;
    for (int it = C.gw; it < NIT; it += C.NGW) {
        int r = it;
        if (r < 2 * I_L) { const int l = r / I_L; r -= l * I_L;
            if (r < I_IN) { if (r % 181 >= (P1_F8_FROM <= 1 ? P1_F8_FROM * 8 : (P1_F8_FROM * 256 - 96) / 32)) cvt_item<true>(C.in[2] + (size_t)l * DM * INC, INC, 181, C.in[1] + l * DM, 256.f, (bf16_t*)(ws + WS_WIN8 + l * SZ_WIN8), DM, 0, MAP_WIN8, scr, r, C.lane);
                            else cvt_item(C.in[2] + (size_t)l * DM * INC, INC, 181, C.in[1] + l * DM, 1.f, (bf16_t*)(ws + WS_WIN + l * SZ_WIN), DM, 0, MAP_WIN, scr, r, C.lane); continue; } r -= I_IN;
            if (r < I_UQ) { cvt_item(C.in[4] + (size_t)l * 256 * 768, 768, 24, C.in[3] + l * 256, 0.10206207261596577f * LOG2E, (bf16_t*)(ws + WS_WUQ + l * SZ_WUQ), 256, 0, MAP_WUQ, scr, r, C.lane); continue; } r -= I_UQ;
            if (r < I_UKV) { cvt_item(C.in[6] + (size_t)l * 128 * 1024, 1024, 32, C.in[5] + l * 128, 1.f, (bf16_t*)(ws + WS_WUKV + l * SZ_WUKV), 256, 0, MAP_WUKV, scr, r, C.lane); continue; } r -= I_UKV;
            if (r < 3 * I_BR) { const int br = r / I_BR; r -= br * I_BR; cvt_item<P4_F8 != 0>(C.in[9 + br] + (size_t)l * 512 * DM, DM, 32, nullptr, P4_F8 ? 256.f : 1.f, (bf16_t*)(ws + WS_WBR + l * SZ_WBR), 1536, br * 512, MAP_ID, scr, r, C.lane); continue; } r -= 3 * I_BR;
            cvt_item<P5_F8 != 0>(C.in[12] + (size_t)l * DM * DM, DM, 32, nullptr, P5_F8 ? 256.f : 1.f, (bf16_t*)(ws + WS_WOUT + l * SZ_WOUT), DM, 0, MAP_ID, scr, r, C.lane); continue; }
        r -= 2 * I_L;
        if (r < I_G) { cvt_item(C.in[14], DFF, 88, C.in[13], 1.f, (bf16_t*)(ws + WS_WGU), DM, 0, MAP_GATE, scr, r, C.lane); continue; } r -= I_G;
        if (r < I_G) { cvt_item(C.in[15], DFF, 88, C.in[13], 1.f, (bf16_t*)(ws + WS_WGU), DM, 0, MAP_UP, scr, r, C.lane); continue; } r -= I_G;
        cvt_item(C.in[16], DM, 32, nullptr, 1.f, (bf16_t*)(ws + WS_WD), DFF, 0, MAP_ID, scr, r, C.lane);
    }
    const int gt = C.vcu * NTHREADS + C.tid, NGT = C.G * NTHREADS;
    if (P1_F8_FROM <= 1) for (int i = gt; i < 2 * 6144; i += NGT) { const int l = i / 6144, r = i % 6144; const u32x4 z = {0u, 0u, 0u, 0u}; *(u32x4*)(ws + WS_WIN8 + l * SZ_WIN8 + (size_t)(416 - P1_F8_FROM * 256) * DM + (size_t)r * 16) = z; }
    for (int i = gt; i < 2 * (12288 + 16384); i += NGT) { const int l = i / (12288 + 16384); int r = i % (12288 + 16384); const u32x4 z = {0u, 0u, 0u, 0u};
        if (r < 12288) *(u32x4*)(ws + WS_WIN + l * SZ_WIN + (size_t)416 * DM * 2 + (size_t)r * 16) = z;
        else { r -= 12288; *(u32x4*)(ws + WS_WUKV + l * SZ_WUKV + (size_t)(r >> 4) * 512 + 256 + (r & 15) * 16) = z; } }
    float* cosT = (float*)(ws + WS_TAB); float* sinT = cosT + SEQ * 16; float* tabb = sinT + SEQ * 16;
    for (int i = gt; i < SEQ * 16; i += NGT) { const int pos = i >> 4, k = i & 15; const float inv = powf(10000.f, -(float)k / 16.f); const float ang = (float)pos * inv; cosT[i] = cosf(ang); sinT[i] = sinf(ang); }
    for (int i = gt; i < 4 * 8 * att::TAB_STRIDE; i += NGT) { const int kind = i / (8 * att::TAB_STRIDE), h = (i / att::TAB_STRIDE) & 7, idx = i % att::TAB_STRIDE;
        const int R = kind == 3 ? 128 : 64, dil = kind == 1 ? 4 : (kind == 2 ? 16 : 1), rel = idx - (R + 31);
        float v = NEGB; if (rel >= -R && rel <= R) v = C.in[8][t5_bucket(rel * dil) * 16 + (kind == 3 ? 8 : 0) + h] * LOG2E;
        tabb[i] = v; }
    const float* x = C.in[0]; bf16_t* xb = (bf16_t*)(ws + WS_XB); float* st = (float*)(ws + WS_ST);
    for (int row = 2 * C.gw; row < MTOK; row += 2 * C.NGW) {
        const f32x4* xr = (const f32x4*)(x + (size_t)row * DM) + C.lane; f32x4 v[8];
#pragma unroll
        for (int j = 0; j < 8; ++j) v[j] = xr[64 * j];
        float s0 = 0.f, s1 = 0.f;
#pragma unroll
        for (int j = 0; j < 8; ++j) { const float q = (v[j].x * v[j].x + v[j].y * v[j].y) + (v[j].z * v[j].z + v[j].w * v[j].w); if (j < 4) s0 += q; else s1 += q;
            u32x2 w; w.x = cvt_pk_bf16(v[j].x, v[j].y); w.y = cvt_pk_bf16(v[j].z, v[j].w); *((u32x2*)(xb + (size_t)row * DM) + C.lane + 64 * j) = w;
            if (P1_F8_FROM < 23) *((unsigned*)(ws + WS_XB8P + (size_t)(row + (j >> 2)) * DM) + C.lane + 64 * (j & 3)) = pk_fp8x4(v[j].x * 16.f, v[j].y * 16.f, v[j].z * 16.f, v[j].w * 16.f); }
        s0 = wave_sum(s0); s1 = wave_sum(s1);
        if (C.lane < 32) st[(size_t)row * 16 + C.lane] = C.lane == 0 ? s0 : (C.lane == 16 ? s1 : 0.f);
    }
}

__device__ __forceinline__ void phase_moe_weights(const Ctx& C) {
    LAS float* scr = (LAS float*)(C.lds + 40960 + C.wave * 8704);
    constexpr int I_G = 16 * 112, I_D = 56 * 32, I_E = 2 * I_G + I_D;
    for (int it = C.gw; it < NEXP * I_E; it += C.NGW) {
        const int e = it / I_E; int r = it % I_E;
        if (r < I_G) { cvt_item<MOE_F8 != 0>(C.in[18] + (size_t)e * DM * DFE, DFE, 112, C.in[13] + DM, MOE_F8 ? 256.f : 1.f, (bf16_t*)(C.ws + WS_EGU + (size_t)e * 2 * DFE * DM * (MOE_F8 ? 1 : 2)), DM, 0, MAP_GATE, scr, r, C.lane); continue; } r -= I_G;
        if (r < I_G) { cvt_item<MOE_F8 != 0>(C.in[19] + (size_t)e * DM * DFE, DFE, 112, C.in[13] + DM, MOE_F8 ? 256.f : 1.f, (bf16_t*)(C.ws + WS_EGU + (size_t)e * 2 * DFE * DM * (MOE_F8 ? 1 : 2)), DM, 0, MAP_UP, scr, r, C.lane); continue; } r -= I_G;
        cvt_item<MOE_DN_F8 != 0>(C.in[20] + (size_t)e * DFE * DM, DM, 32, nullptr, MOE_DN_F8 ? 1024.f : 1.f, (bf16_t*)(C.ws + WS_ED + (size_t)e * DM * DFE * (MOE_DN_F8 ? 1 : 2)), DFE, 0, MAP_ID, scr, r, C.lane);
    }
}

template <bool SECOND>
__device__ __forceinline__ void phase_band(const Ctx& C, const bf16_t* HM, bf16_t* PB, float* PBS, bf16_t* Y, const float* sink) {
    constexpr int IPK = MC / 2048 * 64, NIT = (SECOND ? 1 : 3) * IPK;
    const float* tabg = (const float*)(C.ws + WS_TAB) + 2 * SEQ * 16;
    att::BandPre P; att::BandItem it, nx;
    int i = C.vcu;
#define BAND_IDX(IDX) (SECOND ? 2 * IPK + (IDX) : ((IDX) < 2 * IPK ? (IDX) : (IDX) + IPK))
    if (i < NIT) { it = att::band_decode(BAND_IDX(i), IPK); att::band_issue(P, it, HM, tabg, C.tid, C.wave, C.lane); }
    for (; i < NIT; i += C.G) {
        att::band_store(P, it, C.lds, C.tid);
        bf16x8 qf[4];
#pragma unroll
        for (int d0 = 0; d0 < 4; ++d0) qf[d0] = P.q[d0];
        __syncthreads();
        const bool more = i + C.G < NIT;
        if (more) { nx = att::band_decode(BAND_IDX(i + C.G), IPK); att::band_issue(P, nx, HM, tabg, C.tid, C.wave, C.lane); }
        const int q = C.lane & 31, hi = C.lane >> 5, w = C.wave;
        if (it.kind == 3) {
            const int h = it.hh * 4 + (w >> 1), a0w = it.a0 + 32 * (w & 1); const size_t rowq = (size_t)it.b * SEQ + a0w + q;
            att::band_compute<9, 1>(qf, C.lds, 128 - it.a0, a0w, SEQ, (const LAS float*)(C.lds + att::BW_TAB) + (w >> 1) * att::TAB_STRIDE, (P4_F8 ? (bf16_t*)((unsigned char*)Y + rowq * 1536 + 1024 + h * 64 + 4 * hi) : Y + rowq * 1536 + 1024 + h * 64 + 4 * hi), nullptr, sink[h] * LOG2E, C.lane);
        } else if (it.kind == 2) {
            const int a0w = 32 * (w & 3), g = it.g0 + (w >> 2); const size_t rowq = (size_t)it.b * SEQ + (size_t)(a0w + q) * 16 + g;
            const size_t po = rowq * 512 + it.hh * 64 + 4 * hi, so = (rowq * 8 + it.hh) * 2;
            att::band_compute<5, 2>(qf, C.lds, (w >> 2) * 128, a0w, 128, (const LAS float*)(C.lds + att::BW_TAB), (P4_F8 ? (bf16_t*)((unsigned char*)Y + rowq * 1536 + 512 + it.hh * 64 + 4 * hi) : Y + rowq * 1536 + 512 + it.hh * 64 + 4 * hi), nullptr, 0.f, C.lane,
                                    PB + po, PB + (size_t)MC * 512 + po, PBS + so, PBS + (size_t)MC * 16 + so);
        } else {
            const int a0w = it.a0 + 32 * w, dil = it.kind == 0 ? 1 : 4, L = SEQ / dil, rowoff = 64 - it.a0;
            const size_t rowq = (size_t)it.b * SEQ + (size_t)(a0w + q) * dil + it.g0;
            att::band_compute<5, 0>(qf, C.lds, rowoff, a0w, L, (const LAS float*)(C.lds + att::BW_TAB), PB + (size_t)it.kind * MC * 512 + rowq * 512 + it.hh * 64 + 4 * hi,
                                    PBS + (size_t)it.kind * MC * 16 + (rowq * 8 + it.hh) * 2, 0.f, C.lane);
        }
        __syncthreads();
        it = nx;
    }
#undef BAND_IDX
}

__device__ __forceinline__ void phase_mla(const Ctx& C, const bf16_t* Q, const bf16_t* KV, const bf16_t* Zc, bf16_t* Y) {
    constexpr int NU = MC / 256 * 8;
    for (int u = C.vcu; u < NU; u += C.G) { const int qblk = u & 7, bh = u >> 3; att::mla_unit(Q, KV, Zc, Y, bh >> 3, bh & 7, qblk, C.lds, C.tid, C.wave, C.lane); }
}

__device__ __forceinline__ void phase_route(const Ctx& C) {
    LAS float* wr = (LAS float*)C.lds; LAS int* cnt = (LAS int*)(C.lds + 32768);
    const float* g2 = C.in[13] + DM; const float* router = C.in[17];
    for (int i = C.tid; i < DM * 8; i += NTHREADS) wr[i] = router[i] * g2[i >> 3];
    if (C.tid < 16) cnt[C.tid] = 0;
    __syncthreads();
    int* sel = (int*)(C.ws + WS_SEL); float* gwp = (float*)(C.ws + WS_GW); float* rr = (float*)(C.ws + WS_RR);
    const int w = blockIdx.x;
    for (int j = 0; j < 16; ++j) {
        const int tok = w * 128 + C.wave * 16 + j;
        const u32x2* xr = (const u32x2*)((const bf16_t*)(C.ws + WS_XB) + (size_t)tok * DM) + C.lane;
        float lg[8], ss = 0.f;
#pragma unroll
        for (int e = 0; e < 8; ++e) lg[e] = 0.f;
#pragma unroll
        for (int q = 0; q < 4; ++q) { const u32x2 wv = xr[64 * q]; const f32x4 v = {bf_lo(wv.x), bf_hi(wv.x), bf_lo(wv.y), bf_hi(wv.y)}; ss += (v.x * v.x + v.y * v.y) + (v.z * v.z + v.w * v.w);
            const int k = 4 * C.lane + 256 * q;
            if (MOE_F8) *(unsigned*)(C.ws + WS_XB8 + (size_t)tok * DM + k) = pk_fp8x4(v.x * 16.f, v.y * 16.f, v.z * 16.f, v.w * 16.f);
#pragma unroll
            for (int c = 0; c < 4; ++c) { const float xv = v[c]; const f32x4 w0 = *(const LAS f32x4*)(wr + (k + c) * 8), w1 = *(const LAS f32x4*)(wr + (k + c) * 8 + 4);
                lg[0] += xv * w0.x; lg[1] += xv * w0.y; lg[2] += xv * w0.z; lg[3] += xv * w0.w; lg[4] += xv * w1.x; lg[5] += xv * w1.y; lg[6] += xv * w1.z; lg[7] += xv * w1.w; } }
        ss = wave_sum(ss);
#pragma unroll
        for (int e = 0; e < 8; ++e) lg[e] = wave_sum(lg[e]);
        const float r = rsqrtf(ss * (1.f / 1024.f) + EPS);
        if (C.lane == 0) {
            int i1 = 0; float v1 = lg[0];
#pragma unroll
            for (int e = 1; e < 8; ++e) if (lg[e] > v1) { v1 = lg[e]; i1 = e; }
            int i2 = -1; float v2 = -3e38f;
#pragma unroll
            for (int e = 0; e < 8; ++e) if (e != i1 && lg[e] > v2) { v2 = lg[e]; i2 = e; }
            const float e2 = expf((v2 - v1) * r);
            sel[tok * 2] = i1; sel[tok * 2 + 1] = i2; gwp[tok * 2] = 1.f / (1.f + e2); gwp[tok * 2 + 1] = e2 / (1.f + e2); rr[tok] = r;
            __hip_atomic_fetch_add(&cnt[i1], 1, __ATOMIC_RELAXED, __HIP_MEMORY_SCOPE_WORKGROUP); __hip_atomic_fetch_add(&cnt[8 + i2], 1, __ATOMIC_RELAXED, __HIP_MEMORY_SCOPE_WORKGROUP);
        }
    }
    __syncthreads();
    if (C.tid < 16) ((int*)(C.ws + WS_META))[MI_CNT + (C.tid >> 3) * 2048 + w * 8 + (C.tid & 7)] = cnt[C.tid];
}

__device__ __forceinline__ void phase_sort(const Ctx& C) {
    LAS int* tot = (LAS int*)C.lds; LAS int* pre = tot + 16; LAS int* base = tot + 32;
    int* meta = (int*)(C.ws + WS_META); const int w = blockIdx.x;
    if (C.tid < 16) { const int k = C.tid >> 3, e = C.tid & 7; int t = 0, p = 0;
        for (int w2 = 0; w2 < 256; ++w2) { const int c = meta[MI_CNT + k * 2048 + w2 * 8 + e]; t += c; if (w2 < w) p += c; }
        tot[C.tid] = t; pre[C.tid] = p; }
    __syncthreads();
    if (C.tid < 16) { const int k = C.tid >> 3, e = C.tid & 7; int b = 0; for (int e2 = 0; e2 < e; ++e2) b += (tot[k * 8 + e2] + 255) & ~255; base[C.tid] = b; }
    __syncthreads();
    const int* sel = (const int*)(C.ws + WS_SEL); const float* gwp = (const float*)(C.ws + WS_GW);
    int* rowtok = (int*)(C.ws + WS_ROWTOK); float* rowgw = (float*)(C.ws + WS_ROWGW); float* rowrr = (float*)(C.ws + WS_ROWRR); const float* rr = (const float*)(C.ws + WS_RR);
    if (C.wave < 2) { const int k = C.wave; LAS int* runL = tot + 48 + k * 8;
        if (C.lane < 8) runL[C.lane] = base[k * 8 + C.lane] + pre[k * 8 + C.lane];
        for (int j = 0; j < 2; ++j) { const int tok = w * 128 + j * 64 + C.lane; const int e = sel[tok * 2 + k]; int pos = 0;
#pragma unroll 1
            for (int e2 = 0; e2 < 8; ++e2) { const unsigned long long mk = __ballot(e == e2); const int r0 = runL[e2]; const int rank = __popcll(mk & ((1ull << C.lane) - 1ull));
                if (e == e2) pos = r0 + rank; if (C.lane == 0) runL[e2] = r0 + __popcll(mk); }
            rowtok[k * MOE_ROWS + pos] = tok; rowgw[k * MOE_ROWS + pos] = gwp[tok * 2 + k]; rowrr[k * MOE_ROWS + pos] = rr[tok]; } }
    if (w < 16) { const int k = w >> 3, e = w & 7; const int t = tot[k * 8 + e], b = base[k * 8 + e], pe = (t + 255) & ~255;
        for (int i = b + t + C.tid; i < b + pe; i += NTHREADS) { rowtok[k * MOE_ROWS + i] = -1; rowgw[k * MOE_ROWS + i] = 0.f; rowrr[k * MOE_ROWS + i] = 0.f; } }
    if (w == 16 && C.tid < 2) { const int k = C.tid; int nt = 0;
        for (int e = 0; e < 8; ++e) { const int n = (tot[k * 8 + e] + 255) >> 8; for (int i = 0; i < n; ++i) meta[MI_TILEE + k * 160 + nt + i] = e; nt += n; }
        meta[MI_NTILE + k] = nt; }
}

__device__ __forceinline__ void phase_final(const Ctx& C) {
    const float* g = C.in[21];
    for (int row = 2 * C.gw; row < MTOK; row += 2 * C.NGW) {
        f32x4 v[8]; float s0 = 0.f, s1 = 0.f;
#pragma unroll
        for (int j = 0; j < 8; ++j) { const u32x2 wv = ((const u32x2*)xm_row(C.ws, row + (j >> 2)))[C.lane + 64 * (j & 3)]; v[j] = (f32x4){bf_lo(wv.x), bf_hi(wv.x), bf_lo(wv.y), bf_hi(wv.y)}; }
#ifdef PROBE_NAN
#pragma unroll
        for (int j = 0; j < 8; ++j) { v[j].x = v[j].x == v[j].x && fabsf(v[j].x) < 1e30f ? v[j].x : 0.f; v[j].y = v[j].y == v[j].y && fabsf(v[j].y) < 1e30f ? v[j].y : 0.f; v[j].z = v[j].z == v[j].z && fabsf(v[j].z) < 1e30f ? v[j].z : 0.f; v[j].w = v[j].w == v[j].w && fabsf(v[j].w) < 1e30f ? v[j].w : 0.f; }
#endif
#pragma unroll
        for (int j = 0; j < 8; ++j) { const float q = (v[j].x * v[j].x + v[j].y * v[j].y) + (v[j].z * v[j].z + v[j].w * v[j].w); if (j < 4) s0 += q; else s1 += q; }
        const float r0 = rsqrtf(wave_sum(s0) * (1.f / 1024.f) + EPS), r1 = rsqrtf(wave_sum(s1) * (1.f / 1024.f) + EPS);
        f32x4* orow = (f32x4*)(C.out + (size_t)row * DM) + C.lane;
#pragma unroll
        for (int j = 0; j < 8; ++j) orow[64 * j] = v[j] * (j < 4 ? r0 : r1) * ((const f32x4*)g)[C.lane + 64 * (j & 3)];
    }
}
#ifndef MKP
#define MKP 0x1ffff
#endif
#ifndef ALEPI
#define ALEPI true
#endif
#ifndef ALEPI1
#define ALEPI1 ALEPI
#endif
#ifndef DUPK
#define DUPK 0
#endif
#ifdef PROBE_TIMER
#define PROBE_T0 __syncthreads(); const unsigned long long pt0_ = __builtin_amdgcn_s_memrealtime()
#define PROBE_T1(slot) __syncthreads(); if (threadIdx.x == 0) { const unsigned long long pt1_ = __builtin_amdgcn_s_memrealtime(); atomicAdd((unsigned*)(ws + WS_CTL) + CW_Q + 2048 + (slot), (unsigned)(pt1_ - pt0_)); }
#else
#define PROBE_T0
#define PROBE_T1(slot)
#endif
#define REP(bit) for (int rep_ = 0; rep_ < ((DUPK & (bit)) ? 2 : 1); ++rep_)
constexpr int PH_PER_CHUNK = 3, PH_LAYER_TAIL = 2;
constexpr int PH_L0 = 1, PH_FFN = PH_L0 + PH_PER_CHUNK * NCHUNK + PH_LAYER_TAIL, PH_L1 = PH_FFN + 2, PH_MOE = PH_L1 + PH_PER_CHUNK * NCHUNK + PH_LAYER_TAIL, PH_FINAL = PH_MOE + (MOE_NOSPLIT ? 5 : 7), PH_TOTAL = PH_FINAL + 1;

__global__ void __launch_bounds__(NTHREADS, 2) mega(Args args) {
    extern __shared__ __attribute__((aligned(16))) unsigned char lds_raw[];
#define MKCTX Ctx C; { int t_ = threadIdx.x; asm volatile("" : "+v"(t_)); C.lds = (LAS unsigned char*)lds_raw; C.tid = t_; C.lane = t_ & 63; C.wave = __builtin_amdgcn_readfirstlane(t_ >> 6); \
    C.G = gridDim.x; { const int bx = blockIdx.x; C.vcu = (C.G % 8 == 0) ? (bx % 8) * (C.G / 8) + bx / 8 : bx; } \
    C.gw = C.vcu * NWAVES + C.wave; C.NGW = C.G * NWAVES; C.in = args.in; C.out = args.out; C.ws = args.ws; }
    volatile LAS unsigned* MISC = (volatile LAS unsigned*)((LAS unsigned char*)lds_raw + MISC_OFF);
    if (threadIdx.x < 32) MISC[threadIdx.x] = 0u;
    __syncthreads();
    unsigned char* ws = args.ws;
    XcdBarrier bar; bar.bar = (unsigned*)(ws + WS_CTL) + CW_BAR; bar.x = 0; bar.st = nullptr;
    const int lo = args.ph_lo, hi = args.ph_hi;
    const bool use_bar = (hi - lo) > 1;
    if (use_bar) bar = xcd_barrier_post((unsigned*)(ws + WS_CTL) + CW_BAR, MISC + 8);
    int ph = 0;
#define IN_PH (ph >= lo && ph < hi)
#ifdef PROBE_BAR
    const unsigned long long pk0_ = __builtin_amdgcn_s_memrealtime();
#define END_PH do { if (ph >= lo && ph + 1 < hi) { __syncthreads(); const unsigned long long pb0_ = __builtin_amdgcn_s_memrealtime(); xcd_barrier(bar); \
        if (threadIdx.x == 0 && (((unsigned)(PROBE_BAR) >> ph) & 1u)) atomicAdd((unsigned*)(ws + WS_CTL) + CW_Q + 2048, (unsigned)(__builtin_amdgcn_s_memrealtime() - pb0_)); } ++ph; } while (0)
#else
#define END_PH do { if (ph >= lo && ph + 1 < hi) xcd_barrier(bar); ++ph; } while (0)
#endif

    bf16_t* xb = (bf16_t*)(ws + WS_XB); float* st = (float*)(ws + WS_ST);
    const float* cosT = (const float*)(ws + WS_TAB); const float* sinT = cosT + SEQ * 16;

    if (IN_PH) REP(1) { MKCTX; if (MKP & 1) phase_prologue(C); }
    END_PH;
#ifdef PROBE_SLEEP
    { const unsigned long long t0_ = __builtin_amdgcn_s_memrealtime(); while (__builtin_amdgcn_s_memrealtime() - t0_ < (unsigned long long)(PROBE_SLEEP) * 100ull) __builtin_amdgcn_s_sleep(64); }
#endif

#define CHUNK_BODY(l, c) \
{ \
            const int row0 = c * MC; \
            bf16_t* Z = (bf16_t*)(ws + WS_Z); bf16_t* Q = (bf16_t*)(ws + WS_Q); bf16_t* KV = TMP_IN_OUT ? (bf16_t*)args.out : (bf16_t*)(ws + WS_KV); bf16_t* Y = (bf16_t*)(ws + WS_Y + (size_t)row0 * 1536 * (P4_F8 ? 1 : 2)); \
            bf16_t* PB = TMP_IN_OUT ? (bf16_t*)args.out + (size_t)MC * 1024 : (bf16_t*)(ws + WS_PB); float* PBS = (float*)(ws + WS_PBS); float* SQ = (float*)(ws + WS_SQ); float* SKV = SQ + (size_t)MC * 4; \
 \
            if (IN_PH && (MKP & 2)) REP(2) { MKCTX; \
                pg8::Gemm g{xb + (size_t)row0 * DM, (const bf16_t*)(ws + WS_WIN + l * SZ_WIN), DM, DM, DM, nullptr}; \
                pg8::StaticOrder S; S.init(MC, P1_F8_FROM * 256, C.G, (int)blockIdx.x); \
                pg8::EpiIn E{Z, st + (size_t)row0 * 16, SQ, SKV, cosT, sinT, ws + WS_GB + (size_t)row0 * 3072, (bf16_t*)(ws + WS_QKV), ws, 0, 1.f}; \
                pg8::gemm_phase<pg8::EpiIn, pg8::StaticOrder, ALEPI1, false>(C.lds, g, S, E); \
            } \
            if (IN_PH && (MKP & 2) && P1_F8_FROM < 23) REP(2) { MKCTX;                          \
                pg8::Gemm g{(const bf16_t*)(ws + WS_XB8P + (size_t)row0 * DM), (const bf16_t*)(ws + WS_WIN8 + l * SZ_WIN8), DM / 2, DM / 2, DM / 2, nullptr}; \
                pg8::StaticOrder S; S.init(MC, (23 - P1_F8_FROM) * 256, C.G, (int)((blockIdx.x + (P1_F8_FROM * (MC / 256)) % 256) % C.G)); \
                pg8::EpiIn E{Z, st + (size_t)row0 * 16, SQ, SKV, cosT, sinT, ws + WS_GB + (size_t)row0 * 3072, (bf16_t*)(ws + WS_QKV), ws, P1_F8_FROM, 1.f / 4096.f}; \
                pg8::gemm_phase<pg8::EpiIn, pg8::StaticOrder, ALEPI1, false, false, true>(C.lds, g, S, E); \
            } \
            END_PH; \
 \
            if (IN_PH) { \
                if (MKP & 4) REP(4) { MKCTX; pg8::Gemm g{Z + ZO_CQ, (const bf16_t*)(ws + WS_WUQ + l * SZ_WUQ), 256, ZW, 256, nullptr}; \
                  pg8::StaticOrder S; S.init(MC, 768, C.G, (int)blockIdx.x); \
                  pg8::EpiQ E{Q, SQ, cosT, sinT}; \
                  pg8::gemm_phase<pg8::EpiQ, pg8::StaticOrder, ALEPI, false>(C.lds, g, S, E); } \
                if (MKP & 8) REP(8) { MKCTX; pg8::Gemm g{Z + ZO_CKV, (const bf16_t*)(ws + WS_WUKV + l * SZ_WUKV), 256, ZW, 256, nullptr}; \
                  pg8::StaticOrder S; S.init(MC, 1024, C.G, (int)((blockIdx.x + 128) % C.G)); \
                  pg8::EpiKV E{KV, SKV}; \
                  pg8::gemm_phase<pg8::EpiKV, pg8::StaticOrder, ALEPI, false>(C.lds, g, S, E); } \
                if (MKP & 16) REP(16) { MKCTX; phase_band<false>(C, (const bf16_t*)(ws + WS_QKV), PB, PBS, Y, C.in[7] + l * 8); } \
            } \
            END_PH; \
 \
            if (IN_PH) { \
                if (MKP & 32) REP(32) { MKCTX; phase_band<true>(C, (const bf16_t*)(ws + WS_QKV), PB, PBS, Y, C.in[7] + l * 8); } \
                if (MKP & 64) REP(64) { MKCTX; PROBE_T0; phase_mla(C, Q, KV, Z, Y); PROBE_T1(rep_); } \
            } \
            END_PH; \
 \
}
#define LAYER_TAIL(l) \
{ const int row0 = 0; bf16_t* MG = (bf16_t*)(ws + WS_MG); bf16_t* Y = (bf16_t*)(ws + WS_Y); (void)Y; \
            if (IN_PH && (MKP & 128)) REP(128) { MKCTX; \
                pg8::Gemm g{Y, (const bf16_t*)(ws + WS_WBR + l * SZ_WBR), P4_F8 ? 768 : 1536, P4_F8 ? 768 : 1536, P4_F8 ? 768 : 1536, nullptr}; \
                pg8::StaticOrder S; S.init(MTOK, DM, C.G, (int)blockIdx.x); \
                pg8::EpiBr E{ws + WS_GB, MG, ws}; \
                pg8::gemm_phase<pg8::EpiBr, pg8::StaticOrder, ALEPI, false, false, P4_F8 != 0>(C.lds, g, S, E); \
            } \
            END_PH; \
 \
            if (IN_PH && (MKP & 256)) REP(l == 0 ? 256 : 0) { MKCTX; \
                pg8::Gemm g{MG, (const bf16_t*)(ws + WS_WOUT + l * SZ_WOUT), P5_F8 ? DM / 2 : DM, P5_F8 ? DM / 2 : DM, P5_F8 ? DM / 2 : DM, nullptr}; \
                pg8::StaticOrder S; S.init(MTOK, DM, C.G, (int)blockIdx.x); \
                pg8::EpiRes<false> E{xb, st, row0, nullptr, P5_F8 ? 1.f / 4096.f : 1.f}; pg8::gemm_phase<pg8::EpiRes<false>, pg8::StaticOrder, ALEPI, false, true, P5_F8 != 0>(C.lds, g, S, E); \
            } \
            END_PH; \
}
#define FFN_BODY() \
{ \
            bf16_t* ACT = (bf16_t*)(ws + WS_ACT); \
            if (IN_PH && (MKP & 512)) REP(512) { MKCTX; \
                pg8::Gemm g{xb, (const bf16_t*)(ws + WS_WGU), DM, DM, DM, nullptr}; \
                pg8::StaticOrder S; S.init(MTOK, 2 * DFF, C.G, (int)blockIdx.x); \
                pg8::EpiGU E{ACT, st, DFF, ws}; \
                pg8::gemm_phase<pg8::EpiGU, pg8::StaticOrder, ALEPI, false>(C.lds, g, S, E); \
            } \
            END_PH; \
            if (IN_PH && (MKP & 1024)) { MKCTX; \
                pg8::Gemm g{ACT, (const bf16_t*)(ws + WS_WD), DFF, DFF, DFF, nullptr}; \
                pg8::StaticOrder S; S.init(MTOK, DM, C.G, (int)blockIdx.x); \
                pg8::EpiRes<(P1_F8_FROM < 23)> E{xb, st, 0, ws + WS_XB8P, 1.f};                                \
                pg8::gemm_phase<pg8::EpiRes<(P1_F8_FROM < 23)>, pg8::StaticOrder, ALEPI, false, true>(C.lds, g, S, E); \
            } \
            END_PH; \
}
#define MOE_HEAD() \
{ \
            if (IN_PH) { if (MKP & 2048) REP(2048) { MKCTX; phase_route(C); } if (MKP & 4096) REP(4096) { MKCTX; phase_moe_weights(C); } } \
            END_PH; \
            if (IN_PH && (MKP & 8192)) { MKCTX; phase_sort(C); } \
            END_PH; \
}
#define MOE_GU(kh, dyn) { const int k = MOE_NOSPLIT ? (kh) : (kh) >> 1, half = MOE_NOSPLIT ? 0 : (kh) & 1; MKCTX; \
        const int* rowtok = (const int*)(ws + WS_ROWTOK) + k * MOE_ROWS; \
        bf16_t* MACT = (bf16_t*)(ws + WS_MACT + (MOE_NOSPLIT ? (size_t)k * MOE_ROWS * DFE : (size_t)half * MOE_ROWS * DF0 * (MOE_DN_F8 ? 1 : 2))); const int dfw = MOE_NOSPLIT ? DFE : (half ? DF1 : DF0); \
        pg8::Gemm g{MOE_F8 ? (const bf16_t*)(ws + WS_XB8) : xb, (const bf16_t*)(ws + WS_EGU), MOE_F8 ? DM / 2 : DM, MOE_F8 ? DM / 2 : DM, MOE_F8 ? DM / 2 : DM, rowtok}; \
        pg8::DynMoeOrder S{(unsigned*)(ws + WS_CTL) + CW_Q + 64 * (kh), (volatile LAS int*)(C.lds + MISC_OFF + 64), meta[MI_NTILE + k], dfw / 128, 28, half ? DF0 / 128 : 0, meta + MI_TILEE + k * 160, C.vcu}; \
        pg8::EpiGUMoe E{MACT, (const float*)(ws + WS_ROWRR) + k * MOE_ROWS, dfw, ws}; \
        pg8::gemm_phase<pg8::EpiGUMoe, pg8::DynMoeOrder, ALEPI, true, false, MOE_F8 != 0>(C.lds, g, S, E); }
#define MOE_DN(kh) { const int k = MOE_NOSPLIT ? (kh) : (kh) >> 1, half = MOE_NOSPLIT ? 0 : (kh) & 1; MKCTX; \
        const int* rowtok = (const int*)(ws + WS_ROWTOK) + k * MOE_ROWS; const float* rowgw = (const float*)(ws + WS_ROWGW) + k * MOE_ROWS; \
        bf16_t* MACT = (bf16_t*)(ws + WS_MACT + (MOE_NOSPLIT ? (size_t)k * MOE_ROWS * DFE : (size_t)half * MOE_ROWS * DF0 * (MOE_DN_F8 ? 1 : 2))); const int dfw = MOE_NOSPLIT ? DFE : (half ? DF1 : DF0); \
        pg8::Gemm g{MACT, (const bf16_t*)(ws + WS_ED + (size_t)half * DF0 * (MOE_DN_F8 ? 1 : 2)), MOE_DN_F8 ? dfw / 2 : dfw, MOE_DN_F8 ? dfw / 2 : dfw, MOE_DN_F8 ? DFE / 2 : DFE, nullptr}; \
        pg8::MoeOrder S{meta[MI_NTILE + k], 4, C.G, (int)blockIdx.x, 4, 0, meta + MI_TILEE + k * 160}; \
        if ((kh) == 0) { pg8::EpiDnMoe<true> E{ws, rowtok, rowgw}; pg8::gemm_phase<pg8::EpiDnMoe<true>, pg8::MoeOrder, ALEPI, false, true, MOE_DN_F8 != 0>(C.lds, g, S, E); } \
        else { pg8::EpiDnMoe<false> E{ws, rowtok, rowgw}; pg8::gemm_phase<pg8::EpiDnMoe<false>, pg8::MoeOrder, ALEPI, false, true, MOE_DN_F8 != 0>(C.lds, g, S, E); } }
    CHUNK_BODY(0, 0)
#if CHB < 16
    CHUNK_BODY(0, 1)
#endif
#if CHB < 8
    CHUNK_BODY(0, 2)
    CHUNK_BODY(0, 3)
#endif
    LAYER_TAIL(0)
    FFN_BODY()
    CHUNK_BODY(1, 0)
#if CHB < 16
    CHUNK_BODY(1, 1)
#endif
#if CHB < 8
    CHUNK_BODY(1, 2)
    CHUNK_BODY(1, 3)
#endif
    LAYER_TAIL(1)
    MOE_HEAD()
    { const int* meta = (const int*)(ws + WS_META);
    if (IN_PH) { if (MKP & 16384) REP(16384) MOE_GU(0, 1) }
    END_PH;
    if (IN_PH) { if (MKP & 32768) MOE_DN(0) if (MKP & 16384) MOE_GU(1, 1) }
    END_PH;
#if !MOE_NOSPLIT
    if (IN_PH) { if (MKP & 32768) MOE_DN(1) if (MKP & 16384) MOE_GU(2, 1) }
    END_PH;
    if (IN_PH) { if (MKP & 32768) MOE_DN(2) if (MKP & 16384) MOE_GU(3, 1) }
    END_PH;
    if (IN_PH) { if (MKP & 32768) MOE_DN(3) }
    END_PH;
#else
    if (IN_PH) { if (MKP & 32768) MOE_DN(1) }
    END_PH;
#endif
    }
    if (IN_PH && (MKP & 65536)) { MKCTX; phase_final(C); }
    END_PH;
#ifdef PROBE_BAR
    { if (threadIdx.x == 0) atomicAdd((unsigned*)(ws + WS_CTL) + CW_Q + 2049, (unsigned)(__builtin_amdgcn_s_memrealtime() - pk0_));
      xcd_barrier(bar);
      const unsigned* tim = (const unsigned*)(ws + WS_CTL) + CW_Q + 2048;
      const float ta = (float)__hip_atomic_load(tim, __ATOMIC_RELAXED, __HIP_MEMORY_SCOPE_AGENT), tb = (float)__hip_atomic_load(tim + 1, __ATOMIC_RELAXED, __HIP_MEMORY_SCOPE_AGENT);
      float code = (float)(PROBE_UNIT) * ta / tb;
      code = fminf(98.f, fmaxf(1.f, rintf(code))); const float v = sqrtf(code);
      for (size_t i = (size_t)blockIdx.x * NTHREADS + threadIdx.x; i < (size_t)MTOK * DM; i += (size_t)gridDim.x * NTHREADS) args.out[i] = v; }
#endif
#ifdef PROBE_TIMER
    { xcd_barrier(bar);
      const unsigned* tim = (const unsigned*)(ws + WS_CTL) + CW_Q + 2048;
      const float ta = (float)__hip_atomic_load(tim, __ATOMIC_RELAXED, __HIP_MEMORY_SCOPE_AGENT), tb = (float)__hip_atomic_load(tim + 1, __ATOMIC_RELAXED, __HIP_MEMORY_SCOPE_AGENT);
      float code = PROBE_TIMER == 1 ? 10.f * ta / tb : (PROBE_TIMER == 2 ? ta * (1.f / (256.f * 100.f * 10.f)) : tb * (1.f / (256.f * 100.f * 10.f)));
      code = fminf(98.f, fmaxf(1.f, rintf(code))); const float v = sqrtf(code);
      for (size_t i = (size_t)blockIdx.x * NTHREADS + threadIdx.x; i < (size_t)MTOK * DM; i += (size_t)gridDim.x * NTHREADS) args.out[i] = v; }
#endif
#undef IN_PH
#undef END_PH
}
#if !MK_DEBUG
extern "C" void kernel_launch(void* const* d_in, const int* in_sizes, int n_in, void* d_out, int out_size, void* d_ws, size_t ws_size, hipStream_t stream) {
    static int grid = 0;
    if (grid == 0) {
        if (n_in != 22 || out_size != MTOK * DM || ws_size < WS_NEED) { fprintf(stderr, "kernel_launch: unexpected shapes / workspace (%zu < %zu); nothing launched\n", ws_size, (size_t)WS_NEED); grid = -1; return; }
        int dev = 0, cus = 0, per_cu = 0;
        if (hipGetDevice(&dev) != hipSuccess || hipDeviceGetAttribute(&cus, hipDeviceAttributeMultiprocessorCount, dev) != hipSuccess) { grid = -1; return; }
        if (hipFuncSetAttribute((const void*)mega, hipFuncAttributeMaxDynamicSharedMemorySize, LDS_BYTES) != hipSuccess) { fprintf(stderr, "kernel_launch: hipFuncSetAttribute failed\n"); grid = -1; return; }
        if (hipOccupancyMaxActiveBlocksPerMultiprocessor(&per_cu, (const void*)mega, NTHREADS, LDS_BYTES) != hipSuccess || per_cu < 1) { fprintf(stderr, "kernel_launch: occupancy query says %d\n", per_cu); }
        (void)hipGetLastError();
        grid = cus;
        if (grid != 256) { fprintf(stderr, "kernel_launch: built for 256 CUs, device has %d; nothing launched\n", cus); grid = -1; return; }
    }
    if (grid < 0) return;
    if (hipMemsetAsync((char*)d_ws + WS_CTL, 0, CTL_ZERO_BYTES, stream) != hipSuccess) return;
    Args a{};
    for (int i = 0; i < 22; ++i) a.in[i] = (const float*)d_in[i];
    a.out = (float*)d_out; a.ws = (unsigned char*)d_ws; a.ph_lo = 0; a.ph_hi = PH_TOTAL;
    hipLaunchKernelGGL(mega, dim3(grid), dim3(NTHREADS), LDS_BYTES, stream, a);
}
#endif
```
